# Optimizing an MI355X kernel written in HIP

```python
import math
import jax, jax.numpy as jnp
from jax import lax
import numpy as np

D_MODEL = 1024
BATCH = 8
SEQ = 4096
DEPTH = 1

N_HEADS = 8
HEAD_DIM = 64
D_ATTN = N_HEADS * HEAD_DIM
BLOCK = 256
TOPK = 3
Q_CHUNK = 32
NUM_BUCKETS = 32
MAX_DISTANCE = 128
D_RNN = D_MODEL
RNN_BLOCKS = 16
RNN_BLOCK_DIM = D_RNN // RNN_BLOCKS
CONV_WIDTH = 4
LRU_C = 8.0
D_FF = 4 * D_MODEL
EPS = 1e-6
IN_SPLITS = (D_ATTN, D_ATTN, D_ATTN, D_RNN, D_RNN, D_MODEL, D_MODEL)
D_IN = sum(IN_SPLITS)

kernel_name = "hybrid_moba_rglru_gated_block"


def rmsnorm(x, w):
    xf = x.astype(jnp.float32)
    y = xf * lax.rsqrt(jnp.mean(jnp.square(xf), axis=-1, keepdims=True) + EPS)
    return (y * w.astype(jnp.float32)).astype(x.dtype)


def t5_bucket(rel):
    max_exact = NUM_BUCKETS // 2
    n = jnp.maximum(rel, 0)
    nf = jnp.maximum(n, 1).astype(jnp.float32)
    large = max_exact + (jnp.log(nf / max_exact) / math.log(MAX_DISTANCE / max_exact)
                         * (NUM_BUCKETS - max_exact)).astype(jnp.int32)
    large = jnp.minimum(large, NUM_BUCKETS - 1)
    return jnp.where(n < max_exact, n, large)


def moba_attention(q, k, v, rel_bias):
    B, H, S, Dh = q.shape
    nb = -(-S // BLOCK)
    s_pad = nb * BLOCK
    pad = ((0, 0), (0, 0), (0, s_pad - S), (0, 0))
    q = jnp.pad(q, pad)
    k = jnp.pad(k, pad)
    v = jnp.pad(v, pad)
    kb = k.reshape(B, H, nb, BLOCK, Dh)
    vb = v.reshape(B, H, nb, BLOCK, Dh)
    k_mean = jnp.mean(kb.astype(jnp.float32), axis=3)
    topk = min(TOPK, nb)
    scale = HEAD_DIM ** -0.5
    bias_tab = rel_bias.T
    b_idx = jnp.arange(B)[:, None, None, None]
    h_idx = jnp.arange(H)[None, :, None, None]
    blk_ids = jnp.arange(nb)
    offs = jnp.arange(BLOCK)
    slot_ids = jnp.arange(topk)

    def chunk(c):
        start = c * Q_CHUNK
        qc = lax.dynamic_slice_in_dim(q, start, Q_CHUNK, axis=2)
        q_pos = start + jnp.arange(Q_CHUNK)
        own = start // BLOCK
        gate = jnp.einsum('bhqd,bhnd->bhqn', qc.astype(jnp.float32), k_mean)
        gate = jnp.where(blk_ids < own, gate, -jnp.inf)
        _, sel = lax.top_k(gate, topk)
        sel_valid = slot_ids < own
        k_sel = kb[b_idx, h_idx, sel]
        v_sel = vb[b_idx, h_idx, sel]
        s_sel = jnp.einsum('bhqd,bhqjkd->bhqjk', qc, k_sel).astype(jnp.float32) * scale
        k_pos_sel = sel[..., None] * BLOCK + offs
        bucket_sel = t5_bucket(q_pos[:, None, None] - k_pos_sel)
        s_sel = s_sel + bias_tab[h_idx[..., None], bucket_sel]
        s_sel = jnp.where(sel_valid[:, None], s_sel, -jnp.inf)
        s_sel = s_sel.reshape(B, H, Q_CHUNK, topk * BLOCK)
        k_own = lax.dynamic_slice_in_dim(k, own * BLOCK, BLOCK, axis=2)
        v_own = lax.dynamic_slice_in_dim(v, own * BLOCK, BLOCK, axis=2)
        s_own = jnp.einsum('bhqd,bhkd->bhqk', qc, k_own).astype(jnp.float32) * scale
        rel_own = q_pos[:, None] - (own * BLOCK + offs)[None, :]
        s_own = s_own + bias_tab[:, t5_bucket(rel_own)]
        s_own = jnp.where(rel_own >= 0, s_own, -jnp.inf)
        p = jax.nn.softmax(jnp.concatenate([s_sel, s_own], axis=-1), axis=-1)
        p_sel = p[..., :topk * BLOCK].reshape(B, H, Q_CHUNK, topk, BLOCK).astype(v.dtype)
        p_own = p[..., topk * BLOCK:].astype(v.dtype)
        return (jnp.einsum('bhqjk,bhqjkd->bhqd', p_sel, v_sel)
                + jnp.einsum('bhqk,bhkd->bhqd', p_own, v_own))

    out = lax.map(chunk, jnp.arange(s_pad // Q_CHUNK))
    out = out.transpose(1, 2, 0, 3, 4).reshape(B, H, s_pad, Dh)
    return out[:, :, :S]


def causal_depthwise_conv(x, w, b):
    S = x.shape[1]
    xp = jnp.pad(x, ((0, 0), (CONV_WIDTH - 1, 0), (0, 0)))
    y = b + xp[:, 0:S] * w[0]
    for j in range(1, CONV_WIDTH):
        y = y + xp[:, j:j + S] * w[j]
    return y


def block_diag_linear(x, w, b):
    B, S, _ = x.shape
    xb = x.reshape(B, S, RNN_BLOCKS, RNN_BLOCK_DIM)
    y = jnp.einsum('bsnd,nde->bsne', xb, w).reshape(B, S, D_RNN)
    return y + b


def rg_lru(x, w_a, b_a, w_i, b_i, lam):
    r = jax.nn.sigmoid(block_diag_linear(x, w_a, b_a).astype(jnp.float32))
    i = jax.nn.sigmoid(block_diag_linear(x, w_i, b_i).astype(jnp.float32))
    log_a = -LRU_C * r * jax.nn.softplus(-lam.astype(jnp.float32))
    a = jnp.exp(log_a)
    u = jnp.sqrt(-jnp.expm1(2.0 * log_a)) * (i * x.astype(jnp.float32))

    def combine(left, right):
        a1, b1 = left
        a2, b2 = right
        return a1 * a2, a2 * b1 + b2

    _, h = lax.associative_scan(combine, (a, u), axis=1)
    return h.astype(x.dtype)


def setup_inputs(seed: int = 0) -> dict:
    key = jax.random.key(seed)
    ks = jax.random.split(key, 20)
    L, D = DEPTH, D_MODEL
    nrm = lambda k, shape, s: jax.random.normal(k, shape, jnp.float32) * s
    u = jax.random.uniform(ks[13], (L, D_RNN), jnp.float32, minval=0.9, maxval=0.999)
    sa = u ** (1.0 / LRU_C)
    lam = jnp.log(sa) - jnp.log1p(-sa)
    return {
        "x": nrm(ks[0], (BATCH, SEQ, D), 1.0),
        "norm1_w": 1.0 + nrm(ks[1], (L, D), 0.02),
        "w_in": nrm(ks[2], (L, D, D_IN), D ** -0.5),
        "b_gate": nrm(ks[3], (L, 2, D), 0.1),
        "q_norm_w": 1.0 + nrm(ks[4], (L, HEAD_DIM), 0.02),
        "k_norm_w": 1.0 + nrm(ks[5], (L, HEAD_DIM), 0.02),
        "rel_bias": nrm(ks[6], (NUM_BUCKETS, N_HEADS), 0.2),
        "conv_w": nrm(ks[7], (L, CONV_WIDTH, D_RNN), CONV_WIDTH ** -0.5),
        "conv_b": nrm(ks[8], (L, D_RNN), 0.02),
        "w_rg_a": nrm(ks[9], (L, RNN_BLOCKS, RNN_BLOCK_DIM, RNN_BLOCK_DIM), RNN_BLOCK_DIM ** -0.5),
        "b_rg_a": nrm(ks[10], (L, D_RNN), 0.1),
        "w_rg_i": nrm(ks[11], (L, RNN_BLOCKS, RNN_BLOCK_DIM, RNN_BLOCK_DIM), RNN_BLOCK_DIM ** -0.5),
        "b_rg_i": nrm(ks[12], (L, D_RNN), 0.1),
        "lru_lambda": lam,
        "w_proj_attn": nrm(ks[14], (L, D_ATTN, D), D_ATTN ** -0.5),
        "w_proj_rnn": nrm(ks[15], (L, D_RNN, D), D_RNN ** -0.5),
        "w_out": nrm(ks[16], (L, D, D), D ** -0.5),
        "norm2_w": 1.0 + nrm(ks[17], (L, D), 0.02),
        "w_ff1": nrm(ks[18], (L, D, D_FF), D ** -0.5),
        "w_ff2": nrm(ks[19], (L, D_FF, D), D_FF ** -0.5),
    }


def reference(x, norm1_w, w_in, b_gate, q_norm_w, k_norm_w, rel_bias, conv_w, conv_b,
              w_rg_a, b_rg_a, w_rg_i, b_rg_i, lru_lambda, w_proj_attn, w_proj_rnn,
              w_out, norm2_w, w_ff1, w_ff2):
    B, S, _ = x.shape
    split_points = [int(p) for p in np.cumsum(IN_SPLITS)[:-1]]
    for l in range(DEPTH):
        h = rmsnorm(x, norm1_w[l])
        z = h @ w_in[l]
        q, k, v, xr, yr, ga, gr = jnp.split(z, split_points, axis=-1)
        to_heads = lambda t: t.reshape(B, S, N_HEADS, HEAD_DIM).transpose(0, 2, 1, 3)
        qh = rmsnorm(to_heads(q), q_norm_w[l])
        kh = rmsnorm(to_heads(k), k_norm_w[l])
        vh = to_heads(v)
        o_attn = moba_attention(qh, kh, vh, rel_bias)
        o_attn = o_attn.transpose(0, 2, 1, 3).reshape(B, S, D_ATTN)
        xr = causal_depthwise_conv(xr, conv_w[l], conv_b[l])
        hr = rg_lru(xr, w_rg_a[l], b_rg_a[l], w_rg_i[l], b_rg_i[l], lru_lambda[l])
        o_rnn = hr * jax.nn.gelu(yr)
        g_attn = jax.nn.sigmoid(ga + b_gate[l, 0])
        g_rnn = jax.nn.sigmoid(gr + b_gate[l, 1])
        merged = g_attn * (o_attn @ w_proj_attn[l]) + g_rnn * (o_rnn @ w_proj_rnn[l])
        x = x + merged @ w_out[l]
        h2 = rmsnorm(x, norm2_w[l])
        x = x + jnp.square(jax.nn.relu(h2 @ w_ff1[l])) @ w_ff2[l]
    return x
```

```cpp
#include <hip/hip_runtime.h>
#include <hip/hip_bf16.h>
#include <cstdio>
#include <cstdint>

#ifndef MIDFLAG
#define MIDFLAG true
#endif
#ifndef PHMASK
#define PHMASK 0xff
#endif
#ifndef MK_N_LAUNCHES
#define MK_N_LAUNCHES 0
#endif

constexpr int BATCH = 8, SEQ = 4096, DM = 1024, M = BATCH * SEQ;
constexpr int NH = 8, HD = 64, DA = 512, DR = 1024, DFF = 4096, DIN = 5632;
constexpr int KBLK = 256, NKB = SEQ / KBLK;
constexpr int RB = 16, RBD = 64;
constexpr int OC = DA + DR;
constexpr float EPS = 1e-6f;
constexpr float LOG2E = 1.4426950408889634f;
constexpr float C2 = 0.125f * LOG2E;

#define LAS __attribute__((address_space(3)))
#define GAS __attribute__((address_space(1)))
typedef unsigned short bf16_t;
typedef short bf16x8 __attribute__((ext_vector_type(8)));
typedef float f32x4 __attribute__((ext_vector_type(4)));
typedef float f32x2 __attribute__((ext_vector_type(2)));
typedef unsigned u32x4 __attribute__((ext_vector_type(4)));
typedef unsigned u32x2 __attribute__((ext_vector_type(2)));

constexpr size_t MiB = 1u << 20;
constexpr size_t WS_CTL = 0, CTL_ZERO_BYTES = 1 * MiB;
constexpr size_t WS_WIN = 2 * MiB;
constexpr size_t WS_WCAT = 13 * MiB;
constexpr size_t WS_WOUT = 16 * MiB;
constexpr size_t WS_WFF1 = 18 * MiB;
constexpr size_t WS_WFF2 = 26 * MiB;
constexpr size_t WS_KMP = 34 * MiB;
constexpr size_t WS_SSQ = 35 * MiB;
constexpr size_t WS_COMP = 38 * MiB;
constexpr size_t WS_CARRY = 42 * MiB;
constexpr size_t WS_XN = 48 * MiB;
constexpr size_t WS_Q = 112 * MiB;
constexpr size_t WS_K = 144 * MiB;
constexpr size_t WS_V = 176 * MiB;
constexpr size_t WS_MRG = 144 * MiB;
constexpr size_t WS_XR = 208 * MiB;
constexpr size_t WS_GY = 272 * MiB;
constexpr size_t WS_GA = 336 * MiB;
constexpr size_t WS_GR = 400 * MiB;
constexpr size_t WS_H = 208 * MiB;
constexpr size_t WS_END = 464 * MiB;

constexpr int CW_TMO = 0, CW_BAR = 4096;

__device__ __forceinline__ float bf2f(unsigned short u) { return __uint_as_float(((unsigned)u) << 16); }
__device__ __forceinline__ unsigned f2bf(float f) { unsigned u = __builtin_bit_cast(unsigned, f); return (u + 0x7fffu + ((u >> 16) & 1u)) >> 16; }
__device__ __forceinline__ unsigned pk2(float lo, float hi) { return f2bf(lo) | (f2bf(hi) << 16); }
__device__ __forceinline__ unsigned cvt_pk_bf16(float lo, float hi) { unsigned r; asm volatile("v_cvt_pk_bf16_f32 %0, %1, %2" : "=v"(r) : "v"(lo), "v"(hi)); return r; }
__device__ __forceinline__ float fast_sigmoid(float x) { return __builtin_amdgcn_rcpf(1.0f + __builtin_amdgcn_exp2f(-LOG2E * x)); }
__device__ __forceinline__ float gelu_tanh(float x) { const float u = x + 0.044715f * x * x * x; return x * __builtin_amdgcn_rcpf(1.0f + __builtin_amdgcn_exp2f(-2.302208198f * u)); }
__device__ __forceinline__ float wave_sum(float v) {
#pragma unroll
    for (int o = 1; o < 64; o <<= 1) v += __shfl_xor(v, o);
    return v;
}
__device__ __forceinline__ int t5_bucket(int n) {
    if (n < 16) return n;
    int b = 16;
    b += (n >= 19); b += (n >= 21); b += (n >= 24); b += (n >= 27); b += (n >= 31); b += (n >= 35); b += (n >= 40); b += (n >= 46);
    b += (n >= 52); b += (n >= 59); b += (n >= 67); b += (n >= 77); b += (n >= 87); b += (n >= 99); b += (n >= 113);
    return b;
}

namespace pg8 {
constexpr int BM = 256, BK = 64, HALF = 128, HTB = HALF * BK * 2, STAGE_BYTES = 8 * HTB, NXCD = 8, WGM = 8;
__host__ __device__ __forceinline__ int lds_byte(int r, int c) { const int st = (r >> 4) * 2 + (c >> 5), rr = r & 15, cc = c & 31, ob = rr * 64 + cc * 2; return st * 1024 + (ob ^ (((ob >> 9) & 1) << 5)); }
__host__ __device__ __forceinline__ void stage_rc(int b, int& R, int& C) { const int st = b / 1024, sb = b % 1024, swz = sb ^ (((sb >> 9) & 1) << 5); R = (st >> 1) * 16 + swz / 64; C = (st & 1) * 32 + (swz % 64) / 2; }
__host__ __device__ __forceinline__ int perm32(int rho) { const int n = rho >> 4, i = rho & 15; return 8 * (i >> 2) + 4 * n + (i & 3); }

struct Unit { int pm, pn; };
struct Gemm { const bf16_t* A; const bf16_t* Bt; int lda, ldb, K, N, mid_t; };

struct StaticOrder {
    int nM, nN, nwg, G, c;
    __host__ __device__ void init(int M_, int N_, int G_, int c_) { nM = M_ / BM; nN = N_ / BM; nwg = nM * nN; G = G_; c = c_; }
    __host__ __device__ bool next(int i, Unit& u) const {
        const long L = (long)i * G + c; if (L >= nwg) return false;
        int wgid = (int)L; { const int q = nwg / NXCD, r = nwg % NXCD, xcd = wgid % NXCD, off = wgid / NXCD; wgid = (xcd < r ? xcd * (q + 1) : r * (q + 1) + (xcd - r) * q) + off; }
        const int nig = WGM * nN, gid = wgid / nig, fm = gid * WGM, gsz = (nM - fm) < WGM ? (nM - fm) : WGM;
        u.pm = fm + ((wgid % nig) % gsz); u.pn = (wgid % nig) / gsz; return true;
    }
};

typedef f32x4 Acc[2][2][4][2];

template <class Epi, class Sched, bool MID>
__device__ __forceinline__ void gemm_phase(LAS unsigned char* lds, const Gemm g, const Sched& S, const Epi& E) {
    const int tid = threadIdx.x, wid = __builtin_amdgcn_readfirstlane(tid >> 6), lane = tid & 63, wr = wid >> 2, wc = wid & 3, fr = lane & 15, fq = lane >> 4;
    const int nt = g.K / BK;
    unsigned voffA[2], voffB[2];
#pragma unroll
    for (int i = 0; i < 2; ++i) { int R, C; stage_rc(tid * 16 + i * 8192, R, C); const int Rb = Epi::PERM ? ((R & ~31) + perm32(R & 31)) : R;
        voffA[i] = (unsigned)(R * g.lda + C) * 2u; voffB[i] = (unsigned)(Rb * g.ldb + C) * 2u; }
    const size_t kstep = (size_t)(BK * 2);
    const size_t hstepA = (size_t)HALF * g.lda * 2, hstepB = (size_t)HALF * g.ldb * 2;
    const size_t tstepA = 2 * hstepA, tstepB = 2 * hstepB;
    const unsigned ldsw = (unsigned)wid * 1024u;
    const int aoff = lds_byte(wr * 64 + fr, fq * 8), boff = lds_byte(wc * 32 + fr, fq * 8);
#define PG8_SA(b, h) (((b) * 2 + (h)) * HTB)
#define PG8_SB(b, h) ((4 + (b) * 2 + (h)) * HTB)
#define PG8_STAGE(bufoff, gbase, voff) do { _Pragma("unroll") for (int _i = 0; _i < 2; ++_i) \
        __builtin_amdgcn_global_load_lds((const unsigned*)((const char*)(gbase) + (voff)[_i]), (LAS unsigned*)(lds + (bufoff) + ldsw + _i * 8192), 16, 0, 0); } while (0)
#define PG8_LDA(dst, b, h) do { _Pragma("unroll") for (int m = 0; m < 4; ++m) _Pragma("unroll") for (int k = 0; k < 2; ++k) dst[m][k] = *(const LAS bf16x8*)(lds + PG8_SA(b, h) + aoff + m * 2048 + k * 1024); } while (0)
#define PG8_LDB(dst, b, h) do { _Pragma("unroll") for (int n = 0; n < 2; ++n) _Pragma("unroll") for (int k = 0; k < 2; ++k) dst[n][k] = *(const LAS bf16x8*)(lds + PG8_SB(b, h) + boff + n * 2048 + k * 1024); } while (0)
#define PG8_MMA(ai, bj, At, Bt) do { __builtin_amdgcn_s_setprio(1); _Pragma("unroll") for (int m = 0; m < 4; ++m) _Pragma("unroll") for (int n = 0; n < 2; ++n) _Pragma("unroll") for (int k = 0; k < 2; ++k) \
        acc[ai][bj][m][n] = __builtin_amdgcn_mfma_f32_16x16x32_bf16(Bt[n][k], At[m][k], acc[ai][bj][m][n], 0, 0, 0); __builtin_amdgcn_s_setprio(0); } while (0)
#define PG8_WAIT_V(n) asm volatile("s_waitcnt vmcnt(" #n ")" ::: "memory")
#define PG8_WAIT_L(n) asm volatile("s_waitcnt lgkmcnt(" #n ")" ::: "memory")
#define PG8_BAR __builtin_amdgcn_s_barrier()
#define PG8_SCHED __builtin_amdgcn_sched_barrier(0)
    Unit cur, nxt; int ui = 0;
    if (!S.next(0, cur)) return;
    f32x4 acc[2][2][4][2];
#pragma unroll
    for (int a = 0; a < 2; ++a)
#pragma unroll
        for (int b = 0; b < 2; ++b)
#pragma unroll
            for (int m = 0; m < 4; ++m)
#pragma unroll
                for (int n = 0; n < 2; ++n) acc[a][b][m][n] = (f32x4){0.f, 0.f, 0.f, 0.f};
    bf16x8 At[4][2], B0[2][2], B1[2][2];
    const char* cA = (const char*)g.A + (size_t)cur.pm * tstepA; const char* cB = (const char*)g.Bt + (size_t)cur.pn * tstepB;
    PG8_STAGE(PG8_SB(0, 0), cB, voffB); PG8_STAGE(PG8_SB(0, 1), cB + hstepB, voffB); PG8_STAGE(PG8_SA(0, 0), cA, voffA); PG8_STAGE(PG8_SA(0, 1), cA + hstepA, voffA);
    if (wr == 1) PG8_BAR;
    PG8_WAIT_V(2); PG8_BAR;
    PG8_STAGE(PG8_SB(1, 0), cB + kstep, voffB); PG8_STAGE(PG8_SA(1, 0), cA + kstep, voffA); PG8_STAGE(PG8_SB(1, 1), cB + hstepB + kstep, voffB);
    PG8_WAIT_V(6); PG8_BAR;
    for (;;) {
        const bool has_next = S.next(ui + 1, nxt);
        const char* nA = has_next ? (const char*)g.A + (size_t)nxt.pm * tstepA : cA; const char* nB = has_next ? (const char*)g.Bt + (size_t)nxt.pn * tstepB : cB;
        for (int t = 0; t < nt; t += 2) {
            if constexpr (MID) { if (t == g.mid_t) E.mid(acc, cur, wr, wc, fr, fq); }
            const bool last = (t == nt - 2);
            const char* a1 = cA + (size_t)(t + 1) * kstep;
            const char* a2 = last ? nA : cA + (size_t)(t + 2) * kstep; const char* b2 = last ? nB : cB + (size_t)(t + 2) * kstep;
            const char* a3 = a2 + kstep; const char* b3 = b2 + kstep;
            PG8_LDB(B0, 0, 0); PG8_LDB(B1, 0, 1); PG8_SCHED; PG8_LDA(At, 0, 0); PG8_STAGE(PG8_SA(1, 1), a1 + hstepA, voffA);
            PG8_WAIT_V(8); PG8_WAIT_L(0); PG8_BAR; PG8_MMA(0, 0, At, B0); PG8_MMA(0, 1, At, B1); PG8_BAR; PG8_SCHED;
            PG8_LDA(At, 0, 1); PG8_STAGE(PG8_SB(0, 0), b2, voffB); PG8_STAGE(PG8_SB(0, 1), b2 + hstepB, voffB); PG8_STAGE(PG8_SA(0, 0), a2, voffA);
            PG8_WAIT_V(8); PG8_WAIT_L(0); PG8_BAR; PG8_MMA(1, 0, At, B0); PG8_MMA(1, 1, At, B1); PG8_BAR; PG8_SCHED;
            PG8_LDB(B0, 1, 0); PG8_LDB(B1, 1, 1); PG8_SCHED; PG8_LDA(At, 1, 0); PG8_STAGE(PG8_SA(0, 1), a2 + hstepA, voffA);
            PG8_WAIT_V(8); PG8_WAIT_L(0); PG8_BAR; PG8_MMA(0, 0, At, B0); PG8_MMA(0, 1, At, B1); PG8_BAR; PG8_SCHED;
            PG8_LDA(At, 1, 1); PG8_STAGE(PG8_SB(1, 0), b3, voffB); PG8_STAGE(PG8_SB(1, 1), b3 + hstepB, voffB); PG8_STAGE(PG8_SA(1, 0), a3, voffA);
            PG8_WAIT_V(8); PG8_WAIT_L(0); PG8_BAR; PG8_MMA(1, 0, At, B0); PG8_MMA(1, 1, At, B1); PG8_BAR; PG8_SCHED;
        }
        if (wr == 0) PG8_BAR;
        E(acc, cur, wr, wc, fr, fq);
        if (!has_next) break;
#pragma unroll
        for (int a = 0; a < 2; ++a)
#pragma unroll
            for (int b = 0; b < 2; ++b)
#pragma unroll
                for (int m = 0; m < 4; ++m)
#pragma unroll
                    for (int n = 0; n < 2; ++n) acc[a][b][m][n] = (f32x4){0.f, 0.f, 0.f, 0.f};
        cur = nxt; cA = nA; cB = nB; ++ui;
        if (wr == 1) PG8_BAR;
    }
    PG8_WAIT_V(0);
    PG8_BAR;
#undef PG8_SA
#undef PG8_SB
#undef PG8_STAGE
#undef PG8_LDA
#undef PG8_LDB
#undef PG8_MMA
#undef PG8_WAIT_V
#undef PG8_WAIT_L
#undef PG8_BAR
#undef PG8_SCHED
}

struct EpiZ {
    static constexpr bool PERM = true;
    bf16_t *Q, *K, *V, *XR, *GY, *GA, *GR; float* kmp; const float *qw, *kw, *bg;
    __device__ __forceinline__ void mid(Acc&, const Unit&, int, int, int, int) const {}
    __device__ __forceinline__ void operator()(Acc& acc, const Unit& u, int wr, int wc, int fr, int fq) const {
        const int pn = u.pn; const int row0 = u.pm * BM + wr * 64 + fr;
        if (pn < 4) {
            const bool isq = pn < 2; const int head = (pn & 1) * 4 + wc; const float* nw = isq ? qw : kw; const float osc = isq ? C2 : 1.0f;
            bf16_t* base = (isq ? Q : K) + head * HD + 8 * fq;
            f32x4 wv[2][2];
#pragma unroll
            for (int bj = 0; bj < 2; ++bj)
#pragma unroll
                for (int n = 0; n < 2; ++n) wv[bj][n] = *(const f32x4*)(nw + 32 * bj + 8 * fq + 4 * n) * osc;
            f32x4 cs[2][2];
#pragma unroll
            for (int bj = 0; bj < 2; ++bj)
#pragma unroll
                for (int n = 0; n < 2; ++n) cs[bj][n] = (f32x4){0.f, 0.f, 0.f, 0.f};
#pragma unroll
            for (int ai = 0; ai < 2; ++ai)
#pragma unroll
                for (int m = 0; m < 4; ++m) {
                    float ss = 0.f;
#pragma unroll
                    for (int bj = 0; bj < 2; ++bj)
#pragma unroll
                        for (int n = 0; n < 2; ++n) { const f32x4 v = acc[ai][bj][m][n]; ss += (v[0] * v[0] + v[1] * v[1]) + (v[2] * v[2] + v[3] * v[3]); }
                    ss += __shfl_xor(ss, 16); ss += __shfl_xor(ss, 32);
                    const float rstd = 1.0f / sqrtf(ss * (1.0f / 64.0f) + EPS);
                    bf16_t* rowp = base + (size_t)(row0 + ai * HALF + m * 16) * DA;
#pragma unroll
                    for (int bj = 0; bj < 2; ++bj) {
                        const f32x4 v0 = acc[ai][bj][m][0] * rstd * wv[bj][0], v1 = acc[ai][bj][m][1] * rstd * wv[bj][1];
                        cs[bj][0] += v0; cs[bj][1] += v1;
                        u32x4 w; w.x = cvt_pk_bf16(v0[0], v0[1]); w.y = cvt_pk_bf16(v0[2], v0[3]); w.z = cvt_pk_bf16(v1[0], v1[1]); w.w = cvt_pk_bf16(v1[2], v1[3]);
                        *(u32x4*)(rowp + 32 * bj) = w; }
                }
            if (!isq) {
#pragma unroll
                for (int bj = 0; bj < 2; ++bj)
#pragma unroll
                    for (int n = 0; n < 2; ++n)
#pragma unroll
                        for (int i = 0; i < 4; ++i) { float s = cs[bj][n][i]; s += __shfl_xor(s, 1); s += __shfl_xor(s, 2); s += __shfl_xor(s, 4); s += __shfl_xor(s, 8); cs[bj][n][i] = s; }
                if (fr == 0) { float* kp = kmp + (size_t)(u.pm * 2 + wr) * DA + head * HD + 8 * fq;
#pragma unroll
                    for (int bj = 0; bj < 2; ++bj) { *(f32x4*)(kp + 32 * bj) = cs[bj][0]; *(f32x4*)(kp + 32 * bj + 4) = cs[bj][1]; } }
            }
            return;
        }
        int mode, ldc, colt; bf16_t* base; const float* bias = nullptr;
        if (pn < 6) { base = V; ldc = DA; colt = (pn - 4) * BM; mode = 0; }
        else if (pn < 10) { base = XR; ldc = DR; colt = (pn - 6) * BM; mode = 0; }
        else if (pn < 14) { base = GY; ldc = DR; colt = (pn - 10) * BM; mode = 1; }
        else if (pn < 18) { base = GA; ldc = DM; colt = (pn - 14) * BM; mode = 2; bias = bg; }
        else { base = GR; ldc = DM; colt = (pn - 18) * BM; mode = 2; bias = bg + DM; }
        const int col0 = colt + wc * 32 + 8 * fq;
        f32x4 bv[2][2];
#pragma unroll
        for (int bj = 0; bj < 2; ++bj)
#pragma unroll
            for (int n = 0; n < 2; ++n) bv[bj][n] = bias ? *(const f32x4*)(bias + col0 + bj * HALF + 4 * n) : (f32x4){0.f, 0.f, 0.f, 0.f};
#pragma unroll
        for (int ai = 0; ai < 2; ++ai)
#pragma unroll
            for (int m = 0; m < 4; ++m) { bf16_t* rowp = base + (size_t)(row0 + ai * HALF + m * 16) * ldc + col0;
#pragma unroll
                for (int bj = 0; bj < 2; ++bj) { f32x4 v0 = acc[ai][bj][m][0] + bv[bj][0], v1 = acc[ai][bj][m][1] + bv[bj][1];
                    if (mode == 1) {
#pragma unroll
                        for (int i = 0; i < 4; ++i) { v0[i] = gelu_tanh(v0[i]); v1[i] = gelu_tanh(v1[i]); } }
                    else if (mode == 2) {
#pragma unroll
                        for (int i = 0; i < 4; ++i) { v0[i] = fast_sigmoid(v0[i]); v1[i] = fast_sigmoid(v1[i]); } }
                    u32x4 w; w.x = cvt_pk_bf16(v0[0], v0[1]); w.y = cvt_pk_bf16(v0[2], v0[3]); w.z = cvt_pk_bf16(v1[0], v1[1]); w.w = cvt_pk_bf16(v1[2], v1[3]);
                    *(u32x4*)(rowp + bj * HALF) = w; } }
    }
};

struct EpiMerge {
    static constexpr bool PERM = true;
    const bf16_t *GA, *GR; bf16_t* O;
    __device__ __forceinline__ void mid(Acc& acc, const Unit& u, int wr, int wc, int fr, int fq) const {
        int row0 = u.pm * BM + wr * 64 + fr, col0 = u.pn * BM + wc * 32 + 8 * fq;
        asm volatile("" : "+v"(row0), "+v"(col0));
#pragma unroll
        for (int ai = 0; ai < 2; ++ai)
#pragma unroll
            for (int m = 0; m < 4; ++m) { const size_t off = (size_t)(row0 + ai * HALF + m * 16) * DM + col0;
#pragma unroll
                for (int bj = 0; bj < 2; ++bj) { const u32x4 a = *(const u32x4*)(GA + off + bj * HALF), r = *(const u32x4*)(GR + off + bj * HALF);
#pragma unroll
                    for (int j = 0; j < 4; ++j) { const unsigned aw = a[j], rw = r[j];
                        const float f0 = __uint_as_float(aw << 16) * __builtin_amdgcn_rcpf(__uint_as_float(rw << 16));
                        const float f1 = __uint_as_float(aw & 0xffff0000u) * __builtin_amdgcn_rcpf(__uint_as_float(rw & 0xffff0000u));
                        acc[ai][bj][m][j >> 1][(j & 1) * 2] *= f0; acc[ai][bj][m][j >> 1][(j & 1) * 2 + 1] *= f1; } }
                asm volatile("" ::: "memory"); }
    }
    __device__ __forceinline__ void operator()(Acc& acc, const Unit& u, int wr, int wc, int fr, int fq) const {
        const int row0 = u.pm * BM + wr * 64 + fr, col0 = u.pn * BM + wc * 32 + 8 * fq;
#pragma unroll
        for (int ai = 0; ai < 2; ++ai)
#pragma unroll
            for (int m = 0; m < 4; ++m) { const size_t off = (size_t)(row0 + ai * HALF + m * 16) * DM + col0;
#pragma unroll
                for (int bj = 0; bj < 2; ++bj) { const u32x4 r = *(const u32x4*)(GR + off + bj * HALF); u32x4 w;
#pragma unroll
                    for (int j = 0; j < 4; ++j) { const unsigned rw = r[j];
                        const float v0 = acc[ai][bj][m][j >> 1][(j & 1) * 2] * __uint_as_float(rw << 16), v1 = acc[ai][bj][m][j >> 1][(j & 1) * 2 + 1] * __uint_as_float(rw & 0xffff0000u);
                        w[j] = cvt_pk_bf16(v0, v1); }
                    *(u32x4*)(O + off + bj * HALF) = w; }
                if (m & 1) asm volatile("" ::: "memory"); }
    }
};

struct EpiX1 {
    static constexpr bool PERM = false;
    const float* X; float* X1; bf16_t* XN2; float* ssq;
    __device__ __forceinline__ void mid(Acc&, const Unit&, int, int, int, int) const {}
    __device__ __forceinline__ void operator()(Acc& acc, const Unit& u, int wr, int wc, int fr, int fq) const {
        const int row0 = u.pm * BM + wr * 64 + fr, col0 = u.pn * BM + wc * 32 + 4 * fq;
#pragma unroll
        for (int ai = 0; ai < 2; ++ai)
#pragma unroll
            for (int m = 0; m < 4; ++m) { const int row = row0 + ai * HALF + m * 16; const size_t off = (size_t)row * DM + col0; float ss = 0.f;
#pragma unroll
                for (int bj = 0; bj < 2; ++bj)
#pragma unroll
                    for (int n = 0; n < 2; ++n) { const f32x4 xv = *(const f32x4*)(X + off + bj * HALF + n * 16); const f32x4 v = acc[ai][bj][m][n] + xv;
                        *(f32x4*)(X1 + off + bj * HALF + n * 16) = v;
                        u32x2 w; w.x = cvt_pk_bf16(v[0], v[1]); w.y = cvt_pk_bf16(v[2], v[3]); *(u32x2*)(XN2 + off + bj * HALF + n * 16) = w;
                        ss += (v[0] * v[0] + v[1] * v[1]) + (v[2] * v[2] + v[3] * v[3]); }
                ss += __shfl_xor(ss, 16); ss += __shfl_xor(ss, 32);
                if (fq == 0) ssq[(size_t)row * 16 + u.pn * 4 + wc] = ss;
                if (m & 1) asm volatile("" ::: "memory"); }
    }
};

struct EpiH {
    static constexpr bool PERM = true;
    const float* ssq; bf16_t* H;
    __device__ __forceinline__ void mid(Acc&, const Unit&, int, int, int, int) const {}
    __device__ __forceinline__ void operator()(Acc& acc, const Unit& u, int wr, int wc, int fr, int fq) const {
        const int row0 = u.pm * BM + wr * 64 + fr, col0 = u.pn * BM + wc * 32 + 8 * fq;
#pragma unroll
        for (int ai = 0; ai < 2; ++ai)
#pragma unroll
            for (int m = 0; m < 4; ++m) { const int row = row0 + ai * HALF + m * 16;
                const f32x4 s0 = *(const f32x4*)(ssq + (size_t)row * 16), s1 = *(const f32x4*)(ssq + (size_t)row * 16 + 4), s2 = *(const f32x4*)(ssq + (size_t)row * 16 + 8), s3 = *(const f32x4*)(ssq + (size_t)row * 16 + 12);
                const float tot = (((s0[0] + s0[1]) + (s0[2] + s0[3])) + ((s1[0] + s1[1]) + (s1[2] + s1[3]))) + (((s2[0] + s2[1]) + (s2[2] + s2[3])) + ((s3[0] + s3[1]) + (s3[2] + s3[3])));
                const float rstd = 1.0f / sqrtf(tot * (1.0f / DM) + EPS);
                bf16_t* rowp = H + (size_t)row * DFF + col0;
#pragma unroll
                for (int bj = 0; bj < 2; ++bj) { f32x4 v0 = acc[ai][bj][m][0] * rstd, v1 = acc[ai][bj][m][1] * rstd;
#pragma unroll
                    for (int i = 0; i < 4; ++i) { const float a = fmaxf(v0[i], 0.f), b = fmaxf(v1[i], 0.f); v0[i] = a * a; v1[i] = b * b; }
                    u32x4 w; w.x = cvt_pk_bf16(v0[0], v0[1]); w.y = cvt_pk_bf16(v0[2], v0[3]); w.z = cvt_pk_bf16(v1[0], v1[1]); w.w = cvt_pk_bf16(v1[2], v1[3]);
                    *(u32x4*)(rowp + bj * HALF) = w; }
                if (m & 1) asm volatile("" ::: "memory"); }
    }
};

struct EpiOut {
    static constexpr bool PERM = false;
    float* X1;
    __device__ __forceinline__ void mid(Acc&, const Unit&, int, int, int, int) const {}
    __device__ __forceinline__ void operator()(Acc& acc, const Unit& u, int wr, int wc, int fr, int fq) const {
        const int row0 = u.pm * BM + wr * 64 + fr, col0 = u.pn * BM + wc * 32 + 4 * fq;
#pragma unroll
        for (int ai = 0; ai < 2; ++ai)
#pragma unroll
            for (int m = 0; m < 4; ++m) { const size_t off = (size_t)(row0 + ai * HALF + m * 16) * DM + col0;
#pragma unroll
                for (int bj = 0; bj < 2; ++bj)
#pragma unroll
                    for (int n = 0; n < 2; ++n) { const f32x4 xv = *(const f32x4*)(X1 + off + bj * HALF + n * 16); *(f32x4*)(X1 + off + bj * HALF + n * 16) = acc[ai][bj][m][n] + xv; }
                if (m & 1) asm volatile("" ::: "memory"); }
    }
};
}

#define XB_TMO      128
#define XB_XCNT(j)  (256  + 64 * (j))
#define XB_XSUB(j)  (1280 + 64 * (j))
#define XB_XGEN(j)  (2304 + 64 * (j))
#define XB_TOP      3328
#define XB_TOPGEN   3392
#define XCD_BAR_WORDS 3456
#define XB_SPIN_CAP (1u << 18)
__device__ __forceinline__ unsigned xb_ld(unsigned* p)              { return __hip_atomic_load(p, __ATOMIC_RELAXED, __HIP_MEMORY_SCOPE_AGENT); }
__device__ __forceinline__ unsigned xb_add(unsigned* p, unsigned v) { return __hip_atomic_fetch_add(p, v, __ATOMIC_RELAXED, __HIP_MEMORY_SCOPE_AGENT); }
__device__ __forceinline__ unsigned xb_xcc_id() { return (unsigned)__builtin_amdgcn_s_getreg((3 << 11) | 20) & 0xFu; }
#define XB_SPIN(cond, bar) do { unsigned _sp = 0; while (cond) { __builtin_amdgcn_s_sleep(1); \
    if ((++_sp & 255u) == 0u) { if (xb_ld(&(bar)[XB_TMO])) break; if (_sp > XB_SPIN_CAP) { atomicAdd(&(bar)[XB_TMO], 1u); break; } } } } while (0)
struct XcdBarrier { unsigned* bar; unsigned x; volatile LAS unsigned* st; };
__device__ __forceinline__ XcdBarrier xcd_barrier_post(unsigned* bar, volatile LAS unsigned* st) {
    XcdBarrier b; b.bar = bar; b.x = xb_xcc_id(); b.st = st;
    if (threadIdx.x == 0) (void)xb_add(&bar[XB_XCNT(b.x)], 1u);
    return b;
}
__device__ __forceinline__ void xcd_barrier_complete(unsigned* bar, unsigned x, unsigned& nloc, unsigned& nx) {
    const unsigned G = gridDim.x * gridDim.y * gridDim.z;
    unsigned sum, cnt, mine, sp = 0u;
    for (;;) {
        sum = 0u; cnt = 0u; mine = 0u;
#pragma unroll
        for (unsigned j = 0; j < 16; ++j) { const unsigned c = xb_ld(&bar[XB_XCNT(j)]); sum += c; cnt += (c > 0u) ? 1u : 0u; mine = (j == x) ? c : mine; }
        if (sum == G) break;
        __builtin_amdgcn_s_sleep(1);
        if ((++sp & 255u) == 0u) { if (xb_ld(&bar[XB_TMO])) break; if (sp > XB_SPIN_CAP) { atomicAdd(&bar[XB_TMO], 1u); break; } }
    }
    nloc = mine > 0u ? mine : 1u; nx = cnt > 0u ? cnt : 1u;
}
__device__ __forceinline__ void xcd_barrier(const XcdBarrier& b) {
    asm volatile("s_waitcnt vmcnt(0)" ::: "memory");
    __syncthreads();
    if (threadIdx.x == 0) {
        unsigned* bar = b.bar;
        __builtin_amdgcn_s_waitcnt(0);
        unsigned nloc = b.st[0], nx = b.st[1];
        if (nloc == 0u) { xcd_barrier_complete(bar, b.x, nloc, nx); b.st[0] = nloc; b.st[1] = nx; }
        const unsigned old = xb_add(&bar[XB_XSUB(b.x)], 1u);
        const unsigned gen = old / nloc;
        if (old + 1u == (gen + 1u) * nloc) {
            __builtin_amdgcn_fence(__ATOMIC_RELEASE, "agent");
            asm volatile("s_waitcnt vmcnt(0)" ::: "memory");
            const unsigned og = xb_add(&bar[XB_TOP], 1u);
            const unsigned tg = og / nx;
            if (og + 1u == (tg + 1u) * nx) xb_add(&bar[XB_TOPGEN], 1u);
            else XB_SPIN(xb_ld(&bar[XB_TOPGEN]) == tg, bar);
            __builtin_amdgcn_fence(__ATOMIC_ACQUIRE, "agent");
            xb_add(&bar[XB_XGEN(b.x)], 1u);
            asm volatile("s_waitcnt vmcnt(0)" ::: "memory");
        } else {
            XB_SPIN(xb_ld(&bar[XB_XGEN(b.x)]) == gen, bar);
            __builtin_amdgcn_fence(__ATOMIC_ACQUIRE, "agent");
            asm volatile("s_waitcnt vmcnt(0)" ::: "memory");
        }
    }
    __syncthreads();
}

constexpr int RING_OFF = 0, RING_BYTES = 131072;
constexpr int LDSCTL_OFF = RING_BYTES, MISC_OFF = LDSCTL_OFF + 320;
constexpr int LDS_BYTES = 147456;
constexpr int NWAVES = 8;

struct Args { const float* in[20]; float* out; unsigned char* ws; int ph_lo, ph_hi; };

template <int RMAP>
__device__ __forceinline__ int p0_rowmap(int n) {
    if (RMAP == 1) { if (n < 1024) { const int pn = n >> 8, lc = n & 255, hh = lc >> 6, d = lc & 63; return pn * 256 + 128 * (d >> 5) + 32 * hh + (d & 31); } return n; }
    return n;
}
template <int RMAP>
__device__ __forceinline__ void p0_transpose_item(const float* W, int N, bf16_t* WT, int ldt, int koff, const float* kscale, LAS float* scr, int item, int lane) {
    const int nblk = N / 32, kb = item / nblk, nb = item % nblk, k0 = 64 * kb, n0 = 32 * nb;
#pragma unroll 8
    for (int i = 0; i < 32; ++i) { const int kk = 2 * i + (lane >> 5); float v = W[(size_t)(k0 + kk) * N + n0 + (lane & 31)]; if (kscale) v *= kscale[k0 + kk]; scr[kk * 33 + (lane & 31)] = v; }
    asm volatile("s_waitcnt lgkmcnt(0)" ::: "memory");
    const int c = lane & 7;
#pragma unroll
    for (int j = 0; j < 4; ++j) { const int n = (lane >> 3) + 8 * j; const LAS float* s = scr + (8 * c) * 33 + n;
        u32x4 o; o.x = pk2(s[0 * 33], s[1 * 33]); o.y = pk2(s[2 * 33], s[3 * 33]); o.z = pk2(s[4 * 33], s[5 * 33]); o.w = pk2(s[6 * 33], s[7 * 33]);
        *(u32x4*)(WT + (size_t)p0_rowmap<RMAP>(n0 + n) * ldt + koff + k0 + 8 * c) = o; }
    asm volatile("s_waitcnt lgkmcnt(0)" ::: "memory");
}
__device__ __forceinline__ void rms_row_to_bf16(const float* xrow, const float* w, bf16_t* orow, int lane) {
    const f32x4* xr = (const f32x4*)xrow + lane; const f32x4* wr = (const f32x4*)w + lane;
    f32x4 v[4]; float s = 0.f;
#pragma unroll
    for (int j = 0; j < 4; ++j) { v[j] = xr[64 * j]; s += (v[j].x * v[j].x + v[j].y * v[j].y) + (v[j].z * v[j].z + v[j].w * v[j].w); }
    const float rstd = 1.f / sqrtf(wave_sum(s) * (1.f / DM) + EPS);
    unsigned long long* o8 = (unsigned long long*)orow + lane;
#pragma unroll
    for (int j = 0; j < 4; ++j) { const f32x4 ww = wr[64 * j];
        o8[64 * j] = (unsigned long long)pk2(v[j].x * rstd * ww.x, v[j].y * rstd * ww.y) | ((unsigned long long)pk2(v[j].z * rstd * ww.z, v[j].w * rstd * ww.w) << 32); }
}

__global__ void __launch_bounds__(NWAVES * 64, 2) mk_fwd(Args args) {
    extern __shared__ __attribute__((aligned(16))) unsigned char lds_raw[];
    LAS unsigned char* lds = (LAS unsigned char*)lds_raw;
    const int tid = threadIdx.x, lane = tid & 63, wave = __builtin_amdgcn_readfirstlane(tid >> 6);
    const int G = gridDim.x; const int bx = blockIdx.x; const int vcu = (G % 8 == 0) ? (bx % 8) * (G / 8) + bx / 8 : bx;
    unsigned char* ws = args.ws;
    unsigned* ctl = (unsigned*)(ws + WS_CTL);
    for (int u = tid; u < (LDS_BYTES - LDSCTL_OFF) / 4; u += NWAVES * 64) ((LAS unsigned*)(lds + LDSCTL_OFF))[u] = 0u;
    __syncthreads();
    volatile LAS unsigned* MISC = (volatile LAS unsigned*)(lds + MISC_OFF);
    const int lo = args.ph_lo, hi = args.ph_hi;
    XcdBarrier bar; bar.bar = ctl + CW_BAR; bar.x = 0; bar.st = nullptr;
    const bool multi = (hi - lo) > 1;
    if (multi) bar = xcd_barrier_post(ctl + CW_BAR, MISC + 8);
#define IN(k) (lo <= (k) && (k) < hi)
#define BOTH(k) (IN(k) && IN((k) + 1))
#define GRID_BAR() xcd_barrier(bar)

    const float* x = args.in[0];
    bf16_t* Wt_in = (bf16_t*)(ws + WS_WIN); bf16_t* Wt_cat = (bf16_t*)(ws + WS_WCAT); bf16_t* Wt_out = (bf16_t*)(ws + WS_WOUT);
    bf16_t* Wt_ff1 = (bf16_t*)(ws + WS_WFF1); bf16_t* Wt_ff2 = (bf16_t*)(ws + WS_WFF2);
    bf16_t* XN = (bf16_t*)(ws + WS_XN); bf16_t* Qb = (bf16_t*)(ws + WS_Q); bf16_t* Kb = (bf16_t*)(ws + WS_K); bf16_t* Vb = (bf16_t*)(ws + WS_V);
    bf16_t* XR = (bf16_t*)(ws + WS_XR); bf16_t* GY = (bf16_t*)(ws + WS_GY); bf16_t* GA = (bf16_t*)(ws + WS_GA); bf16_t* GR = (bf16_t*)(ws + WS_GR);
    bf16_t* MRG = (bf16_t*)(ws + WS_MRG); bf16_t* HB = (bf16_t*)(ws + WS_H);
    float* kmp = (float*)(ws + WS_KMP); float* ssq = (float*)(ws + WS_SSQ);
    bf16_t* OCAT = (bf16_t*)args.out;

    if ((PHMASK >> 0 & 1) && IN(0)) {
        LAS float* scr = (LAS float*)(lds + RING_OFF + wave * 16384);
        const int gw = vcu * NWAVES + wave, NGW = G * NWAVES;
        constexpr int I_IN = (DM / 64) * (DIN / 32), I_PA = (DA / 64) * (DM / 32), I_PR = (DR / 64) * (DM / 32), I_OUT = (DM / 64) * (DM / 32), I_F1 = (DM / 64) * (DFF / 32), I_F2 = (DFF / 64) * (DM / 32);
        constexpr int NITEMS = I_IN + I_PA + I_PR + I_OUT + I_F1 + I_F2;
        for (int it = gw; it < NITEMS; it += NGW) {
            int r = it;
            if (r < I_IN) { p0_transpose_item<1>(args.in[2], DIN, Wt_in, DM, 0, nullptr, scr, r, lane); continue; } r -= I_IN;
            if (r < I_PA) { p0_transpose_item<0>(args.in[14], DM, Wt_cat, OC, 0, nullptr, scr, r, lane); continue; } r -= I_PA;
            if (r < I_PR) { p0_transpose_item<0>(args.in[15], DM, Wt_cat, OC, DA, nullptr, scr, r, lane); continue; } r -= I_PR;
            if (r < I_OUT) { p0_transpose_item<0>(args.in[16], DM, Wt_out, DM, 0, nullptr, scr, r, lane); continue; } r -= I_OUT;
            if (r < I_F1) { p0_transpose_item<0>(args.in[18], DFF, Wt_ff1, DM, 0, args.in[17], scr, r, lane); continue; } r -= I_F1;
            p0_transpose_item<0>(args.in[19], DM, Wt_ff2, DFF, 0, nullptr, scr, r, lane);
        }
        for (int m = gw; m < M; m += NGW) rms_row_to_bf16(x + (size_t)m * DM, args.in[1], XN + (size_t)m * DM, lane);
        if (BOTH(0)) GRID_BAR();
    }
    if ((PHMASK >> 1 & 1) && IN(1)) {
        pg8::Gemm g{XN, Wt_in, DM, DM, DM, DIN, -1}; pg8::StaticOrder S; S.init(M, DIN, G, bx);
        pg8::EpiZ E{Qb, Kb, Vb, XR, GY, GA, GR, kmp, args.in[4], args.in[5], args.in[3]};
        pg8::gemm_phase<pg8::EpiZ, pg8::StaticOrder, false>(lds + RING_OFF, g, S, E);
        if (BOTH(1)) GRID_BAR();
    }
    if ((PHMASK >> 3 & 1) && IN(3)) {
        pg8::Gemm g{OCAT, Wt_cat, OC, OC, OC, DM, DA / 64}; pg8::StaticOrder S; S.init(M, DM, G, bx);
        pg8::EpiMerge E{GA, GR, MRG};
        pg8::gemm_phase<pg8::EpiMerge, pg8::StaticOrder, MIDFLAG>(lds + RING_OFF, g, S, E);
        if (BOTH(3)) GRID_BAR();
    }
    if ((PHMASK >> 4 & 1) && IN(4)) {
        pg8::Gemm g{MRG, Wt_out, DM, DM, DM, DM, -1}; pg8::StaticOrder S; S.init(M, DM, G, bx);
        pg8::EpiX1 E{x, args.out, XN, ssq};
        pg8::gemm_phase<pg8::EpiX1, pg8::StaticOrder, false>(lds + RING_OFF, g, S, E);
        if (BOTH(4)) GRID_BAR();
    }
    if ((PHMASK >> 5 & 1) && IN(5)) {
        pg8::Gemm g{XN, Wt_ff1, DM, DM, DM, DFF, -1}; pg8::StaticOrder S; S.init(M, DFF, G, bx);
        pg8::EpiH E{ssq, HB};
        pg8::gemm_phase<pg8::EpiH, pg8::StaticOrder, false>(lds + RING_OFF, g, S, E);
        if (BOTH(5)) GRID_BAR();
    }
    if ((PHMASK >> 6 & 1) && IN(6)) {
        pg8::Gemm g{HB, Wt_ff2, DFF, DFF, DFF, DM, -1}; pg8::StaticOrder S; S.init(M, DM, G, bx);
        pg8::EpiOut E{args.out};
        pg8::gemm_phase<pg8::EpiOut, pg8::StaticOrder, false>(lds + RING_OFF, g, S, E);
    }
#undef IN
#undef BOTH
#undef GRID_BAR
}

__global__ void __launch_bounds__(256) naive_attn(const bf16_t* __restrict__ Q, const bf16_t* __restrict__ K, const bf16_t* __restrict__ V, const float* __restrict__ kmp,
                                                 const float* __restrict__ rel_bias, bf16_t* __restrict__ O) {
    const int idx = blockIdx.x * 256 + threadIdx.x;
    const int t = idx % SEQ, h = (idx / SEQ) % NH, b = idx / (SEQ * NH);
    const size_t row = (size_t)b * SEQ + t;
    float q[64];
    { const u32x4* qp = (const u32x4*)(Q + row * DA + h * HD);
#pragma unroll
      for (int c = 0; c < 8; ++c) { const u32x4 w = qp[c];
#pragma unroll
          for (int j = 0; j < 4; ++j) { q[c * 8 + 2 * j] = __uint_as_float(w[j] << 16); q[c * 8 + 2 * j + 1] = __uint_as_float(w[j] & 0xffff0000u); } } }
    const int own = t / KBLK;
    unsigned mask = 0;
    {
        float g[16];
#pragma unroll
        for (int j = 0; j < 16; ++j) { g[j] = -INFINITY;
            if (j < own) { const float* k0 = kmp + (size_t)((b * NKB + j) * 2) * DA + h * HD; const float* k1 = k0 + DA; float s = 0.f;
#pragma unroll
                for (int d = 0; d < 64; ++d) s += q[d] * ((k0[d] + k1[d]) * (1.0f / 256.0f));
                g[j] = s; } }
#pragma unroll
        for (int r = 0; r < 3; ++r) { float best = -INFINITY; int bi = -1;
#pragma unroll
            for (int j = 0; j < 16; ++j) if (g[j] > best) { best = g[j]; bi = j; }
            if (bi >= 0) { mask |= 1u << bi;
#pragma unroll
                for (int j = 0; j < 16; ++j) if (j == bi) g[j] = -INFINITY; } }
    }
    mask |= 1u << own;
    float o[64];
#pragma unroll
    for (int d = 0; d < 64; ++d) o[d] = 0.f;
    float mx = -INFINITY, l = 0.f;
    for (int j = 0; j <= own; ++j) {
        if (!((mask >> j) & 1u)) continue;
        const int kend = (j == own) ? (t - own * KBLK + 1) : KBLK;
        for (int kk = 0; kk < kend; ++kk) {
            const size_t krow = (size_t)b * SEQ + j * KBLK + kk;
            const u32x4* kp = (const u32x4*)(K + krow * DA + h * HD);
            float s = 0.f;
#pragma unroll
            for (int c = 0; c < 8; ++c) { const u32x4 w = kp[c];
#pragma unroll
                for (int jj = 0; jj < 4; ++jj) { s += q[c * 8 + 2 * jj] * __uint_as_float(w[jj] << 16); s += q[c * 8 + 2 * jj + 1] * __uint_as_float(w[jj] & 0xffff0000u); } }
            const int rel = t - (j * KBLK + kk);
            s += rel_bias[t5_bucket(rel) * NH + h] * LOG2E;
            if (s > mx) { const float f = exp2f(mx - s); l *= f;
#pragma unroll
                for (int d = 0; d < 64; ++d) o[d] *= f;
                mx = s; }
            const float p = exp2f(s - mx); l += p;
            const u32x4* vp = (const u32x4*)(V + krow * DA + h * HD);
#pragma unroll
            for (int c = 0; c < 8; ++c) { const u32x4 w = vp[c];
#pragma unroll
                for (int jj = 0; jj < 4; ++jj) { o[c * 8 + 2 * jj] += p * __uint_as_float(w[jj] << 16); o[c * 8 + 2 * jj + 1] += p * __uint_as_float(w[jj] & 0xffff0000u); } }
        }
    }
    const float il = 1.0f / l;
    u32x4* op = (u32x4*)(O + row * OC + h * HD);
#pragma unroll
    for (int c = 0; c < 8; ++c) { u32x4 w;
#pragma unroll
        for (int jj = 0; jj < 4; ++jj) w[jj] = pk2(o[c * 8 + 2 * jj] * il, o[c * 8 + 2 * jj + 1] * il);
        op[c] = w; }
}

__device__ __forceinline__ void rg_au_ref(float rp, float ip, float xc, float c8sp, float& a, float& u) {
    const float r = 1.0f / (1.0f + expf(-rp)), i = 1.0f / (1.0f + expf(-ip));
    const float la = -c8sp * r; a = expf(la); u = sqrtf(-expm1f(2.0f * la)) * (i * xc);
}
constexpr int NCH = 64, CHL = SEQ / NCH;
template <bool FINAL>
__global__ void __launch_bounds__(64) naive_scan(const bf16_t* __restrict__ XR, const bf16_t* __restrict__ GY, const float* __restrict__ cw, const float* __restrict__ cb,
                                                const float* __restrict__ Wa, const float* __restrict__ ba, const float* __restrict__ Wi, const float* __restrict__ bi,
                                                const float* __restrict__ lam, float* __restrict__ comp, const float* __restrict__ carry, bf16_t* __restrict__ O) {
    __shared__ float xcs[CHL][64];
    const int c = threadIdx.x, blk = blockIdx.x % RB, chunk = (blockIdx.x / RB) % NCH, b = blockIdx.x / (RB * NCH);
    const int ch = blk * RBD + c;
    const float w0 = cw[ch], w1 = cw[DR + ch], w2 = cw[2 * DR + ch], w3 = cw[3 * DR + ch], bb = cb[ch];
    for (int tt = 0; tt < CHL; ++tt) { const int t = chunk * CHL + tt; const bf16_t* xp = XR + ((size_t)b * SEQ + t) * DR + ch;
        float v = bb + w3 * bf2f(xp[0]);
        if (t >= 1) v += w2 * bf2f(xp[-DR]);
        if (t >= 2) v += w1 * bf2f(xp[-2 * DR]);
        if (t >= 3) v += w0 * bf2f(xp[-3 * DR]);
        xcs[tt][c] = v; }
    __syncthreads();
    const float c8sp = 8.0f * log1pf(expf(-lam[ch]));
    const float bav = ba[ch], biv = bi[ch];
    const float* wa = Wa + (size_t)blk * RBD * RBD + c; const float* wi = Wi + (size_t)blk * RBD * RBD + c;
    float A = 1.f, Bc = 0.f, hst = FINAL ? carry[((size_t)b * NCH + chunk) * DR + ch] : 0.f;
    for (int tt = 0; tt < CHL; ++tt) {
        float rp = bav, ip = biv;
#pragma unroll 8
        for (int d = 0; d < 64; ++d) { const float xv = xcs[tt][d]; rp += xv * wa[d * RBD]; ip += xv * wi[d * RBD]; }
        float a, u; rg_au_ref(rp, ip, xcs[tt][c], c8sp, a, u);
        if (FINAL) { hst = a * hst + u; const size_t off = ((size_t)b * SEQ + chunk * CHL + tt); O[off * OC + DA + ch] = (bf16_t)f2bf(hst * bf2f(GY[off * DR + ch])); }
        else { A *= a; Bc = a * Bc + u; }
    }
    if (!FINAL) { float* cp = comp + (((size_t)b * NCH + chunk) * DR + ch) * 2; cp[0] = A; cp[1] = Bc; }
}
__global__ void __launch_bounds__(256) naive_scan_prefix(const float* __restrict__ comp, float* __restrict__ carry) {
    const int idx = blockIdx.x * 256 + threadIdx.x; const int ch = idx % DR, b = idx / DR;
    float h = 0.f;
    for (int k = 0; k < NCH; ++k) { const size_t o = ((size_t)b * NCH + k) * DR + ch; carry[o] = h; h = comp[o * 2] * h + comp[o * 2 + 1]; }
}

extern "C" void kernel_launch(void* const* d_in, const int* in_sizes, int n_in, void* d_out, int out_size, void* d_ws, size_t ws_size, hipStream_t stream) {
    static int grid = 0;
    if (grid == 0) {
        if (n_in != 20 || in_sizes[0] != M * DM || out_size != M * DM || ws_size < WS_END) { fprintf(stderr, "kernel_launch: unexpected shapes (n_in %d, in0 %d, out %d, ws %zu)\n", n_in, n_in > 0 ? in_sizes[0] : -1, out_size, ws_size); grid = -1; return; }
        int dev = 0, cus = 0;
        if (hipGetDevice(&dev) != hipSuccess || hipDeviceGetAttribute(&cus, hipDeviceAttributeMultiprocessorCount, dev) != hipSuccess) { grid = -1; return; }
        if (hipFuncSetAttribute((const void*)mk_fwd, hipFuncAttributeMaxDynamicSharedMemorySize, LDS_BYTES) != hipSuccess) { fprintf(stderr, "kernel_launch: hipFuncSetAttribute failed\n"); grid = -1; return; }
        (void)hipGetLastError();
        grid = cus;
    }
    if (grid < 0) return;
    (void)hipMemsetAsync((char*)d_ws + WS_CTL, 0, CTL_ZERO_BYTES, stream);
    Args a{};
    for (int i = 0; i < 20; ++i) a.in[i] = (const float*)d_in[i];
    a.out = (float*)d_out; a.ws = (unsigned char*)d_ws;
    unsigned char* ws = (unsigned char*)d_ws;
#define LAUNCH_PH(lo_, hi_) do { a.ph_lo = (lo_); a.ph_hi = (hi_); hipLaunchKernelGGL(mk_fwd, dim3(grid), dim3(NWAVES * 64), LDS_BYTES, stream, a); } while (0)
    LAUNCH_PH(0, 1);
    LAUNCH_PH(1, 2);
    hipLaunchKernelGGL(naive_attn, dim3(BATCH * NH * SEQ / 256), dim3(256), 0, stream, (const bf16_t*)(ws + WS_Q), (const bf16_t*)(ws + WS_K), (const bf16_t*)(ws + WS_V),
                       (const float*)(ws + WS_KMP), (const float*)d_in[6], (bf16_t*)d_out);
    hipLaunchKernelGGL(naive_scan<false>, dim3(BATCH * NCH * RB), dim3(64), 0, stream, (const bf16_t*)(ws + WS_XR), (const bf16_t*)(ws + WS_GY), (const float*)d_in[7], (const float*)d_in[8],
                       (const float*)d_in[9], (const float*)d_in[10], (const float*)d_in[11], (const float*)d_in[12], (const float*)d_in[13], (float*)(ws + WS_COMP), (const float*)(ws + WS_CARRY), (bf16_t*)d_out);
    hipLaunchKernelGGL(naive_scan_prefix, dim3(BATCH * DR / 256), dim3(256), 0, stream, (const float*)(ws + WS_COMP), (float*)(ws + WS_CARRY));
    hipLaunchKernelGGL(naive_scan<true>, dim3(BATCH * NCH * RB), dim3(64), 0, stream, (const bf16_t*)(ws + WS_XR), (const bf16_t*)(ws + WS_GY), (const float*)d_in[7], (const float*)d_in[8],
                       (const float*)d_in[9], (const float*)d_in[10], (const float*)d_in[11], (const float*)d_in[12], (const float*)d_in[13], (float*)(ws + WS_COMP), (const float*)(ws + WS_CARRY), (bf16_t*)d_out);
    LAUNCH_PH(3, 4);
    LAUNCH_PH(4, 5);
    LAUNCH_PH(5, 6);
    LAUNCH_PH(6, 7);
#undef LAUNCH_PH
}
```

```cpp
#include <hip/hip_runtime.h>
#include <hip/hip_bf16.h>
#include <cstdio>
#include <cstdint>

#ifndef MIDFLAG
#define MIDFLAG true
#endif
#ifndef PHMASK
#define PHMASK 0xffff
#endif
#ifndef MK_N_LAUNCHES
#define MK_N_LAUNCHES 1
#endif

constexpr int BATCH = 8, SEQ = 4096, DM = 1024, M = BATCH * SEQ;
constexpr int NH = 8, HD = 64, DA = 512, DR = 1024, DFF = 4096, DIN = 5632;
constexpr int KBLK = 256, NKB = SEQ / KBLK;
constexpr int RB = 16, RBD = 64;
constexpr int OC = DA + DR;
constexpr float EPS = 1e-6f;
constexpr float LOG2E = 1.4426950408889634f;
constexpr float C2 = 0.125f * LOG2E;

#define LAS __attribute__((address_space(3)))
#define GAS __attribute__((address_space(1)))
typedef unsigned short bf16_t;
typedef short bf16x8 __attribute__((ext_vector_type(8)));
typedef float f32x4 __attribute__((ext_vector_type(4)));
typedef float f32x2 __attribute__((ext_vector_type(2)));
typedef unsigned u32x4 __attribute__((ext_vector_type(4)));
typedef unsigned u32x2 __attribute__((ext_vector_type(2)));

constexpr size_t MiB = 1u << 20;
constexpr size_t WS_CTL = 0, CTL_ZERO_BYTES = 1 * MiB;
constexpr size_t WS_WIN = 2 * MiB;
constexpr size_t WS_WCAT = 13 * MiB;
constexpr size_t WS_WOUT = 16 * MiB;
constexpr size_t WS_WFF1 = 18 * MiB;
constexpr size_t WS_WFF2 = 26 * MiB;
constexpr size_t WS_KMP = 34 * MiB;
constexpr size_t WS_SSQ = 35 * MiB;
constexpr size_t WS_COMP = 38 * MiB;
constexpr size_t WS_CARRY = 42 * MiB;
constexpr size_t WS_XN = 48 * MiB;
constexpr size_t WS_Q = 112 * MiB;
constexpr size_t WS_K = 144 * MiB;
constexpr size_t WS_V = 176 * MiB;
constexpr size_t WS_MRG = 144 * MiB;
constexpr size_t WS_XR = 208 * MiB;
constexpr size_t WS_GY = 272 * MiB;
constexpr size_t WS_GA = 336 * MiB;
constexpr size_t WS_GR = 400 * MiB;
constexpr size_t WS_H = 208 * MiB;
constexpr size_t WS_END = 464 * MiB;

constexpr int CW_TMO = 0, CW_BAR = 4096;

__device__ __forceinline__ float bf2f(unsigned short u) { return __uint_as_float(((unsigned)u) << 16); }
__device__ __forceinline__ unsigned f2bf(float f) { unsigned u = __builtin_bit_cast(unsigned, f); return (u + 0x7fffu + ((u >> 16) & 1u)) >> 16; }
__device__ __forceinline__ unsigned pk2(float lo, float hi) { return f2bf(lo) | (f2bf(hi) << 16); }
__device__ __forceinline__ unsigned cvt_pk_bf16(float lo, float hi) { unsigned r; asm volatile("v_cvt_pk_bf16_f32 %0, %1, %2" : "=v"(r) : "v"(lo), "v"(hi)); return r; }
__device__ __forceinline__ float fast_sigmoid(float x) { return __builtin_amdgcn_rcpf(1.0f + __builtin_amdgcn_exp2f(-LOG2E * x)); }
__device__ __forceinline__ float gelu_tanh(float x) { const float u = x + 0.044715f * x * x * x; return x * __builtin_amdgcn_rcpf(1.0f + __builtin_amdgcn_exp2f(-2.302208198f * u)); }
__device__ __forceinline__ float wave_sum(float v) {
#pragma unroll
    for (int o = 1; o < 64; o <<= 1) v += __shfl_xor(v, o);
    return v;
}
__device__ __forceinline__ int t5_bucket(int n) {
    if (n < 16) return n;
    int b = 16;
    b += (n >= 19); b += (n >= 21); b += (n >= 24); b += (n >= 27); b += (n >= 31); b += (n >= 35); b += (n >= 40); b += (n >= 46);
    b += (n >= 52); b += (n >= 59); b += (n >= 67); b += (n >= 77); b += (n >= 87); b += (n >= 99); b += (n >= 113);
    return b;
}

namespace pg8 {
constexpr int BM = 256, BK = 64, HALF = 128, HTB = HALF * BK * 2, STAGE_BYTES = 8 * HTB, NXCD = 8, WGM = 8;
__host__ __device__ __forceinline__ int lds_byte(int r, int c) { const int st = (r >> 4) * 2 + (c >> 5), rr = r & 15, cc = c & 31, ob = rr * 64 + cc * 2; return st * 1024 + (ob ^ (((ob >> 9) & 1) << 5)); }
__host__ __device__ __forceinline__ void stage_rc(int b, int& R, int& C) { const int st = b / 1024, sb = b % 1024, swz = sb ^ (((sb >> 9) & 1) << 5); R = (st >> 1) * 16 + swz / 64; C = (st & 1) * 32 + (swz % 64) / 2; }
__host__ __device__ __forceinline__ int perm32(int rho) { const int n = rho >> 4, i = rho & 15; return 8 * (i >> 2) + 4 * n + (i & 3); }

struct Unit { int pm, pn; };
struct Gemm { const bf16_t* A; const bf16_t* Bt; int lda, ldb, K, N, mid_t; };

struct StaticOrder {
    int nM, nN, nwg, G, c;
    __host__ __device__ void init(int M_, int N_, int G_, int c_) { nM = M_ / BM; nN = N_ / BM; nwg = nM * nN; G = G_; c = c_; }
    __host__ __device__ bool next(int i, Unit& u) const {
        const long L = (long)i * G + c; if (L >= nwg) return false;
        int wgid = (int)L; { const int q = nwg / NXCD, r = nwg % NXCD, xcd = wgid % NXCD, off = wgid / NXCD; wgid = (xcd < r ? xcd * (q + 1) : r * (q + 1) + (xcd - r) * q) + off; }
        const int nig = WGM * nN, gid = wgid / nig, fm = gid * WGM, gsz = (nM - fm) < WGM ? (nM - fm) : WGM;
        u.pm = fm + ((wgid % nig) % gsz); u.pn = (wgid % nig) / gsz; return true;
    }
};

typedef f32x4 Acc[2][2][4][2];

template <class Epi, class Sched, bool MID>
__device__ __forceinline__ void gemm_phase(LAS unsigned char* lds, const Gemm g, const Sched& S, const Epi& E) {
    const int tid = threadIdx.x, wid = __builtin_amdgcn_readfirstlane(tid >> 6), lane = tid & 63, wr = wid >> 2, wc = wid & 3, fr = lane & 15, fq = lane >> 4;
    const int nt = g.K / BK;
    unsigned voffA[2], voffB[2];
#pragma unroll
    for (int i = 0; i < 2; ++i) { int R, C; stage_rc(tid * 16 + i * 8192, R, C); const int Rb = Epi::PERM ? ((R & ~31) + perm32(R & 31)) : R;
        voffA[i] = (unsigned)(R * g.lda + C) * 2u; voffB[i] = (unsigned)(Rb * g.ldb + C) * 2u; }
    const size_t kstep = (size_t)(BK * 2);
    const size_t hstepA = (size_t)HALF * g.lda * 2, hstepB = (size_t)HALF * g.ldb * 2;
    const size_t tstepA = 2 * hstepA, tstepB = 2 * hstepB;
    const unsigned ldsw = (unsigned)wid * 1024u;
    const int aoff = lds_byte(wr * 64 + fr, fq * 8), boff = lds_byte(wc * 32 + fr, fq * 8);
#define PG8_SA(b, h) (((b) * 2 + (h)) * HTB)
#define PG8_SB(b, h) ((4 + (b) * 2 + (h)) * HTB)
#define PG8_STAGE(bufoff, gbase, voff) do { _Pragma("unroll") for (int _i = 0; _i < 2; ++_i) \
        __builtin_amdgcn_global_load_lds((const unsigned*)((const char*)(gbase) + (voff)[_i]), (LAS unsigned*)(lds + (bufoff) + ldsw + _i * 8192), 16, 0, 0); } while (0)
#define PG8_LDA(dst, b, h) do { _Pragma("unroll") for (int m = 0; m < 4; ++m) _Pragma("unroll") for (int k = 0; k < 2; ++k) dst[m][k] = *(const LAS bf16x8*)(lds + PG8_SA(b, h) + aoff + m * 2048 + k * 1024); } while (0)
#define PG8_LDB(dst, b, h) do { _Pragma("unroll") for (int n = 0; n < 2; ++n) _Pragma("unroll") for (int k = 0; k < 2; ++k) dst[n][k] = *(const LAS bf16x8*)(lds + PG8_SB(b, h) + boff + n * 2048 + k * 1024); } while (0)
#define PG8_MMA(ai, bj, At, Bt) do { __builtin_amdgcn_s_setprio(1); _Pragma("unroll") for (int m = 0; m < 4; ++m) _Pragma("unroll") for (int n = 0; n < 2; ++n) _Pragma("unroll") for (int k = 0; k < 2; ++k) \
        acc[ai][bj][m][n] = __builtin_amdgcn_mfma_f32_16x16x32_bf16(Bt[n][k], At[m][k], acc[ai][bj][m][n], 0, 0, 0); __builtin_amdgcn_s_setprio(0); } while (0)
#define PG8_WAIT_V(n) asm volatile("s_waitcnt vmcnt(" #n ")" ::: "memory")
#define PG8_WAIT_L(n) asm volatile("s_waitcnt lgkmcnt(" #n ")" ::: "memory")
#define PG8_BAR __builtin_amdgcn_s_barrier()
#define PG8_SCHED __builtin_amdgcn_sched_barrier(0)
    Unit cur, nxt; int ui = 0;
    if (!S.next(0, cur)) return;
    f32x4 acc[2][2][4][2];
#pragma unroll
    for (int a = 0; a < 2; ++a)
#pragma unroll
        for (int b = 0; b < 2; ++b)
#pragma unroll
            for (int m = 0; m < 4; ++m)
#pragma unroll
                for (int n = 0; n < 2; ++n) acc[a][b][m][n] = (f32x4){0.f, 0.f, 0.f, 0.f};
    bf16x8 At[4][2], B0[2][2], B1[2][2];
    const char* cA = (const char*)g.A + (size_t)cur.pm * tstepA; const char* cB = (const char*)g.Bt + (size_t)cur.pn * tstepB;
    PG8_STAGE(PG8_SB(0, 0), cB, voffB); PG8_STAGE(PG8_SB(0, 1), cB + hstepB, voffB); PG8_STAGE(PG8_SA(0, 0), cA, voffA); PG8_STAGE(PG8_SA(0, 1), cA + hstepA, voffA);
    if (wr == 1) PG8_BAR;
    PG8_WAIT_V(2); PG8_BAR;
    PG8_STAGE(PG8_SB(1, 0), cB + kstep, voffB); PG8_STAGE(PG8_SA(1, 0), cA + kstep, voffA); PG8_STAGE(PG8_SB(1, 1), cB + hstepB + kstep, voffB);
    PG8_WAIT_V(6); PG8_BAR;
    for (;;) {
        const bool has_next = S.next(ui + 1, nxt);
        const char* nA = has_next ? (const char*)g.A + (size_t)nxt.pm * tstepA : cA; const char* nB = has_next ? (const char*)g.Bt + (size_t)nxt.pn * tstepB : cB;
        for (int t = 0; t < nt; t += 2) {
            if constexpr (MID) { if (t == g.mid_t) E.mid(acc, cur, wr, wc, fr, fq); }
            const bool last = (t == nt - 2);
            const char* a1 = cA + (size_t)(t + 1) * kstep;
            const char* a2 = last ? nA : cA + (size_t)(t + 2) * kstep; const char* b2 = last ? nB : cB + (size_t)(t + 2) * kstep;
            const char* a3 = a2 + kstep; const char* b3 = b2 + kstep;
            PG8_LDB(B0, 0, 0); PG8_LDB(B1, 0, 1); PG8_SCHED; PG8_LDA(At, 0, 0); PG8_STAGE(PG8_SA(1, 1), a1 + hstepA, voffA);
            PG8_WAIT_V(8); PG8_WAIT_L(0); PG8_BAR; PG8_MMA(0, 0, At, B0); PG8_MMA(0, 1, At, B1); PG8_BAR; PG8_SCHED;
            PG8_LDA(At, 0, 1); PG8_STAGE(PG8_SB(0, 0), b2, voffB); PG8_STAGE(PG8_SB(0, 1), b2 + hstepB, voffB); PG8_STAGE(PG8_SA(0, 0), a2, voffA);
            PG8_WAIT_V(8); PG8_WAIT_L(0); PG8_BAR; PG8_MMA(1, 0, At, B0); PG8_MMA(1, 1, At, B1); PG8_BAR; PG8_SCHED;
            PG8_LDB(B0, 1, 0); PG8_LDB(B1, 1, 1); PG8_SCHED; PG8_LDA(At, 1, 0); PG8_STAGE(PG8_SA(0, 1), a2 + hstepA, voffA);
            PG8_WAIT_V(8); PG8_WAIT_L(0); PG8_BAR; PG8_MMA(0, 0, At, B0); PG8_MMA(0, 1, At, B1); PG8_BAR; PG8_SCHED;
            PG8_LDA(At, 1, 1); PG8_STAGE(PG8_SB(1, 0), b3, voffB); PG8_STAGE(PG8_SB(1, 1), b3 + hstepB, voffB); PG8_STAGE(PG8_SA(1, 0), a3, voffA);
            PG8_WAIT_V(8); PG8_WAIT_L(0); PG8_BAR; PG8_MMA(1, 0, At, B0); PG8_MMA(1, 1, At, B1); PG8_BAR; PG8_SCHED;
        }
        if (wr == 0) PG8_BAR;
        E(acc, cur, wr, wc, fr, fq);
        if (!has_next) break;
#pragma unroll
        for (int a = 0; a < 2; ++a)
#pragma unroll
            for (int b = 0; b < 2; ++b)
#pragma unroll
                for (int m = 0; m < 4; ++m)
#pragma unroll
                    for (int n = 0; n < 2; ++n) acc[a][b][m][n] = (f32x4){0.f, 0.f, 0.f, 0.f};
        cur = nxt; cA = nA; cB = nB; ++ui;
        if (wr == 1) PG8_BAR;
    }
    PG8_WAIT_V(0);
    PG8_BAR;
#undef PG8_SA
#undef PG8_SB
#undef PG8_STAGE
#undef PG8_LDA
#undef PG8_LDB
#undef PG8_MMA
#undef PG8_WAIT_V
#undef PG8_WAIT_L
#undef PG8_BAR
#undef PG8_SCHED
}

struct EpiZ {
    static constexpr bool PERM = true;
    bf16_t *Q, *K, *V, *XR, *GY, *GA, *GR; float* kmp; const float *qw, *kw, *bg;
    __device__ __forceinline__ void mid(Acc&, const Unit&, int, int, int, int) const {}
    __device__ __forceinline__ void operator()(Acc& acc, const Unit& u, int wr, int wc, int fr, int fq) const {
        const int pn = u.pn; const int row0 = u.pm * BM + wr * 64 + fr;
        if (pn < 4) {
            const bool isq = pn < 2; const int head = (pn & 1) * 4 + wc; const float* nw = isq ? qw : kw; const float osc = isq ? C2 : 1.0f;
            bf16_t* base = (isq ? Q : K) + head * HD + 8 * fq;
            f32x4 wv[2][2];
#pragma unroll
            for (int bj = 0; bj < 2; ++bj)
#pragma unroll
                for (int n = 0; n < 2; ++n) wv[bj][n] = *(const f32x4*)(nw + 32 * bj + 8 * fq + 4 * n) * osc;
            f32x4 cs[2][2];
#pragma unroll
            for (int bj = 0; bj < 2; ++bj)
#pragma unroll
                for (int n = 0; n < 2; ++n) cs[bj][n] = (f32x4){0.f, 0.f, 0.f, 0.f};
#pragma unroll
            for (int ai = 0; ai < 2; ++ai)
#pragma unroll
                for (int m = 0; m < 4; ++m) {
                    float ss = 0.f;
#pragma unroll
                    for (int bj = 0; bj < 2; ++bj)
#pragma unroll
                        for (int n = 0; n < 2; ++n) { const f32x4 v = acc[ai][bj][m][n]; ss += (v[0] * v[0] + v[1] * v[1]) + (v[2] * v[2] + v[3] * v[3]); }
                    ss += __shfl_xor(ss, 16); ss += __shfl_xor(ss, 32);
                    const float rstd = 1.0f / sqrtf(ss * (1.0f / 64.0f) + EPS);
                    bf16_t* rowp = base + (size_t)(row0 + ai * HALF + m * 16) * DA;
#pragma unroll
                    for (int bj = 0; bj < 2; ++bj) {
                        const f32x4 v0 = acc[ai][bj][m][0] * rstd * wv[bj][0], v1 = acc[ai][bj][m][1] * rstd * wv[bj][1];
                        cs[bj][0] += v0; cs[bj][1] += v1;
                        u32x4 w; w.x = cvt_pk_bf16(v0[0], v0[1]); w.y = cvt_pk_bf16(v0[2], v0[3]); w.z = cvt_pk_bf16(v1[0], v1[1]); w.w = cvt_pk_bf16(v1[2], v1[3]);
                        *(u32x4*)(rowp + 32 * bj) = w; }
                }
            if (!isq) {
#pragma unroll
                for (int bj = 0; bj < 2; ++bj)
#pragma unroll
                    for (int n = 0; n < 2; ++n)
#pragma unroll
                        for (int i = 0; i < 4; ++i) { float s = cs[bj][n][i]; s += __shfl_xor(s, 1); s += __shfl_xor(s, 2); s += __shfl_xor(s, 4); s += __shfl_xor(s, 8); cs[bj][n][i] = s; }
                if (fr == 0) { float* kp = kmp + (size_t)(u.pm * 2 + wr) * DA + head * HD + 8 * fq;
#pragma unroll
                    for (int bj = 0; bj < 2; ++bj) { *(f32x4*)(kp + 32 * bj) = cs[bj][0]; *(f32x4*)(kp + 32 * bj + 4) = cs[bj][1]; } }
            }
            return;
        }
        int mode, ldc, colt; bf16_t* base; const float* bias = nullptr;
        if (pn < 6) { base = V; ldc = DA; colt = (pn - 4) * BM; mode = 0; }
        else if (pn < 10) { base = XR; ldc = DR; colt = (pn - 6) * BM; mode = 0; }
        else if (pn < 14) { base = GY; ldc = DR; colt = (pn - 10) * BM; mode = 1; }
        else if (pn < 18) { base = GA; ldc = DM; colt = (pn - 14) * BM; mode = 2; bias = bg; }
        else { base = GR; ldc = DM; colt = (pn - 18) * BM; mode = 2; bias = bg + DM; }
        const int col0 = colt + wc * 32 + 8 * fq;
        f32x4 bv[2][2];
#pragma unroll
        for (int bj = 0; bj < 2; ++bj)
#pragma unroll
            for (int n = 0; n < 2; ++n) bv[bj][n] = bias ? *(const f32x4*)(bias + col0 + bj * HALF + 4 * n) : (f32x4){0.f, 0.f, 0.f, 0.f};
#pragma unroll
        for (int ai = 0; ai < 2; ++ai)
#pragma unroll
            for (int m = 0; m < 4; ++m) { bf16_t* rowp = base + (size_t)(row0 + ai * HALF + m * 16) * ldc + col0;
#pragma unroll
                for (int bj = 0; bj < 2; ++bj) { f32x4 v0 = acc[ai][bj][m][0] + bv[bj][0], v1 = acc[ai][bj][m][1] + bv[bj][1];
                    if (mode == 1) {
#pragma unroll
                        for (int i = 0; i < 4; ++i) { v0[i] = gelu_tanh(v0[i]); v1[i] = gelu_tanh(v1[i]); } }
                    else if (mode == 2) {
#pragma unroll
                        for (int i = 0; i < 4; ++i) { v0[i] = fast_sigmoid(v0[i]); v1[i] = fast_sigmoid(v1[i]); } }
                    u32x4 w; w.x = cvt_pk_bf16(v0[0], v0[1]); w.y = cvt_pk_bf16(v0[2], v0[3]); w.z = cvt_pk_bf16(v1[0], v1[1]); w.w = cvt_pk_bf16(v1[2], v1[3]);
                    *(u32x4*)(rowp + bj * HALF) = w; } }
    }
};

struct EpiMerge {
    static constexpr bool PERM = true;
    const bf16_t *GA, *GR; bf16_t* O;
    __device__ __forceinline__ void mid(Acc& acc, const Unit& u, int wr, int wc, int fr, int fq) const {
        int row0 = u.pm * BM + wr * 64 + fr, col0 = u.pn * BM + wc * 32 + 8 * fq;
        asm volatile("" : "+v"(row0), "+v"(col0));
#pragma unroll
        for (int ai = 0; ai < 2; ++ai)
#pragma unroll
            for (int m = 0; m < 4; ++m) { const size_t off = (size_t)(row0 + ai * HALF + m * 16) * DM + col0;
#pragma unroll
                for (int bj = 0; bj < 2; ++bj) { const u32x4 a = *(const u32x4*)(GA + off + bj * HALF), r = *(const u32x4*)(GR + off + bj * HALF);
#pragma unroll
                    for (int j = 0; j < 4; ++j) { const unsigned aw = a[j], rw = r[j];
                        const float f0 = __uint_as_float(aw << 16) * __builtin_amdgcn_rcpf(__uint_as_float(rw << 16));
                        const float f1 = __uint_as_float(aw & 0xffff0000u) * __builtin_amdgcn_rcpf(__uint_as_float(rw & 0xffff0000u));
                        acc[ai][bj][m][j >> 1][(j & 1) * 2] *= f0; acc[ai][bj][m][j >> 1][(j & 1) * 2 + 1] *= f1; } }
                asm volatile("" ::: "memory"); }
    }
    __device__ __forceinline__ void operator()(Acc& acc, const Unit& u, int wr, int wc, int fr, int fq) const {
        const int row0 = u.pm * BM + wr * 64 + fr, col0 = u.pn * BM + wc * 32 + 8 * fq;
#pragma unroll
        for (int ai = 0; ai < 2; ++ai)
#pragma unroll
            for (int m = 0; m < 4; ++m) { const size_t off = (size_t)(row0 + ai * HALF + m * 16) * DM + col0;
#pragma unroll
                for (int bj = 0; bj < 2; ++bj) { const u32x4 r = *(const u32x4*)(GR + off + bj * HALF); u32x4 w;
#pragma unroll
                    for (int j = 0; j < 4; ++j) { const unsigned rw = r[j];
                        const float v0 = acc[ai][bj][m][j >> 1][(j & 1) * 2] * __uint_as_float(rw << 16), v1 = acc[ai][bj][m][j >> 1][(j & 1) * 2 + 1] * __uint_as_float(rw & 0xffff0000u);
                        w[j] = cvt_pk_bf16(v0, v1); }
                    *(u32x4*)(O + off + bj * HALF) = w; }
                if (m & 1) asm volatile("" ::: "memory"); }
    }
};

struct EpiX1 {
    static constexpr bool PERM = false;
    const float* X; float* X1; bf16_t* XN2; float* ssq;
    __device__ __forceinline__ void mid(Acc&, const Unit&, int, int, int, int) const {}
    __device__ __forceinline__ void operator()(Acc& acc, const Unit& u, int wr, int wc, int fr, int fq) const {
        const int row0 = u.pm * BM + wr * 64 + fr, col0 = u.pn * BM + wc * 32 + 4 * fq;
#pragma unroll
        for (int ai = 0; ai < 2; ++ai)
#pragma unroll
            for (int m = 0; m < 4; ++m) { const int row = row0 + ai * HALF + m * 16; const size_t off = (size_t)row * DM + col0; float ss = 0.f;
#pragma unroll
                for (int bj = 0; bj < 2; ++bj)
#pragma unroll
                    for (int n = 0; n < 2; ++n) { const f32x4 xv = *(const f32x4*)(X + off + bj * HALF + n * 16); const f32x4 v = acc[ai][bj][m][n] + xv;
                        *(f32x4*)(X1 + off + bj * HALF + n * 16) = v;
                        u32x2 w; w.x = cvt_pk_bf16(v[0], v[1]); w.y = cvt_pk_bf16(v[2], v[3]); *(u32x2*)(XN2 + off + bj * HALF + n * 16) = w;
                        ss += (v[0] * v[0] + v[1] * v[1]) + (v[2] * v[2] + v[3] * v[3]); }
                ss += __shfl_xor(ss, 16); ss += __shfl_xor(ss, 32);
                if (fq == 0) ssq[(size_t)row * 16 + u.pn * 4 + wc] = ss;
                if (m & 1) asm volatile("" ::: "memory"); }
    }
};

struct EpiH {
    static constexpr bool PERM = true;
    const float* ssq; bf16_t* H;
    __device__ __forceinline__ void mid(Acc&, const Unit&, int, int, int, int) const {}
    __device__ __forceinline__ void operator()(Acc& acc, const Unit& u, int wr, int wc, int fr, int fq) const {
        const int row0 = u.pm * BM + wr * 64 + fr, col0 = u.pn * BM + wc * 32 + 8 * fq;
#pragma unroll
        for (int ai = 0; ai < 2; ++ai)
#pragma unroll
            for (int m = 0; m < 4; ++m) { const int row = row0 + ai * HALF + m * 16;
                const f32x4 s0 = *(const f32x4*)(ssq + (size_t)row * 16), s1 = *(const f32x4*)(ssq + (size_t)row * 16 + 4), s2 = *(const f32x4*)(ssq + (size_t)row * 16 + 8), s3 = *(const f32x4*)(ssq + (size_t)row * 16 + 12);
                const float tot = (((s0[0] + s0[1]) + (s0[2] + s0[3])) + ((s1[0] + s1[1]) + (s1[2] + s1[3]))) + (((s2[0] + s2[1]) + (s2[2] + s2[3])) + ((s3[0] + s3[1]) + (s3[2] + s3[3])));
                const float rstd = 1.0f / sqrtf(tot * (1.0f / DM) + EPS);
                bf16_t* rowp = H + (size_t)row * DFF + col0;
#pragma unroll
                for (int bj = 0; bj < 2; ++bj) { f32x4 v0 = acc[ai][bj][m][0] * rstd, v1 = acc[ai][bj][m][1] * rstd;
#pragma unroll
                    for (int i = 0; i < 4; ++i) { const float a = fmaxf(v0[i], 0.f), b = fmaxf(v1[i], 0.f); v0[i] = a * a; v1[i] = b * b; }
                    u32x4 w; w.x = cvt_pk_bf16(v0[0], v0[1]); w.y = cvt_pk_bf16(v0[2], v0[3]); w.z = cvt_pk_bf16(v1[0], v1[1]); w.w = cvt_pk_bf16(v1[2], v1[3]);
                    *(u32x4*)(rowp + bj * HALF) = w; }
                if (m & 1) asm volatile("" ::: "memory"); }
    }
};

struct EpiOut {
    static constexpr bool PERM = false;
    float* X1;
    __device__ __forceinline__ void mid(Acc&, const Unit&, int, int, int, int) const {}
    __device__ __forceinline__ void operator()(Acc& acc, const Unit& u, int wr, int wc, int fr, int fq) const {
        const int row0 = u.pm * BM + wr * 64 + fr, col0 = u.pn * BM + wc * 32 + 4 * fq;
#pragma unroll
        for (int ai = 0; ai < 2; ++ai)
#pragma unroll
            for (int m = 0; m < 4; ++m) { const size_t off = (size_t)(row0 + ai * HALF + m * 16) * DM + col0;
#pragma unroll
                for (int bj = 0; bj < 2; ++bj)
#pragma unroll
                    for (int n = 0; n < 2; ++n) { const f32x4 xv = *(const f32x4*)(X1 + off + bj * HALF + n * 16); *(f32x4*)(X1 + off + bj * HALF + n * 16) = acc[ai][bj][m][n] + xv; }
                if (m & 1) asm volatile("" ::: "memory"); }
    }
};
}

#define XB_TMO      128
#define XB_XCNT(j)  (256  + 64 * (j))
#define XB_XSUB(j)  (1280 + 64 * (j))
#define XB_XGEN(j)  (2304 + 64 * (j))
#define XB_TOP      3328
#define XB_TOPGEN   3392
#define XCD_BAR_WORDS 3456
#define XB_SPIN_CAP (1u << 18)
__device__ __forceinline__ unsigned xb_ld(unsigned* p)              { return __hip_atomic_load(p, __ATOMIC_RELAXED, __HIP_MEMORY_SCOPE_AGENT); }
__device__ __forceinline__ unsigned xb_add(unsigned* p, unsigned v) { return __hip_atomic_fetch_add(p, v, __ATOMIC_RELAXED, __HIP_MEMORY_SCOPE_AGENT); }
__device__ __forceinline__ unsigned xb_xcc_id() { return (unsigned)__builtin_amdgcn_s_getreg((3 << 11) | 20) & 0xFu; }
#define XB_SPIN(cond, bar) do { unsigned _sp = 0; while (cond) { __builtin_amdgcn_s_sleep(1); \
    if ((++_sp & 255u) == 0u) { if (xb_ld(&(bar)[XB_TMO])) break; if (_sp > XB_SPIN_CAP) { atomicAdd(&(bar)[XB_TMO], 1u); break; } } } } while (0)
struct XcdBarrier { unsigned* bar; unsigned x; volatile LAS unsigned* st; };
__device__ __forceinline__ XcdBarrier xcd_barrier_post(unsigned* bar, volatile LAS unsigned* st) {
    XcdBarrier b; b.bar = bar; b.x = xb_xcc_id(); b.st = st;
    if (threadIdx.x == 0) (void)xb_add(&bar[XB_XCNT(b.x)], 1u);
    return b;
}
__device__ __forceinline__ void xcd_barrier_complete(unsigned* bar, unsigned x, unsigned& nloc, unsigned& nx) {
    const unsigned G = gridDim.x * gridDim.y * gridDim.z;
    unsigned sum, cnt, mine, sp = 0u;
    for (;;) {
        sum = 0u; cnt = 0u; mine = 0u;
#pragma unroll
        for (unsigned j = 0; j < 16; ++j) { const unsigned c = xb_ld(&bar[XB_XCNT(j)]); sum += c; cnt += (c > 0u) ? 1u : 0u; mine = (j == x) ? c : mine; }
        if (sum == G) break;
        __builtin_amdgcn_s_sleep(1);
        if ((++sp & 255u) == 0u) { if (xb_ld(&bar[XB_TMO])) break; if (sp > XB_SPIN_CAP) { atomicAdd(&bar[XB_TMO], 1u); break; } }
    }
    nloc = mine > 0u ? mine : 1u; nx = cnt > 0u ? cnt : 1u;
}
__device__ __forceinline__ void xcd_barrier(const XcdBarrier& b) {
    asm volatile("s_waitcnt vmcnt(0)" ::: "memory");
    __syncthreads();
    if (threadIdx.x == 0) {
        unsigned* bar = b.bar;
        __builtin_amdgcn_s_waitcnt(0);
        unsigned nloc = b.st[0], nx = b.st[1];
        if (nloc == 0u) { xcd_barrier_complete(bar, b.x, nloc, nx); b.st[0] = nloc; b.st[1] = nx; }
        const unsigned old = xb_add(&bar[XB_XSUB(b.x)], 1u);
        const unsigned gen = old / nloc;
        if (old + 1u == (gen + 1u) * nloc) {
            __builtin_amdgcn_fence(__ATOMIC_RELEASE, "agent");
            asm volatile("s_waitcnt vmcnt(0)" ::: "memory");
            const unsigned og = xb_add(&bar[XB_TOP], 1u);
            const unsigned tg = og / nx;
            if (og + 1u == (tg + 1u) * nx) xb_add(&bar[XB_TOPGEN], 1u);
            else XB_SPIN(xb_ld(&bar[XB_TOPGEN]) == tg, bar);
            __builtin_amdgcn_fence(__ATOMIC_ACQUIRE, "agent");
            xb_add(&bar[XB_XGEN(b.x)], 1u);
            asm volatile("s_waitcnt vmcnt(0)" ::: "memory");
        } else {
            XB_SPIN(xb_ld(&bar[XB_XGEN(b.x)]) == gen, bar);
            __builtin_amdgcn_fence(__ATOMIC_ACQUIRE, "agent");
            asm volatile("s_waitcnt vmcnt(0)" ::: "memory");
        }
    }
    __syncthreads();
}

constexpr int RING_OFF = 0, RING_BYTES = 131072;
constexpr int LDSCTL_OFF = RING_BYTES, MISC_OFF = LDSCTL_OFF + 320;
constexpr int LDS_BYTES = 147456;
constexpr int NWAVES = 8;

struct Args { const float* in[20]; float* out; unsigned char* ws; int ph_lo, ph_hi; };

template <int RMAP>
__device__ __forceinline__ int p0_rowmap(int n) {
    if (RMAP == 1) { if (n < 1024) { const int pn = n >> 8, lc = n & 255, hh = lc >> 6, d = lc & 63; return pn * 256 + 128 * (d >> 5) + 32 * hh + (d & 31); } return n; }
    return n;
}
template <int RMAP>
__device__ __forceinline__ void p0_transpose_item(const float* W, int N, bf16_t* WT, int ldt, int koff, const float* kscale, LAS float* scr, int item, int lane) {
    const int nblk = N / 32, kb = item / nblk, nb = item % nblk, k0 = 64 * kb, n0 = 32 * nb;
#pragma unroll 8
    for (int i = 0; i < 32; ++i) { const int kk = 2 * i + (lane >> 5); float v = W[(size_t)(k0 + kk) * N + n0 + (lane & 31)]; if (kscale) v *= kscale[k0 + kk]; scr[kk * 33 + (lane & 31)] = v; }
    asm volatile("s_waitcnt lgkmcnt(0)" ::: "memory");
    const int c = lane & 7;
#pragma unroll
    for (int j = 0; j < 4; ++j) { const int n = (lane >> 3) + 8 * j; const LAS float* s = scr + (8 * c) * 33 + n;
        u32x4 o; o.x = pk2(s[0 * 33], s[1 * 33]); o.y = pk2(s[2 * 33], s[3 * 33]); o.z = pk2(s[4 * 33], s[5 * 33]); o.w = pk2(s[6 * 33], s[7 * 33]);
        *(u32x4*)(WT + (size_t)p0_rowmap<RMAP>(n0 + n) * ldt + koff + k0 + 8 * c) = o; }
    asm volatile("s_waitcnt lgkmcnt(0)" ::: "memory");
}
__device__ __forceinline__ void rms_row_to_bf16(const float* xrow, const float* w, bf16_t* orow, int lane) {
    const f32x4* xr = (const f32x4*)xrow + lane; const f32x4* wr = (const f32x4*)w + lane;
    f32x4 v[4]; float s = 0.f;
#pragma unroll
    for (int j = 0; j < 4; ++j) { v[j] = xr[64 * j]; s += (v[j].x * v[j].x + v[j].y * v[j].y) + (v[j].z * v[j].z + v[j].w * v[j].w); }
    const float rstd = 1.f / sqrtf(wave_sum(s) * (1.f / DM) + EPS);
    unsigned long long* o8 = (unsigned long long*)orow + lane;
#pragma unroll
    for (int j = 0; j < 4; ++j) { const f32x4 ww = wr[64 * j];
        o8[64 * j] = (unsigned long long)pk2(v[j].x * rstd * ww.x, v[j].y * rstd * ww.y) | ((unsigned long long)pk2(v[j].z * rstd * ww.z, v[j].w * rstd * ww.w) << 32); }
}

__device__ __forceinline__ void naive_attn_item(int idx, const bf16_t* __restrict__ Q, const bf16_t* __restrict__ K, const bf16_t* __restrict__ V, const float* __restrict__ kmp,
                                                 const float* __restrict__ rel_bias, bf16_t* __restrict__ O) {
    const int t = idx % SEQ, h = (idx / SEQ) % NH, b = idx / (SEQ * NH);
    const size_t row = (size_t)b * SEQ + t;
    float q[64];
    { const u32x4* qp = (const u32x4*)(Q + row * DA + h * HD);
#pragma unroll
      for (int c = 0; c < 8; ++c) { const u32x4 w = qp[c];
#pragma unroll
          for (int j = 0; j < 4; ++j) { q[c * 8 + 2 * j] = __uint_as_float(w[j] << 16); q[c * 8 + 2 * j + 1] = __uint_as_float(w[j] & 0xffff0000u); } } }
    const int own = t / KBLK;
    unsigned mask = 0;
    {
        float g[16];
#pragma unroll
        for (int j = 0; j < 16; ++j) { g[j] = -INFINITY;
            if (j < own) { const float* k0 = kmp + (size_t)((b * NKB + j) * 2) * DA + h * HD; const float* k1 = k0 + DA; float s = 0.f;
#pragma unroll
                for (int d = 0; d < 64; ++d) s += q[d] * ((k0[d] + k1[d]) * (1.0f / 256.0f));
                g[j] = s; } }
#pragma unroll
        for (int r = 0; r < 3; ++r) { float best = -INFINITY; int bi = -1;
#pragma unroll
            for (int j = 0; j < 16; ++j) if (g[j] > best) { best = g[j]; bi = j; }
            if (bi >= 0) { mask |= 1u << bi;
#pragma unroll
                for (int j = 0; j < 16; ++j) if (j == bi) g[j] = -INFINITY; } }
    }
    mask |= 1u << own;
    float o[64];
#pragma unroll
    for (int d = 0; d < 64; ++d) o[d] = 0.f;
    float mx = -INFINITY, l = 0.f;
    for (int j = 0; j <= own; ++j) {
        if (!((mask >> j) & 1u)) continue;
        const int kend = (j == own) ? (t - own * KBLK + 1) : KBLK;
        for (int kk = 0; kk < kend; ++kk) {
            const size_t krow = (size_t)b * SEQ + j * KBLK + kk;
            const u32x4* kp = (const u32x4*)(K + krow * DA + h * HD);
            float s = 0.f;
#pragma unroll
            for (int c = 0; c < 8; ++c) { const u32x4 w = kp[c];
#pragma unroll
                for (int jj = 0; jj < 4; ++jj) { s += q[c * 8 + 2 * jj] * __uint_as_float(w[jj] << 16); s += q[c * 8 + 2 * jj + 1] * __uint_as_float(w[jj] & 0xffff0000u); } }
            const int rel = t - (j * KBLK + kk);
            s += rel_bias[t5_bucket(rel) * NH + h] * LOG2E;
            if (s > mx) { const float f = exp2f(mx - s); l *= f;
#pragma unroll
                for (int d = 0; d < 64; ++d) o[d] *= f;
                mx = s; }
            const float p = exp2f(s - mx); l += p;
            const u32x4* vp = (const u32x4*)(V + krow * DA + h * HD);
#pragma unroll
            for (int c = 0; c < 8; ++c) { const u32x4 w = vp[c];
#pragma unroll
                for (int jj = 0; jj < 4; ++jj) { o[c * 8 + 2 * jj] += p * __uint_as_float(w[jj] << 16); o[c * 8 + 2 * jj + 1] += p * __uint_as_float(w[jj] & 0xffff0000u); } }
        }
    }
    const float il = 1.0f / l;
    u32x4* op = (u32x4*)(O + row * OC + h * HD);
#pragma unroll
    for (int c = 0; c < 8; ++c) { u32x4 w;
#pragma unroll
        for (int jj = 0; jj < 4; ++jj) w[jj] = pk2(o[c * 8 + 2 * jj] * il, o[c * 8 + 2 * jj + 1] * il);
        op[c] = w; }
}

__device__ __forceinline__ void rg_au_ref(float rp, float ip, float xc, float c8sp, float& a, float& u) {
    const float r = 1.0f / (1.0f + expf(-rp)), i = 1.0f / (1.0f + expf(-ip));
    const float la = -c8sp * r; a = expf(la); u = sqrtf(-expm1f(2.0f * la)) * (i * xc);
}
constexpr int NCH = 64, CHL = SEQ / NCH;
template <bool FINAL>
__device__ __forceinline__ void naive_scan_item(int item, int c, LAS float* xcs, const bf16_t* __restrict__ XR, const bf16_t* __restrict__ GY, const float* __restrict__ cw, const float* __restrict__ cb,
                                                const float* __restrict__ Wa, const float* __restrict__ ba, const float* __restrict__ Wi, const float* __restrict__ bi,
                                                const float* __restrict__ lam, float* __restrict__ comp, const float* __restrict__ carry, bf16_t* __restrict__ O) {
    const int blk = item % RB, chunk = (item / RB) % NCH, b = item / (RB * NCH);
    const int ch = blk * RBD + c;
    const float w0 = cw[ch], w1 = cw[DR + ch], w2 = cw[2 * DR + ch], w3 = cw[3 * DR + ch], bb = cb[ch];
    for (int tt = 0; tt < CHL; ++tt) { const int t = chunk * CHL + tt; const bf16_t* xp = XR + ((size_t)b * SEQ + t) * DR + ch;
        float v = bb + w3 * bf2f(xp[0]);
        if (t >= 1) v += w2 * bf2f(xp[-DR]);
        if (t >= 2) v += w1 * bf2f(xp[-2 * DR]);
        if (t >= 3) v += w0 * bf2f(xp[-3 * DR]);
        xcs[tt * 64 + c] = v; }
    asm volatile("s_waitcnt lgkmcnt(0)" ::: "memory");
    const float c8sp = 8.0f * log1pf(expf(-lam[ch]));
    const float bav = ba[ch], biv = bi[ch];
    const float* wa = Wa + (size_t)blk * RBD * RBD + c; const float* wi = Wi + (size_t)blk * RBD * RBD + c;
    float A = 1.f, Bc = 0.f, hst = FINAL ? carry[((size_t)b * NCH + chunk) * DR + ch] : 0.f;
    for (int tt = 0; tt < CHL; ++tt) {
        float rp = bav, ip = biv;
#pragma unroll 8
        for (int d = 0; d < 64; ++d) { const float xv = xcs[tt * 64 + d]; rp += xv * wa[d * RBD]; ip += xv * wi[d * RBD]; }
        float a, u; rg_au_ref(rp, ip, xcs[tt * 64 + c], c8sp, a, u);
        if (FINAL) { hst = a * hst + u; const size_t off = ((size_t)b * SEQ + chunk * CHL + tt); O[off * OC + DA + ch] = (bf16_t)f2bf(hst * bf2f(GY[off * DR + ch])); }
        else { A *= a; Bc = a * Bc + u; }
    }
    if (!FINAL) { float* cp = comp + (((size_t)b * NCH + chunk) * DR + ch) * 2; cp[0] = A; cp[1] = Bc; }
    asm volatile("s_waitcnt lgkmcnt(0)" ::: "memory");
}
__device__ __forceinline__ void naive_scan_prefix_item(int idx, const float* __restrict__ comp, float* __restrict__ carry) {
    const int ch = idx % DR, b = idx / DR;
    float h = 0.f;
    for (int k = 0; k < NCH; ++k) { const size_t o = ((size_t)b * NCH + k) * DR + ch; carry[o] = h; h = comp[o * 2] * h + comp[o * 2 + 1]; }
}

__global__ void __launch_bounds__(NWAVES * 64, 2) mk_fwd(Args args) {
    extern __shared__ __attribute__((aligned(16))) unsigned char lds_raw[];
    LAS unsigned char* lds = (LAS unsigned char*)lds_raw;
    const int tid = threadIdx.x, lane = tid & 63, wave = __builtin_amdgcn_readfirstlane(tid >> 6);
    const int G = gridDim.x; const int bx = blockIdx.x; const int vcu = (G % 8 == 0) ? (bx % 8) * (G / 8) + bx / 8 : bx;
    unsigned char* ws = args.ws;
    unsigned* ctl = (unsigned*)(ws + WS_CTL);
    for (int u = tid; u < (LDS_BYTES - LDSCTL_OFF) / 4; u += NWAVES * 64) ((LAS unsigned*)(lds + LDSCTL_OFF))[u] = 0u;
    __syncthreads();
    volatile LAS unsigned* MISC = (volatile LAS unsigned*)(lds + MISC_OFF);
    const int lo = args.ph_lo, hi = args.ph_hi;
    XcdBarrier bar; bar.bar = ctl + CW_BAR; bar.x = 0; bar.st = nullptr;
    const bool multi = (hi - lo) > 1;
    if (multi) bar = xcd_barrier_post(ctl + CW_BAR, MISC + 8);
#define IN(k) (lo <= (k) && (k) < hi)
#define BOTH(k) (IN(k) && IN((k) + 1))
#define GRID_BAR() xcd_barrier(bar)

    const float* x = args.in[0];
    bf16_t* Wt_in = (bf16_t*)(ws + WS_WIN); bf16_t* Wt_cat = (bf16_t*)(ws + WS_WCAT); bf16_t* Wt_out = (bf16_t*)(ws + WS_WOUT);
    bf16_t* Wt_ff1 = (bf16_t*)(ws + WS_WFF1); bf16_t* Wt_ff2 = (bf16_t*)(ws + WS_WFF2);
    bf16_t* XN = (bf16_t*)(ws + WS_XN); bf16_t* Qb = (bf16_t*)(ws + WS_Q); bf16_t* Kb = (bf16_t*)(ws + WS_K); bf16_t* Vb = (bf16_t*)(ws + WS_V);
    bf16_t* XR = (bf16_t*)(ws + WS_XR); bf16_t* GY = (bf16_t*)(ws + WS_GY); bf16_t* GA = (bf16_t*)(ws + WS_GA); bf16_t* GR = (bf16_t*)(ws + WS_GR);
    bf16_t* MRG = (bf16_t*)(ws + WS_MRG); bf16_t* HB = (bf16_t*)(ws + WS_H);
    float* kmp = (float*)(ws + WS_KMP); float* ssq = (float*)(ws + WS_SSQ);
    bf16_t* OCAT = (bf16_t*)args.out;

    if ((PHMASK >> 0 & 1) && IN(0)) {
        LAS float* scr = (LAS float*)(lds + RING_OFF + wave * 16384);
        const int gw = vcu * NWAVES + wave, NGW = G * NWAVES;
        constexpr int I_IN = (DM / 64) * (DIN / 32), I_PA = (DA / 64) * (DM / 32), I_PR = (DR / 64) * (DM / 32), I_OUT = (DM / 64) * (DM / 32), I_F1 = (DM / 64) * (DFF / 32), I_F2 = (DFF / 64) * (DM / 32);
        constexpr int NITEMS = I_IN + I_PA + I_PR + I_OUT + I_F1 + I_F2;
        for (int it = gw; it < NITEMS; it += NGW) {
            int r = it;
            if (r < I_IN) { p0_transpose_item<1>(args.in[2], DIN, Wt_in, DM, 0, nullptr, scr, r, lane); continue; } r -= I_IN;
            if (r < I_PA) { p0_transpose_item<0>(args.in[14], DM, Wt_cat, OC, 0, nullptr, scr, r, lane); continue; } r -= I_PA;
            if (r < I_PR) { p0_transpose_item<0>(args.in[15], DM, Wt_cat, OC, DA, nullptr, scr, r, lane); continue; } r -= I_PR;
            if (r < I_OUT) { p0_transpose_item<0>(args.in[16], DM, Wt_out, DM, 0, nullptr, scr, r, lane); continue; } r -= I_OUT;
            if (r < I_F1) { p0_transpose_item<0>(args.in[18], DFF, Wt_ff1, DM, 0, args.in[17], scr, r, lane); continue; } r -= I_F1;
            p0_transpose_item<0>(args.in[19], DM, Wt_ff2, DFF, 0, nullptr, scr, r, lane);
        }
        for (int m = gw; m < M; m += NGW) rms_row_to_bf16(x + (size_t)m * DM, args.in[1], XN + (size_t)m * DM, lane);
        if (BOTH(0)) GRID_BAR();
    }
    if ((PHMASK >> 1 & 1) && IN(1)) {
        pg8::Gemm g{XN, Wt_in, DM, DM, DM, DIN, -1}; pg8::StaticOrder S; S.init(M, DIN, G, bx);
        pg8::EpiZ E{Qb, Kb, Vb, XR, GY, GA, GR, kmp, args.in[4], args.in[5], args.in[3]};
        pg8::gemm_phase<pg8::EpiZ, pg8::StaticOrder, false>(lds + RING_OFF, g, S, E);
        if (BOTH(1)) GRID_BAR();
    }
    {
        const float* cw = args.in[7]; const float* cb = args.in[8]; const float* Wa = args.in[9]; const float* ba = args.in[10]; const float* Wi = args.in[11]; const float* bi = args.in[12]; const float* lam = args.in[13];
        float* comp = (float*)(ws + WS_COMP); float* carry = (float*)(ws + WS_CARRY);
        LAS float* xcs = (LAS float*)(lds + RING_OFF + wave * 16384);
        const int gw = vcu * NWAVES + wave, NGW = G * NWAVES;
        if ((PHMASK >> 2 & 1) && IN(2)) {
            for (int idx = bx * (NWAVES * 64) + tid; idx < BATCH * NH * SEQ; idx += G * NWAVES * 64) naive_attn_item(idx, Qb, Kb, Vb, kmp, args.in[6], OCAT);
            for (int it = gw; it < BATCH * NCH * RB; it += NGW) naive_scan_item<false>(it, lane, xcs, XR, GY, cw, cb, Wa, ba, Wi, bi, lam, comp, carry, OCAT);
            if (BOTH(2)) GRID_BAR();
        }
        if ((PHMASK >> 3 & 1) && IN(3)) {
            for (int idx = bx * (NWAVES * 64) + tid; idx < BATCH * DR; idx += G * NWAVES * 64) naive_scan_prefix_item(idx, comp, carry);
            if (BOTH(3)) GRID_BAR();
        }
        if ((PHMASK >> 4 & 1) && IN(4)) {
            for (int it = gw; it < BATCH * NCH * RB; it += NGW) naive_scan_item<true>(it, lane, xcs, XR, GY, cw, cb, Wa, ba, Wi, bi, lam, comp, carry, OCAT);
            if (BOTH(4)) GRID_BAR();
        }
    }
    if ((PHMASK >> 5 & 1) && IN(5)) {
        pg8::Gemm g{OCAT, Wt_cat, OC, OC, OC, DM, DA / 64}; pg8::StaticOrder S; S.init(M, DM, G, bx);
        pg8::EpiMerge E{GA, GR, MRG};
        pg8::gemm_phase<pg8::EpiMerge, pg8::StaticOrder, MIDFLAG>(lds + RING_OFF, g, S, E);
        if (BOTH(5)) GRID_BAR();
    }
    if ((PHMASK >> 6 & 1) && IN(6)) {
        pg8::Gemm g{MRG, Wt_out, DM, DM, DM, DM, -1}; pg8::StaticOrder S; S.init(M, DM, G, bx);
        pg8::EpiX1 E{x, args.out, XN, ssq};
        pg8::gemm_phase<pg8::EpiX1, pg8::StaticOrder, false>(lds + RING_OFF, g, S, E);
        if (BOTH(6)) GRID_BAR();
    }
    if ((PHMASK >> 7 & 1) && IN(7)) {
        pg8::Gemm g{XN, Wt_ff1, DM, DM, DM, DFF, -1}; pg8::StaticOrder S; S.init(M, DFF, G, bx);
        pg8::EpiH E{ssq, HB};
        pg8::gemm_phase<pg8::EpiH, pg8::StaticOrder, false>(lds + RING_OFF, g, S, E);
        if (BOTH(7)) GRID_BAR();
    }
    if ((PHMASK >> 8 & 1) && IN(8)) {
        pg8::Gemm g{HB, Wt_ff2, DFF, DFF, DFF, DM, -1}; pg8::StaticOrder S; S.init(M, DM, G, bx);
        pg8::EpiOut E{args.out};
        pg8::gemm_phase<pg8::EpiOut, pg8::StaticOrder, false>(lds + RING_OFF, g, S, E);
    }
#undef IN
#undef BOTH
#undef GRID_BAR
}

constexpr int N_PHASES = 9;
extern "C" void kernel_launch(void* const* d_in, const int* in_sizes, int n_in, void* d_out, int out_size, void* d_ws, size_t ws_size, hipStream_t stream) {
    static int grid = 0;
    if (grid == 0) {
        if (n_in != 20 || in_sizes[0] != M * DM || out_size != M * DM || ws_size < WS_END) { fprintf(stderr, "kernel_launch: unexpected shapes (n_in %d, in0 %d, out %d, ws %zu)\n", n_in, n_in > 0 ? in_sizes[0] : -1, out_size, ws_size); grid = -1; return; }
        int dev = 0, cus = 0;
        if (hipGetDevice(&dev) != hipSuccess || hipDeviceGetAttribute(&cus, hipDeviceAttributeMultiprocessorCount, dev) != hipSuccess) { grid = -1; return; }
        if (hipFuncSetAttribute((const void*)mk_fwd, hipFuncAttributeMaxDynamicSharedMemorySize, LDS_BYTES) != hipSuccess) { fprintf(stderr, "kernel_launch: hipFuncSetAttribute failed\n"); grid = -1; return; }
        (void)hipGetLastError();
        grid = cus;
    }
    if (grid < 0) return;
    (void)hipMemsetAsync((char*)d_ws + WS_CTL, 0, CTL_ZERO_BYTES, stream);
    Args a{};
    for (int i = 0; i < 20; ++i) a.in[i] = (const float*)d_in[i];
    a.out = (float*)d_out; a.ws = (unsigned char*)d_ws;
#if MK_N_LAUNCHES == 1
    a.ph_lo = 0; a.ph_hi = N_PHASES;
    hipLaunchKernelGGL(mk_fwd, dim3(grid), dim3(NWAVES * 64), LDS_BYTES, stream, a);
#else
    for (int p = 0; p < N_PHASES; ++p) { a.ph_lo = p; a.ph_hi = p + 1; hipLaunchKernelGGL(mk_fwd, dim3(grid), dim3(NWAVES * 64), LDS_BYTES, stream, a); }
#endif
}
```

```cpp
#include <hip/hip_runtime.h>
#include <hip/hip_bf16.h>
#include <cstdio>
#include <cstdint>

#ifndef MIDFLAG
#define MIDFLAG true
#endif
#ifndef NAIVE_ATTN
#define NAIVE_ATTN 0
#endif
#ifndef NAIVE_SCAN
#define NAIVE_SCAN 1
#endif
#ifndef PHMASK
#define PHMASK 0xffff
#endif
#ifndef MK_N_LAUNCHES
#define MK_N_LAUNCHES 1
#endif

constexpr int BATCH = 8, SEQ = 4096, DM = 1024, M = BATCH * SEQ;
constexpr int NH = 8, HD = 64, DA = 512, DR = 1024, DFF = 4096, DIN = 5632;
constexpr int KBLK = 256, NKB = SEQ / KBLK;
constexpr int RB = 16, RBD = 64;
constexpr int OC = DA + DR;
constexpr float EPS = 1e-6f;
constexpr float LOG2E = 1.4426950408889634f;
constexpr float C2 = 0.125f * LOG2E;

#define LAS __attribute__((address_space(3)))
#define GAS __attribute__((address_space(1)))
typedef unsigned short bf16_t;
typedef short bf16x8 __attribute__((ext_vector_type(8)));
typedef float f32x4 __attribute__((ext_vector_type(4)));
typedef float f32x2 __attribute__((ext_vector_type(2)));
typedef unsigned u32x4 __attribute__((ext_vector_type(4)));
typedef unsigned u32x2 __attribute__((ext_vector_type(2)));

constexpr size_t MiB = 1u << 20;
constexpr size_t WS_CTL = 0, CTL_ZERO_BYTES = 1 * MiB;
constexpr size_t WS_WIN = 2 * MiB;
constexpr size_t WS_WCAT = 13 * MiB;
constexpr size_t WS_WOUT = 16 * MiB;
constexpr size_t WS_WFF1 = 18 * MiB;
constexpr size_t WS_WFF2 = 26 * MiB;
constexpr size_t WS_KMP = 34 * MiB;
constexpr size_t WS_SSQ = 35 * MiB;
constexpr size_t WS_COMP = 38 * MiB;
constexpr size_t WS_CARRY = 42 * MiB;
constexpr size_t WS_XN = 48 * MiB;
constexpr size_t WS_Q = 112 * MiB;
constexpr size_t WS_K = 144 * MiB;
constexpr size_t WS_V = 176 * MiB;
constexpr size_t WS_MRG = 144 * MiB;
constexpr size_t WS_XR = 208 * MiB;
constexpr size_t WS_GY = 272 * MiB;
constexpr size_t WS_GA = 336 * MiB;
constexpr size_t WS_GR = 400 * MiB;
constexpr size_t WS_H = 208 * MiB;
constexpr size_t WS_END = 464 * MiB;

constexpr int CW_TMO = 0, CW_BAR = 4096;

__device__ __forceinline__ float bf2f(unsigned short u) { return __uint_as_float(((unsigned)u) << 16); }
__device__ __forceinline__ unsigned f2bf(float f) { unsigned u = __builtin_bit_cast(unsigned, f); return (u + 0x7fffu + ((u >> 16) & 1u)) >> 16; }
__device__ __forceinline__ unsigned pk2(float lo, float hi) { return f2bf(lo) | (f2bf(hi) << 16); }
__device__ __forceinline__ unsigned cvt_pk_bf16(float lo, float hi) { unsigned r; asm volatile("v_cvt_pk_bf16_f32 %0, %1, %2" : "=v"(r) : "v"(lo), "v"(hi)); return r; }
__device__ __forceinline__ float fast_sigmoid(float x) { return __builtin_amdgcn_rcpf(1.0f + __builtin_amdgcn_exp2f(-LOG2E * x)); }
__device__ __forceinline__ float gelu_tanh(float x) { const float u = x + 0.044715f * x * x * x; return x * __builtin_amdgcn_rcpf(1.0f + __builtin_amdgcn_exp2f(-2.302208198f * u)); }
__device__ __forceinline__ float wave_sum(float v) {
#pragma unroll
    for (int o = 1; o < 64; o <<= 1) v += __shfl_xor(v, o);
    return v;
}
__device__ __forceinline__ int t5_bucket(int n) {
    if (n < 16) return n;
    int b = 16;
    b += (n >= 19); b += (n >= 21); b += (n >= 24); b += (n >= 27); b += (n >= 31); b += (n >= 35); b += (n >= 40); b += (n >= 46);
    b += (n >= 52); b += (n >= 59); b += (n >= 67); b += (n >= 77); b += (n >= 87); b += (n >= 99); b += (n >= 113);
    return b;
}

namespace pg8 {
constexpr int BM = 256, BK = 64, HALF = 128, HTB = HALF * BK * 2, STAGE_BYTES = 8 * HTB, NXCD = 8, WGM = 8;
__host__ __device__ __forceinline__ int lds_byte(int r, int c) { const int st = (r >> 4) * 2 + (c >> 5), rr = r & 15, cc = c & 31, ob = rr * 64 + cc * 2; return st * 1024 + (ob ^ (((ob >> 9) & 1) << 5)); }
__host__ __device__ __forceinline__ void stage_rc(int b, int& R, int& C) { const int st = b / 1024, sb = b % 1024, swz = sb ^ (((sb >> 9) & 1) << 5); R = (st >> 1) * 16 + swz / 64; C = (st & 1) * 32 + (swz % 64) / 2; }
__host__ __device__ __forceinline__ int perm32(int rho) { const int n = rho >> 4, i = rho & 15; return 8 * (i >> 2) + 4 * n + (i & 3); }

struct Unit { int pm, pn; };
struct Gemm { const bf16_t* A; const bf16_t* Bt; int lda, ldb, K, N, mid_t; };

struct StaticOrder {
    int nM, nN, nwg, G, c;
    __host__ __device__ void init(int M_, int N_, int G_, int c_) { nM = M_ / BM; nN = N_ / BM; nwg = nM * nN; G = G_; c = c_; }
    __host__ __device__ bool next(int i, Unit& u) const {
        const long L = (long)i * G + c; if (L >= nwg) return false;
        int wgid = (int)L; { const int q = nwg / NXCD, r = nwg % NXCD, xcd = wgid % NXCD, off = wgid / NXCD; wgid = (xcd < r ? xcd * (q + 1) : r * (q + 1) + (xcd - r) * q) + off; }
        const int nig = WGM * nN, gid = wgid / nig, fm = gid * WGM, gsz = (nM - fm) < WGM ? (nM - fm) : WGM;
        u.pm = fm + ((wgid % nig) % gsz); u.pn = (wgid % nig) / gsz; return true;
    }
};

typedef f32x4 Acc[2][2][4][2];

template <class Epi, class Sched, bool MID>
__device__ __forceinline__ void gemm_phase(LAS unsigned char* lds, const Gemm g, const Sched& S, const Epi& E) {
    const int tid = threadIdx.x, wid = __builtin_amdgcn_readfirstlane(tid >> 6), lane = tid & 63, wr = wid >> 2, wc = wid & 3, fr = lane & 15, fq = lane >> 4;
    const int nt = g.K / BK;
    unsigned voffA[2], voffB[2];
#pragma unroll
    for (int i = 0; i < 2; ++i) { int R, C; stage_rc(tid * 16 + i * 8192, R, C); const int Rb = Epi::PERM ? ((R & ~31) + perm32(R & 31)) : R;
        voffA[i] = (unsigned)(R * g.lda + C) * 2u; voffB[i] = (unsigned)(Rb * g.ldb + C) * 2u; }
    const size_t kstep = (size_t)(BK * 2);
    const size_t hstepA = (size_t)HALF * g.lda * 2, hstepB = (size_t)HALF * g.ldb * 2;
    const size_t tstepA = 2 * hstepA, tstepB = 2 * hstepB;
    const unsigned ldsw = (unsigned)wid * 1024u;
    const int aoff = lds_byte(wr * 64 + fr, fq * 8), boff = lds_byte(wc * 32 + fr, fq * 8);
#define PG8_SA(b, h) (((b) * 2 + (h)) * HTB)
#define PG8_SB(b, h) ((4 + (b) * 2 + (h)) * HTB)
#define PG8_STAGE(bufoff, gbase, voff) do { _Pragma("unroll") for (int _i = 0; _i < 2; ++_i) \
        __builtin_amdgcn_global_load_lds((const unsigned*)((const char*)(gbase) + (voff)[_i]), (LAS unsigned*)(lds + (bufoff) + ldsw + _i * 8192), 16, 0, 0); } while (0)
#define PG8_LDA(dst, b, h) do { _Pragma("unroll") for (int m = 0; m < 4; ++m) _Pragma("unroll") for (int k = 0; k < 2; ++k) dst[m][k] = *(const LAS bf16x8*)(lds + PG8_SA(b, h) + aoff + m * 2048 + k * 1024); } while (0)
#define PG8_LDB(dst, b, h) do { _Pragma("unroll") for (int n = 0; n < 2; ++n) _Pragma("unroll") for (int k = 0; k < 2; ++k) dst[n][k] = *(const LAS bf16x8*)(lds + PG8_SB(b, h) + boff + n * 2048 + k * 1024); } while (0)
#define PG8_MMA(ai, bj, At, Bt) do { __builtin_amdgcn_s_setprio(1); _Pragma("unroll") for (int m = 0; m < 4; ++m) _Pragma("unroll") for (int n = 0; n < 2; ++n) _Pragma("unroll") for (int k = 0; k < 2; ++k) \
        acc[ai][bj][m][n] = __builtin_amdgcn_mfma_f32_16x16x32_bf16(Bt[n][k], At[m][k], acc[ai][bj][m][n], 0, 0, 0); __builtin_amdgcn_s_setprio(0); } while (0)
#define PG8_WAIT_V(n) asm volatile("s_waitcnt vmcnt(" #n ")" ::: "memory")
#define PG8_WAIT_L(n) asm volatile("s_waitcnt lgkmcnt(" #n ")" ::: "memory")
#define PG8_BAR __builtin_amdgcn_s_barrier()
#define PG8_SCHED __builtin_amdgcn_sched_barrier(0)
    Unit cur, nxt; int ui = 0;
    if (!S.next(0, cur)) return;
    f32x4 acc[2][2][4][2];
#pragma unroll
    for (int a = 0; a < 2; ++a)
#pragma unroll
        for (int b = 0; b < 2; ++b)
#pragma unroll
            for (int m = 0; m < 4; ++m)
#pragma unroll
                for (int n = 0; n < 2; ++n) acc[a][b][m][n] = (f32x4){0.f, 0.f, 0.f, 0.f};
    bf16x8 At[4][2], B0[2][2], B1[2][2];
    const char* cA = (const char*)g.A + (size_t)cur.pm * tstepA; const char* cB = (const char*)g.Bt + (size_t)cur.pn * tstepB;
    PG8_STAGE(PG8_SB(0, 0), cB, voffB); PG8_STAGE(PG8_SB(0, 1), cB + hstepB, voffB); PG8_STAGE(PG8_SA(0, 0), cA, voffA); PG8_STAGE(PG8_SA(0, 1), cA + hstepA, voffA);
    if (wr == 1) PG8_BAR;
    PG8_WAIT_V(2); PG8_BAR;
    PG8_STAGE(PG8_SB(1, 0), cB + kstep, voffB); PG8_STAGE(PG8_SA(1, 0), cA + kstep, voffA); PG8_STAGE(PG8_SB(1, 1), cB + hstepB + kstep, voffB);
    PG8_WAIT_V(6); PG8_BAR;
    for (;;) {
        const bool has_next = S.next(ui + 1, nxt);
        const char* nA = has_next ? (const char*)g.A + (size_t)nxt.pm * tstepA : cA; const char* nB = has_next ? (const char*)g.Bt + (size_t)nxt.pn * tstepB : cB;
        for (int t = 0; t < nt; t += 2) {
            if constexpr (MID) { if (t == g.mid_t) E.mid(acc, cur, wr, wc, fr, fq); }
            const bool last = (t == nt - 2);
            const char* a1 = cA + (size_t)(t + 1) * kstep;
            const char* a2 = last ? nA : cA + (size_t)(t + 2) * kstep; const char* b2 = last ? nB : cB + (size_t)(t + 2) * kstep;
            const char* a3 = a2 + kstep; const char* b3 = b2 + kstep;
            PG8_LDB(B0, 0, 0); PG8_LDB(B1, 0, 1); PG8_SCHED; PG8_LDA(At, 0, 0); PG8_STAGE(PG8_SA(1, 1), a1 + hstepA, voffA);
            PG8_WAIT_V(8); PG8_WAIT_L(0); PG8_BAR; PG8_MMA(0, 0, At, B0); PG8_MMA(0, 1, At, B1); PG8_BAR; PG8_SCHED;
            PG8_LDA(At, 0, 1); PG8_STAGE(PG8_SB(0, 0), b2, voffB); PG8_STAGE(PG8_SB(0, 1), b2 + hstepB, voffB); PG8_STAGE(PG8_SA(0, 0), a2, voffA);
            PG8_WAIT_V(8); PG8_WAIT_L(0); PG8_BAR; PG8_MMA(1, 0, At, B0); PG8_MMA(1, 1, At, B1); PG8_BAR; PG8_SCHED;
            PG8_LDB(B0, 1, 0); PG8_LDB(B1, 1, 1); PG8_SCHED; PG8_LDA(At, 1, 0); PG8_STAGE(PG8_SA(0, 1), a2 + hstepA, voffA);
            PG8_WAIT_V(8); PG8_WAIT_L(0); PG8_BAR; PG8_MMA(0, 0, At, B0); PG8_MMA(0, 1, At, B1); PG8_BAR; PG8_SCHED;
            PG8_LDA(At, 1, 1); PG8_STAGE(PG8_SB(1, 0), b3, voffB); PG8_STAGE(PG8_SB(1, 1), b3 + hstepB, voffB); PG8_STAGE(PG8_SA(1, 0), a3, voffA);
            PG8_WAIT_V(8); PG8_WAIT_L(0); PG8_BAR; PG8_MMA(1, 0, At, B0); PG8_MMA(1, 1, At, B1); PG8_BAR; PG8_SCHED;
        }
        if (wr == 0) PG8_BAR;
        E(acc, cur, wr, wc, fr, fq);
        if (!has_next) break;
#pragma unroll
        for (int a = 0; a < 2; ++a)
#pragma unroll
            for (int b = 0; b < 2; ++b)
#pragma unroll
                for (int m = 0; m < 4; ++m)
#pragma unroll
                    for (int n = 0; n < 2; ++n) acc[a][b][m][n] = (f32x4){0.f, 0.f, 0.f, 0.f};
        cur = nxt; cA = nA; cB = nB; ++ui;
        if (wr == 1) PG8_BAR;
    }
    PG8_WAIT_V(0);
    PG8_BAR;
#undef PG8_SA
#undef PG8_SB
#undef PG8_STAGE
#undef PG8_LDA
#undef PG8_LDB
#undef PG8_MMA
#undef PG8_WAIT_V
#undef PG8_WAIT_L
#undef PG8_BAR
#undef PG8_SCHED
}

struct EpiZ {
    static constexpr bool PERM = true;
    bf16_t *Q, *K, *V, *XR, *GY, *GA, *GR; float* kmp; const float *qw, *kw, *bg;
    __device__ __forceinline__ void mid(Acc&, const Unit&, int, int, int, int) const {}
    __device__ __forceinline__ void operator()(Acc& acc, const Unit& u, int wr, int wc, int fr, int fq) const {
        const int pn = u.pn; const int row0 = u.pm * BM + wr * 64 + fr;
        if (pn < 4) {
            const bool isq = pn < 2; const int head = (pn & 1) * 4 + wc; const float* nw = isq ? qw : kw; const float osc = isq ? C2 : 1.0f;
            bf16_t* base = (isq ? Q : K) + head * HD + 8 * fq;
            f32x4 wv[2][2];
#pragma unroll
            for (int bj = 0; bj < 2; ++bj)
#pragma unroll
                for (int n = 0; n < 2; ++n) wv[bj][n] = *(const f32x4*)(nw + 32 * bj + 8 * fq + 4 * n) * osc;
            f32x4 cs[2][2];
#pragma unroll
            for (int bj = 0; bj < 2; ++bj)
#pragma unroll
                for (int n = 0; n < 2; ++n) cs[bj][n] = (f32x4){0.f, 0.f, 0.f, 0.f};
#pragma unroll
            for (int ai = 0; ai < 2; ++ai)
#pragma unroll
                for (int m = 0; m < 4; ++m) {
                    float ss = 0.f;
#pragma unroll
                    for (int bj = 0; bj < 2; ++bj)
#pragma unroll
                        for (int n = 0; n < 2; ++n) { const f32x4 v = acc[ai][bj][m][n]; ss += (v[0] * v[0] + v[1] * v[1]) + (v[2] * v[2] + v[3] * v[3]); }
                    ss += __shfl_xor(ss, 16); ss += __shfl_xor(ss, 32);
                    const float rstd = 1.0f / sqrtf(ss * (1.0f / 64.0f) + EPS);
                    bf16_t* rowp = base + (size_t)(row0 + ai * HALF + m * 16) * DA;
#pragma unroll
                    for (int bj = 0; bj < 2; ++bj) {
                        const f32x4 v0 = acc[ai][bj][m][0] * rstd * wv[bj][0], v1 = acc[ai][bj][m][1] * rstd * wv[bj][1];
                        cs[bj][0] += v0; cs[bj][1] += v1;
                        u32x4 w; w.x = cvt_pk_bf16(v0[0], v0[1]); w.y = cvt_pk_bf16(v0[2], v0[3]); w.z = cvt_pk_bf16(v1[0], v1[1]); w.w = cvt_pk_bf16(v1[2], v1[3]);
                        *(u32x4*)(rowp + 32 * bj) = w; }
                }
            if (!isq) {
#pragma unroll
                for (int bj = 0; bj < 2; ++bj)
#pragma unroll
                    for (int n = 0; n < 2; ++n)
#pragma unroll
                        for (int i = 0; i < 4; ++i) { float s = cs[bj][n][i]; s += __shfl_xor(s, 1); s += __shfl_xor(s, 2); s += __shfl_xor(s, 4); s += __shfl_xor(s, 8); cs[bj][n][i] = s; }
                if (fr == 0) { float* kp = kmp + (size_t)(u.pm * 2 + wr) * DA + head * HD + 8 * fq;
#pragma unroll
                    for (int bj = 0; bj < 2; ++bj) { *(f32x4*)(kp + 32 * bj) = cs[bj][0]; *(f32x4*)(kp + 32 * bj + 4) = cs[bj][1]; } }
            }
            return;
        }
        int mode, ldc, colt; bf16_t* base; const float* bias = nullptr;
        if (pn < 6) { base = V; ldc = DA; colt = (pn - 4) * BM; mode = 0; }
        else if (pn < 10) { base = XR; ldc = DR; colt = (pn - 6) * BM; mode = 0; }
        else if (pn < 14) { base = GY; ldc = DR; colt = (pn - 10) * BM; mode = 1; }
        else if (pn < 18) { base = GA; ldc = DM; colt = (pn - 14) * BM; mode = 2; bias = bg; }
        else { base = GR; ldc = DM; colt = (pn - 18) * BM; mode = 2; bias = bg + DM; }
        const int col0 = colt + wc * 32 + 8 * fq;
        f32x4 bv[2][2];
#pragma unroll
        for (int bj = 0; bj < 2; ++bj)
#pragma unroll
            for (int n = 0; n < 2; ++n) bv[bj][n] = bias ? *(const f32x4*)(bias + col0 + bj * HALF + 4 * n) : (f32x4){0.f, 0.f, 0.f, 0.f};
#pragma unroll
        for (int ai = 0; ai < 2; ++ai)
#pragma unroll
            for (int m = 0; m < 4; ++m) { bf16_t* rowp = base + (size_t)(row0 + ai * HALF + m * 16) * ldc + col0;
#pragma unroll
                for (int bj = 0; bj < 2; ++bj) { f32x4 v0 = acc[ai][bj][m][0] + bv[bj][0], v1 = acc[ai][bj][m][1] + bv[bj][1];
                    if (mode == 1) {
#pragma unroll
                        for (int i = 0; i < 4; ++i) { v0[i] = gelu_tanh(v0[i]); v1[i] = gelu_tanh(v1[i]); } }
                    else if (mode == 2) {
#pragma unroll
                        for (int i = 0; i < 4; ++i) { v0[i] = fast_sigmoid(v0[i]); v1[i] = fast_sigmoid(v1[i]); } }
                    u32x4 w; w.x = cvt_pk_bf16(v0[0], v0[1]); w.y = cvt_pk_bf16(v0[2], v0[3]); w.z = cvt_pk_bf16(v1[0], v1[1]); w.w = cvt_pk_bf16(v1[2], v1[3]);
                    *(u32x4*)(rowp + bj * HALF) = w; } }
    }
};

struct EpiMerge {
    static constexpr bool PERM = true;
    const bf16_t *GA, *GR; bf16_t* O;
    __device__ __forceinline__ void mid(Acc& acc, const Unit& u, int wr, int wc, int fr, int fq) const {
        int row0 = u.pm * BM + wr * 64 + fr, col0 = u.pn * BM + wc * 32 + 8 * fq;
        asm volatile("" : "+v"(row0), "+v"(col0));
#pragma unroll
        for (int ai = 0; ai < 2; ++ai)
#pragma unroll
            for (int m = 0; m < 4; ++m) { const size_t off = (size_t)(row0 + ai * HALF + m * 16) * DM + col0;
#pragma unroll
                for (int bj = 0; bj < 2; ++bj) { const u32x4 a = *(const u32x4*)(GA + off + bj * HALF), r = *(const u32x4*)(GR + off + bj * HALF);
#pragma unroll
                    for (int j = 0; j < 4; ++j) { const unsigned aw = a[j], rw = r[j];
                        const float f0 = __uint_as_float(aw << 16) * __builtin_amdgcn_rcpf(__uint_as_float(rw << 16));
                        const float f1 = __uint_as_float(aw & 0xffff0000u) * __builtin_amdgcn_rcpf(__uint_as_float(rw & 0xffff0000u));
                        acc[ai][bj][m][j >> 1][(j & 1) * 2] *= f0; acc[ai][bj][m][j >> 1][(j & 1) * 2 + 1] *= f1; } }
                asm volatile("" ::: "memory"); }
    }
    __device__ __forceinline__ void operator()(Acc& acc, const Unit& u, int wr, int wc, int fr, int fq) const {
        const int row0 = u.pm * BM + wr * 64 + fr, col0 = u.pn * BM + wc * 32 + 8 * fq;
#pragma unroll
        for (int ai = 0; ai < 2; ++ai)
#pragma unroll
            for (int m = 0; m < 4; ++m) { const size_t off = (size_t)(row0 + ai * HALF + m * 16) * DM + col0;
#pragma unroll
                for (int bj = 0; bj < 2; ++bj) { const u32x4 r = *(const u32x4*)(GR + off + bj * HALF); u32x4 w;
#pragma unroll
                    for (int j = 0; j < 4; ++j) { const unsigned rw = r[j];
                        const float v0 = acc[ai][bj][m][j >> 1][(j & 1) * 2] * __uint_as_float(rw << 16), v1 = acc[ai][bj][m][j >> 1][(j & 1) * 2 + 1] * __uint_as_float(rw & 0xffff0000u);
                        w[j] = cvt_pk_bf16(v0, v1); }
                    *(u32x4*)(O + off + bj * HALF) = w; }
                if (m & 1) asm volatile("" ::: "memory"); }
    }
};

struct EpiX1 {
    static constexpr bool PERM = false;
    const float* X; float* X1; bf16_t* XN2; float* ssq;
    __device__ __forceinline__ void mid(Acc&, const Unit&, int, int, int, int) const {}
    __device__ __forceinline__ void operator()(Acc& acc, const Unit& u, int wr, int wc, int fr, int fq) const {
        const int row0 = u.pm * BM + wr * 64 + fr, col0 = u.pn * BM + wc * 32 + 4 * fq;
#pragma unroll
        for (int ai = 0; ai < 2; ++ai)
#pragma unroll
            for (int m = 0; m < 4; ++m) { const int row = row0 + ai * HALF + m * 16; const size_t off = (size_t)row * DM + col0; float ss = 0.f;
#pragma unroll
                for (int bj = 0; bj < 2; ++bj)
#pragma unroll
                    for (int n = 0; n < 2; ++n) { const f32x4 xv = *(const f32x4*)(X + off + bj * HALF + n * 16); const f32x4 v = acc[ai][bj][m][n] + xv;
                        *(f32x4*)(X1 + off + bj * HALF + n * 16) = v;
                        u32x2 w; w.x = cvt_pk_bf16(v[0], v[1]); w.y = cvt_pk_bf16(v[2], v[3]); *(u32x2*)(XN2 + off + bj * HALF + n * 16) = w;
                        ss += (v[0] * v[0] + v[1] * v[1]) + (v[2] * v[2] + v[3] * v[3]); }
                ss += __shfl_xor(ss, 16); ss += __shfl_xor(ss, 32);
                if (fq == 0) ssq[(size_t)row * 16 + u.pn * 4 + wc] = ss;
                if (m & 1) asm volatile("" ::: "memory"); }
    }
};

struct EpiH {
    static constexpr bool PERM = true;
    const float* ssq; bf16_t* H;
    __device__ __forceinline__ void mid(Acc&, const Unit&, int, int, int, int) const {}
    __device__ __forceinline__ void operator()(Acc& acc, const Unit& u, int wr, int wc, int fr, int fq) const {
        const int row0 = u.pm * BM + wr * 64 + fr, col0 = u.pn * BM + wc * 32 + 8 * fq;
#pragma unroll
        for (int ai = 0; ai < 2; ++ai)
#pragma unroll
            for (int m = 0; m < 4; ++m) { const int row = row0 + ai * HALF + m * 16;
                const f32x4 s0 = *(const f32x4*)(ssq + (size_t)row * 16), s1 = *(const f32x4*)(ssq + (size_t)row * 16 + 4), s2 = *(const f32x4*)(ssq + (size_t)row * 16 + 8), s3 = *(const f32x4*)(ssq + (size_t)row * 16 + 12);
                const float tot = (((s0[0] + s0[1]) + (s0[2] + s0[3])) + ((s1[0] + s1[1]) + (s1[2] + s1[3]))) + (((s2[0] + s2[1]) + (s2[2] + s2[3])) + ((s3[0] + s3[1]) + (s3[2] + s3[3])));
                const float rstd = 1.0f / sqrtf(tot * (1.0f / DM) + EPS);
                bf16_t* rowp = H + (size_t)row * DFF + col0;
#pragma unroll
                for (int bj = 0; bj < 2; ++bj) { f32x4 v0 = acc[ai][bj][m][0] * rstd, v1 = acc[ai][bj][m][1] * rstd;
#pragma unroll
                    for (int i = 0; i < 4; ++i) { const float a = fmaxf(v0[i], 0.f), b = fmaxf(v1[i], 0.f); v0[i] = a * a; v1[i] = b * b; }
                    u32x4 w; w.x = cvt_pk_bf16(v0[0], v0[1]); w.y = cvt_pk_bf16(v0[2], v0[3]); w.z = cvt_pk_bf16(v1[0], v1[1]); w.w = cvt_pk_bf16(v1[2], v1[3]);
                    *(u32x4*)(rowp + bj * HALF) = w; }
                if (m & 1) asm volatile("" ::: "memory"); }
    }
};

struct EpiOut {
    static constexpr bool PERM = false;
    float* X1;
    __device__ __forceinline__ void mid(Acc&, const Unit&, int, int, int, int) const {}
    __device__ __forceinline__ void operator()(Acc& acc, const Unit& u, int wr, int wc, int fr, int fq) const {
        const int row0 = u.pm * BM + wr * 64 + fr, col0 = u.pn * BM + wc * 32 + 4 * fq;
#pragma unroll
        for (int ai = 0; ai < 2; ++ai)
#pragma unroll
            for (int m = 0; m < 4; ++m) { const size_t off = (size_t)(row0 + ai * HALF + m * 16) * DM + col0;
#pragma unroll
                for (int bj = 0; bj < 2; ++bj)
#pragma unroll
                    for (int n = 0; n < 2; ++n) { const f32x4 xv = *(const f32x4*)(X1 + off + bj * HALF + n * 16); *(f32x4*)(X1 + off + bj * HALF + n * 16) = acc[ai][bj][m][n] + xv; }
                if (m & 1) asm volatile("" ::: "memory"); }
    }
};
}

#define XB_TMO      128
#define XB_XCNT(j)  (256  + 64 * (j))
#define XB_XSUB(j)  (1280 + 64 * (j))
#define XB_XGEN(j)  (2304 + 64 * (j))
#define XB_TOP      3328
#define XB_TOPGEN   3392
#define XCD_BAR_WORDS 3456
#define XB_SPIN_CAP (1u << 18)
__device__ __forceinline__ unsigned xb_ld(unsigned* p)              { return __hip_atomic_load(p, __ATOMIC_RELAXED, __HIP_MEMORY_SCOPE_AGENT); }
__device__ __forceinline__ unsigned xb_add(unsigned* p, unsigned v) { return __hip_atomic_fetch_add(p, v, __ATOMIC_RELAXED, __HIP_MEMORY_SCOPE_AGENT); }
__device__ __forceinline__ unsigned xb_xcc_id() { return (unsigned)__builtin_amdgcn_s_getreg((3 << 11) | 20) & 0xFu; }
#define XB_SPIN(cond, bar) do { unsigned _sp = 0; while (cond) { __builtin_amdgcn_s_sleep(1); \
    if ((++_sp & 255u) == 0u) { if (xb_ld(&(bar)[XB_TMO])) break; if (_sp > XB_SPIN_CAP) { atomicAdd(&(bar)[XB_TMO], 1u); break; } } } } while (0)
struct XcdBarrier { unsigned* bar; unsigned x; volatile LAS unsigned* st; };
__device__ __forceinline__ XcdBarrier xcd_barrier_post(unsigned* bar, volatile LAS unsigned* st) {
    XcdBarrier b; b.bar = bar; b.x = xb_xcc_id(); b.st = st;
    if (threadIdx.x == 0) (void)xb_add(&bar[XB_XCNT(b.x)], 1u);
    return b;
}
__device__ __forceinline__ void xcd_barrier_complete(unsigned* bar, unsigned x, unsigned& nloc, unsigned& nx) {
    const unsigned G = gridDim.x * gridDim.y * gridDim.z;
    unsigned sum, cnt, mine, sp = 0u;
    for (;;) {
        sum = 0u; cnt = 0u; mine = 0u;
#pragma unroll
        for (unsigned j = 0; j < 16; ++j) { const unsigned c = xb_ld(&bar[XB_XCNT(j)]); sum += c; cnt += (c > 0u) ? 1u : 0u; mine = (j == x) ? c : mine; }
        if (sum == G) break;
        __builtin_amdgcn_s_sleep(1);
        if ((++sp & 255u) == 0u) { if (xb_ld(&bar[XB_TMO])) break; if (sp > XB_SPIN_CAP) { atomicAdd(&bar[XB_TMO], 1u); break; } }
    }
    nloc = mine > 0u ? mine : 1u; nx = cnt > 0u ? cnt : 1u;
}
__device__ __forceinline__ void xcd_barrier(const XcdBarrier& b) {
    asm volatile("s_waitcnt vmcnt(0)" ::: "memory");
    __syncthreads();
    if (threadIdx.x == 0) {
        unsigned* bar = b.bar;
        __builtin_amdgcn_s_waitcnt(0);
        unsigned nloc = b.st[0], nx = b.st[1];
        if (nloc == 0u) { xcd_barrier_complete(bar, b.x, nloc, nx); b.st[0] = nloc; b.st[1] = nx; }
        const unsigned old = xb_add(&bar[XB_XSUB(b.x)], 1u);
        const unsigned gen = old / nloc;
        if (old + 1u == (gen + 1u) * nloc) {
            __builtin_amdgcn_fence(__ATOMIC_RELEASE, "agent");
            asm volatile("s_waitcnt vmcnt(0)" ::: "memory");
            const unsigned og = xb_add(&bar[XB_TOP], 1u);
            const unsigned tg = og / nx;
            if (og + 1u == (tg + 1u) * nx) xb_add(&bar[XB_TOPGEN], 1u);
            else XB_SPIN(xb_ld(&bar[XB_TOPGEN]) == tg, bar);
            __builtin_amdgcn_fence(__ATOMIC_ACQUIRE, "agent");
            xb_add(&bar[XB_XGEN(b.x)], 1u);
            asm volatile("s_waitcnt vmcnt(0)" ::: "memory");
        } else {
            XB_SPIN(xb_ld(&bar[XB_XGEN(b.x)]) == gen, bar);
            __builtin_amdgcn_fence(__ATOMIC_ACQUIRE, "agent");
            asm volatile("s_waitcnt vmcnt(0)" ::: "memory");
        }
    }
    __syncthreads();
}

constexpr int RING_OFF = 0, RING_BYTES = 131072;
constexpr int LDSCTL_OFF = RING_BYTES, MISC_OFF = LDSCTL_OFF + 320;
constexpr int LDS_BYTES = 147456;
constexpr int NWAVES = 8;

struct Args { const float* in[20]; float* out; unsigned char* ws; int ph_lo, ph_hi; };

template <int RMAP>
__device__ __forceinline__ int p0_rowmap(int n) {
    if (RMAP == 1) { if (n < 1024) { const int pn = n >> 8, lc = n & 255, hh = lc >> 6, d = lc & 63; return pn * 256 + 128 * (d >> 5) + 32 * hh + (d & 31); } return n; }
    return n;
}
template <int RMAP>
__device__ __forceinline__ void p0_transpose_item(const float* W, int N, bf16_t* WT, int ldt, int koff, const float* kscale, LAS float* scr, int item, int lane) {
    const int nblk = N / 32, kb = item / nblk, nb = item % nblk, k0 = 64 * kb, n0 = 32 * nb;
#pragma unroll 8
    for (int i = 0; i < 32; ++i) { const int kk = 2 * i + (lane >> 5); float v = W[(size_t)(k0 + kk) * N + n0 + (lane & 31)]; if (kscale) v *= kscale[k0 + kk]; scr[kk * 33 + (lane & 31)] = v; }
    asm volatile("s_waitcnt lgkmcnt(0)" ::: "memory");
    const int c = lane & 7;
#pragma unroll
    for (int j = 0; j < 4; ++j) { const int n = (lane >> 3) + 8 * j; const LAS float* s = scr + (8 * c) * 33 + n;
        u32x4 o; o.x = pk2(s[0 * 33], s[1 * 33]); o.y = pk2(s[2 * 33], s[3 * 33]); o.z = pk2(s[4 * 33], s[5 * 33]); o.w = pk2(s[6 * 33], s[7 * 33]);
        *(u32x4*)(WT + (size_t)p0_rowmap<RMAP>(n0 + n) * ldt + koff + k0 + 8 * c) = o; }
    asm volatile("s_waitcnt lgkmcnt(0)" ::: "memory");
}
__device__ __forceinline__ void rms_row_to_bf16(const float* xrow, const float* w, bf16_t* orow, int lane) {
    const f32x4* xr = (const f32x4*)xrow + lane; const f32x4* wr = (const f32x4*)w + lane;
    f32x4 v[4]; float s = 0.f;
#pragma unroll
    for (int j = 0; j < 4; ++j) { v[j] = xr[64 * j]; s += (v[j].x * v[j].x + v[j].y * v[j].y) + (v[j].z * v[j].z + v[j].w * v[j].w); }
    const float rstd = 1.f / sqrtf(wave_sum(s) * (1.f / DM) + EPS);
    unsigned long long* o8 = (unsigned long long*)orow + lane;
#pragma unroll
    for (int j = 0; j < 4; ++j) { const f32x4 ww = wr[64 * j];
        o8[64 * j] = (unsigned long long)pk2(v[j].x * rstd * ww.x, v[j].y * rstd * ww.y) | ((unsigned long long)pk2(v[j].z * rstd * ww.z, v[j].w * rstd * ww.w) << 32); }
}

namespace attn_body {
using bf16=__hip_bfloat16;
using s16x4=__attribute__((ext_vector_type(4)))short;
using f32x16=__attribute__((ext_vector_type(16)))float;
constexpr int D=64,PQ=::DA,PO=::OC;
constexpr int NW=8,QBLK=32,QB=QBLK*NW,KVBLK=64,NQB=::SEQ/QB;
constexpr int TAB_N=384, LDS_TAB=86016;
__device__ __forceinline__ int crow(int r,int hi){return (r&3)+8*(r>>2)+4*hi;}
#define SBAR() __builtin_amdgcn_sched_barrier(0)
__device__ __forceinline__ void bmask(f32x16&p0,f32x16&p1,int jb,int qrel,int hi,const __attribute__((address_space(3))) float*tab){
  const int base=qrel-64*jb-4*hi+255;
  #pragma unroll
  for(int r=0;r<16;++r){const int i0=base-((r&3)+8*(r>>2)); const int j0=i0<368?i0:368; const int i1=i0-32; const int j1=i1<368?i1:368; p0[r]+=tab[j0]; p1[r]+=tab[j1];}
}

constexpr int NSLOT=3, SLOTB=8192;
constexpr int LDS_K=0, LDS_V=NSLOT*SLOTB, LDS_WS=2*NSLOT*SLOTB, LDS_OST=LDS_WS+NW*64*4, LDS_BYTES=LDS_OST+NW*4096;
__device__ __forceinline__ void glds16(const void*gsrc,unsigned lds_dst){unsigned keep;
  asm volatile("s_mov_b32 %0, m0\n\ts_mov_b32 m0, %2\n\ts_nop 0\n\tglobal_load_lds_dwordx4 %1, off\n\ts_mov_b32 m0, %0":"=&s"(keep):"v"(gsrc),"s"(lds_dst):"memory");}
__device__ __forceinline__ float max3f(float a,float b,float c){float r;asm("v_max3_f32 %0, %1, %2, %3":"=v"(r):"v"(a),"v"(b),"v"(c));return r;}
__device__ __forceinline__ float max2f(float a,float b){float r;asm("v_max_f32_e32 %0, %1, %2":"=v"(r):"v"(a),"v"(b));return r;}
__device__ __forceinline__ float fadd_s(float a,float b){float r;asm("v_add_f32_e32 %0, %1, %2":"=v"(r):"v"(a),"v"(b));return r;}
__device__ __forceinline__ float fsub_s(float a,float b){float r;asm("v_sub_f32_e32 %0, %1, %2":"=v"(r):"v"(a),"v"(b));return r;}
typedef float f32x2_t __attribute__((ext_vector_type(2))); typedef __bf16 bf16x2_t __attribute__((ext_vector_type(2)));
__device__ __forceinline__ unsigned cvtpk_s(float lo,float hi){f32x2_t v={lo,hi};bf16x2_t b=__builtin_convertvector(v,bf16x2_t);return __builtin_bit_cast(unsigned,b);}
#define WAIT_BAR(N) asm volatile("s_waitcnt vmcnt(" #N ") lgkmcnt(0)\n\ts_barrier":::"memory")

__device__ __forceinline__ void qkt(f32x16&p0,f32x16&p1,const char*Kslot,const bf16x8*qr,const f32x16&negm,int r32,int hi){
  const char*kb=Kslot+hi*1024+r32*16;
  #pragma unroll
  for(int d0=0;d0<4;++d0){
    const bf16x8 b0=*reinterpret_cast<const bf16x8*>(kb+d0*2048);
    const bf16x8 b1=*reinterpret_cast<const bf16x8*>(kb+d0*2048+512);
    if(d0==0){p0=__builtin_amdgcn_mfma_f32_32x32x16_bf16(b0,qr[0],negm,0,0,0);p1=__builtin_amdgcn_mfma_f32_32x32x16_bf16(b1,qr[0],negm,0,0,0);}
    else{p0=__builtin_amdgcn_mfma_f32_32x32x16_bf16(b0,qr[d0],p0,0,0,0);p1=__builtin_amdgcn_mfma_f32_32x32x16_bf16(b1,qr[d0],p1,0,0,0);}}
}
typedef __attribute__((address_space(3))) const char* lds_cptr;
typedef short v4i16_t __attribute__((ext_vector_type(4)));
__device__ __forceinline__ void kload8(bf16x8*kf,lds_cptr kp){
  kf[0]=*(const __attribute__((address_space(3))) bf16x8*)(kp);      kf[1]=*(const __attribute__((address_space(3))) bf16x8*)(kp+512);
  kf[2]=*(const __attribute__((address_space(3))) bf16x8*)(kp+2048); kf[3]=*(const __attribute__((address_space(3))) bf16x8*)(kp+2560);
  kf[4]=*(const __attribute__((address_space(3))) bf16x8*)(kp+4096); kf[5]=*(const __attribute__((address_space(3))) bf16x8*)(kp+4608);
  kf[6]=*(const __attribute__((address_space(3))) bf16x8*)(kp+6144); kf[7]=*(const __attribute__((address_space(3))) bf16x8*)(kp+6656);
}
__device__ __forceinline__ void kload2(bf16x8*kf,lds_cptr kp,int j){ kf[2*j]=*(const __attribute__((address_space(3))) bf16x8*)(kp+j*2048); kf[2*j+1]=*(const __attribute__((address_space(3))) bf16x8*)(kp+j*2048+512); }
__device__ __forceinline__ s16x4 vtr(lds_cptr p){ return __builtin_bit_cast(s16x4,__builtin_amdgcn_ds_read_tr16_b64_v4i16((__attribute__((address_space(3))) v4i16_t*)p)); }
__device__ __forceinline__ float rowmax(const f32x16&p0,const f32x16&p1){
  float a=max3f(p0[0],p0[1],p1[0]),b=max3f(p0[2],p0[3],p1[1]);a=max3f(a,p1[2],p1[3]);
  #pragma unroll
  for(int r=4;r<16;r+=4){a=max3f(a,p0[r],p0[r+1]);b=max3f(b,p0[r+2],p0[r+3]);a=max3f(a,p1[r],p1[r+1]);b=max3f(b,p1[r+2],p1[r+3]);}
  const float m=max2f(a,b);
  auto rr=__builtin_amdgcn_permlane32_swap(__float_as_uint(m),__float_as_uint(m),false,false);
  return max2f(__uint_as_float(rr[0]),__uint_as_float(rr[1]));
}
__device__ __forceinline__ void pv(f32x16*o,int vb,bf16x8 pa0,bf16x8 pa1,bf16x8 pa2,bf16x8 pa3){
  #pragma unroll
  for(int d0=0;d0<2;++d0){s16x4 lo[4],hi[4];
    #pragma unroll
    for(int ks=0;ks<4;++ks){
      asm volatile("ds_read_b64_tr_b16 %0,%1 offset:%c2":"=&v"(lo[ks]):"v"(vb),"i"(d0*4096+ks*1024):"memory");
      asm volatile("ds_read_b64_tr_b16 %0,%1 offset:%c2":"=&v"(hi[ks]):"v"(vb),"i"(d0*4096+ks*1024+512):"memory");}
    asm volatile("s_waitcnt lgkmcnt(0)":::"memory");SBAR();
    #define PK(k) (bf16x8){lo[k][0],lo[k][1],lo[k][2],lo[k][3],hi[k][0],hi[k][1],hi[k][2],hi[k][3]}
    o[d0]=__builtin_amdgcn_mfma_f32_32x32x16_bf16(pa0,PK(0),o[d0],0,0,0);
    o[d0]=__builtin_amdgcn_mfma_f32_32x32x16_bf16(pa1,PK(1),o[d0],0,0,0);
    o[d0]=__builtin_amdgcn_mfma_f32_32x32x16_bf16(pa2,PK(2),o[d0],0,0,0);
    o[d0]=__builtin_amdgcn_mfma_f32_32x32x16_bf16(pa3,PK(3),o[d0],0,0,0);
    #undef PK
  }
}

#ifndef ATTN_STORE16
#define ATTN_STORE16(p,v) (*(u32x4*)(p)=(v))
#endif
template<int THRL> __device__ __forceinline__ void attn_unit(int b,int h,int qb,const bf16*Q,const bf16*__restrict__ K,const bf16*__restrict__ V,const float*__restrict__ kmp,bf16*O,char*shm){
  const int tid=threadIdx.x,lane=tid&63,r32=lane&31,hi=lane>>5; const int wid=__builtin_amdgcn_readfirstlane(tid>>6);
  const long rowbase=(long)b*::SEQ; const int q0=qb*QB;
  const bf16*Qw=Q+(rowbase+q0+wid*QBLK)*PQ+h*D;
  const bf16*Kh=K+rowbase*PQ+h*D,*Vh=V+rowbase*PQ+h*D;
  const unsigned lds0=(unsigned)(uintptr_t)shm;
  float*wsf=(float*)(shm+LDS_WS)+wid*64;
  const bf16*ksrc=Kh+(long)lane*PQ+wid*8;
  const bf16*vsrc=Vh+(long)(16*(wid&3)+(lane>>2))*PQ+(wid>>2)*32+(lane&3)*8;
  const unsigned kdst=lds0+LDS_K+wid*1024, vdst=lds0+LDS_V+wid*1024;
  #define TOFF(t) ((long)(((t)<4)?(q0+KVBLK*(t)):(KVBLK*((t)-4)))*PQ)
  #define DMA_K(t,slot) glds16(ksrc+TOFF(t),(unsigned)__builtin_amdgcn_readfirstlane(kdst+(slot)))
  #define DMA_V(t,slot) glds16(vsrc+TOFF(t),(unsigned)__builtin_amdgcn_readfirstlane(vdst+(slot)))
  const int vb0=(int)(lds0+LDS_V)+((lane>>4)&1)*32+(lane&3)*8+(4*hi+((lane&15)>>2))*64;
  const char*Kbase=shm+LDS_K; bf16x8 kf[8];
  const lds_cptr shm3=(lds_cptr)shm; const lds_cptr kp0=shm3+LDS_K+hi*1024+r32*16; const lds_cptr vp0=shm3+LDS_V+((lane>>4)&1)*32+(lane&3)*8+(4*hi+((lane&15)>>2))*64;
  const int NT=(q0+QB)/KVBLK;
  DMA_K(0,0);DMA_V(0,0);DMA_K(1,SLOTB);
  bf16x8 qr[4];
  #pragma unroll
  for(int d0=0;d0<4;++d0)qr[d0]=*reinterpret_cast<const bf16x8*>(&Qw[(long)r32*PQ+d0*16+hi*8]);
  float mhat=0.f,l_reg=0.f;f32x16 o[2];o[0]=f32x16{};o[1]=f32x16{};f32x16 negm=f32x16{};asm volatile("":"+v"(negm));
  const int qrel=wid*QBLK+r32;
  const __attribute__((address_space(3))) float*tab=(const __attribute__((address_space(3))) float*)((lds_cptr)shm+LDS_TAB)+h*TAB_N;
  unsigned selmask=0u;
  if(qb>0){
    f32x16 gacc=f32x16{};
    const float*kmA=kmp+((size_t)(b*::NKB+(r32&15))*2)*::DA+h*D+hi*8;
    #pragma unroll
    for(int d0=0;d0<4;++d0){ const float*p=kmA+d0*16;
      const f32x4 a0=*(const f32x4*)p,a1=*(const f32x4*)(p+4),b0=*(const f32x4*)(p+::DA),b1=*(const f32x4*)(p+::DA+4);
      float v[8]; v[0]=a0[0]+b0[0];v[1]=a0[1]+b0[1];v[2]=a0[2]+b0[2];v[3]=a0[3]+b0[3];v[4]=a1[0]+b1[0];v[5]=a1[1]+b1[1];v[6]=a1[2]+b1[2];v[7]=a1[3]+b1[3];
      u32x4 wh,wl;
      #pragma unroll
      for(int j=0;j<4;++j){ const unsigned h0=::f2bf(v[2*j]),h1=::f2bf(v[2*j+1]); wh[j]=h0|(h1<<16);
        const float r0=v[2*j]-__uint_as_float(h0<<16),r1=v[2*j+1]-__uint_as_float(h1<<16); wl[j]=::f2bf(r0)|(::f2bf(r1)<<16); }
      gacc=__builtin_amdgcn_mfma_f32_32x32x16_bf16(__builtin_bit_cast(bf16x8,wh),qr[d0],gacc,0,0,0);
      gacc=__builtin_amdgcn_mfma_f32_32x32x16_bf16(__builtin_bit_cast(bf16x8,wl),qr[d0],gacc,0,0,0); }
    float g[16];
    #pragma unroll
    for(int r=0;r<4;++r){ const float m0=gacc[r],o0=__shfl_xor(m0,32),m1=gacc[4+r],o1=__shfl_xor(m1,32);
      g[r]=hi?o0:m0; g[4+r]=hi?m0:o0; g[8+r]=hi?o1:m1; g[12+r]=hi?m1:o1; }
    #pragma unroll
    for(int j=0;j<16;++j) if(j>=qb) g[j]=-INFINITY;
    #pragma unroll
    for(int rd=0;rd<3;++rd){ float best=-INFINITY; int bi=-1;
      #pragma unroll
      for(int j=0;j<16;++j) if(g[j]>best){best=g[j];bi=j;}
      if(bi>=0) selmask|=1u<<bi;
      #pragma unroll
      for(int j=0;j<16;++j) if(j==bi) g[j]=-INFINITY; }
  }
  #define SELT(t) (((t)<4)||((selmask>>(((t)-4)>>2))&1u))
  #define CMASK(P0,P1,t) do{ if((t)<4) bmask(P0,P1,(t),qrel,hi,tab); else if((t)>=NT-2) bmask(P0,P1,0,qrel+128-64*((t)-(NT-2)),hi,tab); }while(0)
  bool resc=false;
  #define START(P0,P1) do{ const float rm=rowmax(P0,P1); resc=false; \
    { const float dl=rm; mhat=fadd_s(mhat,dl); \
      _Pragma("unroll") for(int r=0;r<16;++r){P0[r]=fsub_s(P0[r],dl);P1[r]=fsub_s(P1[r],dl);} \
      _Pragma("unroll") for(int r=0;r<16;++r)negm[r]=-mhat; asm volatile("":"+v"(negm)); } \
    _Pragma("unroll") for(int r=0;r<16;++r)P0[r]=__builtin_amdgcn_exp2f(P0[r]); }while(0)
  #define RESC() do{ if(resc){ asm volatile("s_waitcnt lgkmcnt(0)":::"memory"); \
      _Pragma("unroll") for(int d_=0;d_<2;++d_) _Pragma("unroll") for(int r=0;r<16;++r)o[d_][r]*=wsf[crow(r,hi)]; } }while(0)
  f32x16 pA0,pA1,pB0,pB1;
  int sl_prev=0,sl_cur=0,sl_next=SLOTB;
  #define ROT() do{sl_prev=sl_cur;sl_cur=sl_next;sl_next=(sl_next==(NSLOT-1)*SLOTB)?0:sl_next+SLOTB;}while(0)
  DMA_K(2,2*SLOTB);
  WAIT_BAR(3);
  qkt(pA0,pA1,Kbase,qr,negm,r32,hi);asm volatile("s_nop 15\n\ts_nop 7":"+v"(pA0),"+v"(pA1));CMASK(pA0,pA1,0);
  START(pA0,pA1);
  _Pragma("unroll") for(int r=0;r<16;++r)pA1[r]=__builtin_amdgcn_exp2f(pA1[r]);
  WAIT_BAR(0);
  DMA_K(3,0);DMA_V(1,SLOTB);
  ROT();
  kload8(kf,kp0+sl_cur);
  WAIT_BAR(2);
  s16x4 vlo[8],vhi[8]; u32x4 pw0,pw1,pw2,pw3;
  #define PKW(P,B) cvtpk_s(P[B],P[B+1])
  #define PAF(k) __builtin_bit_cast(bf16x8,pw##k)
  #define VFR(i) (bf16x8){vlo[i][0],vlo[i][1],vlo[i][2],vlo[i][3],vhi[i][0],vhi[i][1],vhi[i][2],vhi[i][3]}
  #define PIN(x) asm volatile("":"+v"(x))
  #define MX3(a,b,c) __builtin_fmaxf(__builtin_fmaxf((a),(b)),(c))
  #define GAPA(MF,A0,A1,A2,A3,W0,W1,PW) do{ MF; sacc+=A0; sacc+=A1; sacc+=A2; sacc+=A3; PIN(sacc); W0; W1; PIN(PW); SBAR(); }while(0)
  #define EX(v) __builtin_amdgcn_exp2f(v)
  #define GAPB(MF,X,B) do{ MF; X[B]=EX(X[B]); X[B+1]=EX(X[B+1]); X[B+2]=EX(X[B+2]); X[B+3]=EX(X[B+3]); PIN(X); SBAR(); }while(0)
  #define VRD(i) do{ vlo[i]=vtr(vp_+(((i)>>2)*4096+((i)&3)*1024)); vhi[i]=vtr(vp_+(((i)>>2)*4096+((i)&3)*1024+512)); }while(0)
  #define KRD(G,j) do{ if(G){ kload2(kf,kp0+sl_next,j); SBAR(); } }while(0)
  #define STEP(C0,C1,P0,P1,t,GK,GV,GL) do{ SBAR(); \
    { const float nv_=SELT(t)?-mhat:-INFINITY; _Pragma("unroll") for(int r=0;r<16;++r)negm[r]=nv_; asm volatile("":"+v"(negm)); } SBAR(); \
    const lds_cptr vp_=vp0+sl_prev; \
    VRD(0); SBAR(); float sacc=(P0[0]+P0[1]); \
    GAPA(C0=__builtin_amdgcn_mfma_f32_32x32x16_bf16(kf[0],qr[0],negm,0,0,0), P0[2],P0[3],P0[4],P0[5],     pw0[0]=PKW(P0,0), pw0[1]=PKW(P0,2), pw0); \
    VRD(4); SBAR(); GAPA(C1=__builtin_amdgcn_mfma_f32_32x32x16_bf16(kf[1],qr[0],negm,0,0,0), P0[6],P0[7],P0[8],P0[9],     pw0[2]=PKW(P0,4), pw0[3]=PKW(P0,6), pw0); \
    VRD(1); SBAR(); GAPA(C0=__builtin_amdgcn_mfma_f32_32x32x16_bf16(kf[2],qr[1],C0,0,0,0),   P0[10],P0[11],P0[12],P0[13], pw1[0]=PKW(P0,8), pw1[1]=PKW(P0,10), pw1); \
    VRD(5); SBAR(); GAPA(C1=__builtin_amdgcn_mfma_f32_32x32x16_bf16(kf[3],qr[1],C1,0,0,0),   P0[14],P0[15],P1[0],P1[1],   pw1[2]=PKW(P0,12),pw1[3]=PKW(P0,14), pw1); \
    VRD(2); SBAR(); GAPA(C0=__builtin_amdgcn_mfma_f32_32x32x16_bf16(kf[4],qr[2],C0,0,0,0),   P1[2],P1[3],P1[4],P1[5],     pw2[0]=PKW(P1,0), pw2[1]=PKW(P1,2), pw2); \
    VRD(6); SBAR(); GAPA(C1=__builtin_amdgcn_mfma_f32_32x32x16_bf16(kf[5],qr[2],C1,0,0,0),   P1[6],P1[7],P1[8],P1[9],     pw2[2]=PKW(P1,4), pw2[3]=PKW(P1,6), pw2); \
    VRD(3); SBAR(); GAPA(C0=__builtin_amdgcn_mfma_f32_32x32x16_bf16(kf[6],qr[3],C0,0,0,0),   P1[10],P1[11],P1[12],P1[13], pw3[0]=PKW(P1,8), pw3[1]=PKW(P1,10), pw3); \
    VRD(7); SBAR(); GAPA(C1=__builtin_amdgcn_mfma_f32_32x32x16_bf16(kf[7],qr[3],C1,0,0,0),   P1[14],P1[15],0.f,0.f,       pw3[2]=PKW(P1,12),pw3[3]=PKW(P1,14), pw3); \
    l_reg+=sacc; \
    if(GK){DMA_K((t)+3,sl_cur);} if(GV){DMA_V((t)+1,sl_next);} \
    if(MASKON){CMASK(C0,C1,t);} \
    { float a=MX3(C0[0],C0[1],C1[0]),b=MX3(C0[2],C0[3],C1[1]); a=MX3(a,C1[2],C1[3]); \
      _Pragma("unroll") for(int r=4;r<16;r+=4){a=MX3(a,C0[r],C0[r+1]);b=MX3(b,C0[r+2],C0[r+3]);a=MX3(a,C1[r],C1[r+1]);b=MX3(b,C1[r+2],C1[r+3]);} \
      float rm=__builtin_fmaxf(a,b); { auto rr=__builtin_amdgcn_permlane32_swap(__float_as_uint(rm),__float_as_uint(rm),false,false); rm=__builtin_fmaxf(__uint_as_float(rr[0]),__uint_as_float(rr[1])); } \
      resc=false; \
      if(__builtin_expect(__any(rm>(float)THRL),0)){ const float dl=__builtin_fmaxf(rm,0.f); mhat+=dl; \
        _Pragma("unroll") for(int r=0;r<16;++r){C0[r]-=dl;C1[r]-=dl;} \
        const float f=__builtin_amdgcn_exp2f(-dl); l_reg*=f; if(hi==0)wsf[r32]=f; resc=true; } } \
    SBAR(); \
    GAPB(o[0]=__builtin_amdgcn_mfma_f32_32x32x16_bf16(PAF(0),VFR(0),o[0],0,0,0), C0,0); \
    GAPB(o[1]=__builtin_amdgcn_mfma_f32_32x32x16_bf16(PAF(0),VFR(4),o[1],0,0,0), C0,4); \
    KRD(GL,0); GAPB(o[0]=__builtin_amdgcn_mfma_f32_32x32x16_bf16(PAF(1),VFR(1),o[0],0,0,0), C0,8); \
    KRD(GL,1); GAPB(o[1]=__builtin_amdgcn_mfma_f32_32x32x16_bf16(PAF(1),VFR(5),o[1],0,0,0), C0,12); \
    KRD(GL,2); GAPB(o[0]=__builtin_amdgcn_mfma_f32_32x32x16_bf16(PAF(2),VFR(2),o[0],0,0,0), C1,0); \
    KRD(GL,3); GAPB(o[1]=__builtin_amdgcn_mfma_f32_32x32x16_bf16(PAF(2),VFR(6),o[1],0,0,0), C1,4); \
    GAPB(o[0]=__builtin_amdgcn_mfma_f32_32x32x16_bf16(PAF(3),VFR(3),o[0],0,0,0), C1,8); \
    GAPB(o[1]=__builtin_amdgcn_mfma_f32_32x32x16_bf16(PAF(3),VFR(7),o[1],0,0,0), C1,12); \
    }while(0)
  int t=1;
  #define ENDW(tt) do{ if((tt)+3<NT){WAIT_BAR(2);} else if((tt)+2<NT){WAIT_BAR(1);} else {WAIT_BAR(0);} }while(0)
  #define MASKON 1
  for(;t<4&&t+1<NT;t+=2){
    STEP(pB0,pB1,pA0,pA1,t,(t+3<NT),(t+1<NT),(t+1<NT));       ENDW(t);   RESC(); ROT();
    STEP(pA0,pA1,pB0,pB1,t+1,(t+4<NT),(t+2<NT),(t+2<NT));     ENDW(t+1); RESC(); ROT();
  }
  #undef MASKON
  #define MASKON 0
  for(;t+5<NT;t+=2){
    STEP(pB0,pB1,pA0,pA1,t,true,true,true);     WAIT_BAR(2); RESC(); ROT();
    STEP(pA0,pA1,pB0,pB1,t+1,true,true,true);   WAIT_BAR(2); RESC(); ROT();
  }
  #undef MASKON
  #define MASKON 1
  for(;t+1<NT;t+=2){
    STEP(pB0,pB1,pA0,pA1,t,(t+3<NT),(t+1<NT),(t+1<NT));       ENDW(t);   RESC(); ROT();
    STEP(pA0,pA1,pB0,pB1,t+1,(t+4<NT),(t+2<NT),(t+2<NT));     ENDW(t+1); RESC(); ROT();
  }
  STEP(pB0,pB1,pA0,pA1,NT-1,false,false,false); RESC();
  { float sacc=pB0[0]+pB0[1]; _Pragma("unroll") for(int r=2;r<16;++r)sacc+=pB0[r]; _Pragma("unroll") for(int r=0;r<16;++r)sacc+=pB1[r]; l_reg+=sacc;
    pw0=(u32x4){PKW(pB0,0),PKW(pB0,2),PKW(pB0,4),PKW(pB0,6)};pw1=(u32x4){PKW(pB0,8),PKW(pB0,10),PKW(pB0,12),PKW(pB0,14)};pw2=(u32x4){PKW(pB1,0),PKW(pB1,2),PKW(pB1,4),PKW(pB1,6)};pw3=(u32x4){PKW(pB1,8),PKW(pB1,10),PKW(pB1,12),PKW(pB1,14)};
    SBAR(); pv(o,vb0+sl_cur,PAF(0),PAF(1),PAF(2),PAF(3)); }
  #undef PKW
  #undef PAF
  #undef VFR
  #undef PIN
  #undef MX3
  #undef GAPA
  #undef GAPB
  #undef EX
  #undef VRD
  #undef KRD
  #undef STEP
  #undef ENDW
  {auto rr=__builtin_amdgcn_permlane32_swap(__float_as_uint(l_reg),__float_as_uint(l_reg),false,false);l_reg=__uint_as_float(rr[0])+__uint_as_float(rr[1]);}
  if(hi==0)wsf[32+r32]=l_reg;asm volatile("s_waitcnt lgkmcnt(0)":::"memory");
  float rli[16];
  #pragma unroll
  for(int r=0;r<16;++r)rli[r]=__builtin_amdgcn_rcpf(wsf[32+crow(r,hi)]);
  bf16*Ow=O+(rowbase+q0+wid*QBLK)*PO+h*D;
  { bf16*stg=(bf16*)(shm+LDS_OST)+wid*2048;
    #pragma unroll
    for(int r=0;r<16;++r){const int orow=crow(r,hi);
      #pragma unroll
      for(int d0=0;d0<2;++d0)stg[orow*64+d0*32+r32]=__float2bfloat16(o[d0][r]*rli[r]);}
    asm volatile("s_waitcnt lgkmcnt(0)":::"memory");
    #pragma unroll
    for(int i=0;i<4;++i){const int row=i*8+(lane>>3),ch=lane&7; const u32x4 v=*(const u32x4*)(stg+row*64+ch*8); ATTN_STORE16(Ow+(long)row*PO+ch*8,v);} }
  asm volatile("s_waitcnt lgkmcnt(0)\n\ts_barrier":::"memory");
  #undef DMA_K
  #undef TOFF
  #undef SELT
  #undef MASKON
  #undef DMA_V
  #undef CMASK
  #undef START
  #undef RESC
  #undef ROT
}
constexpr int ATTN_LDS_BYTES=LDS_BYTES;
struct AttnTensors { const bf16* Q; const bf16* K; const bf16* V; const float* kmp; const float* rel_bias; bf16* O; };
struct AttnUnit { int bh; int qb; };
struct StaticOrder {
  int vcu;
  __device__ __forceinline__ explicit StaticOrder(int v):vcu(v){}
  __device__ __forceinline__ bool next(int i,AttnUnit&u)const{ if(i>=4)return false; const int s=vcu&3; u.bh=vcu>>2; u.qb=(i==0)?s:(i==1)?7-s:(i==2)?8+s:15-s; return true; }
};
template<int THRL=8> __device__ __forceinline__ void attn_phase(char*lds,const AttnTensors&T,int vcu0,int G){
  { __attribute__((address_space(3))) float*tb=(__attribute__((address_space(3))) float*)((lds_cptr)lds+LDS_TAB);
    for(int i=threadIdx.x;i<8*TAB_N;i+=NW*64){ const int hh=i/TAB_N,k=i%TAB_N,rel=k-255; float v=0.f;
      if(rel<0)v=-INFINITY; else if(rel<=112)v=(T.rel_bias[::t5_bucket(rel)*::NH+hh]-T.rel_bias[31*::NH+hh])*::LOG2E;
      tb[i]=v; }
    asm volatile("s_waitcnt lgkmcnt(0)\n\ts_barrier":::"memory"); }
  for(int v=vcu0;v<256;v+=G){ const StaticOrder S(v); AttnUnit u;
    for(int i=0;S.next(i,u);++i) attn_unit<THRL>(u.bh / ::NH, u.bh % ::NH, u.qb,T.Q,T.K,T.V,T.kmp,T.O,lds); }
}
#undef SBAR
#undef WAIT_BAR
}

__device__ __forceinline__ void naive_attn_item(int idx, const bf16_t* __restrict__ Q, const bf16_t* __restrict__ K, const bf16_t* __restrict__ V, const float* __restrict__ kmp,
                                                 const float* __restrict__ rel_bias, bf16_t* __restrict__ O) {
    const int t = idx % SEQ, h = (idx / SEQ) % NH, b = idx / (SEQ * NH);
    const size_t row = (size_t)b * SEQ + t;
    float q[64];
    { const u32x4* qp = (const u32x4*)(Q + row * DA + h * HD);
#pragma unroll
      for (int c = 0; c < 8; ++c) { const u32x4 w = qp[c];
#pragma unroll
          for (int j = 0; j < 4; ++j) { q[c * 8 + 2 * j] = __uint_as_float(w[j] << 16); q[c * 8 + 2 * j + 1] = __uint_as_float(w[j] & 0xffff0000u); } } }
    const int own = t / KBLK;
    unsigned mask = 0;
    {
        float g[16];
#pragma unroll
        for (int j = 0; j < 16; ++j) { g[j] = -INFINITY;
            if (j < own) { const float* k0 = kmp + (size_t)((b * NKB + j) * 2) * DA + h * HD; const float* k1 = k0 + DA; float s = 0.f;
#pragma unroll
                for (int d = 0; d < 64; ++d) s += q[d] * ((k0[d] + k1[d]) * (1.0f / 256.0f));
                g[j] = s; } }
#pragma unroll
        for (int r = 0; r < 3; ++r) { float best = -INFINITY; int bi = -1;
#pragma unroll
            for (int j = 0; j < 16; ++j) if (g[j] > best) { best = g[j]; bi = j; }
            if (bi >= 0) { mask |= 1u << bi;
#pragma unroll
                for (int j = 0; j < 16; ++j) if (j == bi) g[j] = -INFINITY; } }
    }
    mask |= 1u << own;
    float o[64];
#pragma unroll
    for (int d = 0; d < 64; ++d) o[d] = 0.f;
    float mx = -INFINITY, l = 0.f;
    for (int j = 0; j <= own; ++j) {
        if (!((mask >> j) & 1u)) continue;
        const int kend = (j == own) ? (t - own * KBLK + 1) : KBLK;
        for (int kk = 0; kk < kend; ++kk) {
            const size_t krow = (size_t)b * SEQ + j * KBLK + kk;
            const u32x4* kp = (const u32x4*)(K + krow * DA + h * HD);
            float s = 0.f;
#pragma unroll
            for (int c = 0; c < 8; ++c) { const u32x4 w = kp[c];
#pragma unroll
                for (int jj = 0; jj < 4; ++jj) { s += q[c * 8 + 2 * jj] * __uint_as_float(w[jj] << 16); s += q[c * 8 + 2 * jj + 1] * __uint_as_float(w[jj] & 0xffff0000u); } }
            const int rel = t - (j * KBLK + kk);
            s += rel_bias[t5_bucket(rel) * NH + h] * LOG2E;
            if (s > mx) { const float f = exp2f(mx - s); l *= f;
#pragma unroll
                for (int d = 0; d < 64; ++d) o[d] *= f;
                mx = s; }
            const float p = exp2f(s - mx); l += p;
            const u32x4* vp = (const u32x4*)(V + krow * DA + h * HD);
#pragma unroll
            for (int c = 0; c < 8; ++c) { const u32x4 w = vp[c];
#pragma unroll
                for (int jj = 0; jj < 4; ++jj) { o[c * 8 + 2 * jj] += p * __uint_as_float(w[jj] << 16); o[c * 8 + 2 * jj + 1] += p * __uint_as_float(w[jj] & 0xffff0000u); } }
        }
    }
    const float il = 1.0f / l;
    u32x4* op = (u32x4*)(O + row * OC + h * HD);
#pragma unroll
    for (int c = 0; c < 8; ++c) { u32x4 w;
#pragma unroll
        for (int jj = 0; jj < 4; ++jj) w[jj] = pk2(o[c * 8 + 2 * jj] * il, o[c * 8 + 2 * jj + 1] * il);
        op[c] = w; }
}

__device__ __forceinline__ void rg_au_ref(float rp, float ip, float xc, float c8sp, float& a, float& u) {
    const float r = 1.0f / (1.0f + expf(-rp)), i = 1.0f / (1.0f + expf(-ip));
    const float la = -c8sp * r; a = expf(la); u = sqrtf(-expm1f(2.0f * la)) * (i * xc);
}
constexpr int NCH = 64, CHL = SEQ / NCH;
template <bool FINAL>
__device__ __forceinline__ void naive_scan_item(int item, int c, LAS float* xcs, const bf16_t* __restrict__ XR, const bf16_t* __restrict__ GY, const float* __restrict__ cw, const float* __restrict__ cb,
                                                const float* __restrict__ Wa, const float* __restrict__ ba, const float* __restrict__ Wi, const float* __restrict__ bi,
                                                const float* __restrict__ lam, float* __restrict__ comp, const float* __restrict__ carry, bf16_t* __restrict__ O) {
    const int blk = item % RB, chunk = (item / RB) % NCH, b = item / (RB * NCH);
    const int ch = blk * RBD + c;
    const float w0 = cw[ch], w1 = cw[DR + ch], w2 = cw[2 * DR + ch], w3 = cw[3 * DR + ch], bb = cb[ch];
    for (int tt = 0; tt < CHL; ++tt) { const int t = chunk * CHL + tt; const bf16_t* xp = XR + ((size_t)b * SEQ + t) * DR + ch;
        float v = bb + w3 * bf2f(xp[0]);
        if (t >= 1) v += w2 * bf2f(xp[-DR]);
        if (t >= 2) v += w1 * bf2f(xp[-2 * DR]);
        if (t >= 3) v += w0 * bf2f(xp[-3 * DR]);
        xcs[tt * 64 + c] = v; }
    asm volatile("s_waitcnt lgkmcnt(0)" ::: "memory");
    const float c8sp = 8.0f * log1pf(expf(-lam[ch]));
    const float bav = ba[ch], biv = bi[ch];
    const float* wa = Wa + (size_t)blk * RBD * RBD + c; const float* wi = Wi + (size_t)blk * RBD * RBD + c;
    float A = 1.f, Bc = 0.f, hst = FINAL ? carry[((size_t)b * NCH + chunk) * DR + ch] : 0.f;
    for (int tt = 0; tt < CHL; ++tt) {
        float rp = bav, ip = biv;
#pragma unroll 8
        for (int d = 0; d < 64; ++d) { const float xv = xcs[tt * 64 + d]; rp += xv * wa[d * RBD]; ip += xv * wi[d * RBD]; }
        float a, u; rg_au_ref(rp, ip, xcs[tt * 64 + c], c8sp, a, u);
        if (FINAL) { hst = a * hst + u; const size_t off = ((size_t)b * SEQ + chunk * CHL + tt); O[off * OC + DA + ch] = (bf16_t)f2bf(hst * bf2f(GY[off * DR + ch])); }
        else { A *= a; Bc = a * Bc + u; }
    }
    if (!FINAL) { float* cp = comp + (((size_t)b * NCH + chunk) * DR + ch) * 2; cp[0] = A; cp[1] = Bc; }
    asm volatile("s_waitcnt lgkmcnt(0)" ::: "memory");
}
__device__ __forceinline__ void naive_scan_prefix_item(int idx, const float* __restrict__ comp, float* __restrict__ carry) {
    const int ch = idx % DR, b = idx / DR;
    float h = 0.f;
    for (int k = 0; k < NCH; ++k) { const size_t o = ((size_t)b * NCH + k) * DR + ch; carry[o] = h; h = comp[o * 2] * h + comp[o * 2 + 1]; }
}

__global__ void __launch_bounds__(NWAVES * 64, 2) mk_fwd(Args args) {
    extern __shared__ __attribute__((aligned(16))) unsigned char lds_raw[];
    LAS unsigned char* lds = (LAS unsigned char*)lds_raw;
    const int tid = threadIdx.x, lane = tid & 63, wave = __builtin_amdgcn_readfirstlane(tid >> 6);
    const int G = gridDim.x; const int bx = blockIdx.x; const int vcu = (G % 8 == 0) ? (bx % 8) * (G / 8) + bx / 8 : bx;
    unsigned char* ws = args.ws;
    unsigned* ctl = (unsigned*)(ws + WS_CTL);
    for (int u = tid; u < (LDS_BYTES - LDSCTL_OFF) / 4; u += NWAVES * 64) ((LAS unsigned*)(lds + LDSCTL_OFF))[u] = 0u;
    __syncthreads();
    volatile LAS unsigned* MISC = (volatile LAS unsigned*)(lds + MISC_OFF);
    const int lo = args.ph_lo, hi = args.ph_hi;
    XcdBarrier bar; bar.bar = ctl + CW_BAR; bar.x = 0; bar.st = nullptr;
    const bool multi = (hi - lo) > 1;
    if (multi) bar = xcd_barrier_post(ctl + CW_BAR, MISC + 8);
#define IN(k) (lo <= (k) && (k) < hi)
#define BOTH(k) (IN(k) && IN((k) + 1))
#define GRID_BAR() xcd_barrier(bar)

    const float* x = args.in[0];
    bf16_t* Wt_in = (bf16_t*)(ws + WS_WIN); bf16_t* Wt_cat = (bf16_t*)(ws + WS_WCAT); bf16_t* Wt_out = (bf16_t*)(ws + WS_WOUT);
    bf16_t* Wt_ff1 = (bf16_t*)(ws + WS_WFF1); bf16_t* Wt_ff2 = (bf16_t*)(ws + WS_WFF2);
    bf16_t* XN = (bf16_t*)(ws + WS_XN); bf16_t* Qb = (bf16_t*)(ws + WS_Q); bf16_t* Kb = (bf16_t*)(ws + WS_K); bf16_t* Vb = (bf16_t*)(ws + WS_V);
    bf16_t* XR = (bf16_t*)(ws + WS_XR); bf16_t* GY = (bf16_t*)(ws + WS_GY); bf16_t* GA = (bf16_t*)(ws + WS_GA); bf16_t* GR = (bf16_t*)(ws + WS_GR);
    bf16_t* MRG = (bf16_t*)(ws + WS_MRG); bf16_t* HB = (bf16_t*)(ws + WS_H);
    float* kmp = (float*)(ws + WS_KMP); float* ssq = (float*)(ws + WS_SSQ);
    bf16_t* OCAT = (bf16_t*)args.out;

    if ((PHMASK >> 0 & 1) && IN(0)) {
        LAS float* scr = (LAS float*)(lds + RING_OFF + wave * 16384);
        const int gw = vcu * NWAVES + wave, NGW = G * NWAVES;
        constexpr int I_IN = (DM / 64) * (DIN / 32), I_PA = (DA / 64) * (DM / 32), I_PR = (DR / 64) * (DM / 32), I_OUT = (DM / 64) * (DM / 32), I_F1 = (DM / 64) * (DFF / 32), I_F2 = (DFF / 64) * (DM / 32);
        constexpr int NITEMS = I_IN + I_PA + I_PR + I_OUT + I_F1 + I_F2;
        for (int it = gw; it < NITEMS; it += NGW) {
            int r = it;
            if (r < I_IN) { p0_transpose_item<1>(args.in[2], DIN, Wt_in, DM, 0, nullptr, scr, r, lane); continue; } r -= I_IN;
            if (r < I_PA) { p0_transpose_item<0>(args.in[14], DM, Wt_cat, OC, 0, nullptr, scr, r, lane); continue; } r -= I_PA;
            if (r < I_PR) { p0_transpose_item<0>(args.in[15], DM, Wt_cat, OC, DA, nullptr, scr, r, lane); continue; } r -= I_PR;
            if (r < I_OUT) { p0_transpose_item<0>(args.in[16], DM, Wt_out, DM, 0, nullptr, scr, r, lane); continue; } r -= I_OUT;
            if (r < I_F1) { p0_transpose_item<0>(args.in[18], DFF, Wt_ff1, DM, 0, args.in[17], scr, r, lane); continue; } r -= I_F1;
            p0_transpose_item<0>(args.in[19], DM, Wt_ff2, DFF, 0, nullptr, scr, r, lane);
        }
        for (int m = gw; m < M; m += NGW) rms_row_to_bf16(x + (size_t)m * DM, args.in[1], XN + (size_t)m * DM, lane);
        if (BOTH(0)) GRID_BAR();
    }
    if ((PHMASK >> 1 & 1) && IN(1)) {
        pg8::Gemm g{XN, Wt_in, DM, DM, DM, DIN, -1}; pg8::StaticOrder S; S.init(M, DIN, G, bx);
        pg8::EpiZ E{Qb, Kb, Vb, XR, GY, GA, GR, kmp, args.in[4], args.in[5], args.in[3]};
        pg8::gemm_phase<pg8::EpiZ, pg8::StaticOrder, false>(lds + RING_OFF, g, S, E);
        if (BOTH(1)) GRID_BAR();
    }
    {
        const float* cw = args.in[7]; const float* cb = args.in[8]; const float* Wa = args.in[9]; const float* ba = args.in[10]; const float* Wi = args.in[11]; const float* bi = args.in[12]; const float* lam = args.in[13];
        float* comp = (float*)(ws + WS_COMP); float* carry = (float*)(ws + WS_CARRY);
        LAS float* xcs = (LAS float*)(lds + RING_OFF + wave * 16384);
        const int gw = vcu * NWAVES + wave, NGW = G * NWAVES;
        if ((PHMASK >> 2 & 1) && IN(2)) {
#if NAIVE_ATTN
            for (int idx = bx * (NWAVES * 64) + tid; idx < BATCH * NH * SEQ; idx += G * NWAVES * 64) naive_attn_item(idx, Qb, Kb, Vb, kmp, args.in[6], OCAT);
#else
            { const attn_body::AttnTensors AT{(const attn_body::bf16*)Qb, (const attn_body::bf16*)Kb, (const attn_body::bf16*)Vb, kmp, args.in[6], (attn_body::bf16*)OCAT};
              attn_body::attn_phase<8>((char*)lds_raw + RING_OFF, AT, vcu, G); }
#endif
            for (int it = gw; it < BATCH * NCH * RB; it += NGW) naive_scan_item<false>(it, lane, xcs, XR, GY, cw, cb, Wa, ba, Wi, bi, lam, comp, carry, OCAT);
            if (BOTH(2)) GRID_BAR();
        }
        if ((PHMASK >> 3 & 1) && IN(3)) {
            for (int idx = bx * (NWAVES * 64) + tid; idx < BATCH * DR; idx += G * NWAVES * 64) naive_scan_prefix_item(idx, comp, carry);
            if (BOTH(3)) GRID_BAR();
        }
        if ((PHMASK >> 4 & 1) && IN(4)) {
            for (int it = gw; it < BATCH * NCH * RB; it += NGW) naive_scan_item<true>(it, lane, xcs, XR, GY, cw, cb, Wa, ba, Wi, bi, lam, comp, carry, OCAT);
            if (BOTH(4)) GRID_BAR();
        }
    }
    if ((PHMASK >> 5 & 1) && IN(5)) {
        pg8::Gemm g{OCAT, Wt_cat, OC, OC, OC, DM, DA / 64}; pg8::StaticOrder S; S.init(M, DM, G, bx);
        pg8::EpiMerge E{GA, GR, MRG};
        pg8::gemm_phase<pg8::EpiMerge, pg8::StaticOrder, MIDFLAG>(lds + RING_OFF, g, S, E);
        if (BOTH(5)) GRID_BAR();
    }
    if ((PHMASK >> 6 & 1) && IN(6)) {
        pg8::Gemm g{MRG, Wt_out, DM, DM, DM, DM, -1}; pg8::StaticOrder S; S.init(M, DM, G, bx);
        pg8::EpiX1 E{x, args.out, XN, ssq};
        pg8::gemm_phase<pg8::EpiX1, pg8::StaticOrder, false>(lds + RING_OFF, g, S, E);
        if (BOTH(6)) GRID_BAR();
    }
    if ((PHMASK >> 7 & 1) && IN(7)) {
        pg8::Gemm g{XN, Wt_ff1, DM, DM, DM, DFF, -1}; pg8::StaticOrder S; S.init(M, DFF, G, bx);
        pg8::EpiH E{ssq, HB};
        pg8::gemm_phase<pg8::EpiH, pg8::StaticOrder, false>(lds + RING_OFF, g, S, E);
        if (BOTH(7)) GRID_BAR();
    }
    if ((PHMASK >> 8 & 1) && IN(8)) {
        pg8::Gemm g{HB, Wt_ff2, DFF, DFF, DFF, DM, -1}; pg8::StaticOrder S; S.init(M, DM, G, bx);
        pg8::EpiOut E{args.out};
        pg8::gemm_phase<pg8::EpiOut, pg8::StaticOrder, false>(lds + RING_OFF, g, S, E);
    }
#undef IN
#undef BOTH
#undef GRID_BAR
}

constexpr int N_PHASES = 9;
extern "C" void kernel_launch(void* const* d_in, const int* in_sizes, int n_in, void* d_out, int out_size, void* d_ws, size_t ws_size, hipStream_t stream) {
    static int grid = 0;
    if (grid == 0) {
        if (n_in != 20 || in_sizes[0] != M * DM || out_size != M * DM || ws_size < WS_END) { fprintf(stderr, "kernel_launch: unexpected shapes (n_in %d, in0 %d, out %d, ws %zu)\n", n_in, n_in > 0 ? in_sizes[0] : -1, out_size, ws_size); grid = -1; return; }
        int dev = 0, cus = 0;
        if (hipGetDevice(&dev) != hipSuccess || hipDeviceGetAttribute(&cus, hipDeviceAttributeMultiprocessorCount, dev) != hipSuccess) { grid = -1; return; }
        if (hipFuncSetAttribute((const void*)mk_fwd, hipFuncAttributeMaxDynamicSharedMemorySize, LDS_BYTES) != hipSuccess) { fprintf(stderr, "kernel_launch: hipFuncSetAttribute failed\n"); grid = -1; return; }
        (void)hipGetLastError();
        grid = cus;
    }
    if (grid < 0) return;
    (void)hipMemsetAsync((char*)d_ws + WS_CTL, 0, CTL_ZERO_BYTES, stream);
    Args a{};
    for (int i = 0; i < 20; ++i) a.in[i] = (const float*)d_in[i];
    a.out = (float*)d_out; a.ws = (unsigned char*)d_ws;
#if MK_N_LAUNCHES == 1
    a.ph_lo = 0; a.ph_hi = N_PHASES;
    hipLaunchKernelGGL(mk_fwd, dim3(grid), dim3(NWAVES * 64), LDS_BYTES, stream, a);
#else
    for (int p = 0; p < N_PHASES; ++p) { a.ph_lo = p; a.ph_hi = p + 1; hipLaunchKernelGGL(mk_fwd, dim3(grid), dim3(NWAVES * 64), LDS_BYTES, stream, a); }
#endif
}
```

```cpp
#include <hip/hip_runtime.h>
#include <hip/hip_bf16.h>
#include <cstdio>
#include <cstdint>

#ifndef MIDFLAG
#define MIDFLAG true
#endif
#ifndef NAIVE_ATTN
#define NAIVE_ATTN 0
#endif
#ifndef NAIVE_SCAN
#define NAIVE_SCAN 0
#endif
#ifndef DBG_ATTN
#define DBG_ATTN 0
#endif
#ifndef DBG_AMP
#define DBG_AMP 10.0f
#endif
#ifndef PHMASK
#define PHMASK 0xffff
#endif
#ifndef MK_N_LAUNCHES
#define MK_N_LAUNCHES 1
#endif

constexpr int BATCH = 8, SEQ = 4096, DM = 1024, M = BATCH * SEQ;
constexpr int NH = 8, HD = 64, DA = 512, DR = 1024, DFF = 4096, DIN = 5632;
constexpr int KBLK = 256, NKB = SEQ / KBLK;
constexpr int RB = 16, RBD = 64;
constexpr int OC = DA + DR;
constexpr float EPS = 1e-6f;
constexpr float LOG2E = 1.4426950408889634f;
constexpr float C2 = 0.125f * LOG2E;

#define LAS __attribute__((address_space(3)))
#define GAS __attribute__((address_space(1)))
typedef unsigned short bf16_t;
typedef short bf16x8 __attribute__((ext_vector_type(8)));
typedef float f32x4 __attribute__((ext_vector_type(4)));
typedef float f32x2 __attribute__((ext_vector_type(2)));
typedef unsigned u32x4 __attribute__((ext_vector_type(4)));
typedef unsigned u32x2 __attribute__((ext_vector_type(2)));

constexpr size_t MiB = 1u << 20;
constexpr size_t WS_CTL = 0, CTL_ZERO_BYTES = 1 * MiB;
constexpr size_t WS_WIN = 2 * MiB;
constexpr size_t WS_WCAT = 13 * MiB;
constexpr size_t WS_WOUT = 16 * MiB;
constexpr size_t WS_WFF1 = 18 * MiB;
constexpr size_t WS_WFF2 = 26 * MiB;
constexpr size_t WS_KMP = 34 * MiB;
constexpr size_t WS_SSQ = 35 * MiB;
constexpr size_t WS_COMP = 38 * MiB;
constexpr size_t WS_CARRY = 42 * MiB;
constexpr size_t WS_XN = 48 * MiB;
constexpr size_t WS_Q = 112 * MiB;
constexpr size_t WS_K = 144 * MiB;
constexpr size_t WS_V = 176 * MiB;
constexpr size_t WS_MRG = 144 * MiB;
constexpr size_t WS_XR = 208 * MiB;
constexpr size_t WS_GY = 272 * MiB;
constexpr size_t WS_GA = 336 * MiB;
constexpr size_t WS_GR = 400 * MiB;
constexpr size_t WS_H = 208 * MiB;
constexpr size_t WS_END = 464 * MiB;

constexpr int CW_TMO = 0, CW_BAR = 4096;

__device__ __forceinline__ float bf2f(unsigned short u) { return __uint_as_float(((unsigned)u) << 16); }
__device__ __forceinline__ unsigned f2bf(float f) { unsigned u = __builtin_bit_cast(unsigned, f); return (u + 0x7fffu + ((u >> 16) & 1u)) >> 16; }
__device__ __forceinline__ unsigned pk2(float lo, float hi) { return f2bf(lo) | (f2bf(hi) << 16); }
__device__ __forceinline__ unsigned cvt_pk_bf16(float lo, float hi) { unsigned r; asm volatile("v_cvt_pk_bf16_f32 %0, %1, %2" : "=v"(r) : "v"(lo), "v"(hi)); return r; }
__device__ __forceinline__ float fast_sigmoid(float x) { return __builtin_amdgcn_rcpf(1.0f + __builtin_amdgcn_exp2f(-LOG2E * x)); }
__device__ __forceinline__ float gelu_tanh(float x) { const float u = x + 0.044715f * x * x * x; return x * __builtin_amdgcn_rcpf(1.0f + __builtin_amdgcn_exp2f(-2.302208198f * u)); }
__device__ __forceinline__ float wave_sum(float v) {
#pragma unroll
    for (int o = 1; o < 64; o <<= 1) v += __shfl_xor(v, o);
    return v;
}
__device__ __forceinline__ int t5_bucket(int n) {
    if (n < 16) return n;
    int b = 16;
    b += (n >= 19); b += (n >= 21); b += (n >= 24); b += (n >= 27); b += (n >= 31); b += (n >= 35); b += (n >= 40); b += (n >= 46);
    b += (n >= 52); b += (n >= 59); b += (n >= 67); b += (n >= 77); b += (n >= 87); b += (n >= 99); b += (n >= 113);
    return b;
}

namespace pg8 {
constexpr int BM = 256, BK = 64, HALF = 128, HTB = HALF * BK * 2, STAGE_BYTES = 8 * HTB, NXCD = 8, WGM = 8;
__host__ __device__ __forceinline__ int lds_byte(int r, int c) { const int st = (r >> 4) * 2 + (c >> 5), rr = r & 15, cc = c & 31, ob = rr * 64 + cc * 2; return st * 1024 + (ob ^ (((ob >> 9) & 1) << 5)); }
__host__ __device__ __forceinline__ void stage_rc(int b, int& R, int& C) { const int st = b / 1024, sb = b % 1024, swz = sb ^ (((sb >> 9) & 1) << 5); R = (st >> 1) * 16 + swz / 64; C = (st & 1) * 32 + (swz % 64) / 2; }
__host__ __device__ __forceinline__ int perm32(int rho) { const int n = rho >> 4, i = rho & 15; return 8 * (i >> 2) + 4 * n + (i & 3); }

struct Unit { int pm, pn; };
struct Gemm { const bf16_t* A; const bf16_t* Bt; int lda, ldb, K, N, mid_t; };

struct StaticOrder {
    int nM, nN, nwg, G, c;
    __host__ __device__ void init(int M_, int N_, int G_, int c_) { nM = M_ / BM; nN = N_ / BM; nwg = nM * nN; G = G_; c = c_; }
    __host__ __device__ bool next(int i, Unit& u) const {
        const long L = (long)i * G + c; if (L >= nwg) return false;
        int wgid = (int)L; { const int q = nwg / NXCD, r = nwg % NXCD, xcd = wgid % NXCD, off = wgid / NXCD; wgid = (xcd < r ? xcd * (q + 1) : r * (q + 1) + (xcd - r) * q) + off; }
        const int nig = WGM * nN, gid = wgid / nig, fm = gid * WGM, gsz = (nM - fm) < WGM ? (nM - fm) : WGM;
        u.pm = fm + ((wgid % nig) % gsz); u.pn = (wgid % nig) / gsz; return true;
    }
};

typedef f32x4 Acc[2][2][4][2];

template <class Epi, class Sched, bool MID>
__device__ __forceinline__ void gemm_phase(LAS unsigned char* lds, const Gemm g, const Sched& S, const Epi& E) {
    const int tid = threadIdx.x, wid = __builtin_amdgcn_readfirstlane(tid >> 6), lane = tid & 63, wr = wid >> 2, wc = wid & 3, fr = lane & 15, fq = lane >> 4;
    const int nt = g.K / BK;
    unsigned voffA[2], voffB[2];
#pragma unroll
    for (int i = 0; i < 2; ++i) { int R, C; stage_rc(tid * 16 + i * 8192, R, C); const int Rb = Epi::PERM ? ((R & ~31) + perm32(R & 31)) : R;
        voffA[i] = (unsigned)(R * g.lda + C) * 2u; voffB[i] = (unsigned)(Rb * g.ldb + C) * 2u; }
    const size_t kstep = (size_t)(BK * 2);
    const size_t hstepA = (size_t)HALF * g.lda * 2, hstepB = (size_t)HALF * g.ldb * 2;
    const size_t tstepA = 2 * hstepA, tstepB = 2 * hstepB;
    const unsigned ldsw = (unsigned)wid * 1024u;
    const int aoff = lds_byte(wr * 64 + fr, fq * 8), boff = lds_byte(wc * 32 + fr, fq * 8);
#define PG8_SA(b, h) (((b) * 2 + (h)) * HTB)
#define PG8_SB(b, h) ((4 + (b) * 2 + (h)) * HTB)
#define PG8_STAGE(bufoff, gbase, voff) do { _Pragma("unroll") for (int _i = 0; _i < 2; ++_i) \
        __builtin_amdgcn_global_load_lds((const unsigned*)((const char*)(gbase) + (voff)[_i]), (LAS unsigned*)(lds + (bufoff) + ldsw + _i * 8192), 16, 0, 0); } while (0)
#define PG8_LDA(dst, b, h) do { _Pragma("unroll") for (int m = 0; m < 4; ++m) _Pragma("unroll") for (int k = 0; k < 2; ++k) dst[m][k] = *(const LAS bf16x8*)(lds + PG8_SA(b, h) + aoff + m * 2048 + k * 1024); } while (0)
#define PG8_LDB(dst, b, h) do { _Pragma("unroll") for (int n = 0; n < 2; ++n) _Pragma("unroll") for (int k = 0; k < 2; ++k) dst[n][k] = *(const LAS bf16x8*)(lds + PG8_SB(b, h) + boff + n * 2048 + k * 1024); } while (0)
#define PG8_MMA(ai, bj, At, Bt) do { __builtin_amdgcn_s_setprio(1); _Pragma("unroll") for (int m = 0; m < 4; ++m) _Pragma("unroll") for (int n = 0; n < 2; ++n) _Pragma("unroll") for (int k = 0; k < 2; ++k) \
        acc[ai][bj][m][n] = __builtin_amdgcn_mfma_f32_16x16x32_bf16(Bt[n][k], At[m][k], acc[ai][bj][m][n], 0, 0, 0); __builtin_amdgcn_s_setprio(0); } while (0)
#define PG8_WAIT_V(n) asm volatile("s_waitcnt vmcnt(" #n ")" ::: "memory")
#define PG8_WAIT_L(n) asm volatile("s_waitcnt lgkmcnt(" #n ")" ::: "memory")
#define PG8_BAR __builtin_amdgcn_s_barrier()
#define PG8_SCHED __builtin_amdgcn_sched_barrier(0)
    Unit cur, nxt; int ui = 0;
    if (!S.next(0, cur)) return;
    f32x4 acc[2][2][4][2];
#pragma unroll
    for (int a = 0; a < 2; ++a)
#pragma unroll
        for (int b = 0; b < 2; ++b)
#pragma unroll
            for (int m = 0; m < 4; ++m)
#pragma unroll
                for (int n = 0; n < 2; ++n) acc[a][b][m][n] = (f32x4){0.f, 0.f, 0.f, 0.f};
    bf16x8 At[4][2], B0[2][2], B1[2][2];
    const char* cA = (const char*)g.A + (size_t)cur.pm * tstepA; const char* cB = (const char*)g.Bt + (size_t)cur.pn * tstepB;
    PG8_STAGE(PG8_SB(0, 0), cB, voffB); PG8_STAGE(PG8_SB(0, 1), cB + hstepB, voffB); PG8_STAGE(PG8_SA(0, 0), cA, voffA); PG8_STAGE(PG8_SA(0, 1), cA + hstepA, voffA);
    if (wr == 1) PG8_BAR;
    PG8_WAIT_V(2); PG8_BAR;
    PG8_STAGE(PG8_SB(1, 0), cB + kstep, voffB); PG8_STAGE(PG8_SA(1, 0), cA + kstep, voffA); PG8_STAGE(PG8_SB(1, 1), cB + hstepB + kstep, voffB);
    PG8_WAIT_V(6); PG8_BAR;
    for (;;) {
        const bool has_next = S.next(ui + 1, nxt);
        const char* nA = has_next ? (const char*)g.A + (size_t)nxt.pm * tstepA : cA; const char* nB = has_next ? (const char*)g.Bt + (size_t)nxt.pn * tstepB : cB;
        for (int t = 0; t < nt; t += 2) {
            if constexpr (MID) { if (t == g.mid_t) E.mid(acc, cur, wr, wc, fr, fq); }
            const bool last = (t == nt - 2);
            const char* a1 = cA + (size_t)(t + 1) * kstep;
            const char* a2 = last ? nA : cA + (size_t)(t + 2) * kstep; const char* b2 = last ? nB : cB + (size_t)(t + 2) * kstep;
            const char* a3 = a2 + kstep; const char* b3 = b2 + kstep;
            PG8_LDB(B0, 0, 0); PG8_LDB(B1, 0, 1); PG8_SCHED; PG8_LDA(At, 0, 0); PG8_STAGE(PG8_SA(1, 1), a1 + hstepA, voffA);
            PG8_WAIT_V(8); PG8_WAIT_L(0); PG8_BAR; PG8_MMA(0, 0, At, B0); PG8_MMA(0, 1, At, B1); PG8_BAR; PG8_SCHED;
            PG8_LDA(At, 0, 1); PG8_STAGE(PG8_SB(0, 0), b2, voffB); PG8_STAGE(PG8_SB(0, 1), b2 + hstepB, voffB); PG8_STAGE(PG8_SA(0, 0), a2, voffA);
            PG8_WAIT_V(8); PG8_WAIT_L(0); PG8_BAR; PG8_MMA(1, 0, At, B0); PG8_MMA(1, 1, At, B1); PG8_BAR; PG8_SCHED;
            PG8_LDB(B0, 1, 0); PG8_LDB(B1, 1, 1); PG8_SCHED; PG8_LDA(At, 1, 0); PG8_STAGE(PG8_SA(0, 1), a2 + hstepA, voffA);
            PG8_WAIT_V(8); PG8_WAIT_L(0); PG8_BAR; PG8_MMA(0, 0, At, B0); PG8_MMA(0, 1, At, B1); PG8_BAR; PG8_SCHED;
            PG8_LDA(At, 1, 1); PG8_STAGE(PG8_SB(1, 0), b3, voffB); PG8_STAGE(PG8_SB(1, 1), b3 + hstepB, voffB); PG8_STAGE(PG8_SA(1, 0), a3, voffA);
            PG8_WAIT_V(8); PG8_WAIT_L(0); PG8_BAR; PG8_MMA(1, 0, At, B0); PG8_MMA(1, 1, At, B1); PG8_BAR; PG8_SCHED;
        }
        if (wr == 0) PG8_BAR;
        E(acc, cur, wr, wc, fr, fq);
        if (!has_next) break;
#pragma unroll
        for (int a = 0; a < 2; ++a)
#pragma unroll
            for (int b = 0; b < 2; ++b)
#pragma unroll
                for (int m = 0; m < 4; ++m)
#pragma unroll
                    for (int n = 0; n < 2; ++n) acc[a][b][m][n] = (f32x4){0.f, 0.f, 0.f, 0.f};
        cur = nxt; cA = nA; cB = nB; ++ui;
        if (wr == 1) PG8_BAR;
    }
    PG8_WAIT_V(0);
    PG8_BAR;
#undef PG8_SA
#undef PG8_SB
#undef PG8_STAGE
#undef PG8_LDA
#undef PG8_LDB
#undef PG8_MMA
#undef PG8_WAIT_V
#undef PG8_WAIT_L
#undef PG8_BAR
#undef PG8_SCHED
}

struct EpiZ {
    static constexpr bool PERM = true;
    bf16_t *Q, *K, *V, *XR, *GY, *GA, *GR; float* kmp; const float *qw, *kw, *bg;
    __device__ __forceinline__ void mid(Acc&, const Unit&, int, int, int, int) const {}
    __device__ __forceinline__ void operator()(Acc& acc, const Unit& u, int wr, int wc, int fr, int fq) const {
        const int pn = u.pn; const int row0 = u.pm * BM + wr * 64 + fr;
        if (pn < 4) {
            const bool isq = pn < 2; const int head = (pn & 1) * 4 + wc; const float* nw = isq ? qw : kw; const float osc = isq ? C2 : 1.0f;
            bf16_t* base = (isq ? Q : K) + head * HD + 8 * fq;
            f32x4 wv[2][2];
#pragma unroll
            for (int bj = 0; bj < 2; ++bj)
#pragma unroll
                for (int n = 0; n < 2; ++n) wv[bj][n] = *(const f32x4*)(nw + 32 * bj + 8 * fq + 4 * n) * osc;
            f32x4 cs[2][2];
#pragma unroll
            for (int bj = 0; bj < 2; ++bj)
#pragma unroll
                for (int n = 0; n < 2; ++n) cs[bj][n] = (f32x4){0.f, 0.f, 0.f, 0.f};
#pragma unroll
            for (int ai = 0; ai < 2; ++ai)
#pragma unroll
                for (int m = 0; m < 4; ++m) {
                    float ss = 0.f;
#pragma unroll
                    for (int bj = 0; bj < 2; ++bj)
#pragma unroll
                        for (int n = 0; n < 2; ++n) { const f32x4 v = acc[ai][bj][m][n]; ss += (v[0] * v[0] + v[1] * v[1]) + (v[2] * v[2] + v[3] * v[3]); }
                    ss += __shfl_xor(ss, 16); ss += __shfl_xor(ss, 32);
                    const float rstd = 1.0f / sqrtf(ss * (1.0f / 64.0f) + EPS);
                    bf16_t* rowp = base + (size_t)(row0 + ai * HALF + m * 16) * DA;
#pragma unroll
                    for (int bj = 0; bj < 2; ++bj) {
                        const f32x4 v0 = acc[ai][bj][m][0] * rstd * wv[bj][0], v1 = acc[ai][bj][m][1] * rstd * wv[bj][1];
                        cs[bj][0] += v0; cs[bj][1] += v1;
                        u32x4 w; w.x = cvt_pk_bf16(v0[0], v0[1]); w.y = cvt_pk_bf16(v0[2], v0[3]); w.z = cvt_pk_bf16(v1[0], v1[1]); w.w = cvt_pk_bf16(v1[2], v1[3]);
                        *(u32x4*)(rowp + 32 * bj) = w; }
                }
            if (!isq) {
#pragma unroll
                for (int bj = 0; bj < 2; ++bj)
#pragma unroll
                    for (int n = 0; n < 2; ++n)
#pragma unroll
                        for (int i = 0; i < 4; ++i) { float s = cs[bj][n][i]; s += __shfl_xor(s, 1); s += __shfl_xor(s, 2); s += __shfl_xor(s, 4); s += __shfl_xor(s, 8); cs[bj][n][i] = s; }
                if (fr == 0) { float* kp = kmp + (size_t)(u.pm * 2 + wr) * DA + head * HD + 8 * fq;
#pragma unroll
                    for (int bj = 0; bj < 2; ++bj) { *(f32x4*)(kp + 32 * bj) = cs[bj][0]; *(f32x4*)(kp + 32 * bj + 4) = cs[bj][1]; } }
            }
            return;
        }
        int mode, ldc, colt; bf16_t* base; const float* bias = nullptr;
        if (pn < 6) { base = V; ldc = DA; colt = (pn - 4) * BM; mode = 0; }
        else if (pn < 10) { base = XR; ldc = DR; colt = (pn - 6) * BM; mode = 0; }
        else if (pn < 14) { base = GY; ldc = DR; colt = (pn - 10) * BM; mode = 1; }
        else if (pn < 18) { base = GA; ldc = DM; colt = (pn - 14) * BM; mode = 2; bias = bg; }
        else { base = GR; ldc = DM; colt = (pn - 18) * BM; mode = 2; bias = bg + DM; }
        const int col0 = colt + wc * 32 + 8 * fq;
        f32x4 bv[2][2];
#pragma unroll
        for (int bj = 0; bj < 2; ++bj)
#pragma unroll
            for (int n = 0; n < 2; ++n) bv[bj][n] = bias ? *(const f32x4*)(bias + col0 + bj * HALF + 4 * n) : (f32x4){0.f, 0.f, 0.f, 0.f};
#pragma unroll
        for (int ai = 0; ai < 2; ++ai)
#pragma unroll
            for (int m = 0; m < 4; ++m) { bf16_t* rowp = base + (size_t)(row0 + ai * HALF + m * 16) * ldc + col0;
#pragma unroll
                for (int bj = 0; bj < 2; ++bj) { f32x4 v0 = acc[ai][bj][m][0] + bv[bj][0], v1 = acc[ai][bj][m][1] + bv[bj][1];
                    if (mode == 1) {
#pragma unroll
                        for (int i = 0; i < 4; ++i) { v0[i] = gelu_tanh(v0[i]); v1[i] = gelu_tanh(v1[i]); } }
                    else if (mode == 2) {
#pragma unroll
                        for (int i = 0; i < 4; ++i) { v0[i] = fast_sigmoid(v0[i]); v1[i] = fast_sigmoid(v1[i]); } }
                    u32x4 w; w.x = cvt_pk_bf16(v0[0], v0[1]); w.y = cvt_pk_bf16(v0[2], v0[3]); w.z = cvt_pk_bf16(v1[0], v1[1]); w.w = cvt_pk_bf16(v1[2], v1[3]);
                    *(u32x4*)(rowp + bj * HALF) = w; } }
    }
};

struct EpiMerge {
    static constexpr bool PERM = true;
    const bf16_t *GA, *GR; bf16_t* O;
    __device__ __forceinline__ void mid(Acc& acc, const Unit& u, int wr, int wc, int fr, int fq) const {
        int row0 = u.pm * BM + wr * 64 + fr, col0 = u.pn * BM + wc * 32 + 8 * fq;
        asm volatile("" : "+v"(row0), "+v"(col0));
#pragma unroll
        for (int ai = 0; ai < 2; ++ai)
#pragma unroll
            for (int m = 0; m < 4; ++m) { const size_t off = (size_t)(row0 + ai * HALF + m * 16) * DM + col0;
#pragma unroll
                for (int bj = 0; bj < 2; ++bj) { const u32x4 a = *(const u32x4*)(GA + off + bj * HALF), r = *(const u32x4*)(GR + off + bj * HALF);
#pragma unroll
                    for (int j = 0; j < 4; ++j) { const unsigned aw = a[j], rw = r[j];
                        const float f0 = __uint_as_float(aw << 16) * __builtin_amdgcn_rcpf(__uint_as_float(rw << 16));
                        const float f1 = __uint_as_float(aw & 0xffff0000u) * __builtin_amdgcn_rcpf(__uint_as_float(rw & 0xffff0000u));
                        acc[ai][bj][m][j >> 1][(j & 1) * 2] *= f0; acc[ai][bj][m][j >> 1][(j & 1) * 2 + 1] *= f1; } }
                asm volatile("" ::: "memory"); }
    }
    __device__ __forceinline__ void operator()(Acc& acc, const Unit& u, int wr, int wc, int fr, int fq) const {
        const int row0 = u.pm * BM + wr * 64 + fr, col0 = u.pn * BM + wc * 32 + 8 * fq;
#pragma unroll
        for (int ai = 0; ai < 2; ++ai)
#pragma unroll
            for (int m = 0; m < 4; ++m) { const size_t off = (size_t)(row0 + ai * HALF + m * 16) * DM + col0;
#pragma unroll
                for (int bj = 0; bj < 2; ++bj) { const u32x4 r = *(const u32x4*)(GR + off + bj * HALF); u32x4 w;
#pragma unroll
                    for (int j = 0; j < 4; ++j) { const unsigned rw = r[j];
                        const float v0 = acc[ai][bj][m][j >> 1][(j & 1) * 2] * __uint_as_float(rw << 16), v1 = acc[ai][bj][m][j >> 1][(j & 1) * 2 + 1] * __uint_as_float(rw & 0xffff0000u);
                        w[j] = cvt_pk_bf16(v0, v1); }
                    *(u32x4*)(O + off + bj * HALF) = w; }
                if (m & 1) asm volatile("" ::: "memory"); }
    }
};

struct EpiX1 {
    static constexpr bool PERM = false;
    const float* X; float* X1; bf16_t* XN2; float* ssq;
    __device__ __forceinline__ void mid(Acc&, const Unit&, int, int, int, int) const {}
    __device__ __forceinline__ void operator()(Acc& acc, const Unit& u, int wr, int wc, int fr, int fq) const {
        const int row0 = u.pm * BM + wr * 64 + fr, col0 = u.pn * BM + wc * 32 + 4 * fq;
#pragma unroll
        for (int ai = 0; ai < 2; ++ai)
#pragma unroll
            for (int m = 0; m < 4; ++m) { const int row = row0 + ai * HALF + m * 16; const size_t off = (size_t)row * DM + col0; float ss = 0.f;
#pragma unroll
                for (int bj = 0; bj < 2; ++bj)
#pragma unroll
                    for (int n = 0; n < 2; ++n) { const f32x4 xv = *(const f32x4*)(X + off + bj * HALF + n * 16); const f32x4 v = acc[ai][bj][m][n] + xv;
                        *(f32x4*)(X1 + off + bj * HALF + n * 16) = v;
                        u32x2 w; w.x = cvt_pk_bf16(v[0], v[1]); w.y = cvt_pk_bf16(v[2], v[3]); *(u32x2*)(XN2 + off + bj * HALF + n * 16) = w;
                        ss += (v[0] * v[0] + v[1] * v[1]) + (v[2] * v[2] + v[3] * v[3]); }
                ss += __shfl_xor(ss, 16); ss += __shfl_xor(ss, 32);
                if (fq == 0) ssq[(size_t)row * 16 + u.pn * 4 + wc] = ss;
                if (m & 1) asm volatile("" ::: "memory"); }
    }
};

struct EpiH {
    static constexpr bool PERM = true;
    const float* ssq; bf16_t* H;
    __device__ __forceinline__ void mid(Acc&, const Unit&, int, int, int, int) const {}
    __device__ __forceinline__ void operator()(Acc& acc, const Unit& u, int wr, int wc, int fr, int fq) const {
        const int row0 = u.pm * BM + wr * 64 + fr, col0 = u.pn * BM + wc * 32 + 8 * fq;
#pragma unroll
        for (int ai = 0; ai < 2; ++ai)
#pragma unroll
            for (int m = 0; m < 4; ++m) { const int row = row0 + ai * HALF + m * 16;
                const f32x4 s0 = *(const f32x4*)(ssq + (size_t)row * 16), s1 = *(const f32x4*)(ssq + (size_t)row * 16 + 4), s2 = *(const f32x4*)(ssq + (size_t)row * 16 + 8), s3 = *(const f32x4*)(ssq + (size_t)row * 16 + 12);
                const float tot = (((s0[0] + s0[1]) + (s0[2] + s0[3])) + ((s1[0] + s1[1]) + (s1[2] + s1[3]))) + (((s2[0] + s2[1]) + (s2[2] + s2[3])) + ((s3[0] + s3[1]) + (s3[2] + s3[3])));
                const float rstd = 1.0f / sqrtf(tot * (1.0f / DM) + EPS);
                bf16_t* rowp = H + (size_t)row * DFF + col0;
#pragma unroll
                for (int bj = 0; bj < 2; ++bj) { f32x4 v0 = acc[ai][bj][m][0] * rstd, v1 = acc[ai][bj][m][1] * rstd;
#pragma unroll
                    for (int i = 0; i < 4; ++i) { const float a = fmaxf(v0[i], 0.f), b = fmaxf(v1[i], 0.f); v0[i] = a * a; v1[i] = b * b; }
                    u32x4 w; w.x = cvt_pk_bf16(v0[0], v0[1]); w.y = cvt_pk_bf16(v0[2], v0[3]); w.z = cvt_pk_bf16(v1[0], v1[1]); w.w = cvt_pk_bf16(v1[2], v1[3]);
                    *(u32x4*)(rowp + bj * HALF) = w; }
                if (m & 1) asm volatile("" ::: "memory"); }
    }
};

struct EpiOut {
    static constexpr bool PERM = false;
    float* X1;
    __device__ __forceinline__ void mid(Acc&, const Unit&, int, int, int, int) const {}
    __device__ __forceinline__ void operator()(Acc& acc, const Unit& u, int wr, int wc, int fr, int fq) const {
        const int row0 = u.pm * BM + wr * 64 + fr, col0 = u.pn * BM + wc * 32 + 4 * fq;
#pragma unroll
        for (int ai = 0; ai < 2; ++ai)
#pragma unroll
            for (int m = 0; m < 4; ++m) { const size_t off = (size_t)(row0 + ai * HALF + m * 16) * DM + col0;
#pragma unroll
                for (int bj = 0; bj < 2; ++bj)
#pragma unroll
                    for (int n = 0; n < 2; ++n) { const f32x4 xv = *(const f32x4*)(X1 + off + bj * HALF + n * 16); *(f32x4*)(X1 + off + bj * HALF + n * 16) = acc[ai][bj][m][n] + xv; }
                if (m & 1) asm volatile("" ::: "memory"); }
    }
};
}

#define XB_TMO      128
#define XB_XCNT(j)  (256  + 64 * (j))
#define XB_XSUB(j)  (1280 + 64 * (j))
#define XB_XGEN(j)  (2304 + 64 * (j))
#define XB_TOP      3328
#define XB_TOPGEN   3392
#define XCD_BAR_WORDS 3456
#define XB_SPIN_CAP (1u << 18)
__device__ __forceinline__ unsigned xb_ld(unsigned* p)              { return __hip_atomic_load(p, __ATOMIC_RELAXED, __HIP_MEMORY_SCOPE_AGENT); }
__device__ __forceinline__ unsigned xb_add(unsigned* p, unsigned v) { return __hip_atomic_fetch_add(p, v, __ATOMIC_RELAXED, __HIP_MEMORY_SCOPE_AGENT); }
__device__ __forceinline__ unsigned xb_xcc_id() { return (unsigned)__builtin_amdgcn_s_getreg((3 << 11) | 20) & 0xFu; }
#define XB_SPIN(cond, bar) do { unsigned _sp = 0; while (cond) { __builtin_amdgcn_s_sleep(1); \
    if ((++_sp & 255u) == 0u) { if (xb_ld(&(bar)[XB_TMO])) break; if (_sp > XB_SPIN_CAP) { atomicAdd(&(bar)[XB_TMO], 1u); break; } } } } while (0)
struct XcdBarrier { unsigned* bar; unsigned x; volatile LAS unsigned* st; };
__device__ __forceinline__ XcdBarrier xcd_barrier_post(unsigned* bar, volatile LAS unsigned* st) {
    XcdBarrier b; b.bar = bar; b.x = xb_xcc_id(); b.st = st;
    if (threadIdx.x == 0) (void)xb_add(&bar[XB_XCNT(b.x)], 1u);
    return b;
}
__device__ __forceinline__ void xcd_barrier_complete(unsigned* bar, unsigned x, unsigned& nloc, unsigned& nx) {
    const unsigned G = gridDim.x * gridDim.y * gridDim.z;
    unsigned sum, cnt, mine, sp = 0u;
    for (;;) {
        sum = 0u; cnt = 0u; mine = 0u;
#pragma unroll
        for (unsigned j = 0; j < 16; ++j) { const unsigned c = xb_ld(&bar[XB_XCNT(j)]); sum += c; cnt += (c > 0u) ? 1u : 0u; mine = (j == x) ? c : mine; }
        if (sum == G) break;
        __builtin_amdgcn_s_sleep(1);
        if ((++sp & 255u) == 0u) { if (xb_ld(&bar[XB_TMO])) break; if (sp > XB_SPIN_CAP) { atomicAdd(&bar[XB_TMO], 1u); break; } }
    }
    nloc = mine > 0u ? mine : 1u; nx = cnt > 0u ? cnt : 1u;
}
__device__ __forceinline__ void xcd_barrier(const XcdBarrier& b) {
    asm volatile("s_waitcnt vmcnt(0)" ::: "memory");
    __syncthreads();
    if (threadIdx.x == 0) {
        unsigned* bar = b.bar;
        __builtin_amdgcn_s_waitcnt(0);
        unsigned nloc = b.st[0], nx = b.st[1];
        if (nloc == 0u) { xcd_barrier_complete(bar, b.x, nloc, nx); b.st[0] = nloc; b.st[1] = nx; }
        const unsigned old = xb_add(&bar[XB_XSUB(b.x)], 1u);
        const unsigned gen = old / nloc;
        if (old + 1u == (gen + 1u) * nloc) {
            __builtin_amdgcn_fence(__ATOMIC_RELEASE, "agent");
            asm volatile("s_waitcnt vmcnt(0)" ::: "memory");
            const unsigned og = xb_add(&bar[XB_TOP], 1u);
            const unsigned tg = og / nx;
            if (og + 1u == (tg + 1u) * nx) xb_add(&bar[XB_TOPGEN], 1u);
            else XB_SPIN(xb_ld(&bar[XB_TOPGEN]) == tg, bar);
            __builtin_amdgcn_fence(__ATOMIC_ACQUIRE, "agent");
            xb_add(&bar[XB_XGEN(b.x)], 1u);
            asm volatile("s_waitcnt vmcnt(0)" ::: "memory");
        } else {
            XB_SPIN(xb_ld(&bar[XB_XGEN(b.x)]) == gen, bar);
            __builtin_amdgcn_fence(__ATOMIC_ACQUIRE, "agent");
            asm volatile("s_waitcnt vmcnt(0)" ::: "memory");
        }
    }
    __syncthreads();
}

constexpr int RING_OFF = 0, RING_BYTES = 131072;
constexpr int LDSCTL_OFF = RING_BYTES, MISC_OFF = LDSCTL_OFF + 320;
constexpr int LDS_BYTES = 147456;
constexpr int NWAVES = 8;

struct Args { const float* in[20]; float* out; unsigned char* ws; int ph_lo, ph_hi; };

template <int RMAP>
__device__ __forceinline__ int p0_rowmap(int n) {
    if (RMAP == 1) { if (n < 1024) { const int pn = n >> 8, lc = n & 255, hh = lc >> 6, d = lc & 63; return pn * 256 + 128 * (d >> 5) + 32 * hh + (d & 31); } return n; }
    return n;
}
template <int RMAP>
__device__ __forceinline__ void p0_transpose_item(const float* W, int N, bf16_t* WT, int ldt, int koff, const float* kscale, LAS float* scr, int item, int lane) {
    const int nblk = N / 32, kb = item / nblk, nb = item % nblk, k0 = 64 * kb, n0 = 32 * nb;
#pragma unroll 8
    for (int i = 0; i < 32; ++i) { const int kk = 2 * i + (lane >> 5); float v = W[(size_t)(k0 + kk) * N + n0 + (lane & 31)]; if (kscale) v *= kscale[k0 + kk]; scr[kk * 33 + (lane & 31)] = v; }
    asm volatile("s_waitcnt lgkmcnt(0)" ::: "memory");
    const int c = lane & 7;
#pragma unroll
    for (int j = 0; j < 4; ++j) { const int n = (lane >> 3) + 8 * j; const LAS float* s = scr + (8 * c) * 33 + n;
        u32x4 o; o.x = pk2(s[0 * 33], s[1 * 33]); o.y = pk2(s[2 * 33], s[3 * 33]); o.z = pk2(s[4 * 33], s[5 * 33]); o.w = pk2(s[6 * 33], s[7 * 33]);
        *(u32x4*)(WT + (size_t)p0_rowmap<RMAP>(n0 + n) * ldt + koff + k0 + 8 * c) = o; }
    asm volatile("s_waitcnt lgkmcnt(0)" ::: "memory");
}
__device__ __forceinline__ void rms_row_to_bf16(const float* xrow, const float* w, bf16_t* orow, int lane) {
    const f32x4* xr = (const f32x4*)xrow + lane; const f32x4* wr = (const f32x4*)w + lane;
    f32x4 v[4]; float s = 0.f;
#pragma unroll
    for (int j = 0; j < 4; ++j) { v[j] = xr[64 * j]; s += (v[j].x * v[j].x + v[j].y * v[j].y) + (v[j].z * v[j].z + v[j].w * v[j].w); }
    const float rstd = 1.f / sqrtf(wave_sum(s) * (1.f / DM) + EPS);
    unsigned long long* o8 = (unsigned long long*)orow + lane;
#pragma unroll
    for (int j = 0; j < 4; ++j) { const f32x4 ww = wr[64 * j];
        o8[64 * j] = (unsigned long long)pk2(v[j].x * rstd * ww.x, v[j].y * rstd * ww.y) | ((unsigned long long)pk2(v[j].z * rstd * ww.z, v[j].w * rstd * ww.w) << 32); }
}

namespace attn_body {
using bf16=__hip_bfloat16;
using s16x4=__attribute__((ext_vector_type(4)))short;
using f32x16=__attribute__((ext_vector_type(16)))float;
constexpr int D=64,PQ=::DA,PO=::OC;
constexpr int NW=8,QBLK=32,QB=QBLK*NW,KVBLK=64,NQB=::SEQ/QB;
constexpr int TAB_N=384, LDS_TAB=86016;
__device__ __forceinline__ int crow(int r,int hi){return (r&3)+8*(r>>2)+4*hi;}
#define SBAR() __builtin_amdgcn_sched_barrier(0)
__device__ __forceinline__ void bmask(f32x16&p0,f32x16&p1,int jb,int qrel,int hi,const __attribute__((address_space(3))) float*tab){
  const int base=qrel-64*jb-4*hi+255;
  #pragma unroll
  for(int r=0;r<16;++r){const int i0=base-((r&3)+8*(r>>2)); const int j0=i0<368?i0:368; const int i1=i0-32; const int j1=i1<368?i1:368; p0[r]+=tab[j0]; p1[r]+=tab[j1];}
}

constexpr int NSLOT=3, SLOTB=8192;
constexpr int LDS_K=0, LDS_V=NSLOT*SLOTB, LDS_WS=2*NSLOT*SLOTB, LDS_OST=LDS_WS+NW*64*4, LDS_BYTES=LDS_OST+NW*4096;
__device__ __forceinline__ void glds16(const void*gsrc,unsigned lds_dst){unsigned keep;
  asm volatile("s_mov_b32 %0, m0\n\ts_mov_b32 m0, %2\n\ts_nop 0\n\tglobal_load_lds_dwordx4 %1, off\n\ts_mov_b32 m0, %0":"=&s"(keep):"v"(gsrc),"s"(lds_dst):"memory");}
__device__ __forceinline__ float max3f(float a,float b,float c){float r;asm("v_max3_f32 %0, %1, %2, %3":"=v"(r):"v"(a),"v"(b),"v"(c));return r;}
__device__ __forceinline__ float max2f(float a,float b){float r;asm("v_max_f32_e32 %0, %1, %2":"=v"(r):"v"(a),"v"(b));return r;}
__device__ __forceinline__ float fadd_s(float a,float b){float r;asm("v_add_f32_e32 %0, %1, %2":"=v"(r):"v"(a),"v"(b));return r;}
__device__ __forceinline__ float fsub_s(float a,float b){float r;asm("v_sub_f32_e32 %0, %1, %2":"=v"(r):"v"(a),"v"(b));return r;}
typedef float f32x2_t __attribute__((ext_vector_type(2))); typedef __bf16 bf16x2_t __attribute__((ext_vector_type(2)));
__device__ __forceinline__ unsigned cvtpk_s(float lo,float hi){f32x2_t v={lo,hi};bf16x2_t b=__builtin_convertvector(v,bf16x2_t);return __builtin_bit_cast(unsigned,b);}
#define WAIT_BAR(N) asm volatile("s_waitcnt vmcnt(" #N ") lgkmcnt(0)\n\ts_barrier":::"memory")

__device__ __forceinline__ void qkt(f32x16&p0,f32x16&p1,const char*Kslot,const bf16x8*qr,const f32x16&negm,int r32,int hi){
  const char*kb=Kslot+hi*1024+r32*16;
  #pragma unroll
  for(int d0=0;d0<4;++d0){
    const bf16x8 b0=*reinterpret_cast<const bf16x8*>(kb+d0*2048);
    const bf16x8 b1=*reinterpret_cast<const bf16x8*>(kb+d0*2048+512);
    if(d0==0){p0=__builtin_amdgcn_mfma_f32_32x32x16_bf16(b0,qr[0],negm,0,0,0);p1=__builtin_amdgcn_mfma_f32_32x32x16_bf16(b1,qr[0],negm,0,0,0);}
    else{p0=__builtin_amdgcn_mfma_f32_32x32x16_bf16(b0,qr[d0],p0,0,0,0);p1=__builtin_amdgcn_mfma_f32_32x32x16_bf16(b1,qr[d0],p1,0,0,0);}}
}
typedef __attribute__((address_space(3))) const char* lds_cptr;
typedef short v4i16_t __attribute__((ext_vector_type(4)));
__device__ __forceinline__ void kload8(bf16x8*kf,lds_cptr kp){
  kf[0]=*(const __attribute__((address_space(3))) bf16x8*)(kp);      kf[1]=*(const __attribute__((address_space(3))) bf16x8*)(kp+512);
  kf[2]=*(const __attribute__((address_space(3))) bf16x8*)(kp+2048); kf[3]=*(const __attribute__((address_space(3))) bf16x8*)(kp+2560);
  kf[4]=*(const __attribute__((address_space(3))) bf16x8*)(kp+4096); kf[5]=*(const __attribute__((address_space(3))) bf16x8*)(kp+4608);
  kf[6]=*(const __attribute__((address_space(3))) bf16x8*)(kp+6144); kf[7]=*(const __attribute__((address_space(3))) bf16x8*)(kp+6656);
}
__device__ __forceinline__ void kload2(bf16x8*kf,lds_cptr kp,int j){ kf[2*j]=*(const __attribute__((address_space(3))) bf16x8*)(kp+j*2048); kf[2*j+1]=*(const __attribute__((address_space(3))) bf16x8*)(kp+j*2048+512); }
__device__ __forceinline__ s16x4 vtr(lds_cptr p){ return __builtin_bit_cast(s16x4,__builtin_amdgcn_ds_read_tr16_b64_v4i16((__attribute__((address_space(3))) v4i16_t*)p)); }
__device__ __forceinline__ float rowmax(const f32x16&p0,const f32x16&p1){
  float a=max3f(p0[0],p0[1],p1[0]),b=max3f(p0[2],p0[3],p1[1]);a=max3f(a,p1[2],p1[3]);
  #pragma unroll
  for(int r=4;r<16;r+=4){a=max3f(a,p0[r],p0[r+1]);b=max3f(b,p0[r+2],p0[r+3]);a=max3f(a,p1[r],p1[r+1]);b=max3f(b,p1[r+2],p1[r+3]);}
  const float m=max2f(a,b);
  auto rr=__builtin_amdgcn_permlane32_swap(__float_as_uint(m),__float_as_uint(m),false,false);
  return max2f(__uint_as_float(rr[0]),__uint_as_float(rr[1]));
}
__device__ __forceinline__ void pv(f32x16*o,int vb,bf16x8 pa0,bf16x8 pa1,bf16x8 pa2,bf16x8 pa3){
  #pragma unroll
  for(int d0=0;d0<2;++d0){s16x4 lo[4],hi[4];
    #pragma unroll
    for(int ks=0;ks<4;++ks){
      asm volatile("ds_read_b64_tr_b16 %0,%1 offset:%c2":"=&v"(lo[ks]):"v"(vb),"i"(d0*4096+ks*1024):"memory");
      asm volatile("ds_read_b64_tr_b16 %0,%1 offset:%c2":"=&v"(hi[ks]):"v"(vb),"i"(d0*4096+ks*1024+512):"memory");}
    asm volatile("s_waitcnt lgkmcnt(0)":::"memory");SBAR();
    #define PK(k) (bf16x8){lo[k][0],lo[k][1],lo[k][2],lo[k][3],hi[k][0],hi[k][1],hi[k][2],hi[k][3]}
    o[d0]=__builtin_amdgcn_mfma_f32_32x32x16_bf16(pa0,PK(0),o[d0],0,0,0);
    o[d0]=__builtin_amdgcn_mfma_f32_32x32x16_bf16(pa1,PK(1),o[d0],0,0,0);
    o[d0]=__builtin_amdgcn_mfma_f32_32x32x16_bf16(pa2,PK(2),o[d0],0,0,0);
    o[d0]=__builtin_amdgcn_mfma_f32_32x32x16_bf16(pa3,PK(3),o[d0],0,0,0);
    #undef PK
  }
}

#ifndef ATTN_STORE16
#define ATTN_STORE16(p,v) (*(u32x4*)(p)=(v))
#endif
template<int THRL> __device__ __forceinline__ void attn_unit(int b,int h,int qb,const bf16*Q,const bf16*__restrict__ K,const bf16*__restrict__ V,const float*__restrict__ kmp,bf16*O,char*shm){
  const int tid=threadIdx.x,lane=tid&63,r32=lane&31,hi=lane>>5; const int wid=__builtin_amdgcn_readfirstlane(tid>>6);
  const long rowbase=(long)b*::SEQ; const int q0=qb*QB;
  const bf16*Qw=Q+(rowbase+q0+wid*QBLK)*PQ+h*D;
  const bf16*Kh=K+rowbase*PQ+h*D,*Vh=V+rowbase*PQ+h*D;
  const unsigned lds0=(unsigned)(uintptr_t)shm;
  float*wsf=(float*)(shm+LDS_WS)+wid*64;
  const bf16*ksrc=Kh+(long)lane*PQ+wid*8;
  const bf16*vsrc=Vh+(long)(16*(wid&3)+(lane>>2))*PQ+(wid>>2)*32+(lane&3)*8;
  const unsigned kdst=lds0+LDS_K+wid*1024, vdst=lds0+LDS_V+wid*1024;
  #define TOFF(t) ((long)(((t)<4)?(q0+KVBLK*(t)):(KVBLK*((t)-4)))*PQ)
  #define DMA_K(t,slot) glds16(ksrc+TOFF(t),(unsigned)__builtin_amdgcn_readfirstlane(kdst+(slot)))
  #define DMA_V(t,slot) glds16(vsrc+TOFF(t),(unsigned)__builtin_amdgcn_readfirstlane(vdst+(slot)))
  const int vb0=(int)(lds0+LDS_V)+((lane>>4)&1)*32+(lane&3)*8+(4*hi+((lane&15)>>2))*64;
  const char*Kbase=shm+LDS_K; bf16x8 kf[8];
  const lds_cptr shm3=(lds_cptr)shm; const lds_cptr kp0=shm3+LDS_K+hi*1024+r32*16; const lds_cptr vp0=shm3+LDS_V+((lane>>4)&1)*32+(lane&3)*8+(4*hi+((lane&15)>>2))*64;
  const int NT=(q0+QB)/KVBLK;
  DMA_K(0,0);DMA_V(0,0);DMA_K(1,SLOTB);
  bf16x8 qr[4];
  #pragma unroll
  for(int d0=0;d0<4;++d0)qr[d0]=*reinterpret_cast<const bf16x8*>(&Qw[(long)r32*PQ+d0*16+hi*8]);
  float mhat=0.f,l_reg=0.f;f32x16 o[2];o[0]=f32x16{};o[1]=f32x16{};f32x16 negm=f32x16{};asm volatile("":"+v"(negm));
  const int qrel=wid*QBLK+r32;
  const __attribute__((address_space(3))) float*tab=(const __attribute__((address_space(3))) float*)((lds_cptr)shm+LDS_TAB)+h*TAB_N;
  unsigned selmask=0u;
  if(qb>0){
    f32x16 gacc=f32x16{};
    const float*kmA=kmp+((size_t)(b*::NKB+(r32&15))*2)*::DA+h*D+hi*8;
    #pragma unroll
    for(int d0=0;d0<4;++d0){ const float*p=kmA+d0*16;
      const f32x4 a0=*(const f32x4*)p,a1=*(const f32x4*)(p+4),b0=*(const f32x4*)(p+::DA),b1=*(const f32x4*)(p+::DA+4);
      float v[8]; v[0]=a0[0]+b0[0];v[1]=a0[1]+b0[1];v[2]=a0[2]+b0[2];v[3]=a0[3]+b0[3];v[4]=a1[0]+b1[0];v[5]=a1[1]+b1[1];v[6]=a1[2]+b1[2];v[7]=a1[3]+b1[3];
      u32x4 wh,wl;
      #pragma unroll
      for(int j=0;j<4;++j){ const unsigned h0=::f2bf(v[2*j]),h1=::f2bf(v[2*j+1]); wh[j]=h0|(h1<<16);
        const float r0=v[2*j]-__uint_as_float(h0<<16),r1=v[2*j+1]-__uint_as_float(h1<<16); wl[j]=::f2bf(r0)|(::f2bf(r1)<<16); }
      gacc=__builtin_amdgcn_mfma_f32_32x32x16_bf16(__builtin_bit_cast(bf16x8,wh),qr[d0],gacc,0,0,0);
      gacc=__builtin_amdgcn_mfma_f32_32x32x16_bf16(__builtin_bit_cast(bf16x8,wl),qr[d0],gacc,0,0,0); }
    float g[16];
    #pragma unroll
    for(int r=0;r<4;++r){ const float m0=gacc[r],o0=__shfl_xor(m0,32),m1=gacc[4+r],o1=__shfl_xor(m1,32);
      g[r]=hi?o0:m0; g[4+r]=hi?m0:o0; g[8+r]=hi?o1:m1; g[12+r]=hi?m1:o1; }
    #pragma unroll
    for(int j=0;j<16;++j) if(j>=qb) g[j]=-INFINITY;
    #pragma unroll
    for(int rd=0;rd<3;++rd){ float best=-INFINITY; int bi=-1;
      #pragma unroll
      for(int j=0;j<16;++j) if(g[j]>best){best=g[j];bi=j;}
      if(bi>=0) selmask|=1u<<bi;
      #pragma unroll
      for(int j=0;j<16;++j) if(j==bi) g[j]=-INFINITY; }
  }
  #define SELT(t) (((t)<4)||((selmask>>(((t)-4)>>2))&1u))
  #define CMASK(P0,P1,t) do{ if((t)<4) bmask(P0,P1,(t),qrel,hi,tab); else if((t)>=NT-2) bmask(P0,P1,0,qrel+128-64*((t)-(NT-2)),hi,tab); }while(0)
  bool resc=false;
  #define START(P0,P1) do{ const float rm=rowmax(P0,P1); resc=false; \
    { const float dl=rm; mhat=fadd_s(mhat,dl); \
      _Pragma("unroll") for(int r=0;r<16;++r){P0[r]=fsub_s(P0[r],dl);P1[r]=fsub_s(P1[r],dl);} \
      _Pragma("unroll") for(int r=0;r<16;++r)negm[r]=-mhat; asm volatile("":"+v"(negm)); } \
    _Pragma("unroll") for(int r=0;r<16;++r)P0[r]=__builtin_amdgcn_exp2f(P0[r]); }while(0)
  #define RESC() do{ if(resc){ asm volatile("s_waitcnt lgkmcnt(0)":::"memory"); \
      _Pragma("unroll") for(int d_=0;d_<2;++d_) _Pragma("unroll") for(int r=0;r<16;++r)o[d_][r]*=wsf[crow(r,hi)]; } }while(0)
  f32x16 pA0,pA1,pB0,pB1;
  int sl_prev=0,sl_cur=0,sl_next=SLOTB;
  #define ROT() do{sl_prev=sl_cur;sl_cur=sl_next;sl_next=(sl_next==(NSLOT-1)*SLOTB)?0:sl_next+SLOTB;}while(0)
  DMA_K(2,2*SLOTB);
  WAIT_BAR(3);
  qkt(pA0,pA1,Kbase,qr,negm,r32,hi);asm volatile("s_nop 15\n\ts_nop 7":"+v"(pA0),"+v"(pA1));CMASK(pA0,pA1,0);
  START(pA0,pA1);
  _Pragma("unroll") for(int r=0;r<16;++r)pA1[r]=__builtin_amdgcn_exp2f(pA1[r]);
  WAIT_BAR(0);
  DMA_K(3,0);DMA_V(1,SLOTB);
  ROT();
  kload8(kf,kp0+sl_cur);
  WAIT_BAR(2);
  s16x4 vlo[8],vhi[8]; u32x4 pw0,pw1,pw2,pw3;
  #define PKW(P,B) cvtpk_s(P[B],P[B+1])
  #define PAF(k) __builtin_bit_cast(bf16x8,pw##k)
  #define VFR(i) (bf16x8){vlo[i][0],vlo[i][1],vlo[i][2],vlo[i][3],vhi[i][0],vhi[i][1],vhi[i][2],vhi[i][3]}
  #define PIN(x) asm volatile("":"+v"(x))
  #define MX3(a,b,c) __builtin_fmaxf(__builtin_fmaxf((a),(b)),(c))
  #define GAPA(MF,A0,A1,A2,A3,W0,W1,PW) do{ MF; sacc+=A0; sacc+=A1; sacc+=A2; sacc+=A3; PIN(sacc); W0; W1; PIN(PW); SBAR(); }while(0)
  #define EX(v) __builtin_amdgcn_exp2f(v)
  #define GAPB(MF,X,B) do{ MF; X[B]=EX(X[B]); X[B+1]=EX(X[B+1]); X[B+2]=EX(X[B+2]); X[B+3]=EX(X[B+3]); PIN(X); SBAR(); }while(0)
  #define VRD(i) do{ vlo[i]=vtr(vp_+(((i)>>2)*4096+((i)&3)*1024)); vhi[i]=vtr(vp_+(((i)>>2)*4096+((i)&3)*1024+512)); }while(0)
  #define KRD(G,j) do{ if(G){ kload2(kf,kp0+sl_next,j); SBAR(); } }while(0)
  #define STEP(C0,C1,P0,P1,t,GK,GV,GL) do{ SBAR(); \
    { const float nv_=SELT(t)?-mhat:-INFINITY; _Pragma("unroll") for(int r=0;r<16;++r)negm[r]=nv_; asm volatile("":"+v"(negm)); } SBAR(); \
    const lds_cptr vp_=vp0+sl_prev; \
    VRD(0); SBAR(); float sacc=(P0[0]+P0[1]); \
    GAPA(C0=__builtin_amdgcn_mfma_f32_32x32x16_bf16(kf[0],qr[0],negm,0,0,0), P0[2],P0[3],P0[4],P0[5],     pw0[0]=PKW(P0,0), pw0[1]=PKW(P0,2), pw0); \
    VRD(4); SBAR(); GAPA(C1=__builtin_amdgcn_mfma_f32_32x32x16_bf16(kf[1],qr[0],negm,0,0,0), P0[6],P0[7],P0[8],P0[9],     pw0[2]=PKW(P0,4), pw0[3]=PKW(P0,6), pw0); \
    VRD(1); SBAR(); GAPA(C0=__builtin_amdgcn_mfma_f32_32x32x16_bf16(kf[2],qr[1],C0,0,0,0),   P0[10],P0[11],P0[12],P0[13], pw1[0]=PKW(P0,8), pw1[1]=PKW(P0,10), pw1); \
    VRD(5); SBAR(); GAPA(C1=__builtin_amdgcn_mfma_f32_32x32x16_bf16(kf[3],qr[1],C1,0,0,0),   P0[14],P0[15],P1[0],P1[1],   pw1[2]=PKW(P0,12),pw1[3]=PKW(P0,14), pw1); \
    VRD(2); SBAR(); GAPA(C0=__builtin_amdgcn_mfma_f32_32x32x16_bf16(kf[4],qr[2],C0,0,0,0),   P1[2],P1[3],P1[4],P1[5],     pw2[0]=PKW(P1,0), pw2[1]=PKW(P1,2), pw2); \
    VRD(6); SBAR(); GAPA(C1=__builtin_amdgcn_mfma_f32_32x32x16_bf16(kf[5],qr[2],C1,0,0,0),   P1[6],P1[7],P1[8],P1[9],     pw2[2]=PKW(P1,4), pw2[3]=PKW(P1,6), pw2); \
    VRD(3); SBAR(); GAPA(C0=__builtin_amdgcn_mfma_f32_32x32x16_bf16(kf[6],qr[3],C0,0,0,0),   P1[10],P1[11],P1[12],P1[13], pw3[0]=PKW(P1,8), pw3[1]=PKW(P1,10), pw3); \
    VRD(7); SBAR(); GAPA(C1=__builtin_amdgcn_mfma_f32_32x32x16_bf16(kf[7],qr[3],C1,0,0,0),   P1[14],P1[15],0.f,0.f,       pw3[2]=PKW(P1,12),pw3[3]=PKW(P1,14), pw3); \
    l_reg+=sacc; \
    if(GK){DMA_K((t)+3,sl_cur);} if(GV){DMA_V((t)+1,sl_next);} \
    if(MASKON){CMASK(C0,C1,t);} \
    { float a=MX3(C0[0],C0[1],C1[0]),b=MX3(C0[2],C0[3],C1[1]); a=MX3(a,C1[2],C1[3]); \
      _Pragma("unroll") for(int r=4;r<16;r+=4){a=MX3(a,C0[r],C0[r+1]);b=MX3(b,C0[r+2],C0[r+3]);a=MX3(a,C1[r],C1[r+1]);b=MX3(b,C1[r+2],C1[r+3]);} \
      float rm=__builtin_fmaxf(a,b); { auto rr=__builtin_amdgcn_permlane32_swap(__float_as_uint(rm),__float_as_uint(rm),false,false); rm=__builtin_fmaxf(__uint_as_float(rr[0]),__uint_as_float(rr[1])); } \
      resc=false; \
      if(__builtin_expect(__any(rm>(float)THRL),0)){ const float dl=__builtin_fmaxf(rm,0.f); mhat+=dl; \
        _Pragma("unroll") for(int r=0;r<16;++r){C0[r]-=dl;C1[r]-=dl;} \
        const float f=__builtin_amdgcn_exp2f(-dl); l_reg*=f; if(hi==0)wsf[r32]=f; resc=true; } } \
    SBAR(); \
    GAPB(o[0]=__builtin_amdgcn_mfma_f32_32x32x16_bf16(PAF(0),VFR(0),o[0],0,0,0), C0,0); \
    GAPB(o[1]=__builtin_amdgcn_mfma_f32_32x32x16_bf16(PAF(0),VFR(4),o[1],0,0,0), C0,4); \
    KRD(GL,0); GAPB(o[0]=__builtin_amdgcn_mfma_f32_32x32x16_bf16(PAF(1),VFR(1),o[0],0,0,0), C0,8); \
    KRD(GL,1); GAPB(o[1]=__builtin_amdgcn_mfma_f32_32x32x16_bf16(PAF(1),VFR(5),o[1],0,0,0), C0,12); \
    KRD(GL,2); GAPB(o[0]=__builtin_amdgcn_mfma_f32_32x32x16_bf16(PAF(2),VFR(2),o[0],0,0,0), C1,0); \
    KRD(GL,3); GAPB(o[1]=__builtin_amdgcn_mfma_f32_32x32x16_bf16(PAF(2),VFR(6),o[1],0,0,0), C1,4); \
    GAPB(o[0]=__builtin_amdgcn_mfma_f32_32x32x16_bf16(PAF(3),VFR(3),o[0],0,0,0), C1,8); \
    GAPB(o[1]=__builtin_amdgcn_mfma_f32_32x32x16_bf16(PAF(3),VFR(7),o[1],0,0,0), C1,12); \
    }while(0)
  int t=1;
  #define ENDW(tt) do{ if((tt)+3<NT){WAIT_BAR(2);} else if((tt)+2<NT){WAIT_BAR(1);} else {WAIT_BAR(0);} }while(0)
  #define MASKON 1
  for(;t<4&&t+1<NT;t+=2){
    STEP(pB0,pB1,pA0,pA1,t,(t+3<NT),(t+1<NT),(t+1<NT));       ENDW(t);   RESC(); ROT();
    STEP(pA0,pA1,pB0,pB1,t+1,(t+4<NT),(t+2<NT),(t+2<NT));     ENDW(t+1); RESC(); ROT();
  }
  #undef MASKON
  #define MASKON 0
  for(;t+5<NT;t+=2){
    STEP(pB0,pB1,pA0,pA1,t,true,true,true);     WAIT_BAR(2); RESC(); ROT();
    STEP(pA0,pA1,pB0,pB1,t+1,true,true,true);   WAIT_BAR(2); RESC(); ROT();
  }
  #undef MASKON
  #define MASKON 1
  for(;t+1<NT;t+=2){
    STEP(pB0,pB1,pA0,pA1,t,(t+3<NT),(t+1<NT),(t+1<NT));       ENDW(t);   RESC(); ROT();
    STEP(pA0,pA1,pB0,pB1,t+1,(t+4<NT),(t+2<NT),(t+2<NT));     ENDW(t+1); RESC(); ROT();
  }
  STEP(pB0,pB1,pA0,pA1,NT-1,false,false,false); RESC();
  { float sacc=pB0[0]+pB0[1]; _Pragma("unroll") for(int r=2;r<16;++r)sacc+=pB0[r]; _Pragma("unroll") for(int r=0;r<16;++r)sacc+=pB1[r]; l_reg+=sacc;
    pw0=(u32x4){PKW(pB0,0),PKW(pB0,2),PKW(pB0,4),PKW(pB0,6)};pw1=(u32x4){PKW(pB0,8),PKW(pB0,10),PKW(pB0,12),PKW(pB0,14)};pw2=(u32x4){PKW(pB1,0),PKW(pB1,2),PKW(pB1,4),PKW(pB1,6)};pw3=(u32x4){PKW(pB1,8),PKW(pB1,10),PKW(pB1,12),PKW(pB1,14)};
    SBAR(); pv(o,vb0+sl_cur,PAF(0),PAF(1),PAF(2),PAF(3)); }
  #undef PKW
  #undef PAF
  #undef VFR
  #undef PIN
  #undef MX3
  #undef GAPA
  #undef GAPB
  #undef EX
  #undef VRD
  #undef KRD
  #undef STEP
  #undef ENDW
  {auto rr=__builtin_amdgcn_permlane32_swap(__float_as_uint(l_reg),__float_as_uint(l_reg),false,false);l_reg=__uint_as_float(rr[0])+__uint_as_float(rr[1]);}
  if(hi==0)wsf[32+r32]=l_reg;asm volatile("s_waitcnt lgkmcnt(0)":::"memory");
  float rli[16];
  #pragma unroll
  for(int r=0;r<16;++r)rli[r]=__builtin_amdgcn_rcpf(wsf[32+crow(r,hi)]);
  bf16*Ow=O+(rowbase+q0+wid*QBLK)*PO+h*D;
  { bf16*stg=(bf16*)(shm+LDS_OST)+wid*2048;
    #pragma unroll
    for(int r=0;r<16;++r){const int orow=crow(r,hi);
      #pragma unroll
      for(int d0=0;d0<2;++d0)stg[orow*64+d0*32+r32]=__float2bfloat16(o[d0][r]*rli[r]);}
    asm volatile("s_waitcnt lgkmcnt(0)":::"memory");
    #pragma unroll
    for(int i=0;i<4;++i){const int row=i*8+(lane>>3),ch=lane&7; const u32x4 v=*(const u32x4*)(stg+row*64+ch*8); ATTN_STORE16(Ow+(long)row*PO+ch*8,v);} }
  asm volatile("s_waitcnt lgkmcnt(0)\n\ts_barrier":::"memory");
  #undef DMA_K
  #undef TOFF
  #undef SELT
  #undef MASKON
  #undef DMA_V
  #undef CMASK
  #undef START
  #undef RESC
  #undef ROT
}
constexpr int ATTN_LDS_BYTES=LDS_BYTES;
struct AttnTensors { const bf16* Q; const bf16* K; const bf16* V; const float* kmp; const float* rel_bias; bf16* O; };
struct AttnUnit { int bh; int qb; };
struct StaticOrder {
  int vcu;
  __device__ __forceinline__ explicit StaticOrder(int v):vcu(v){}
  __device__ __forceinline__ bool next(int i,AttnUnit&u)const{ if(i>=4)return false; const int s=vcu&3; u.bh=vcu>>2; u.qb=(i==0)?s:(i==1)?7-s:(i==2)?8+s:15-s; return true; }
};
template<int THRL=8> __device__ __forceinline__ void attn_phase(char*lds,const AttnTensors&T,int vcu0,int G){
  { __attribute__((address_space(3))) float*tb=(__attribute__((address_space(3))) float*)((lds_cptr)lds+LDS_TAB);
    for(int i=threadIdx.x;i<8*TAB_N;i+=NW*64){ const int hh=i/TAB_N,k=i%TAB_N,rel=k-255; float v=0.f;
      if(rel<0)v=-INFINITY; else if(rel<=112)v=(T.rel_bias[::t5_bucket(rel)*::NH+hh]-T.rel_bias[31*::NH+hh])*::LOG2E;
      tb[i]=v; }
    asm volatile("s_waitcnt lgkmcnt(0)\n\ts_barrier":::"memory"); }
  for(int v=vcu0;v<256;v+=G){ const StaticOrder S(v); AttnUnit u;
    for(int i=0;S.next(i,u);++i) attn_unit<THRL>(u.bh / ::NH, u.bh % ::NH, u.qb,T.Q,T.K,T.V,T.kmp,T.O,lds); }
}
#undef SBAR
#undef WAIT_BAR
}

namespace rnn {
typedef float f32x16 __attribute__((ext_vector_type(16)));
constexpr int NCHK = 16, CHT = SEQ / NCHK, TILES = CHT / 32;
constexpr int LDS_BEXT = 98304, LDS_CW = LDS_BEXT + 24576, LDS_STG = 0;
__device__ __forceinline__ void fill_tables(LAS unsigned char* lds, int blk, const float* __restrict__ Wa, const float* __restrict__ Wi, const float* __restrict__ cw, const float* __restrict__ cb, int tid) {
    for (int e = tid; e < 24 * 64; e += NWAVES * 64) {
        const int frag = e >> 6, ln = e & 63, ntile = frag >> 2, ks = frag & 3, n = ln & 31, hi = ln >> 5;
        const int col = (ntile & 1) * 32 + n, k0 = 16 * ks + 8 * hi;
        const float* W = (ntile < 2 ? Wa : Wi) + (size_t)blk * RBD * RBD + col;
        u32x4 w;
#pragma unroll
        for (int j2 = 0; j2 < 4; ++j2) { const int k = k0 + 2 * j2; float v0, v1;
            if (ntile < 4) { v0 = W[k * RBD]; v1 = W[(k + 1) * RBD]; } else { v0 = (k == col) ? 1.f : 0.f; v1 = (k + 1 == col) ? 1.f : 0.f; }
            w[j2] = pk2(v0, v1); }
        *(LAS u32x4*)(lds + LDS_BEXT + e * 16) = w;
    }
    for (int e = tid; e < 5 * 64; e += NWAVES * 64) { const int j = e >> 6, c = e & 63; ((LAS float*)(lds + LDS_CW))[e] = (j < 4) ? cw[j * DR + blk * RBD + c] : cb[blk * RBD + c]; }
}
template <bool FINAL>
__device__ __forceinline__ void scan_chunk(LAS unsigned char* lds, int b, int blk, int chunk, int wave, int lane, const bf16_t* __restrict__ XR, const bf16_t* __restrict__ GY,
                                           const float* __restrict__ ba, const float* __restrict__ bi, const float* __restrict__ lam, float* comp, bf16_t* __restrict__ O) {
    const int r32 = lane & 31, hi = lane >> 5;
    float cba[2], cbi[2], c8[2], H[2], Ac[2];
#pragma unroll
    for (int nt = 0; nt < 2; ++nt) { const int ch = blk * RBD + 32 * nt + r32; cba[nt] = ba[ch]; cbi[nt] = bi[ch]; c8[nt] = 8.0f * log1pf(expf(-lam[ch])); H[nt] = 0.f; Ac[nt] = 1.f; }
    if (FINAL) {
        for (int k = 0; k < chunk; ++k) {
#pragma unroll
            for (int nt = 0; nt < 2; ++nt) { const f32x2 c = *(const f32x2*)(comp + (((size_t)b * NCHK + k) * DR + blk * RBD + 32 * nt + r32) * 2); H[nt] = c[0] * H[nt] + c[1]; } }
    }
    const size_t row0 = (size_t)b * SEQ + (size_t)chunk * CHT;
    const LAS f32x4* cwp = (const LAS f32x4*)(lds + LDS_CW) + 2 * hi;
    const LAS bf16x8* bfr = (const LAS bf16x8*)(lds + LDS_BEXT) + lane;
    LAS bf16_t* stg = (LAS bf16_t*)(lds + LDS_STG + wave * 4096);
    for (int tile = 0; tile < TILES; ++tile) {
        const int tpos = chunk * CHT + tile * 32 + r32;
        const bf16_t* xp = XR + (row0 + tile * 32 + r32) * DR + blk * RBD + 8 * hi;
        u32x4 gyv[4];
        if (FINAL) {
#pragma unroll
            for (int i = 0; i < 4; ++i) gyv[i] = *(const u32x4*)(GY + (row0 + tile * 32 + 8 * i + (lane >> 3)) * DR + blk * RBD + (lane & 7) * 8);
        }
        bf16x8 af[4];
#pragma unroll
        for (int ks = 0; ks < 4; ++ks) {
            u32x4 xj[4];
            xj[3] = *(const u32x4*)(xp + 16 * ks);
#pragma unroll
            for (int j = 0; j < 3; ++j) { const bool ok = (tpos + j - 3) >= 0; const u32x4 v = *(const u32x4*)(xp + (ok ? (long)(j - 3) * DR : 0) + 16 * ks); xj[j] = ok ? v : (u32x4){0u, 0u, 0u, 0u}; }
            f32x4 alo = cwp[64 + 4 * ks], ahi = cwp[64 + 4 * ks + 1];
#pragma unroll
            for (int j = 0; j < 4; ++j) { const f32x4 wlo = cwp[16 * j + 4 * ks], whi = cwp[16 * j + 4 * ks + 1]; const u32x4 x = xj[j];
                const f32x4 xlo = {__uint_as_float(x[0] << 16), __uint_as_float(x[0] & 0xffff0000u), __uint_as_float(x[1] << 16), __uint_as_float(x[1] & 0xffff0000u)};
                const f32x4 xhi = {__uint_as_float(x[2] << 16), __uint_as_float(x[2] & 0xffff0000u), __uint_as_float(x[3] << 16), __uint_as_float(x[3] & 0xffff0000u)};
                alo += wlo * xlo; ahi += whi * xhi; }
            u32x4 pk; pk[0] = cvt_pk_bf16(alo[0], alo[1]); pk[1] = cvt_pk_bf16(alo[2], alo[3]); pk[2] = cvt_pk_bf16(ahi[0], ahi[1]); pk[3] = cvt_pk_bf16(ahi[2], ahi[3]);
            af[ks] = __builtin_bit_cast(bf16x8, pk);
            asm volatile("" ::: "memory");
        }
#pragma unroll
        for (int nt = 0; nt < 2; ++nt) {
            f32x16 aR = f32x16{}, aI = f32x16{}, aX = f32x16{};
#pragma unroll
            for (int ks = 0; ks < 4; ++ks) {
                aR = __builtin_amdgcn_mfma_f32_32x32x16_bf16(af[ks], bfr[64 * (4 * nt + ks)], aR, 0, 0, 0);
                aI = __builtin_amdgcn_mfma_f32_32x32x16_bf16(af[ks], bfr[64 * (4 * (2 + nt) + ks)], aI, 0, 0, 0);
                aX = __builtin_amdgcn_mfma_f32_32x32x16_bf16(af[ks], bfr[64 * (4 * (4 + nt) + ks)], aX, 0, 0, 0); }
            float av[16], uv[16];
#pragma unroll
            for (int r = 0; r < 16; ++r) {
                const float rr = fast_sigmoid(aR[r] + cba[nt]), ii = fast_sigmoid(aI[r] + cbi[nt]);
                const float la = -c8[nt] * rr; const float a = __builtin_amdgcn_exp2f(la * LOG2E); const float y = la + la;
                float p = 1.0f / 720.0f; p = p * y + (1.0f / 120.0f); p = p * y + (1.0f / 24.0f); p = p * y + (1.0f / 6.0f); p = p * y + 0.5f; p = p * y + 1.0f; p = -(p * y);
                const float om = (y > -0.5f) ? p : (1.0f - a * a);
                av[r] = a; uv[r] = __builtin_amdgcn_sqrtf(om) * (ii * aX[r]); }
            float As[4], Bs[4], pA[4], pB[4], st[4];
#pragma unroll
            for (int g = 0; g < 4; ++g) { As[g] = (av[4 * g] * av[4 * g + 1]) * (av[4 * g + 2] * av[4 * g + 3]);
                Bs[g] = ((uv[4 * g] * av[4 * g + 1] + uv[4 * g + 1]) * av[4 * g + 2] + uv[4 * g + 2]) * av[4 * g + 3] + uv[4 * g + 3];
                pA[g] = __shfl_xor(As[g], 32); pB[g] = __shfl_xor(Bs[g], 32); }
            float Hc = H[nt];
#pragma unroll
            for (int g = 0; g < 4; ++g) { const float Ae = hi ? pA[g] : As[g], Be = hi ? pB[g] : Bs[g], Ao = hi ? As[g] : pA[g], Bo = hi ? Bs[g] : pB[g];
                const float h0 = Hc; Hc = Ae * Hc + Be; const float h1 = Hc; Hc = Ao * Hc + Bo; st[g] = hi ? h1 : h0;
                if (!FINAL) Ac[nt] *= Ae * Ao; }
            H[nt] = Hc;
            if (FINAL) {
#pragma unroll
                for (int g = 0; g < 4; ++g) { float h = st[g];
#pragma unroll
                    for (int i = 0; i < 4; ++i) { h = av[4 * g + i] * h + uv[4 * g + i]; stg[(8 * g + 4 * hi + i) * 64 + 32 * nt + r32] = (bf16_t)f2bf(h); } }
            }
        }
        if (FINAL) {
            asm volatile("s_waitcnt lgkmcnt(0)" ::: "memory");
#pragma unroll
            for (int i = 0; i < 4; ++i) { const int row = 8 * i + (lane >> 3), c8c = (lane & 7) * 8; const u32x4 hv = *(const LAS u32x4*)(stg + row * 64 + c8c); const u32x4 gv = gyv[i]; u32x4 w;
#pragma unroll
                for (int j = 0; j < 4; ++j) w[j] = cvt_pk_bf16(__uint_as_float(hv[j] << 16) * __uint_as_float(gv[j] << 16), __uint_as_float(hv[j] & 0xffff0000u) * __uint_as_float(gv[j] & 0xffff0000u));
                *(u32x4*)(O + (row0 + tile * 32 + row) * OC + DA + blk * RBD + c8c) = w; }
            asm volatile("s_waitcnt lgkmcnt(0)" ::: "memory");
        }
    }
    if (!FINAL && hi == 0) {
#pragma unroll
        for (int nt = 0; nt < 2; ++nt) *(f32x2*)(comp + (((size_t)b * NCHK + chunk) * DR + blk * RBD + 32 * nt + r32) * 2) = (f32x2){Ac[nt], H[nt]};
    }
}
template <bool FINAL>
__device__ __forceinline__ void scan_phase(LAS unsigned char* lds, int vcu, int G, int wave, int lane, int tid, const bf16_t* XR, const bf16_t* GY, const float* cw, const float* cb, const float* Wa, const float* ba,
                                           const float* Wi, const float* bi, const float* lam, float* comp, bf16_t* O) {
    for (int v = vcu; v < 256; v += G) {
        const int b = v >> 5, blk = (v >> 1) & 15, chunk = (v & 1) * 8 + wave;
        __syncthreads();
        fill_tables(lds, blk, Wa, Wi, cw, cb, tid);
        __syncthreads();
        scan_chunk<FINAL>(lds, b, blk, chunk, wave, lane, XR, GY, ba, bi, lam, comp, O);
    }
}
}

__device__ __forceinline__ void naive_attn_item(int idx, const bf16_t* __restrict__ Q, const bf16_t* __restrict__ K, const bf16_t* __restrict__ V, const float* __restrict__ kmp,
                                                 const float* __restrict__ rel_bias, bf16_t* __restrict__ O, int opitch) {
    const int t = idx % SEQ, h = (idx / SEQ) % NH, b = idx / (SEQ * NH);
    const size_t row = (size_t)b * SEQ + t;
    float q[64];
    { const u32x4* qp = (const u32x4*)(Q + row * DA + h * HD);
#pragma unroll
      for (int c = 0; c < 8; ++c) { const u32x4 w = qp[c];
#pragma unroll
          for (int j = 0; j < 4; ++j) { q[c * 8 + 2 * j] = __uint_as_float(w[j] << 16); q[c * 8 + 2 * j + 1] = __uint_as_float(w[j] & 0xffff0000u); } } }
    const int own = t / KBLK;
    unsigned mask = 0;
    {
        float g[16];
#pragma unroll
        for (int j = 0; j < 16; ++j) { g[j] = -INFINITY;
            if (j < own) { const float* k0 = kmp + (size_t)((b * NKB + j) * 2) * DA + h * HD; const float* k1 = k0 + DA; float s = 0.f;
#pragma unroll
                for (int d = 0; d < 64; ++d) s += q[d] * ((k0[d] + k1[d]) * (1.0f / 256.0f));
                g[j] = s; } }
#pragma unroll
        for (int r = 0; r < 3; ++r) { float best = -INFINITY; int bi = -1;
#pragma unroll
            for (int j = 0; j < 16; ++j) if (g[j] > best) { best = g[j]; bi = j; }
            if (bi >= 0) { mask |= 1u << bi;
#pragma unroll
                for (int j = 0; j < 16; ++j) if (j == bi) g[j] = -INFINITY; } }
    }
    mask |= 1u << own;
    float o[64];
#pragma unroll
    for (int d = 0; d < 64; ++d) o[d] = 0.f;
    float mx = -INFINITY, l = 0.f;
    for (int j = 0; j <= own; ++j) {
        if (!((mask >> j) & 1u)) continue;
        const int kend = (j == own) ? (t - own * KBLK + 1) : KBLK;
        for (int kk = 0; kk < kend; ++kk) {
            const size_t krow = (size_t)b * SEQ + j * KBLK + kk;
            const u32x4* kp = (const u32x4*)(K + krow * DA + h * HD);
            float s = 0.f;
#pragma unroll
            for (int c = 0; c < 8; ++c) { const u32x4 w = kp[c];
#pragma unroll
                for (int jj = 0; jj < 4; ++jj) { s += q[c * 8 + 2 * jj] * __uint_as_float(w[jj] << 16); s += q[c * 8 + 2 * jj + 1] * __uint_as_float(w[jj] & 0xffff0000u); } }
            const int rel = t - (j * KBLK + kk);
            s += rel_bias[t5_bucket(rel) * NH + h] * LOG2E;
            if (s > mx) { const float f = exp2f(mx - s); l *= f;
#pragma unroll
                for (int d = 0; d < 64; ++d) o[d] *= f;
                mx = s; }
            const float p = exp2f(s - mx); l += p;
            const u32x4* vp = (const u32x4*)(V + krow * DA + h * HD);
#pragma unroll
            for (int c = 0; c < 8; ++c) { const u32x4 w = vp[c];
#pragma unroll
                for (int jj = 0; jj < 4; ++jj) { o[c * 8 + 2 * jj] += p * __uint_as_float(w[jj] << 16); o[c * 8 + 2 * jj + 1] += p * __uint_as_float(w[jj] & 0xffff0000u); } }
        }
    }
    const float il = 1.0f / l;
    u32x4* op = (u32x4*)(O + row * opitch + h * HD);
#pragma unroll
    for (int c = 0; c < 8; ++c) { u32x4 w;
#pragma unroll
        for (int jj = 0; jj < 4; ++jj) w[jj] = pk2(o[c * 8 + 2 * jj] * il, o[c * 8 + 2 * jj + 1] * il);
        op[c] = w; }
}

__device__ __forceinline__ void rg_au_ref(float rp, float ip, float xc, float c8sp, float& a, float& u) {
    const float r = 1.0f / (1.0f + expf(-rp)), i = 1.0f / (1.0f + expf(-ip));
    const float la = -c8sp * r; a = expf(la); u = sqrtf(-expm1f(2.0f * la)) * (i * xc);
}
constexpr int NCH = 64, CHL = SEQ / NCH;
template <bool FINAL>
__device__ __forceinline__ void naive_scan_item(int item, int c, LAS float* xcs, const bf16_t* __restrict__ XR, const bf16_t* __restrict__ GY, const float* __restrict__ cw, const float* __restrict__ cb,
                                                const float* __restrict__ Wa, const float* __restrict__ ba, const float* __restrict__ Wi, const float* __restrict__ bi,
                                                const float* __restrict__ lam, float* __restrict__ comp, const float* __restrict__ carry, bf16_t* __restrict__ O) {
    const int blk = item % RB, chunk = (item / RB) % NCH, b = item / (RB * NCH);
    const int ch = blk * RBD + c;
    const float w0 = cw[ch], w1 = cw[DR + ch], w2 = cw[2 * DR + ch], w3 = cw[3 * DR + ch], bb = cb[ch];
    for (int tt = 0; tt < CHL; ++tt) { const int t = chunk * CHL + tt; const bf16_t* xp = XR + ((size_t)b * SEQ + t) * DR + ch;
        float v = bb + w3 * bf2f(xp[0]);
        if (t >= 1) v += w2 * bf2f(xp[-DR]);
        if (t >= 2) v += w1 * bf2f(xp[-2 * DR]);
        if (t >= 3) v += w0 * bf2f(xp[-3 * DR]);
        xcs[tt * 64 + c] = v; }
    asm volatile("s_waitcnt lgkmcnt(0)" ::: "memory");
    const float c8sp = 8.0f * log1pf(expf(-lam[ch]));
    const float bav = ba[ch], biv = bi[ch];
    const float* wa = Wa + (size_t)blk * RBD * RBD + c; const float* wi = Wi + (size_t)blk * RBD * RBD + c;
    float A = 1.f, Bc = 0.f, hst = FINAL ? carry[((size_t)b * NCH + chunk) * DR + ch] : 0.f;
    for (int tt = 0; tt < CHL; ++tt) {
        float rp = bav, ip = biv;
#pragma unroll 8
        for (int d = 0; d < 64; ++d) { const float xv = xcs[tt * 64 + d]; rp += xv * wa[d * RBD]; ip += xv * wi[d * RBD]; }
        float a, u; rg_au_ref(rp, ip, xcs[tt * 64 + c], c8sp, a, u);
        if (FINAL) { hst = a * hst + u; const size_t off = ((size_t)b * SEQ + chunk * CHL + tt); O[off * OC + DA + ch] = (bf16_t)f2bf(hst * bf2f(GY[off * DR + ch])); }
        else { A *= a; Bc = a * Bc + u; }
    }
    if (!FINAL) { float* cp = comp + (((size_t)b * NCH + chunk) * DR + ch) * 2; cp[0] = A; cp[1] = Bc; }
    asm volatile("s_waitcnt lgkmcnt(0)" ::: "memory");
}
__device__ __forceinline__ void naive_scan_prefix_item(int idx, const float* __restrict__ comp, float* __restrict__ carry) {
    const int ch = idx % DR, b = idx / DR;
    float h = 0.f;
    for (int k = 0; k < NCH; ++k) { const size_t o = ((size_t)b * NCH + k) * DR + ch; carry[o] = h; h = comp[o * 2] * h + comp[o * 2 + 1]; }
}

__global__ void __launch_bounds__(NWAVES * 64, 2) mk_fwd(Args args) {
    extern __shared__ __attribute__((aligned(16))) unsigned char lds_raw[];
    LAS unsigned char* lds = (LAS unsigned char*)lds_raw;
    const int tid = threadIdx.x, lane = tid & 63, wave = __builtin_amdgcn_readfirstlane(tid >> 6);
    const int G = gridDim.x; const int bx = blockIdx.x; const int vcu = (G % 8 == 0) ? (bx % 8) * (G / 8) + bx / 8 : bx;
    unsigned char* ws = args.ws;
    unsigned* ctl = (unsigned*)(ws + WS_CTL);
    for (int u = tid; u < (LDS_BYTES - LDSCTL_OFF) / 4; u += NWAVES * 64) ((LAS unsigned*)(lds + LDSCTL_OFF))[u] = 0u;
    __syncthreads();
    volatile LAS unsigned* MISC = (volatile LAS unsigned*)(lds + MISC_OFF);
    const int lo = args.ph_lo, hi = args.ph_hi;
    XcdBarrier bar; bar.bar = ctl + CW_BAR + lo * XCD_BAR_WORDS; bar.x = 0; bar.st = nullptr;
    const bool multi = (hi - lo) > 1;
    if (multi) bar = xcd_barrier_post(ctl + CW_BAR + lo * XCD_BAR_WORDS, MISC + 8);
#define IN(k) (lo <= (k) && (k) < hi)
#define BOTH(k) (IN(k) && IN((k) + 1))
#define GRID_BAR() xcd_barrier(bar)

    const float* x = args.in[0];
    bf16_t* Wt_in = (bf16_t*)(ws + WS_WIN); bf16_t* Wt_cat = (bf16_t*)(ws + WS_WCAT); bf16_t* Wt_out = (bf16_t*)(ws + WS_WOUT);
    bf16_t* Wt_ff1 = (bf16_t*)(ws + WS_WFF1); bf16_t* Wt_ff2 = (bf16_t*)(ws + WS_WFF2);
    bf16_t* XN = (bf16_t*)(ws + WS_XN); bf16_t* Qb = (bf16_t*)(ws + WS_Q); bf16_t* Kb = (bf16_t*)(ws + WS_K); bf16_t* Vb = (bf16_t*)(ws + WS_V);
    bf16_t* XR = (bf16_t*)(ws + WS_XR); bf16_t* GY = (bf16_t*)(ws + WS_GY); bf16_t* GA = (bf16_t*)(ws + WS_GA); bf16_t* GR = (bf16_t*)(ws + WS_GR);
    bf16_t* MRG = (bf16_t*)(ws + WS_MRG); bf16_t* HB = (bf16_t*)(ws + WS_H);
    float* kmp = (float*)(ws + WS_KMP); float* ssq = (float*)(ws + WS_SSQ);
    bf16_t* OCAT = (bf16_t*)args.out;

    if ((PHMASK >> 0 & 1) && IN(0)) {
        LAS float* scr = (LAS float*)(lds + RING_OFF + wave * 16384);
        const int gw = vcu * NWAVES + wave, NGW = G * NWAVES;
        constexpr int I_IN = (DM / 64) * (DIN / 32), I_PA = (DA / 64) * (DM / 32), I_PR = (DR / 64) * (DM / 32), I_OUT = (DM / 64) * (DM / 32), I_F1 = (DM / 64) * (DFF / 32), I_F2 = (DFF / 64) * (DM / 32);
        constexpr int NITEMS = I_IN + I_PA + I_PR + I_OUT + I_F1 + I_F2;
        for (int it = gw; it < NITEMS; it += NGW) {
            int r = it;
            if (r < I_IN) { p0_transpose_item<1>(args.in[2], DIN, Wt_in, DM, 0, nullptr, scr, r, lane); continue; } r -= I_IN;
            if (r < I_PA) { p0_transpose_item<0>(args.in[14], DM, Wt_cat, OC, 0, nullptr, scr, r, lane); continue; } r -= I_PA;
            if (r < I_PR) { p0_transpose_item<0>(args.in[15], DM, Wt_cat, OC, DA, nullptr, scr, r, lane); continue; } r -= I_PR;
            if (r < I_OUT) { p0_transpose_item<0>(args.in[16], DM, Wt_out, DM, 0, nullptr, scr, r, lane); continue; } r -= I_OUT;
            if (r < I_F1) { p0_transpose_item<0>(args.in[18], DFF, Wt_ff1, DM, 0, args.in[17], scr, r, lane); continue; } r -= I_F1;
            p0_transpose_item<0>(args.in[19], DM, Wt_ff2, DFF, 0, nullptr, scr, r, lane);
        }
        for (int m = gw; m < M; m += NGW) rms_row_to_bf16(x + (size_t)m * DM, args.in[1], XN + (size_t)m * DM, lane);
        if (BOTH(0)) GRID_BAR();
    }
    if ((PHMASK >> 1 & 1) && IN(1)) {
        pg8::Gemm g{XN, Wt_in, DM, DM, DM, DIN, -1}; pg8::StaticOrder S; S.init(M, DIN, G, bx);
        pg8::EpiZ E{Qb, Kb, Vb, XR, GY, GA, GR, kmp, args.in[4], args.in[5], args.in[3]};
        pg8::gemm_phase<pg8::EpiZ, pg8::StaticOrder, false>(lds + RING_OFF, g, S, E);
        if (BOTH(1)) GRID_BAR();
    }
    {
        const float* cw = args.in[7]; const float* cb = args.in[8]; const float* Wa = args.in[9]; const float* ba = args.in[10]; const float* Wi = args.in[11]; const float* bi = args.in[12]; const float* lam = args.in[13];
        float* comp = (float*)(ws + WS_COMP); float* carry = (float*)(ws + WS_CARRY);
        LAS float* xcs = (LAS float*)(lds + RING_OFF + wave * 16384);
        const int gw = vcu * NWAVES + wave, NGW = G * NWAVES;
        if ((PHMASK >> 2 & 1) && IN(2)) {
#if NAIVE_ATTN
            for (int idx = bx * (NWAVES * 64) + tid; idx < BATCH * NH * SEQ; idx += G * NWAVES * 64) naive_attn_item(idx, Qb, Kb, Vb, kmp, args.in[6], OCAT, OC);
#else
            { const attn_body::AttnTensors AT{(const attn_body::bf16*)Qb, (const attn_body::bf16*)Kb, (const attn_body::bf16*)Vb, kmp, args.in[6], (attn_body::bf16*)OCAT};
              attn_body::attn_phase<8>((char*)lds_raw + RING_OFF, AT, vcu, G); }
#endif
#if NAIVE_SCAN
            for (int it = gw; it < BATCH * NCH * RB; it += NGW) naive_scan_item<false>(it, lane, xcs, XR, GY, cw, cb, Wa, ba, Wi, bi, lam, comp, carry, OCAT);
#else
            rnn::scan_phase<false>(lds, vcu, G, wave, lane, tid, XR, GY, cw, cb, Wa, ba, Wi, bi, lam, comp, OCAT);
#endif
            if (BOTH(2)) GRID_BAR();
        }
        if ((PHMASK >> 3 & 1) && IN(3)) {
#if DBG_ATTN
            { float sd = 0.f, sr = 0.f;
              for (size_t i = (size_t)bx * (NWAVES * 64) + tid; i < (size_t)M * DA; i += (size_t)G * NWAVES * 64) { const size_t r = i / DA, c = i % DA;
                  const float a = bf2f(OCAT[r * OC + c]), b = bf2f(XN[r * DA + c]); sd += (a - b) * (a - b); sr += b * b; }
              sd = wave_sum(sd); sr = wave_sum(sr);
              if (lane == 0) { atomicAdd((float*)(ctl + 16), sd); atomicAdd((float*)(ctl + 17), sr); } }
#endif
#if NAIVE_SCAN
            for (int idx = bx * (NWAVES * 64) + tid; idx < BATCH * DR; idx += G * NWAVES * 64) naive_scan_prefix_item(idx, comp, carry);
            if (BOTH(3)) GRID_BAR();
#endif
        }
        if ((PHMASK >> 4 & 1) && IN(4)) {
#if NAIVE_SCAN
            for (int it = gw; it < BATCH * NCH * RB; it += NGW) naive_scan_item<true>(it, lane, xcs, XR, GY, cw, cb, Wa, ba, Wi, bi, lam, comp, carry, OCAT);
#else
            rnn::scan_phase<true>(lds, vcu, G, wave, lane, tid, XR, GY, cw, cb, Wa, ba, Wi, bi, lam, comp, OCAT);
#endif
            if (BOTH(4)) GRID_BAR();
        }
    }
    if ((PHMASK >> 5 & 1) && IN(5)) {
        pg8::Gemm g{OCAT, Wt_cat, OC, OC, OC, DM, DA / 64}; pg8::StaticOrder S; S.init(M, DM, G, bx);
        pg8::EpiMerge E{GA, GR, MRG};
        pg8::gemm_phase<pg8::EpiMerge, pg8::StaticOrder, MIDFLAG>(lds + RING_OFF, g, S, E);
        if (BOTH(5)) GRID_BAR();
    }
    if ((PHMASK >> 6 & 1) && IN(6)) {
        pg8::Gemm g{MRG, Wt_out, DM, DM, DM, DM, -1}; pg8::StaticOrder S; S.init(M, DM, G, bx);
        pg8::EpiX1 E{x, args.out, XN, ssq};
        pg8::gemm_phase<pg8::EpiX1, pg8::StaticOrder, false>(lds + RING_OFF, g, S, E);
        if (BOTH(6)) GRID_BAR();
    }
    if ((PHMASK >> 7 & 1) && IN(7)) {
        pg8::Gemm g{XN, Wt_ff1, DM, DM, DM, DFF, -1}; pg8::StaticOrder S; S.init(M, DFF, G, bx);
        pg8::EpiH E{ssq, HB};
        pg8::gemm_phase<pg8::EpiH, pg8::StaticOrder, false>(lds + RING_OFF, g, S, E);
        if (BOTH(7)) GRID_BAR();
    }
    if ((PHMASK >> 8 & 1) && IN(8)) {
        pg8::Gemm g{HB, Wt_ff2, DFF, DFF, DFF, DM, -1}; pg8::StaticOrder S; S.init(M, DM, G, bx);
        pg8::EpiOut E{args.out};
        pg8::gemm_phase<pg8::EpiOut, pg8::StaticOrder, false>(lds + RING_OFF, g, S, E);
#if DBG_ATTN
        GRID_BAR();
        { const float sd = __hip_atomic_load((float*)(ctl + 16), __ATOMIC_RELAXED, __HIP_MEMORY_SCOPE_AGENT), sr = __hip_atomic_load((float*)(ctl + 17), __ATOMIC_RELAXED, __HIP_MEMORY_SCOPE_AGENT);
          const float e = sqrtf(sd / sr) * DBG_AMP;
          for (size_t i = (size_t)bx * (NWAVES * 64) + tid; i < (size_t)M * DM; i += (size_t)G * NWAVES * 64) args.out[i] *= (1.0f + e); }
#endif
    }
#undef IN
#undef BOTH
#undef GRID_BAR
}

#if DBG_ATTN
__global__ void __launch_bounds__(256) naive_attn_k(const bf16_t* Q, const bf16_t* K, const bf16_t* V, const float* kmp, const float* rel_bias, bf16_t* O, int opitch) {
    naive_attn_item(blockIdx.x * 256 + threadIdx.x, Q, K, V, kmp, rel_bias, O, opitch);
}
#endif
constexpr int N_PHASES = 9;
extern "C" void kernel_launch(void* const* d_in, const int* in_sizes, int n_in, void* d_out, int out_size, void* d_ws, size_t ws_size, hipStream_t stream) {
    static int grid = 0;
    if (grid == 0) {
        if (n_in != 20 || in_sizes[0] != M * DM || out_size != M * DM || ws_size < WS_END) { fprintf(stderr, "kernel_launch: unexpected shapes (n_in %d, in0 %d, out %d, ws %zu)\n", n_in, n_in > 0 ? in_sizes[0] : -1, out_size, ws_size); grid = -1; return; }
        int dev = 0, cus = 0;
        if (hipGetDevice(&dev) != hipSuccess || hipDeviceGetAttribute(&cus, hipDeviceAttributeMultiprocessorCount, dev) != hipSuccess) { grid = -1; return; }
        if (hipFuncSetAttribute((const void*)mk_fwd, hipFuncAttributeMaxDynamicSharedMemorySize, LDS_BYTES) != hipSuccess) { fprintf(stderr, "kernel_launch: hipFuncSetAttribute failed\n"); grid = -1; return; }
        (void)hipGetLastError();
        grid = cus;
    }
    if (grid < 0) return;
    (void)hipMemsetAsync((char*)d_ws + WS_CTL, 0, CTL_ZERO_BYTES, stream);
    Args a{};
    for (int i = 0; i < 20; ++i) a.in[i] = (const float*)d_in[i];
    a.out = (float*)d_out; a.ws = (unsigned char*)d_ws;
#if DBG_ATTN
    a.ph_lo = 0; a.ph_hi = 2;
    hipLaunchKernelGGL(mk_fwd, dim3(grid), dim3(NWAVES * 64), LDS_BYTES, stream, a);
    { unsigned char* ws = (unsigned char*)d_ws;
      hipLaunchKernelGGL(naive_attn_k, dim3(BATCH * NH * SEQ / 256), dim3(256), 0, stream, (const bf16_t*)(ws + WS_Q), (const bf16_t*)(ws + WS_K), (const bf16_t*)(ws + WS_V),
                         (const float*)(ws + WS_KMP), (const float*)d_in[6], (bf16_t*)(ws + WS_XN), DA); }
    a.ph_lo = 2; a.ph_hi = N_PHASES;
    hipLaunchKernelGGL(mk_fwd, dim3(grid), dim3(NWAVES * 64), LDS_BYTES, stream, a);
#elif MK_N_LAUNCHES == 1
    a.ph_lo = 0; a.ph_hi = N_PHASES;
    hipLaunchKernelGGL(mk_fwd, dim3(grid), dim3(NWAVES * 64), LDS_BYTES, stream, a);
#else
    for (int p = 0; p < N_PHASES; ++p) { a.ph_lo = p; a.ph_hi = p + 1; hipLaunchKernelGGL(mk_fwd, dim3(grid), dim3(NWAVES * 64), LDS_BYTES, stream, a); }
#endif
}
```

```cpp
#include <hip/hip_runtime.h>
#include <hip/hip_bf16.h>
#include <cstdio>
#include <cstdint>

#ifndef MIDFLAG
#define MIDFLAG true
#endif
#ifndef NAIVE_ATTN
#define NAIVE_ATTN 0
#endif
#ifndef NAIVE_SCAN
#define NAIVE_SCAN 0
#endif
#ifndef DBG_ATTN
#define DBG_ATTN 0
#endif
#ifndef DBG_AMP
#define DBG_AMP 10.0f
#endif
#ifndef STAG1
#define STAG1 0
#endif
#ifndef STAG7
#define STAG7 0
#endif
#ifndef PAIR_SYNC
#define PAIR_SYNC 1
#endif
#ifndef PHMASK
#define PHMASK 0xffff
#endif
#ifndef MK_N_LAUNCHES
#define MK_N_LAUNCHES 1
#endif

constexpr int BATCH = 8, SEQ = 4096, DM = 1024, M = BATCH * SEQ;
constexpr int NH = 8, HD = 64, DA = 512, DR = 1024, DFF = 4096, DIN = 5632;
constexpr int KBLK = 256, NKB = SEQ / KBLK;
constexpr int RB = 16, RBD = 64;
constexpr int OC = DA + DR;
constexpr int HP = DFF + 128;
constexpr float EPS = 1e-6f;
constexpr float LOG2E = 1.4426950408889634f;
constexpr float C2 = 0.125f * LOG2E;

#define LAS __attribute__((address_space(3)))
#define GAS __attribute__((address_space(1)))
typedef unsigned short bf16_t;
typedef short bf16x8 __attribute__((ext_vector_type(8)));
typedef float f32x4 __attribute__((ext_vector_type(4)));
typedef float f32x2 __attribute__((ext_vector_type(2)));
typedef unsigned u32x4 __attribute__((ext_vector_type(4)));
typedef unsigned u32x2 __attribute__((ext_vector_type(2)));

constexpr size_t MiB = 1u << 20;
constexpr size_t WS_CTL = 0, CTL_ZERO_BYTES = 256 * 1024;
constexpr size_t WS_WIN = 2 * MiB;
constexpr size_t WS_WCAT = 13 * MiB;
constexpr size_t WS_WOUT = 16 * MiB;
constexpr size_t WS_WFF1 = 18 * MiB;
constexpr size_t WS_WFF2 = 26 * MiB;
constexpr size_t WS_KMP = 35 * MiB;
constexpr size_t WS_SSQ = 36 * MiB;
constexpr size_t WS_COMP = 38 * MiB;
constexpr size_t WS_CARRY = 42 * MiB;
constexpr size_t WS_KMH = 45 * MiB;
constexpr size_t WS_KML = 45 * MiB + 512 * 1024;
constexpr size_t WS_RSTD1 = 44 * MiB;
constexpr size_t WS_XB = 48 * MiB;
constexpr size_t WS_XR = 112 * MiB;
constexpr size_t WS_GY = 176 * MiB;
constexpr size_t WS_GA = 240 * MiB;
constexpr size_t WS_GR = 304 * MiB;
constexpr size_t WS_H = 112 * MiB;
constexpr size_t WS_K = 368 * MiB;
constexpr size_t WS_V = 400 * MiB;
constexpr size_t WS_MRG = 368 * MiB;
constexpr size_t WS_Q = 432 * MiB;
constexpr size_t WS_XN = 432 * MiB;
constexpr size_t WS_END = 496 * MiB;

constexpr int CW_TMO = 0, CW_BAR = 4096, CW_PAIR = 40000;

__device__ __forceinline__ float bf2f(unsigned short u) { return __uint_as_float(((unsigned)u) << 16); }
__device__ __forceinline__ unsigned f2bf(float f) { unsigned u = __builtin_bit_cast(unsigned, f); return (u + 0x7fffu + ((u >> 16) & 1u)) >> 16; }
__device__ __forceinline__ unsigned pk2(float lo, float hi) { return f2bf(lo) | (f2bf(hi) << 16); }
__device__ __forceinline__ unsigned cvt_pk_bf16(float lo, float hi) { unsigned r; asm volatile("s_nop 0\n\tv_cvt_pk_bf16_f32 %0, %1, %2" : "=v"(r) : "v"(lo), "v"(hi)); return r; }
__device__ __forceinline__ float fast_sigmoid(float x) { return __builtin_amdgcn_rcpf(1.0f + __builtin_amdgcn_exp2f(-LOG2E * x)); }
__device__ __forceinline__ float gelu_tanh(float x) { const float u = x + 0.044715f * x * x * x; return x * __builtin_amdgcn_rcpf(1.0f + __builtin_amdgcn_exp2f(-2.302208198f * u)); }
__device__ __forceinline__ float wave_sum(float v) {
#pragma unroll
    for (int o = 1; o < 64; o <<= 1) v += __shfl_xor(v, o);
    return v;
}
__device__ __forceinline__ int t5_bucket(int n) {
    if (n < 16) return n;
    int b = 16;
    b += (n >= 19); b += (n >= 21); b += (n >= 24); b += (n >= 27); b += (n >= 31); b += (n >= 35); b += (n >= 40); b += (n >= 46);
    b += (n >= 52); b += (n >= 59); b += (n >= 67); b += (n >= 77); b += (n >= 87); b += (n >= 99); b += (n >= 113);
    return b;
}

namespace pg8 {
constexpr int BM = 256, BK = 64, HALF = 128, HTB = HALF * BK * 2, STAGE_BYTES = 8 * HTB, NXCD = 8, WGM = 8;
__host__ __device__ __forceinline__ int lds_byte(int r, int c) { const int st = (r >> 4) * 2 + (c >> 5), rr = r & 15, cc = c & 31, ob = rr * 64 + cc * 2; return st * 1024 + (ob ^ (((ob >> 9) & 1) << 5)); }
__host__ __device__ __forceinline__ void stage_rc(int b, int& R, int& C) { const int st = b / 1024, sb = b % 1024, swz = sb ^ (((sb >> 9) & 1) << 5); R = (st >> 1) * 16 + swz / 64; C = (st & 1) * 32 + (swz % 64) / 2; }
__host__ __device__ __forceinline__ int perm32(int rho) { const int n = rho >> 4, i = rho & 15; return 8 * (i >> 2) + 4 * n + (i & 3); }

struct Unit { int pm, pn, idx; };
struct Gemm { const bf16_t* A; const bf16_t* Bt; int lda, ldb, K, N, mid_t, flags; size_t kstepA, kstepB, tstepA, tstepB; int imgA; };
__host__ __device__ __forceinline__ Gemm gemm_rowmajor(const bf16_t* A, const bf16_t* Bt, int lda, int ldb, int K, int N, int mid_t, int flags) { return Gemm{A, Bt, lda, ldb, K, N, mid_t, flags, (size_t)128, (size_t)128, (size_t)512 * lda, (size_t)512 * ldb, 0}; }

struct StaticOrder {
    int nM, nN, nwg, G, c;
    __host__ __device__ void init(int M_, int N_, int G_, int c_) { nM = M_ / BM; nN = N_ / BM; nwg = nM * nN; G = G_; c = c_; }
    __host__ __device__ bool next(int i, Unit& u) const {
        const long L = (long)i * G + c; if (L >= nwg) return false;
        int wgid = (int)L; { const int q = nwg / NXCD, r = nwg % NXCD, xcd = wgid % NXCD, off = wgid / NXCD; wgid = (xcd < r ? xcd * (q + 1) : r * (q + 1) + (xcd - r) * q) + off; }
        const int nig = WGM * nN, gid = wgid / nig, fm = gid * WGM, gsz = (nM - fm) < WGM ? (nM - fm) : WGM;
        u.pm = fm + ((wgid % nig) % gsz); u.pn = (wgid % nig) / gsz; u.idx = i; return true;
    }
};

typedef f32x4 Acc[2][2][4][2];

template <class Epi, class Sched, bool MID>
__device__ __forceinline__ void gemm_phase(LAS unsigned char* lds, const Gemm g, const Sched& S, const Epi& E) {
    const int tid = threadIdx.x, wid = __builtin_amdgcn_readfirstlane(tid >> 6), lane = tid & 63, wr = wid >> 2, wc = wid & 3, fr = lane & 15, fq = lane >> 4;
    const int nt = g.K / BK;
    unsigned voffA[2], voffB[2];
#pragma unroll
    for (int i = 0; i < 2; ++i) { int R, C; stage_rc(tid * 16 + i * 8192, R, C); const int Rb = Epi::PERM ? ((R & ~31) + perm32(R & 31)) : R;
        voffA[i] = g.imgA ? (unsigned)(tid * 16 + i * 8192) : (unsigned)(R * g.lda + C) * 2u; voffB[i] = (unsigned)(Rb * g.ldb + C) * 2u; }
    const size_t kstepA = g.kstepA, kstepB = g.kstepB;
    const size_t hstepA = g.imgA ? (size_t)HTB : (size_t)HALF * g.lda * 2, hstepB = (size_t)HALF * g.ldb * 2;
    const size_t tstepA = (g.flags & 2) ? 0 : g.tstepA, tstepB = (g.flags & 2) ? 0 : g.tstepB;
    const unsigned ldsw = (unsigned)wid * 1024u;
    const int aoff = lds_byte(wr * 64 + fr, fq * 8), boff = lds_byte(wc * 32 + fr, fq * 8);
#define PG8_SA(b, h) (((b) * 2 + (h)) * HTB)
#define PG8_SB(b, h) ((4 + (b) * 2 + (h)) * HTB)
#define PG8_STAGE(bufoff, gbase, voff) do { _Pragma("unroll") for (int _i = 0; _i < 2; ++_i) \
        __builtin_amdgcn_global_load_lds((const unsigned*)((const char*)(gbase) + (voff)[_i]), (LAS unsigned*)(lds + (bufoff) + ldsw + _i * 8192), 16, 0, 0); } while (0)
#define PG8_LDA(dst, b, h) do { _Pragma("unroll") for (int m = 0; m < 4; ++m) _Pragma("unroll") for (int k = 0; k < 2; ++k) dst[m][k] = *(const LAS bf16x8*)(lds + PG8_SA(b, h) + aoff + m * 2048 + k * 1024); } while (0)
#define PG8_LDB(dst, b, h) do { _Pragma("unroll") for (int n = 0; n < 2; ++n) _Pragma("unroll") for (int k = 0; k < 2; ++k) dst[n][k] = *(const LAS bf16x8*)(lds + PG8_SB(b, h) + boff + n * 2048 + k * 1024); } while (0)
#define PG8_MMA(ai, bj, At, Bt) do { __builtin_amdgcn_s_setprio(1); _Pragma("unroll") for (int m = 0; m < 4; ++m) _Pragma("unroll") for (int n = 0; n < 2; ++n) _Pragma("unroll") for (int k = 0; k < 2; ++k) \
        acc[ai][bj][m][n] = __builtin_amdgcn_mfma_f32_16x16x32_bf16(Bt[n][k], At[m][k], acc[ai][bj][m][n], 0, 0, 0); __builtin_amdgcn_s_setprio(0); } while (0)
#define PG8_WAIT_V(n) asm volatile("s_waitcnt vmcnt(" #n ")" ::: "memory")
#define PG8_WAIT_L(n) asm volatile("s_waitcnt lgkmcnt(" #n ")" ::: "memory")
#define PG8_BAR __builtin_amdgcn_s_barrier()
#define PG8_SCHED __builtin_amdgcn_sched_barrier(0)
    Unit cur, nxt; int ui = 0;
    if (!S.next(0, cur)) return;
    f32x4 acc[2][2][4][2];
#pragma unroll
    for (int a = 0; a < 2; ++a)
#pragma unroll
        for (int b = 0; b < 2; ++b)
#pragma unroll
            for (int m = 0; m < 4; ++m)
#pragma unroll
                for (int n = 0; n < 2; ++n) acc[a][b][m][n] = (f32x4){0.f, 0.f, 0.f, 0.f};
    bf16x8 At[4][2], B0[2][2], B1[2][2];
    const char* cA = (const char*)g.A + (size_t)cur.pm * tstepA; const char* cB = (const char*)g.Bt + (size_t)cur.pn * tstepB;
    PG8_STAGE(PG8_SB(0, 0), cB, voffB); PG8_STAGE(PG8_SB(0, 1), cB + hstepB, voffB); PG8_STAGE(PG8_SA(0, 0), cA, voffA); PG8_STAGE(PG8_SA(0, 1), cA + hstepA, voffA);
    if (wr == 1) PG8_BAR;
    PG8_WAIT_V(2); PG8_BAR;
    PG8_STAGE(PG8_SB(1, 0), cB + kstepB, voffB); PG8_STAGE(PG8_SA(1, 0), cA + kstepA, voffA); PG8_STAGE(PG8_SB(1, 1), cB + hstepB + kstepB, voffB);
    PG8_WAIT_V(6); PG8_BAR;
    for (;;) {
        const bool has_next = S.next(ui + 1, nxt);
        const char* nA = has_next ? (const char*)g.A + (size_t)nxt.pm * tstepA : cA; const char* nB = has_next ? (const char*)g.Bt + (size_t)nxt.pn * tstepB : cB;
        for (int t = 0; t < nt; t += 2) {
            if constexpr (MID) { if (t == g.mid_t) E.mid(acc, cur, wr, wc, fr, fq); }
            const bool last = (t == nt - 2);
            const char* a1 = cA + (size_t)(t + 1) * kstepA;
            const char* a2 = last ? nA : cA + (size_t)(t + 2) * kstepA; const char* b2 = last ? nB : cB + (size_t)(t + 2) * kstepB;
            const char* a3 = a2 + kstepA; const char* b3 = b2 + kstepB;
            PG8_LDB(B0, 0, 0); PG8_LDB(B1, 0, 1); PG8_SCHED; PG8_LDA(At, 0, 0); PG8_STAGE(PG8_SA(1, 1), a1 + hstepA, voffA);
            PG8_WAIT_V(8); PG8_WAIT_L(0); PG8_BAR; PG8_MMA(0, 0, At, B0); PG8_MMA(0, 1, At, B1); PG8_BAR; PG8_SCHED;
            PG8_LDA(At, 0, 1); PG8_STAGE(PG8_SB(0, 0), b2, voffB); PG8_STAGE(PG8_SB(0, 1), b2 + hstepB, voffB); PG8_STAGE(PG8_SA(0, 0), a2, voffA);
            PG8_WAIT_V(8); PG8_WAIT_L(0); PG8_BAR; PG8_MMA(1, 0, At, B0); PG8_MMA(1, 1, At, B1); PG8_BAR; PG8_SCHED;
            PG8_LDB(B0, 1, 0); PG8_LDB(B1, 1, 1); PG8_SCHED; PG8_LDA(At, 1, 0); PG8_STAGE(PG8_SA(0, 1), a2 + hstepA, voffA);
            PG8_WAIT_V(8); PG8_WAIT_L(0); PG8_BAR; PG8_MMA(0, 0, At, B0); PG8_MMA(0, 1, At, B1); PG8_BAR; PG8_SCHED;
            PG8_LDA(At, 1, 1); PG8_STAGE(PG8_SB(1, 0), b3, voffB); PG8_STAGE(PG8_SB(1, 1), b3 + hstepB, voffB); PG8_STAGE(PG8_SA(1, 0), a3, voffA);
            PG8_WAIT_V(8); PG8_WAIT_L(0); PG8_BAR; PG8_MMA(1, 0, At, B0); PG8_MMA(1, 1, At, B1); PG8_BAR; PG8_SCHED;
        }
        if (wr == 0) PG8_BAR;
        if (g.flags & 1) {
#pragma unroll
            for (int a = 0; a < 2; ++a)
#pragma unroll
                for (int b = 0; b < 2; ++b)
#pragma unroll
                    for (int m = 0; m < 4; ++m)
#pragma unroll
                        for (int n = 0; n < 2; ++n) asm volatile("" :: "v"(acc[a][b][m][n]));
        } else E(acc, cur, wr, wc, fr, fq);
        if (!has_next) break;
#pragma unroll
        for (int a = 0; a < 2; ++a)
#pragma unroll
            for (int b = 0; b < 2; ++b)
#pragma unroll
                for (int m = 0; m < 4; ++m)
#pragma unroll
                    for (int n = 0; n < 2; ++n) acc[a][b][m][n] = (f32x4){0.f, 0.f, 0.f, 0.f};
        cur = nxt; cA = nA; cB = nB; ++ui;
        if (wr == 1) PG8_BAR;
    }
    PG8_WAIT_V(0);
    PG8_BAR;
#undef PG8_SA
#undef PG8_SB
#undef PG8_STAGE
#undef PG8_LDA
#undef PG8_LDB
#undef PG8_MMA
#undef PG8_WAIT_V
#undef PG8_WAIT_L
#undef PG8_BAR
#undef PG8_SCHED
}

__device__ __forceinline__ size_t img_off(int pm, int lrow, int col, int KT) { return (((size_t)pm * KT + (col >> 6)) * 2 + (lrow >> 7)) * (size_t)(HTB / 2) + lds_byte(lrow & 127, col & 63) / 2; }
struct EpiZ {
    static constexpr bool PERM = true;
    bf16_t *Q, *K, *V, *XR, *GY, *GA, *GR; float* kmp; const float *qw, *kw, *bg; const LAS float* rs; unsigned char* wsb; LAS float* kx;
    __device__ __forceinline__ void mid(Acc&, const Unit&, int, int, int, int) const {}
    __device__ __forceinline__ void operator()(Acc& acc, const Unit& u, int wr, int wc, int fr, int fq) const {
        const int pn = u.pn; const int row0 = u.pm * BM + wr * 64 + fr;
        const LAS float* rsu = rs + u.idx * BM + wr * 64 + fr;
        if (pn < 4) {
            const bool isq = pn < 2; const int head = (pn & 1) * 4 + wc; const float* nw = isq ? qw : kw; const float osc = isq ? C2 : 1.0f;
            bf16_t* base = (isq ? Q : K) + head * HD + 8 * fq;
            f32x4 wv[2][2];
#pragma unroll
            for (int bj = 0; bj < 2; ++bj)
#pragma unroll
                for (int n = 0; n < 2; ++n) wv[bj][n] = *(const f32x4*)(nw + 32 * bj + 8 * fq + 4 * n) * osc;
            f32x4 cs[2][2];
#pragma unroll
            for (int bj = 0; bj < 2; ++bj)
#pragma unroll
                for (int n = 0; n < 2; ++n) cs[bj][n] = (f32x4){0.f, 0.f, 0.f, 0.f};
#pragma unroll
            for (int ai = 0; ai < 2; ++ai)
#pragma unroll
                for (int m = 0; m < 4; ++m) {
                    float ss = 0.f;
#pragma unroll
                    for (int bj = 0; bj < 2; ++bj)
#pragma unroll
                        for (int n = 0; n < 2; ++n) { const f32x4 v = acc[ai][bj][m][n]; ss += (v[0] * v[0] + v[1] * v[1]) + (v[2] * v[2] + v[3] * v[3]); }
                    ss += __shfl_xor(ss, 16); ss += __shfl_xor(ss, 32);
                    const float r1 = rsu[ai * HALF + m * 16];
                    const float rstd = r1 / sqrtf(ss * (r1 * r1) * (1.0f / 64.0f) + EPS);
                    bf16_t* rowp = base + (size_t)(row0 + ai * HALF + m * 16) * DA;
#pragma unroll
                    for (int bj = 0; bj < 2; ++bj) {
                        const f32x4 v0 = acc[ai][bj][m][0] * rstd * wv[bj][0], v1 = acc[ai][bj][m][1] * rstd * wv[bj][1];
                        cs[bj][0] += v0; cs[bj][1] += v1;
                        u32x4 w; w.x = cvt_pk_bf16(v0[0], v0[1]); w.y = cvt_pk_bf16(v0[2], v0[3]); w.z = cvt_pk_bf16(v1[0], v1[1]); w.w = cvt_pk_bf16(v1[2], v1[3]);
                        *(u32x4*)(rowp + 32 * bj) = w; }
                }
            if (!isq) {
#pragma unroll
                for (int bj = 0; bj < 2; ++bj)
#pragma unroll
                    for (int n = 0; n < 2; ++n)
#pragma unroll
                        for (int i = 0; i < 4; ++i) { float s = cs[bj][n][i]; s += __shfl_xor(s, 1); s += __shfl_xor(s, 2); s += __shfl_xor(s, 4); s += __shfl_xor(s, 8); cs[bj][n][i] = s; }
                if (fr == 0) { float* kp = kmp + (size_t)(u.pm * 2 + wr) * DA + head * HD + 8 * fq;
#pragma unroll
                    for (int bj = 0; bj < 2; ++bj) { *(f32x4*)(kp + 32 * bj) = cs[bj][0]; *(f32x4*)(kp + 32 * bj + 4) = cs[bj][1]; } }
                if (fr == 0) { LAS float* kl = kx + wr * 256 + wc * 64 + 8 * fq;
#pragma unroll
                    for (int bj = 0; bj < 2; ++bj) { *(LAS f32x4*)(kl + 32 * bj) = cs[bj][0]; *(LAS f32x4*)(kl + 32 * bj + 4) = cs[bj][1]; } }
                asm volatile("s_waitcnt lgkmcnt(0)" ::: "memory"); __builtin_amdgcn_s_barrier(); asm volatile("" ::: "memory");
                if (wr == 0) { const int d = fr + 16 * fq; const float mean = (kx[wc * 64 + d] + kx[256 + wc * 64 + d]) * (1.0f / 256.0f);
                    const unsigned hb = f2bf(mean), lb = f2bf(mean - __uint_as_float(hb << 16));
                    const size_t o = ((size_t)((u.pm >> 4) * NH + head) * NKB + (u.pm & 15)) * HD + d;
                    ((bf16_t*)(wsb + WS_KMH))[o] = (bf16_t)hb; ((bf16_t*)(wsb + WS_KML))[o] = (bf16_t)lb; }
            }
            return;
        }
        if (pn >= 14) {
            const int ch0 = (pn - 14) * 128 + wc * 32 + 8 * fq;
            const f32x4 ba0 = *(const f32x4*)(bg + ch0), ba1 = *(const f32x4*)(bg + ch0 + 4), br0 = *(const f32x4*)(bg + DM + ch0), br1 = *(const f32x4*)(bg + DM + ch0 + 4);
#pragma unroll
            for (int ai = 0; ai < 2; ++ai)
#pragma unroll
                for (int m = 0; m < 4; ++m) { const float r1 = rsu[ai * HALF + m * 16]; const size_t off = (size_t)(row0 + ai * HALF + m * 16) * DM + ch0;
                    unsigned r0_, r1_, r2_, r3_, g0_, g1_, g2_, g3_;
                    { const f32x4 a = acc[ai][0][m][0] * r1 + ba0, g = acc[ai][1][m][0] * r1 + br0;
                      const float ea0 = 1.0f + __builtin_amdgcn_exp2f(-LOG2E * a[0]), er0 = 1.0f + __builtin_amdgcn_exp2f(-LOG2E * g[0]), ea1 = 1.0f + __builtin_amdgcn_exp2f(-LOG2E * a[1]), er1 = 1.0f + __builtin_amdgcn_exp2f(-LOG2E * g[1]);
                      const float ea2 = 1.0f + __builtin_amdgcn_exp2f(-LOG2E * a[2]), er2 = 1.0f + __builtin_amdgcn_exp2f(-LOG2E * g[2]), ea3 = 1.0f + __builtin_amdgcn_exp2f(-LOG2E * a[3]), er3 = 1.0f + __builtin_amdgcn_exp2f(-LOG2E * g[3]);
                      r0_ = cvt_pk_bf16(er0 * __builtin_amdgcn_rcpf(ea0), er1 * __builtin_amdgcn_rcpf(ea1)); r1_ = cvt_pk_bf16(er2 * __builtin_amdgcn_rcpf(ea2), er3 * __builtin_amdgcn_rcpf(ea3));
                      g0_ = cvt_pk_bf16(__builtin_amdgcn_rcpf(er0), __builtin_amdgcn_rcpf(er1)); g1_ = cvt_pk_bf16(__builtin_amdgcn_rcpf(er2), __builtin_amdgcn_rcpf(er3)); }
                    { const f32x4 a = acc[ai][0][m][1] * r1 + ba1, g = acc[ai][1][m][1] * r1 + br1;
                      const float ea0 = 1.0f + __builtin_amdgcn_exp2f(-LOG2E * a[0]), er0 = 1.0f + __builtin_amdgcn_exp2f(-LOG2E * g[0]), ea1 = 1.0f + __builtin_amdgcn_exp2f(-LOG2E * a[1]), er1 = 1.0f + __builtin_amdgcn_exp2f(-LOG2E * g[1]);
                      const float ea2 = 1.0f + __builtin_amdgcn_exp2f(-LOG2E * a[2]), er2 = 1.0f + __builtin_amdgcn_exp2f(-LOG2E * g[2]), ea3 = 1.0f + __builtin_amdgcn_exp2f(-LOG2E * a[3]), er3 = 1.0f + __builtin_amdgcn_exp2f(-LOG2E * g[3]);
                      r2_ = cvt_pk_bf16(er0 * __builtin_amdgcn_rcpf(ea0), er1 * __builtin_amdgcn_rcpf(ea1)); r3_ = cvt_pk_bf16(er2 * __builtin_amdgcn_rcpf(ea2), er3 * __builtin_amdgcn_rcpf(ea3));
                      g2_ = cvt_pk_bf16(__builtin_amdgcn_rcpf(er0), __builtin_amdgcn_rcpf(er1)); g3_ = cvt_pk_bf16(__builtin_amdgcn_rcpf(er2), __builtin_amdgcn_rcpf(er3)); }
                    const u32x4 wr_ = {r0_, r1_, r2_, r3_}, wg_ = {g0_, g1_, g2_, g3_};
                    *(u32x4*)(GA + off) = wr_; *(u32x4*)(GR + off) = wg_;
                    asm volatile("" ::: "memory"); }
            return;
        }
        int mode, ldc, colt; bf16_t* base; const float* bias = nullptr;
        { const size_t boff = (pn < 6) ? WS_V : (pn < 10) ? WS_XR : WS_GY; base = (bf16_t*)(wsb + boff); ldc = (pn < 6) ? DA : DR; colt = (pn - ((pn < 6) ? 4 : (pn < 10) ? 6 : 10)) * BM; mode = (pn < 10) ? 0 : 1; }
        const int col0 = colt + wc * 32 + 8 * fq;
        f32x4 bv[2][2];
#pragma unroll
        for (int bj = 0; bj < 2; ++bj)
#pragma unroll
            for (int n = 0; n < 2; ++n) bv[bj][n] = bias ? *(const f32x4*)(bias + col0 + bj * HALF + 4 * n) : (f32x4){0.f, 0.f, 0.f, 0.f};
#pragma unroll
        for (int ai = 0; ai < 2; ++ai)
#pragma unroll
            for (int m = 0; m < 4; ++m) { bf16_t* rowp = base + (size_t)(row0 + ai * HALF + m * 16) * ldc + col0;
#pragma unroll
                for (int bj = 0; bj < 2; ++bj) { const float r1 = rsu[ai * HALF + m * 16]; f32x4 v0 = acc[ai][bj][m][0] * r1 + bv[bj][0], v1 = acc[ai][bj][m][1] * r1 + bv[bj][1];
                    if (mode == 1) {
#pragma unroll
                        for (int i = 0; i < 4; ++i) { v0[i] = gelu_tanh(v0[i]); v1[i] = gelu_tanh(v1[i]); } }
                    else if (mode == 2) {
#pragma unroll
                        for (int i = 0; i < 4; ++i) { v0[i] = fast_sigmoid(v0[i]); v1[i] = fast_sigmoid(v1[i]); } }
                    u32x4 w; w.x = cvt_pk_bf16(v0[0], v0[1]); w.y = cvt_pk_bf16(v0[2], v0[3]); w.z = cvt_pk_bf16(v1[0], v1[1]); w.w = cvt_pk_bf16(v1[2], v1[3]);
                    *(u32x4*)(rowp + bj * HALF) = w; } }
    }
};

struct EpiMerge {
    static constexpr bool PERM = true;
    const bf16_t *GA, *GR; bf16_t* O;
    __device__ __forceinline__ void mid(Acc& acc, const Unit& u, int wr, int wc, int fr, int fq) const {
        int row0 = u.pm * BM + wr * 64 + fr, col0 = u.pn * BM + wc * 32 + 8 * fq;
        asm volatile("" : "+v"(row0), "+v"(col0));
#pragma unroll
        for (int ai = 0; ai < 2; ++ai)
#pragma unroll
            for (int m = 0; m < 4; ++m) { const size_t off = (size_t)(row0 + ai * HALF + m * 16) * DM + col0;
#pragma unroll
                for (int bj = 0; bj < 2; ++bj) { const u32x4 a = *(const u32x4*)(GA + off + bj * HALF);
#pragma unroll
                    for (int j = 0; j < 4; ++j) { const unsigned aw = a[j];
                        acc[ai][bj][m][j >> 1][(j & 1) * 2] *= __uint_as_float(aw << 16); acc[ai][bj][m][j >> 1][(j & 1) * 2 + 1] *= __uint_as_float(aw & 0xffff0000u); } }
                if (m & 1) asm volatile("" ::: "memory"); }
    }
    __device__ __forceinline__ void operator()(Acc& acc, const Unit& u, int wr, int wc, int fr, int fq) const {
        const int row0 = u.pm * BM + wr * 64 + fr, col0 = u.pn * BM + wc * 32 + 8 * fq;
#pragma unroll
        for (int ai = 0; ai < 2; ++ai)
#pragma unroll
            for (int m = 0; m < 4; ++m) { const size_t off = (size_t)(row0 + ai * HALF + m * 16) * DM + col0;
#pragma unroll
                for (int bj = 0; bj < 2; ++bj) { const u32x4 r = *(const u32x4*)(GR + off + bj * HALF); u32x4 w;
#pragma unroll
                    for (int j = 0; j < 4; ++j) { const unsigned rw = r[j];
                        const float v0 = acc[ai][bj][m][j >> 1][(j & 1) * 2] * __uint_as_float(rw << 16), v1 = acc[ai][bj][m][j >> 1][(j & 1) * 2 + 1] * __uint_as_float(rw & 0xffff0000u);
                        w[j] = cvt_pk_bf16(v0, v1); }
                    *(u32x4*)(O + img_off(u.pm, wr * 64 + ai * HALF + m * 16 + fr, u.pn * BM + bj * HALF + wc * 32 + 8 * fq, DM / 64)) = w; }
                if (m & 1) asm volatile("" ::: "memory"); }
    }
};

struct EpiX1 {
    static constexpr bool PERM = true;
    const bf16_t* XB; bf16_t* XN2; float* ssq;
    __device__ __forceinline__ void mid(Acc&, const Unit&, int, int, int, int) const {}
    __device__ __forceinline__ void operator()(Acc& acc, const Unit& u, int wr, int wc, int fr, int fq) const {
        const int row0 = u.pm * BM + wr * 64 + fr, col0 = u.pn * BM + wc * 32 + 8 * fq;
#pragma unroll
        for (int ai = 0; ai < 2; ++ai)
#pragma unroll
            for (int m = 0; m < 4; ++m) { const int row = row0 + ai * HALF + m * 16; const size_t off = (size_t)row * DM + col0; float ss = 0.f;
#pragma unroll
                for (int bj = 0; bj < 2; ++bj) { const u32x4 xw = *(const u32x4*)(XB + off + bj * HALF);
                    const f32x4 x0 = {__uint_as_float(xw.x << 16), __uint_as_float(xw.x & 0xffff0000u), __uint_as_float(xw.y << 16), __uint_as_float(xw.y & 0xffff0000u)};
                    const f32x4 x1 = {__uint_as_float(xw.z << 16), __uint_as_float(xw.z & 0xffff0000u), __uint_as_float(xw.w << 16), __uint_as_float(xw.w & 0xffff0000u)};
                    const f32x4 v0 = acc[ai][bj][m][0] + x0, v1 = acc[ai][bj][m][1] + x1;
                    u32x4 w; w.x = cvt_pk_bf16(v0[0], v0[1]); w.y = cvt_pk_bf16(v0[2], v0[3]); w.z = cvt_pk_bf16(v1[0], v1[1]); w.w = cvt_pk_bf16(v1[2], v1[3]);
                    *(u32x4*)(XN2 + img_off(u.pm, wr * 64 + ai * HALF + m * 16 + fr, u.pn * BM + bj * HALF + wc * 32 + 8 * fq, DM / 64)) = w;
                    ss += ((v0[0] * v0[0] + v0[1] * v0[1]) + (v0[2] * v0[2] + v0[3] * v0[3])) + ((v1[0] * v1[0] + v1[1] * v1[1]) + (v1[2] * v1[2] + v1[3] * v1[3])); }
                ss += __shfl_xor(ss, 16); ss += __shfl_xor(ss, 32);
                if (fq == 0) ssq[(size_t)row * 16 + u.pn * 4 + wc] = ss;
                if (m & 1) asm volatile("" ::: "memory"); }
    }
};

struct EpiH {
    static constexpr bool PERM = true;
    const LAS float* rs; bf16_t* H;
    __device__ __forceinline__ void mid(Acc&, const Unit&, int, int, int, int) const {}
    __device__ __forceinline__ void operator()(Acc& acc, const Unit& u, int wr, int wc, int fr, int fq) const {
        const int lrow0 = wr * 64 + fr;
        const LAS float* rsu = rs + u.idx * BM;
#pragma unroll
        for (int ai = 0; ai < 2; ++ai)
#pragma unroll
            for (int m = 0; m < 4; ++m) { const int lrow = lrow0 + ai * HALF + m * 16;
                const float rstd = rsu[lrow];
                bf16_t* rowp = H + (((size_t)u.pm * (DFF / 64) + u.pn * 4 + (wc >> 1)) * 2 + ai) * (HTB / 2) + lds_byte(wr * 64 + m * 16 + fr, (wc & 1) * 32 + 8 * fq) / 2;
#pragma unroll
                for (int bj = 0; bj < 2; ++bj) { f32x4 v0 = acc[ai][bj][m][0] * rstd, v1 = acc[ai][bj][m][1] * rstd;
#pragma unroll
                    for (int i = 0; i < 4; ++i) { const float a = fmaxf(v0[i], 0.f), b = fmaxf(v1[i], 0.f); v0[i] = a * a; v1[i] = b * b; }
                    u32x4 w; w.x = cvt_pk_bf16(v0[0], v0[1]); w.y = cvt_pk_bf16(v0[2], v0[3]); w.z = cvt_pk_bf16(v1[0], v1[1]); w.w = cvt_pk_bf16(v1[2], v1[3]);
                    *(u32x4*)(rowp + bj * (2 * 256 * 64)) = w; } }
    }
};

struct EpiOut {
    static constexpr bool PERM = true;
    const bf16_t* XN2; float* OUT;
    __device__ __forceinline__ void mid(Acc&, const Unit&, int, int, int, int) const {}
    __device__ __forceinline__ void operator()(Acc& acc, const Unit& u, int wr, int wc, int fr, int fq) const {
        const int row0 = u.pm * BM + wr * 64 + fr, col0 = u.pn * BM + wc * 32 + 8 * fq;
#pragma unroll
        for (int ai = 0; ai < 2; ++ai)
#pragma unroll
            for (int m = 0; m < 4; ++m) { const size_t off = (size_t)(row0 + ai * HALF + m * 16) * DM + col0;
#pragma unroll
                for (int bj = 0; bj < 2; ++bj) { const u32x4 xw = *(const u32x4*)(XN2 + img_off(u.pm, wr * 64 + ai * HALF + m * 16 + fr, u.pn * BM + bj * HALF + wc * 32 + 8 * fq, DM / 64));
                    const f32x4 x0 = {__uint_as_float(xw.x << 16), __uint_as_float(xw.x & 0xffff0000u), __uint_as_float(xw.y << 16), __uint_as_float(xw.y & 0xffff0000u)};
                    const f32x4 x1 = {__uint_as_float(xw.z << 16), __uint_as_float(xw.z & 0xffff0000u), __uint_as_float(xw.w << 16), __uint_as_float(xw.w & 0xffff0000u)};
                    *(f32x4*)(OUT + off + bj * HALF) = acc[ai][bj][m][0] + x0; *(f32x4*)(OUT + off + bj * HALF + 4) = acc[ai][bj][m][1] + x1; }
                if (m & 1) asm volatile("" ::: "memory"); }
    }
};
}

#define XB_TMO      128
#define XB_XCNT(j)  (256  + 64 * (j))
#define XB_XSUB(j)  (1280 + 64 * (j))
#define XB_XGEN(j)  (2304 + 64 * (j))
#define XB_TOP      3328
#define XB_TOPGEN   3392
#define XCD_BAR_WORDS 3456
#define XB_SPIN_CAP (1u << 18)
__device__ __forceinline__ unsigned xb_ld(unsigned* p)              { return __hip_atomic_load(p, __ATOMIC_RELAXED, __HIP_MEMORY_SCOPE_AGENT); }
__device__ __forceinline__ unsigned xb_add(unsigned* p, unsigned v) { return __hip_atomic_fetch_add(p, v, __ATOMIC_RELAXED, __HIP_MEMORY_SCOPE_AGENT); }
__device__ __forceinline__ unsigned xb_xcc_id() { return (unsigned)__builtin_amdgcn_s_getreg((3 << 11) | 20) & 0xFu; }
#define XB_SPIN(cond, bar) do { unsigned _sp = 0; while (cond) { __builtin_amdgcn_s_sleep(1); \
    if ((++_sp & 255u) == 0u) { if (xb_ld(&(bar)[XB_TMO])) break; if (_sp > XB_SPIN_CAP) { atomicAdd(&(bar)[XB_TMO], 1u); break; } } } } while (0)
struct XcdBarrier { unsigned* bar; unsigned x; volatile LAS unsigned* st; };
__device__ __forceinline__ XcdBarrier xcd_barrier_post(unsigned* bar, volatile LAS unsigned* st) {
    XcdBarrier b; b.bar = bar; b.x = xb_xcc_id(); b.st = st;
    if (threadIdx.x == 0) (void)xb_add(&bar[XB_XCNT(b.x)], 1u);
    return b;
}
__device__ __forceinline__ void xcd_barrier_complete(unsigned* bar, unsigned x, unsigned& nloc, unsigned& nx) {
    const unsigned G = gridDim.x * gridDim.y * gridDim.z;
    unsigned sum, cnt, mine, sp = 0u;
    for (;;) {
        sum = 0u; cnt = 0u; mine = 0u;
#pragma unroll
        for (unsigned j = 0; j < 16; ++j) { const unsigned c = xb_ld(&bar[XB_XCNT(j)]); sum += c; cnt += (c > 0u) ? 1u : 0u; mine = (j == x) ? c : mine; }
        if (sum == G) break;
        __builtin_amdgcn_s_sleep(1);
        if ((++sp & 255u) == 0u) { if (xb_ld(&bar[XB_TMO])) break; if (sp > XB_SPIN_CAP) { atomicAdd(&bar[XB_TMO], 1u); break; } }
    }
    nloc = mine > 0u ? mine : 1u; nx = cnt > 0u ? cnt : 1u;
}
__device__ __forceinline__ void xcd_barrier(const XcdBarrier& b) {
    asm volatile("s_waitcnt vmcnt(0)" ::: "memory");
    __syncthreads();
    if (threadIdx.x == 0) {
        unsigned* bar = b.bar;
        __builtin_amdgcn_s_waitcnt(0);
        unsigned nloc = b.st[0], nx = b.st[1];
        if (nloc == 0u) { xcd_barrier_complete(bar, b.x, nloc, nx); b.st[0] = nloc; b.st[1] = nx; }
        const unsigned old = xb_add(&bar[XB_XSUB(b.x)], 1u);
        const unsigned gen = old / nloc;
        if (old + 1u == (gen + 1u) * nloc) {
            __builtin_amdgcn_fence(__ATOMIC_RELEASE, "agent");
            asm volatile("s_waitcnt vmcnt(0)" ::: "memory");
            const unsigned og = xb_add(&bar[XB_TOP], 1u);
            const unsigned tg = og / nx;
            if (og + 1u == (tg + 1u) * nx) xb_add(&bar[XB_TOPGEN], 1u);
            else XB_SPIN(xb_ld(&bar[XB_TOPGEN]) == tg, bar);
            __builtin_amdgcn_fence(__ATOMIC_ACQUIRE, "agent");
            xb_add(&bar[XB_XGEN(b.x)], 1u);
            asm volatile("s_waitcnt vmcnt(0)" ::: "memory");
        } else {
            XB_SPIN(xb_ld(&bar[XB_XGEN(b.x)]) == gen, bar);
            __builtin_amdgcn_fence(__ATOMIC_ACQUIRE, "agent");
            asm volatile("s_waitcnt vmcnt(0)" ::: "memory");
        }
    }
    __syncthreads();
}

constexpr int RING_OFF = 0, RING_BYTES = 131072;
constexpr int LDSCTL_OFF = RING_BYTES, MISC_OFF = LDSCTL_OFF + 320;
constexpr int LDS_BYTES = 147456;
constexpr int NWAVES = 8;

struct Args { const float* in[20]; float* out; unsigned char* ws; int ph_lo, ph_hi, flags, pad; };

template <int RMAP>
__device__ __forceinline__ int p0_rowmap(int n) {
    if (RMAP == 1) { if (n < 1024) { const int pn = n >> 8, lc = n & 255, hh = lc >> 6, d = lc & 63; return pn * 256 + 128 * (d >> 5) + 32 * hh + (d & 31); }
        if (n >= 3584) { const int isr = n >= 4608, c = n - (isr ? 4608 : 3584); return 256 * (14 + (c >> 7)) + 128 * isr + (c & 127); }
        return n; }
    return n;
}
template <int RMAP>
__device__ __forceinline__ void p0_transpose_item(const float* W, int N, bf16_t* WT, int ldt, int koff, const float* kscale, LAS float* scr, int item, int lane) {
    const int nblk = N / 32, kb = item / nblk, nb = item % nblk, k0 = 64 * kb, n0 = 32 * nb;
    float wv_[32];
#pragma unroll
    for (int i = 0; i < 32; ++i) { const int kk = 2 * i + (lane >> 5); wv_[i] = W[(size_t)(k0 + kk) * N + n0 + (lane & 31)]; }
    if (kscale) {
#pragma unroll
        for (int i = 0; i < 32; ++i) wv_[i] *= kscale[k0 + 2 * i + (lane >> 5)]; }
#pragma unroll
    for (int i = 0; i < 32; ++i) scr[(2 * i + (lane >> 5)) * 33 + (lane & 31)] = wv_[i];
    asm volatile("s_waitcnt lgkmcnt(0)" ::: "memory");
    const int c = lane & 7;
#pragma unroll
    for (int j = 0; j < 4; ++j) { const int n = (lane >> 3) + 8 * j; const LAS float* s = scr + (8 * c) * 33 + n;
        u32x4 o; o.x = pk2(s[0 * 33], s[1 * 33]); o.y = pk2(s[2 * 33], s[3 * 33]); o.z = pk2(s[4 * 33], s[5 * 33]); o.w = pk2(s[6 * 33], s[7 * 33]);
        *(u32x4*)(WT + (size_t)p0_rowmap<RMAP>(n0 + n) * ldt + koff + k0 + 8 * c) = o; }
    asm volatile("s_waitcnt lgkmcnt(0)" ::: "memory");
}
__device__ __forceinline__ void rms_row_to_bf16(const f32x4 (&v)[4], float* rstd_out, bf16_t* orow, int lane) {
    float s = 0.f;
#pragma unroll
    for (int j = 0; j < 4; ++j) s += (v[j].x * v[j].x + v[j].y * v[j].y) + (v[j].z * v[j].z + v[j].w * v[j].w);
    const float rstd = 1.f / sqrtf(wave_sum(s) * (1.f / DM) + EPS);
    if (lane == 0) *rstd_out = rstd;
    unsigned p[4][2];
#pragma unroll
    for (int j = 0; j < 4; ++j) { p[j][0] = pk2(v[j].x, v[j].y); p[j][1] = pk2(v[j].z, v[j].w); }
    const bool odd = lane & 1;
#pragma unroll
    for (int h = 0; h < 2; ++h) {
        const unsigned s0 = odd ? p[2 * h][0] : p[2 * h + 1][0], s1 = odd ? p[2 * h][1] : p[2 * h + 1][1];
        const unsigned r0 = __shfl_xor(s0, 1), r1 = __shfl_xor(s1, 1);
        u32x4 o; if (odd) { o.x = r0; o.y = r1; o.z = p[2 * h + 1][0]; o.w = p[2 * h + 1][1]; } else { o.x = p[2 * h][0]; o.y = p[2 * h][1]; o.z = r0; o.w = r1; }
        *(u32x4*)(orow + 256 * (2 * h + (odd ? 1 : 0)) + 8 * (lane >> 1)) = o; }
}

namespace attn_body {
using bf16=__hip_bfloat16;
using s16x4=__attribute__((ext_vector_type(4)))short;
using f32x16=__attribute__((ext_vector_type(16)))float;
constexpr int D=64,PQ=::DA,PO=::OC;
constexpr int NW=8,QBLK=32,QB=QBLK*NW,KVBLK=64,NQB=::SEQ/QB;
constexpr int TAB_N=384, LDS_TAB=86016;
__device__ __forceinline__ int crow(int r,int hi){return (r&3)+8*(r>>2)+4*hi;}
#define SBAR() __builtin_amdgcn_sched_barrier(0)
__device__ __forceinline__ void bmask(f32x16&p0,f32x16&p1,int jb,int qrel,int hi,const __attribute__((address_space(3))) float*tab){
  const int base=qrel-64*jb-4*hi+255;
  #pragma unroll
  for(int r=0;r<16;++r){const int i0=base-((r&3)+8*(r>>2)); const int j0=i0<368?i0:368; const int i1=i0-32; const int j1=i1<368?i1:368; p0[r]+=tab[j0]; p1[r]+=tab[j1];}
}

constexpr int NSLOT=3, SLOTB=8192;
constexpr int LDS_K=0, LDS_V=NSLOT*SLOTB, LDS_WS=2*NSLOT*SLOTB, LDS_OST=LDS_WS+NW*64*4, LDS_BYTES=LDS_OST+NW*4096;
__device__ __forceinline__ void glds16(const void*gsrc,unsigned lds_dst){unsigned keep;
  asm volatile("s_mov_b32 %0, m0\n\ts_mov_b32 m0, %2\n\ts_nop 0\n\tglobal_load_lds_dwordx4 %1, off\n\ts_mov_b32 m0, %0":"=&s"(keep):"v"(gsrc),"s"(lds_dst):"memory");}
__device__ __forceinline__ float max3f(float a,float b,float c){float r;asm("v_max3_f32 %0, %1, %2, %3":"=v"(r):"v"(a),"v"(b),"v"(c));return r;}
__device__ __forceinline__ float max2f(float a,float b){float r;asm("v_max_f32_e32 %0, %1, %2":"=v"(r):"v"(a),"v"(b));return r;}
__device__ __forceinline__ float fadd_s(float a,float b){float r;asm("v_add_f32_e32 %0, %1, %2":"=v"(r):"v"(a),"v"(b));return r;}
__device__ __forceinline__ float fsub_s(float a,float b){float r;asm("v_sub_f32_e32 %0, %1, %2":"=v"(r):"v"(a),"v"(b));return r;}
typedef float f32x2_t __attribute__((ext_vector_type(2))); typedef __bf16 bf16x2_t __attribute__((ext_vector_type(2)));
__device__ __forceinline__ unsigned cvtpk_s(float lo,float hi){f32x2_t v={lo,hi};bf16x2_t b=__builtin_convertvector(v,bf16x2_t);return __builtin_bit_cast(unsigned,b);}
#define WAIT_BAR(N) asm volatile("s_waitcnt vmcnt(" #N ") lgkmcnt(0)\n\ts_barrier":::"memory")

__device__ __forceinline__ void qkt(f32x16&p0,f32x16&p1,const char*Kslot,const bf16x8*qr,const f32x16&negm,int r32,int hi){
  const char*kb=Kslot+hi*1024+r32*16;
  #pragma unroll
  for(int d0=0;d0<4;++d0){
    const bf16x8 b0=*reinterpret_cast<const bf16x8*>(kb+d0*2048);
    const bf16x8 b1=*reinterpret_cast<const bf16x8*>(kb+d0*2048+512);
    if(d0==0){p0=__builtin_amdgcn_mfma_f32_32x32x16_bf16(b0,qr[0],negm,0,0,0);p1=__builtin_amdgcn_mfma_f32_32x32x16_bf16(b1,qr[0],negm,0,0,0);}
    else{p0=__builtin_amdgcn_mfma_f32_32x32x16_bf16(b0,qr[d0],p0,0,0,0);p1=__builtin_amdgcn_mfma_f32_32x32x16_bf16(b1,qr[d0],p1,0,0,0);}}
}
typedef __attribute__((address_space(3))) const char* lds_cptr;
typedef short v4i16_t __attribute__((ext_vector_type(4)));
__device__ __forceinline__ void kload8(bf16x8*kf,lds_cptr kp){
  kf[0]=*(const __attribute__((address_space(3))) bf16x8*)(kp);      kf[1]=*(const __attribute__((address_space(3))) bf16x8*)(kp+512);
  kf[2]=*(const __attribute__((address_space(3))) bf16x8*)(kp+2048); kf[3]=*(const __attribute__((address_space(3))) bf16x8*)(kp+2560);
  kf[4]=*(const __attribute__((address_space(3))) bf16x8*)(kp+4096); kf[5]=*(const __attribute__((address_space(3))) bf16x8*)(kp+4608);
  kf[6]=*(const __attribute__((address_space(3))) bf16x8*)(kp+6144); kf[7]=*(const __attribute__((address_space(3))) bf16x8*)(kp+6656);
}
__device__ __forceinline__ void kload2(bf16x8*kf,lds_cptr kp,int j){ kf[2*j]=*(const __attribute__((address_space(3))) bf16x8*)(kp+j*2048); kf[2*j+1]=*(const __attribute__((address_space(3))) bf16x8*)(kp+j*2048+512); }
__device__ __forceinline__ s16x4 vtr(lds_cptr p){ return __builtin_bit_cast(s16x4,__builtin_amdgcn_ds_read_tr16_b64_v4i16((__attribute__((address_space(3))) v4i16_t*)p)); }
__device__ __forceinline__ float rowmax(const f32x16&p0,const f32x16&p1){
  float a=max3f(p0[0],p0[1],p1[0]),b=max3f(p0[2],p0[3],p1[1]);a=max3f(a,p1[2],p1[3]);
  #pragma unroll
  for(int r=4;r<16;r+=4){a=max3f(a,p0[r],p0[r+1]);b=max3f(b,p0[r+2],p0[r+3]);a=max3f(a,p1[r],p1[r+1]);b=max3f(b,p1[r+2],p1[r+3]);}
  const float m=max2f(a,b);
  auto rr=__builtin_amdgcn_permlane32_swap(__float_as_uint(m),__float_as_uint(m),false,false);
  return max2f(__uint_as_float(rr[0]),__uint_as_float(rr[1]));
}
__device__ __forceinline__ void pv(f32x16*o,int vb,bf16x8 pa0,bf16x8 pa1,bf16x8 pa2,bf16x8 pa3){
  #pragma unroll
  for(int d0=0;d0<2;++d0){s16x4 lo[4],hi[4];
    #pragma unroll
    for(int ks=0;ks<4;++ks){
      asm volatile("ds_read_b64_tr_b16 %0,%1 offset:%c2":"=&v"(lo[ks]):"v"(vb),"i"(d0*4096+ks*1024):"memory");
      asm volatile("ds_read_b64_tr_b16 %0,%1 offset:%c2":"=&v"(hi[ks]):"v"(vb),"i"(d0*4096+ks*1024+512):"memory");}
    asm volatile("s_waitcnt lgkmcnt(0)":::"memory");SBAR();
    #define PK(k) (bf16x8){lo[k][0],lo[k][1],lo[k][2],lo[k][3],hi[k][0],hi[k][1],hi[k][2],hi[k][3]}
    o[d0]=__builtin_amdgcn_mfma_f32_32x32x16_bf16(pa0,PK(0),o[d0],0,0,0);
    o[d0]=__builtin_amdgcn_mfma_f32_32x32x16_bf16(pa1,PK(1),o[d0],0,0,0);
    o[d0]=__builtin_amdgcn_mfma_f32_32x32x16_bf16(pa2,PK(2),o[d0],0,0,0);
    o[d0]=__builtin_amdgcn_mfma_f32_32x32x16_bf16(pa3,PK(3),o[d0],0,0,0);
    #undef PK
  }
}

#ifndef ATTN_STORE16
#define ATTN_STORE16(p,v) (*(u32x4*)(p)=(v))
#endif
template<int THRL> __device__ __forceinline__ void attn_unit(int b,int h,int qb,const bf16*Q,const bf16*__restrict__ K,const bf16*__restrict__ V,const unsigned short*__restrict__ kmh,const unsigned short*__restrict__ kml,bf16*O,char*shm){
  const int tid=threadIdx.x,lane=tid&63,r32=lane&31,hi=lane>>5; const int wid=__builtin_amdgcn_readfirstlane(tid>>6);
  const long rowbase=(long)b*::SEQ; const int q0=qb*QB;
  const bf16*Qw=Q+(rowbase+q0+wid*QBLK)*PQ+h*D;
  const bf16*Kh=K+rowbase*PQ+h*D,*Vh=V+rowbase*PQ+h*D;
  const unsigned lds0=(unsigned)(uintptr_t)shm;
  float*wsf=(float*)(shm+LDS_WS)+wid*64;
  const bf16*ksrc=Kh+(long)lane*PQ+wid*8;
  const bf16*vsrc=Vh+(long)(16*(wid&3)+(lane>>2))*PQ+(wid>>2)*32+(lane&3)*8;
  const unsigned kdst=lds0+LDS_K+wid*1024, vdst=lds0+LDS_V+wid*1024;
  #define TOFF(t) ((long)(((t)<4)?(q0+KVBLK*(t)):(KVBLK*((t)-4)))*PQ)
  #define DMA_K(t,slot) glds16(ksrc+TOFF(t),(unsigned)__builtin_amdgcn_readfirstlane(kdst+(slot)))
  #define DMA_V(t,slot) glds16(vsrc+TOFF(t),(unsigned)__builtin_amdgcn_readfirstlane(vdst+(slot)))
  const int vb0=(int)(lds0+LDS_V)+((lane>>4)&1)*32+(lane&3)*8+(4*hi+((lane&15)>>2))*64;
  const char*Kbase=shm+LDS_K; bf16x8 kf[8];
  const lds_cptr shm3=(lds_cptr)shm; const lds_cptr kp0=shm3+LDS_K+hi*1024+r32*16; const lds_cptr vp0=shm3+LDS_V+((lane>>4)&1)*32+(lane&3)*8+(4*hi+((lane&15)>>2))*64;
  const int NT=(q0+QB)/KVBLK;
  DMA_K(0,0);DMA_V(0,0);DMA_K(1,SLOTB);
  bf16x8 qr[4];
  #pragma unroll
  for(int d0=0;d0<4;++d0)qr[d0]=*reinterpret_cast<const bf16x8*>(&Qw[(long)r32*PQ+d0*16+hi*8]);
  float mhat=0.f,l_reg=0.f;f32x16 o[2];o[0]=f32x16{};o[1]=f32x16{};f32x16 negm=f32x16{};asm volatile("":"+v"(negm));
  const int qrel=wid*QBLK+r32;
  const __attribute__((address_space(3))) float*tab=(const __attribute__((address_space(3))) float*)((lds_cptr)shm+LDS_TAB)+h*TAB_N;
  unsigned selmask=0u;
  if(qb>0){
    f32x16 gacc=f32x16{};
    const size_t ko=((size_t)(b*::NH+h)*::NKB+(r32&15))*D+hi*8;
    #pragma unroll
    for(int d0=0;d0<4;++d0){ const bf16x8 ah=*(const bf16x8*)(kmh+ko+d0*16), al=*(const bf16x8*)(kml+ko+d0*16);
      gacc=__builtin_amdgcn_mfma_f32_32x32x16_bf16(ah,qr[d0],gacc,0,0,0);
      gacc=__builtin_amdgcn_mfma_f32_32x32x16_bf16(al,qr[d0],gacc,0,0,0); }
    float g[16];
    #pragma unroll
    for(int r=0;r<4;++r){ const float m0=gacc[r],o0=__shfl_xor(m0,32),m1=gacc[4+r],o1=__shfl_xor(m1,32);
      g[r]=hi?o0:m0; g[4+r]=hi?m0:o0; g[8+r]=hi?o1:m1; g[12+r]=hi?m1:o1; }
    #pragma unroll
    for(int j=0;j<16;++j) if(j>=qb) g[j]=-INFINITY;
    #pragma unroll
    for(int rd=0;rd<3;++rd){ float best=-INFINITY; int bi=-1;
      #pragma unroll
      for(int j=0;j<16;++j) if(g[j]>best){best=g[j];bi=j;}
      if(bi>=0) selmask|=1u<<bi;
      #pragma unroll
      for(int j=0;j<16;++j) if(j==bi) g[j]=-INFINITY; }
  }
  #define SELT(t) (((t)<4)||((selmask>>(((t)-4)>>2))&1u))
  #define CMASK(P0,P1,t) do{ if((t)<4){ const int rmax_=wid*32+31-64*(t), rmin_=wid*32-64*(t)-63; if(rmax_<0){ _Pragma("unroll") for(int r=0;r<16;++r){P0[r]=-INFINITY;P1[r]=-INFINITY;} } else if(rmin_<=112) bmask(P0,P1,(t),qrel,hi,tab); } \
    else if((t)>=NT-2){ const int q0_=wid*32+128-64*((t)-(NT-2)); if(q0_-63<=112) bmask(P0,P1,0,qrel+128-64*((t)-(NT-2)),hi,tab); } }while(0)
  bool resc=false;
  #define START(P0,P1) do{ const float rm=rowmax(P0,P1); resc=false; \
    { const float dl=rm; mhat=fadd_s(mhat,dl); \
      _Pragma("unroll") for(int r=0;r<16;++r){P0[r]=fsub_s(P0[r],dl);P1[r]=fsub_s(P1[r],dl);} \
      _Pragma("unroll") for(int r=0;r<16;++r)negm[r]=-mhat; asm volatile("":"+v"(negm)); } \
    _Pragma("unroll") for(int r=0;r<16;++r)P0[r]=__builtin_amdgcn_exp2f(P0[r]); }while(0)
  #define RESC() do{ if(resc){ asm volatile("s_waitcnt lgkmcnt(0)":::"memory"); \
      _Pragma("unroll") for(int d_=0;d_<2;++d_) _Pragma("unroll") for(int r=0;r<16;++r)o[d_][r]*=wsf[crow(r,hi)]; } }while(0)
  f32x16 pA0,pA1,pB0,pB1;
  int sl_prev=0,sl_cur=0,sl_next=SLOTB;
  #define ROT() do{sl_prev=sl_cur;sl_cur=sl_next;sl_next=(sl_next==(NSLOT-1)*SLOTB)?0:sl_next+SLOTB;}while(0)
  DMA_K(2,2*SLOTB);
  WAIT_BAR(3);
  qkt(pA0,pA1,Kbase,qr,negm,r32,hi);asm volatile("s_nop 15\n\ts_nop 7":"+v"(pA0),"+v"(pA1));CMASK(pA0,pA1,0);
  START(pA0,pA1);
  _Pragma("unroll") for(int r=0;r<16;++r)pA1[r]=__builtin_amdgcn_exp2f(pA1[r]);
  WAIT_BAR(0);
  DMA_K(3,0);DMA_V(1,SLOTB);
  ROT();
  kload8(kf,kp0+sl_cur);
  WAIT_BAR(2);
  s16x4 vlo[8],vhi[8]; u32x4 pw0,pw1,pw2,pw3;
  #define PKW(P,B) cvtpk_s(P[B],P[B+1])
  #define PAF(k) __builtin_bit_cast(bf16x8,pw##k)
  #define VFR(i) (bf16x8){vlo[i][0],vlo[i][1],vlo[i][2],vlo[i][3],vhi[i][0],vhi[i][1],vhi[i][2],vhi[i][3]}
  #define PIN(x) asm volatile("":"+v"(x))
  #define MX3(a,b,c) __builtin_fmaxf(__builtin_fmaxf((a),(b)),(c))
  #define GAPA(MF,A0,A1,A2,A3,W0,W1,PW) do{ MF; sacc+=A0; sacc+=A1; sacc+=A2; sacc+=A3; PIN(sacc); W0; W1; PIN(PW); SBAR(); }while(0)
  #define EX(v) __builtin_amdgcn_exp2f(v)
  #define GAPB(MF,X,B) do{ MF; X[B]=EX(X[B]); X[B+1]=EX(X[B+1]); X[B+2]=EX(X[B+2]); X[B+3]=EX(X[B+3]); PIN(X); SBAR(); }while(0)
  #define VRD(i) do{ vlo[i]=vtr(vp_+(((i)>>2)*4096+((i)&3)*1024)); vhi[i]=vtr(vp_+(((i)>>2)*4096+((i)&3)*1024+512)); }while(0)
  #define KRD(G,j) do{ if(G){ kload2(kf,kp0+sl_next,j); SBAR(); } }while(0)
  #define STEP(C0,C1,P0,P1,t,GK,GV,GL) do{ SBAR(); \
    { const float nv_=SELT(t)?-mhat:-INFINITY; _Pragma("unroll") for(int r=0;r<16;++r)negm[r]=nv_; asm volatile("":"+v"(negm)); } SBAR(); \
    const lds_cptr vp_=vp0+sl_prev; \
    VRD(0); SBAR(); float sacc=(P0[0]+P0[1]); \
    GAPA(C0=__builtin_amdgcn_mfma_f32_32x32x16_bf16(kf[0],qr[0],negm,0,0,0), P0[2],P0[3],P0[4],P0[5],     pw0[0]=PKW(P0,0), pw0[1]=PKW(P0,2), pw0); \
    VRD(4); SBAR(); GAPA(C1=__builtin_amdgcn_mfma_f32_32x32x16_bf16(kf[1],qr[0],negm,0,0,0), P0[6],P0[7],P0[8],P0[9],     pw0[2]=PKW(P0,4), pw0[3]=PKW(P0,6), pw0); \
    VRD(1); SBAR(); GAPA(C0=__builtin_amdgcn_mfma_f32_32x32x16_bf16(kf[2],qr[1],C0,0,0,0),   P0[10],P0[11],P0[12],P0[13], pw1[0]=PKW(P0,8), pw1[1]=PKW(P0,10), pw1); \
    VRD(5); SBAR(); GAPA(C1=__builtin_amdgcn_mfma_f32_32x32x16_bf16(kf[3],qr[1],C1,0,0,0),   P0[14],P0[15],P1[0],P1[1],   pw1[2]=PKW(P0,12),pw1[3]=PKW(P0,14), pw1); \
    VRD(2); SBAR(); GAPA(C0=__builtin_amdgcn_mfma_f32_32x32x16_bf16(kf[4],qr[2],C0,0,0,0),   P1[2],P1[3],P1[4],P1[5],     pw2[0]=PKW(P1,0), pw2[1]=PKW(P1,2), pw2); \
    VRD(6); SBAR(); GAPA(C1=__builtin_amdgcn_mfma_f32_32x32x16_bf16(kf[5],qr[2],C1,0,0,0),   P1[6],P1[7],P1[8],P1[9],     pw2[2]=PKW(P1,4), pw2[3]=PKW(P1,6), pw2); \
    VRD(3); SBAR(); GAPA(C0=__builtin_amdgcn_mfma_f32_32x32x16_bf16(kf[6],qr[3],C0,0,0,0),   P1[10],P1[11],P1[12],P1[13], pw3[0]=PKW(P1,8), pw3[1]=PKW(P1,10), pw3); \
    VRD(7); SBAR(); GAPA(C1=__builtin_amdgcn_mfma_f32_32x32x16_bf16(kf[7],qr[3],C1,0,0,0),   P1[14],P1[15],0.f,0.f,       pw3[2]=PKW(P1,12),pw3[3]=PKW(P1,14), pw3); \
    l_reg+=sacc; \
    if(GK){DMA_K((t)+3,sl_cur);} if(GV){DMA_V((t)+1,sl_next);} \
    if(MASKON){CMASK(C0,C1,t);} \
    { float a=MX3(C0[0],C0[1],C1[0]),b=MX3(C0[2],C0[3],C1[1]); a=MX3(a,C1[2],C1[3]); \
      _Pragma("unroll") for(int r=4;r<16;r+=4){a=MX3(a,C0[r],C0[r+1]);b=MX3(b,C0[r+2],C0[r+3]);a=MX3(a,C1[r],C1[r+1]);b=MX3(b,C1[r+2],C1[r+3]);} \
      float rm=__builtin_fmaxf(a,b); { auto rr=__builtin_amdgcn_permlane32_swap(__float_as_uint(rm),__float_as_uint(rm),false,false); rm=__builtin_fmaxf(__uint_as_float(rr[0]),__uint_as_float(rr[1])); } \
      resc=false; \
      if(__builtin_expect(__any(rm>(float)THRL),0)){ const float dl=__builtin_fmaxf(rm,0.f); mhat+=dl; \
        _Pragma("unroll") for(int r=0;r<16;++r){C0[r]-=dl;C1[r]-=dl;} \
        const float f=__builtin_amdgcn_exp2f(-dl); l_reg*=f; if(hi==0)wsf[r32]=f; resc=true; } } \
    SBAR(); \
    GAPB(o[0]=__builtin_amdgcn_mfma_f32_32x32x16_bf16(PAF(0),VFR(0),o[0],0,0,0), C0,0); \
    GAPB(o[1]=__builtin_amdgcn_mfma_f32_32x32x16_bf16(PAF(0),VFR(4),o[1],0,0,0), C0,4); \
    KRD(GL,0); GAPB(o[0]=__builtin_amdgcn_mfma_f32_32x32x16_bf16(PAF(1),VFR(1),o[0],0,0,0), C0,8); \
    KRD(GL,1); GAPB(o[1]=__builtin_amdgcn_mfma_f32_32x32x16_bf16(PAF(1),VFR(5),o[1],0,0,0), C0,12); \
    KRD(GL,2); GAPB(o[0]=__builtin_amdgcn_mfma_f32_32x32x16_bf16(PAF(2),VFR(2),o[0],0,0,0), C1,0); \
    KRD(GL,3); GAPB(o[1]=__builtin_amdgcn_mfma_f32_32x32x16_bf16(PAF(2),VFR(6),o[1],0,0,0), C1,4); \
    GAPB(o[0]=__builtin_amdgcn_mfma_f32_32x32x16_bf16(PAF(3),VFR(3),o[0],0,0,0), C1,8); \
    GAPB(o[1]=__builtin_amdgcn_mfma_f32_32x32x16_bf16(PAF(3),VFR(7),o[1],0,0,0), C1,12); \
    }while(0)
  int t=1;
  #define MASKON 1
  for(;t<4&&t+3<NT;t+=2){
    STEP(pB0,pB1,pA0,pA1,t,true,true,true);     WAIT_BAR(2); RESC(); ROT();
    STEP(pA0,pA1,pB0,pB1,t+1,true,true,true);   WAIT_BAR(2); RESC(); ROT();
  }
  #undef MASKON
  #define MASKON 0
  for(;t+3<NT;t+=2){
    STEP(pB0,pB1,pA0,pA1,t,true,true,true);     WAIT_BAR(2); RESC(); ROT();
    STEP(pA0,pA1,pB0,pB1,t+1,true,true,true);   WAIT_BAR(2); RESC(); ROT();
  }
  #undef MASKON
  #define MASKON 1
  STEP(pB0,pB1,pA0,pA1,t,false,true,true);      WAIT_BAR(1); RESC(); ROT();
  STEP(pA0,pA1,pB0,pB1,t+1,false,true,true);    WAIT_BAR(0); RESC(); ROT();
  STEP(pB0,pB1,pA0,pA1,NT-1,false,false,false); RESC();
  { float sacc=pB0[0]+pB0[1]; _Pragma("unroll") for(int r=2;r<16;++r)sacc+=pB0[r]; _Pragma("unroll") for(int r=0;r<16;++r)sacc+=pB1[r]; l_reg+=sacc;
    pw0=(u32x4){PKW(pB0,0),PKW(pB0,2),PKW(pB0,4),PKW(pB0,6)};pw1=(u32x4){PKW(pB0,8),PKW(pB0,10),PKW(pB0,12),PKW(pB0,14)};pw2=(u32x4){PKW(pB1,0),PKW(pB1,2),PKW(pB1,4),PKW(pB1,6)};pw3=(u32x4){PKW(pB1,8),PKW(pB1,10),PKW(pB1,12),PKW(pB1,14)};
    SBAR(); pv(o,vb0+sl_cur,PAF(0),PAF(1),PAF(2),PAF(3)); }
  #undef PKW
  #undef PAF
  #undef VFR
  #undef PIN
  #undef MX3
  #undef GAPA
  #undef GAPB
  #undef EX
  #undef VRD
  #undef KRD
  #undef STEP
  {auto rr=__builtin_amdgcn_permlane32_swap(__float_as_uint(l_reg),__float_as_uint(l_reg),false,false);l_reg=__uint_as_float(rr[0])+__uint_as_float(rr[1]);}
  if(hi==0)wsf[32+r32]=l_reg;asm volatile("s_waitcnt lgkmcnt(0)":::"memory");
  float rli[16];
  #pragma unroll
  for(int r=0;r<16;++r)rli[r]=__builtin_amdgcn_rcpf(wsf[32+crow(r,hi)]);
  bf16*Ow=O+(rowbase+q0+wid*QBLK)*PO+h*D;
  { bf16*stg=(bf16*)(shm+LDS_OST)+wid*2048;
    #pragma unroll
    for(int r=0;r<16;++r){const int orow=crow(r,hi);
      #pragma unroll
      for(int d0=0;d0<2;++d0)stg[orow*64+d0*32+r32]=__float2bfloat16(o[d0][r]*rli[r]);}
    asm volatile("s_waitcnt lgkmcnt(0)":::"memory");
    #pragma unroll
    for(int i=0;i<4;++i){const int row=i*8+(lane>>3),ch=lane&7; const u32x4 v=*(const u32x4*)(stg+row*64+ch*8); ATTN_STORE16(Ow+(long)row*PO+ch*8,v);} }
  asm volatile("s_waitcnt lgkmcnt(0)\n\ts_barrier":::"memory");
  #undef DMA_K
  #undef TOFF
  #undef SELT
  #undef MASKON
  #undef DMA_V
  #undef CMASK
  #undef START
  #undef RESC
  #undef ROT
}
constexpr int ATTN_LDS_BYTES=LDS_BYTES;
struct AttnTensors { const bf16* Q; const bf16* K; const bf16* V; const unsigned short* kmh; const unsigned short* kml; const float* rel_bias; bf16* O; };
struct AttnUnit { int bh; int qb; };
struct StaticOrder {
  int vcu;
  __device__ __forceinline__ explicit StaticOrder(int v):vcu(v){}
  __device__ __forceinline__ bool next(int i,AttnUnit&u)const{ if(i>=4)return false; const int s=vcu&3; u.bh=vcu>>2; u.qb=(i==0)?15-s:(i==1)?8+s:(i==2)?7-s:s; return true; }
};
template<int THRL=8> __device__ __forceinline__ void attn_phase(char*lds,const AttnTensors&T,int vcu0,int G){
  { __attribute__((address_space(3))) float*tb=(__attribute__((address_space(3))) float*)((lds_cptr)lds+LDS_TAB);
    for(int i=threadIdx.x;i<8*TAB_N;i+=NW*64){ const int hh=i/TAB_N,k=i%TAB_N,rel=k-255; float v=0.f;
      if(rel<0)v=-INFINITY; else if(rel<=112)v=(T.rel_bias[::t5_bucket(rel)*::NH+hh]-T.rel_bias[31*::NH+hh])*::LOG2E;
      tb[i]=v; }
    asm volatile("s_waitcnt lgkmcnt(0)\n\ts_barrier":::"memory"); }
  for(int v=vcu0;v<256;v+=G){ const StaticOrder S(v); AttnUnit u;
    for(int i=0;S.next(i,u);++i) attn_unit<THRL>(u.bh / ::NH, u.bh % ::NH, u.qb,T.Q,T.K,T.V,T.kmh,T.kml,T.O,lds); }
}
#undef SBAR
#undef WAIT_BAR
}

namespace rnn {
typedef float f32x16 __attribute__((ext_vector_type(16)));
constexpr int NCHK = 16, CHT = SEQ / NCHK, TILES = CHT / 32;
constexpr int LDS_BEXT = 98304, LDS_CW = LDS_BEXT + 24576, LDS_STG = 0;
__device__ __forceinline__ void fill_tables(LAS unsigned char* lds, int blk, const float* __restrict__ Wa, const float* __restrict__ Wi, const float* __restrict__ cw, const float* __restrict__ cb, int tid) {
#pragma unroll 1
    for (int it = 0; it < (24 * 64) / (NWAVES * 64); ++it) { const int e = tid + it * (NWAVES * 64);
        const int frag = e >> 6, ln = e & 63, ntile = frag >> 2, ks = frag & 3, n = ln & 31, hi = ln >> 5;
        const int col = (ntile & 1) * 32 + n, k0 = 16 * ks + 8 * hi;
        const float* W = (ntile < 2 ? Wa : Wi) + (size_t)blk * RBD * RBD + col;
        u32x4 w;
#pragma unroll
        for (int j2 = 0; j2 < 4; ++j2) { const int k = k0 + 2 * j2; float v0, v1;
            if (ntile < 4) { v0 = W[k * RBD]; v1 = W[(k + 1) * RBD]; } else { v0 = (k == col) ? 1.f : 0.f; v1 = (k + 1 == col) ? 1.f : 0.f; }
            w[j2] = pk2(v0, v1); }
        *(LAS u32x4*)(lds + LDS_BEXT + e * 16) = w;
    }
    if (tid < 5 * 64) { const int e = tid, j = e >> 6, c = e & 63; ((LAS float*)(lds + LDS_CW))[e] = (j < 4) ? cw[j * DR + blk * RBD + c] : cb[blk * RBD + c]; }
}
template <bool FINAL>
__device__ __forceinline__ void scan_chunk(LAS unsigned char* lds, int b, int blk, int chunk, int wave, int lane, const bf16_t* __restrict__ XR, const bf16_t* __restrict__ GY,
                                           const float* __restrict__ ba, const float* __restrict__ bi, const float* __restrict__ lam, float* comp, bf16_t* __restrict__ O) {
    const int r32 = lane & 31, hi = lane >> 5;
    float cba[2], cbi[2], c8[2], H[2], Ac[2];
#pragma unroll
    for (int nt = 0; nt < 2; ++nt) { const int ch = blk * RBD + 32 * nt + r32; cba[nt] = -LOG2E * ba[ch]; cbi[nt] = -LOG2E * bi[ch]; c8[nt] = -8.0f * LOG2E * log1pf(expf(-lam[ch])); H[nt] = 0.f; Ac[nt] = 1.f; }
    if (FINAL) {
        for (int k = 0; k < chunk; ++k) {
#pragma unroll
            for (int nt = 0; nt < 2; ++nt) { const f32x2 c = *(const f32x2*)(comp + (((size_t)b * NCHK + k) * DR + blk * RBD + 32 * nt + r32) * 2); H[nt] = c[0] * H[nt] + c[1]; } }
    }
    const size_t row0 = (size_t)b * SEQ + (size_t)chunk * CHT;
    const LAS f32x4* cwp = (const LAS f32x4*)(lds + LDS_CW) + 2 * hi;
    const LAS bf16x8* bfr = (const LAS bf16x8*)(lds + LDS_BEXT) + lane;
    LAS bf16_t* stg = (LAS bf16_t*)(lds + LDS_STG + wave * 4096);
    u32x4 xraw[4][4];
#define RNN_LOAD_TILE(tl) do { const int tpos_ = chunk * CHT + (tl) * 32 + r32; const bf16_t* xp_ = XR + (row0 + (tl) * 32 + r32) * DR + blk * RBD + 8 * hi; \
        _Pragma("unroll") for (int ks_ = 0; ks_ < 4; ++ks_) { xraw[ks_][3] = *(const u32x4*)(xp_ + 16 * ks_); \
            _Pragma("unroll") for (int j_ = 0; j_ < 3; ++j_) { const bool ok_ = (tpos_ + j_ - 3) >= 0; const u32x4 v_ = *(const u32x4*)(xp_ + (ok_ ? (long)(j_ - 3) * DR : 0) + 16 * ks_); xraw[ks_][j_] = ok_ ? v_ : (u32x4){0u, 0u, 0u, 0u}; } } } while (0)
    RNN_LOAD_TILE(0);
    for (int tile = 0; tile < TILES; ++tile) {
        u32x4 gyv[4];
        if (FINAL) {
#pragma unroll
            for (int i = 0; i < 4; ++i) gyv[i] = *(const u32x4*)(GY + (row0 + tile * 32 + 8 * i + (lane >> 3)) * DR + blk * RBD + (lane & 7) * 8);
        }
        bf16x8 af[4];
#pragma unroll
        for (int ks = 0; ks < 4; ++ks) {
            f32x4 alo = cwp[64 + 4 * ks], ahi = cwp[64 + 4 * ks + 1];
#pragma unroll
            for (int j = 0; j < 4; ++j) { const f32x4 wlo = cwp[16 * j + 4 * ks], whi = cwp[16 * j + 4 * ks + 1]; const u32x4 x = xraw[ks][j];
                const f32x4 xlo = {__uint_as_float(x[0] << 16), __uint_as_float(x[0] & 0xffff0000u), __uint_as_float(x[1] << 16), __uint_as_float(x[1] & 0xffff0000u)};
                const f32x4 xhi = {__uint_as_float(x[2] << 16), __uint_as_float(x[2] & 0xffff0000u), __uint_as_float(x[3] << 16), __uint_as_float(x[3] & 0xffff0000u)};
                alo += wlo * xlo; ahi += whi * xhi; }
            u32x4 pk; pk[0] = cvt_pk_bf16(alo[0], alo[1]); pk[1] = cvt_pk_bf16(alo[2], alo[3]); pk[2] = cvt_pk_bf16(ahi[0], ahi[1]); pk[3] = cvt_pk_bf16(ahi[2], ahi[3]);
            af[ks] = __builtin_bit_cast(bf16x8, pk);
        }
        if (tile + 1 < TILES) RNN_LOAD_TILE(tile + 1);
#pragma unroll
        for (int nt = 0; nt < 2; ++nt) {
            f32x16 aR = f32x16{}, aI = f32x16{}, aX = f32x16{};
#pragma unroll
            for (int ks = 0; ks < 4; ++ks) {
                aR = __builtin_amdgcn_mfma_f32_32x32x16_bf16(af[ks], bfr[64 * (4 * nt + ks)], aR, 0, 0, 0);
                aI = __builtin_amdgcn_mfma_f32_32x32x16_bf16(af[ks], bfr[64 * (4 * (2 + nt) + ks)], aI, 0, 0, 0);
                aX = __builtin_amdgcn_mfma_f32_32x32x16_bf16(af[ks], bfr[64 * (4 * (4 + nt) + ks)], aX, 0, 0, 0); }
            float av[16], uv[16];
#pragma unroll
            for (int r = 0; r < 16; ++r) {
                const float rr = __builtin_amdgcn_rcpf(1.0f + __builtin_amdgcn_exp2f(__builtin_fmaf(aR[r], -LOG2E, cba[nt]))), ii = __builtin_amdgcn_rcpf(1.0f + __builtin_amdgcn_exp2f(__builtin_fmaf(aI[r], -LOG2E, cbi[nt])));
                const float a = __builtin_amdgcn_exp2f(rr * c8[nt]); const float om = __builtin_fmaf(-a, a, 1.0f);
                av[r] = a; uv[r] = __builtin_amdgcn_sqrtf(om) * (ii * aX[r]); }
            float As[4], Bs[4], pA[4], pB[4], st[4];
#pragma unroll
            for (int g = 0; g < 4; ++g) { As[g] = (av[4 * g] * av[4 * g + 1]) * (av[4 * g + 2] * av[4 * g + 3]);
                Bs[g] = ((uv[4 * g] * av[4 * g + 1] + uv[4 * g + 1]) * av[4 * g + 2] + uv[4 * g + 2]) * av[4 * g + 3] + uv[4 * g + 3];
                pA[g] = __shfl_xor(As[g], 32); pB[g] = __shfl_xor(Bs[g], 32); }
            float Hc = H[nt];
#pragma unroll
            for (int g = 0; g < 4; ++g) { const float Ae = hi ? pA[g] : As[g], Be = hi ? pB[g] : Bs[g], Ao = hi ? As[g] : pA[g], Bo = hi ? Bs[g] : pB[g];
                const float h0 = Hc; Hc = Ae * Hc + Be; const float h1 = Hc; Hc = Ao * Hc + Bo; st[g] = hi ? h1 : h0;
                if (!FINAL) Ac[nt] *= Ae * Ao; }
            H[nt] = Hc;
            if (FINAL) {
#pragma unroll
                for (int g = 0; g < 4; ++g) { float h = st[g];
#pragma unroll
                    for (int i = 0; i < 4; ++i) { h = av[4 * g + i] * h + uv[4 * g + i]; stg[(8 * g + 4 * hi + i) * 64 + 32 * nt + r32] = (bf16_t)cvt_pk_bf16(h, h); } }
            }
        }
        if (FINAL) {
            asm volatile("s_waitcnt lgkmcnt(0)" ::: "memory");
#pragma unroll
            for (int i = 0; i < 4; ++i) { const int row = 8 * i + (lane >> 3), c8c = (lane & 7) * 8; const u32x4 hv = *(const LAS u32x4*)(stg + row * 64 + c8c); const u32x4 gv = gyv[i]; u32x4 w;
#pragma unroll
                for (int j = 0; j < 4; ++j) w[j] = cvt_pk_bf16(__uint_as_float(hv[j] << 16) * __uint_as_float(gv[j] << 16), __uint_as_float(hv[j] & 0xffff0000u) * __uint_as_float(gv[j] & 0xffff0000u));
                *(u32x4*)(O + (row0 + tile * 32 + row) * OC + DA + blk * RBD + c8c) = w; }
            asm volatile("s_waitcnt lgkmcnt(0)" ::: "memory");
        }
    }
    if (!FINAL && hi == 0) {
#pragma unroll
        for (int nt = 0; nt < 2; ++nt) *(f32x2*)(comp + (((size_t)b * NCHK + chunk) * DR + blk * RBD + 32 * nt + r32) * 2) = (f32x2){Ac[nt], H[nt]};
    }
}
template <bool FINAL>
__device__ __forceinline__ void scan_phase(LAS unsigned char* lds, int vcu, int G, int wave, int lane, int tid, const bf16_t* XR, const bf16_t* GY, const float* cw, const float* cb, const float* Wa, const float* ba,
                                           const float* Wi, const float* bi, const float* lam, float* comp, bf16_t* O) {
    asm volatile("" : "+v"(lane), "+v"(tid));
    for (int v = vcu; v < 256; v += G) {
        const int b = v >> 5, blk = (v >> 1) & 15, chunk = (v & 1) * 8 + wave;
        __syncthreads();
        fill_tables(lds, blk, Wa, Wi, cw, cb, tid);
        __syncthreads();
        scan_chunk<FINAL>(lds, b, blk, chunk, wave, lane, XR, GY, ba, bi, lam, comp, O);
    }
}
#undef RNN_LOAD_TILE
}

__device__ __forceinline__ void naive_attn_item(int idx, const bf16_t* __restrict__ Q, const bf16_t* __restrict__ K, const bf16_t* __restrict__ V, const float* __restrict__ kmp,
                                                 const float* __restrict__ rel_bias, bf16_t* __restrict__ O, int opitch) {
    const int t = idx % SEQ, h = (idx / SEQ) % NH, b = idx / (SEQ * NH);
    const size_t row = (size_t)b * SEQ + t;
    float q[64];
    { const u32x4* qp = (const u32x4*)(Q + row * DA + h * HD);
#pragma unroll
      for (int c = 0; c < 8; ++c) { const u32x4 w = qp[c];
#pragma unroll
          for (int j = 0; j < 4; ++j) { q[c * 8 + 2 * j] = __uint_as_float(w[j] << 16); q[c * 8 + 2 * j + 1] = __uint_as_float(w[j] & 0xffff0000u); } } }
    const int own = t / KBLK;
    unsigned mask = 0;
    {
        float g[16];
#pragma unroll
        for (int j = 0; j < 16; ++j) { g[j] = -INFINITY;
            if (j < own) { const float* k0 = kmp + (size_t)((b * NKB + j) * 2) * DA + h * HD; const float* k1 = k0 + DA; float s = 0.f;
#pragma unroll
                for (int d = 0; d < 64; ++d) s += q[d] * ((k0[d] + k1[d]) * (1.0f / 256.0f));
                g[j] = s; } }
#pragma unroll
        for (int r = 0; r < 3; ++r) { float best = -INFINITY; int bi = -1;
#pragma unroll
            for (int j = 0; j < 16; ++j) if (g[j] > best) { best = g[j]; bi = j; }
            if (bi >= 0) { mask |= 1u << bi;
#pragma unroll
                for (int j = 0; j < 16; ++j) if (j == bi) g[j] = -INFINITY; } }
    }
    mask |= 1u << own;
    float o[64];
#pragma unroll
    for (int d = 0; d < 64; ++d) o[d] = 0.f;
    float mx = -INFINITY, l = 0.f;
    for (int j = 0; j <= own; ++j) {
        if (!((mask >> j) & 1u)) continue;
        const int kend = (j == own) ? (t - own * KBLK + 1) : KBLK;
        for (int kk = 0; kk < kend; ++kk) {
            const size_t krow = (size_t)b * SEQ + j * KBLK + kk;
            const u32x4* kp = (const u32x4*)(K + krow * DA + h * HD);
            float s = 0.f;
#pragma unroll
            for (int c = 0; c < 8; ++c) { const u32x4 w = kp[c];
#pragma unroll
                for (int jj = 0; jj < 4; ++jj) { s += q[c * 8 + 2 * jj] * __uint_as_float(w[jj] << 16); s += q[c * 8 + 2 * jj + 1] * __uint_as_float(w[jj] & 0xffff0000u); } }
            const int rel = t - (j * KBLK + kk);
            s += rel_bias[t5_bucket(rel) * NH + h] * LOG2E;
            if (s > mx) { const float f = exp2f(mx - s); l *= f;
#pragma unroll
                for (int d = 0; d < 64; ++d) o[d] *= f;
                mx = s; }
            const float p = exp2f(s - mx); l += p;
            const u32x4* vp = (const u32x4*)(V + krow * DA + h * HD);
#pragma unroll
            for (int c = 0; c < 8; ++c) { const u32x4 w = vp[c];
#pragma unroll
                for (int jj = 0; jj < 4; ++jj) { o[c * 8 + 2 * jj] += p * __uint_as_float(w[jj] << 16); o[c * 8 + 2 * jj + 1] += p * __uint_as_float(w[jj] & 0xffff0000u); } }
        }
    }
    const float il = 1.0f / l;
    u32x4* op = (u32x4*)(O + row * opitch + h * HD);
#pragma unroll
    for (int c = 0; c < 8; ++c) { u32x4 w;
#pragma unroll
        for (int jj = 0; jj < 4; ++jj) w[jj] = pk2(o[c * 8 + 2 * jj] * il, o[c * 8 + 2 * jj + 1] * il);
        op[c] = w; }
}

__device__ __forceinline__ void rg_au_ref(float rp, float ip, float xc, float c8sp, float& a, float& u) {
    const float r = 1.0f / (1.0f + expf(-rp)), i = 1.0f / (1.0f + expf(-ip));
    const float la = -c8sp * r; a = expf(la); u = sqrtf(-expm1f(2.0f * la)) * (i * xc);
}
constexpr int NCH = 64, CHL = SEQ / NCH;
template <bool FINAL>
__device__ __forceinline__ void naive_scan_item(int item, int c, LAS float* xcs, const bf16_t* __restrict__ XR, const bf16_t* __restrict__ GY, const float* __restrict__ cw, const float* __restrict__ cb,
                                                const float* __restrict__ Wa, const float* __restrict__ ba, const float* __restrict__ Wi, const float* __restrict__ bi,
                                                const float* __restrict__ lam, float* __restrict__ comp, const float* __restrict__ carry, bf16_t* __restrict__ O) {
    const int blk = item % RB, chunk = (item / RB) % NCH, b = item / (RB * NCH);
    const int ch = blk * RBD + c;
    const float w0 = cw[ch], w1 = cw[DR + ch], w2 = cw[2 * DR + ch], w3 = cw[3 * DR + ch], bb = cb[ch];
    for (int tt = 0; tt < CHL; ++tt) { const int t = chunk * CHL + tt; const bf16_t* xp = XR + ((size_t)b * SEQ + t) * DR + ch;
        float v = bb + w3 * bf2f(xp[0]);
        if (t >= 1) v += w2 * bf2f(xp[-DR]);
        if (t >= 2) v += w1 * bf2f(xp[-2 * DR]);
        if (t >= 3) v += w0 * bf2f(xp[-3 * DR]);
        xcs[tt * 64 + c] = v; }
    asm volatile("s_waitcnt lgkmcnt(0)" ::: "memory");
    const float c8sp = 8.0f * log1pf(expf(-lam[ch]));
    const float bav = ba[ch], biv = bi[ch];
    const float* wa = Wa + (size_t)blk * RBD * RBD + c; const float* wi = Wi + (size_t)blk * RBD * RBD + c;
    float A = 1.f, Bc = 0.f, hst = FINAL ? carry[((size_t)b * NCH + chunk) * DR + ch] : 0.f;
    for (int tt = 0; tt < CHL; ++tt) {
        float rp = bav, ip = biv;
#pragma unroll 8
        for (int d = 0; d < 64; ++d) { const float xv = xcs[tt * 64 + d]; rp += xv * wa[d * RBD]; ip += xv * wi[d * RBD]; }
        float a, u; rg_au_ref(rp, ip, xcs[tt * 64 + c], c8sp, a, u);
        if (FINAL) { hst = a * hst + u; const size_t off = ((size_t)b * SEQ + chunk * CHL + tt); O[off * OC + DA + ch] = (bf16_t)f2bf(hst * bf2f(GY[off * DR + ch])); }
        else { A *= a; Bc = a * Bc + u; }
    }
    if (!FINAL) { float* cp = comp + (((size_t)b * NCH + chunk) * DR + ch) * 2; cp[0] = A; cp[1] = Bc; }
    asm volatile("s_waitcnt lgkmcnt(0)" ::: "memory");
}
__device__ __forceinline__ void naive_scan_prefix_item(int idx, const float* __restrict__ comp, float* __restrict__ carry) {
    const int ch = idx % DR, b = idx / DR;
    float h = 0.f;
    for (int k = 0; k < NCH; ++k) { const size_t o = ((size_t)b * NCH + k) * DR + ch; carry[o] = h; h = comp[o * 2] * h + comp[o * 2 + 1]; }
}

__global__ void __launch_bounds__(NWAVES * 64, 2) mk_fwd(Args args) {
    extern __shared__ __attribute__((aligned(16))) unsigned char lds_raw[];
    LAS unsigned char* lds = (LAS unsigned char*)lds_raw;
    const int tid = threadIdx.x, lane = tid & 63, wave = __builtin_amdgcn_readfirstlane(tid >> 6);
    const int G = gridDim.x; const int bx = blockIdx.x; const int vcu = (G % 8 == 0) ? (bx % 8) * (G / 8) + bx / 8 : bx;
    unsigned char* ws = args.ws;
    unsigned* ctl = (unsigned*)(ws + WS_CTL);
    for (int u = tid; u < (LDS_BYTES - LDSCTL_OFF) / 4; u += NWAVES * 64) ((LAS unsigned*)(lds + LDSCTL_OFF))[u] = 0u;
    __syncthreads();
    volatile LAS unsigned* MISC = (volatile LAS unsigned*)(lds + MISC_OFF);
    const int lo = args.ph_lo, hi = args.ph_hi;
    XcdBarrier bar; bar.bar = ctl + CW_BAR + lo * XCD_BAR_WORDS; bar.x = 0; bar.st = nullptr;
    const bool multi = (hi - lo) > 1;
    if (multi) bar = xcd_barrier_post(ctl + CW_BAR + lo * XCD_BAR_WORDS, MISC + 8);
#define IN(k) (lo <= (k) && (k) < hi)
#define BOTH(k) (IN(k) && IN((k) + 1))
#define GRID_BAR() xcd_barrier(bar)
#define STAGGER(ticks) do { if ((ticks) > 0) { const unsigned long long t0_ = __builtin_amdgcn_s_memrealtime(), d_ = (unsigned long long)(vcu & 3) * (unsigned long long)(ticks); while (__builtin_amdgcn_s_memrealtime() - t0_ < d_) __builtin_amdgcn_s_sleep(8); } } while (0)

    const float* x = args.in[0];
    bf16_t* Wt_in = (bf16_t*)(ws + WS_WIN); bf16_t* Wt_cat = (bf16_t*)(ws + WS_WCAT); bf16_t* Wt_out = (bf16_t*)(ws + WS_WOUT);
    bf16_t* Wt_ff1 = (bf16_t*)(ws + WS_WFF1); bf16_t* Wt_ff2 = (bf16_t*)(ws + WS_WFF2);
    bf16_t* XN = (bf16_t*)(ws + WS_XN); bf16_t* XB = (bf16_t*)(ws + WS_XB); float* rstd1 = (float*)(ws + WS_RSTD1); bf16_t* Qb = (bf16_t*)(ws + WS_Q); bf16_t* Kb = (bf16_t*)(ws + WS_K); bf16_t* Vb = (bf16_t*)(ws + WS_V);
    bf16_t* XR = (bf16_t*)(ws + WS_XR); bf16_t* GY = (bf16_t*)(ws + WS_GY); bf16_t* GA = (bf16_t*)(ws + WS_GA); bf16_t* GR = (bf16_t*)(ws + WS_GR);
    bf16_t* MRG = (bf16_t*)(ws + WS_MRG); bf16_t* HB = (bf16_t*)(ws + WS_H);
    float* kmp = (float*)(ws + WS_KMP); float* ssq = (float*)(ws + WS_SSQ);
    bf16_t* OCAT = (bf16_t*)args.out;

    if ((PHMASK >> 0 & 1) && IN(0)) {
        LAS float* scr = (LAS float*)(lds + RING_OFF + wave * 16384);
        const int gw = vcu * NWAVES + wave, NGW = G * NWAVES;
        constexpr int I_IN = (DM / 64) * (DIN / 32), I_PA = (DA / 64) * (DM / 32), I_PR = (DR / 64) * (DM / 32), I_OUT = (DM / 64) * (DM / 32), I_F1 = (DM / 64) * (DFF / 32), I_F2 = (DFF / 64) * (DM / 32);
        (void)I_PA; (void)I_PR; (void)I_OUT; (void)I_F1; (void)I_F2;
        for (int it = gw; it < I_IN; it += NGW) p0_transpose_item<1>(args.in[2], DIN, Wt_in, DM, 0, args.in[1], scr, it, lane);
        { f32x4 cur[4], nxt[4];
#pragma unroll
          for (int j = 0; j < 4; ++j) cur[j] = ((const f32x4*)(x + (size_t)gw * DM) + lane)[64 * j];
          for (int m = gw; m < M; m += NGW) { const int mn = (m + NGW < M) ? m + NGW : m;
#pragma unroll
              for (int j = 0; j < 4; ++j) nxt[j] = ((const f32x4*)(x + (size_t)mn * DM) + lane)[64 * j];
              rms_row_to_bf16(cur, rstd1 + m, XB + (size_t)m * DM, lane);
#pragma unroll
              for (int j = 0; j < 4; ++j) cur[j] = nxt[j]; } }
        if (BOTH(0)) GRID_BAR();
    }
    if ((PHMASK >> 1 & 1) && IN(1)) {
        pg8::Gemm g = pg8::gemm_rowmajor(XB, Wt_in, DM, DM, DM, DIN, -1, args.flags); pg8::StaticOrder S; S.init(M, DIN, G, bx);
        LAS float* rs = (LAS float*)(lds + LDSCTL_OFF + 1024);
        { pg8::Unit u0; int nu = 0; while (nu < 11 && S.next(nu, u0)) ++nu;
          for (int e = tid; e < nu * 256; e += NWAVES * 64) { pg8::Unit u1; S.next(e >> 8, u1); rs[e] = rstd1[u1.pm * 256 + (e & 255)]; }
          __syncthreads(); }
        pg8::EpiZ E{Qb, Kb, Vb, XR, GY, GA, GR, kmp, args.in[4], args.in[5], args.in[3], rs, ws, (LAS float*)(lds + LDSCTL_OFF + 13312)};
        STAGGER(STAG1);
        pg8::gemm_phase<pg8::EpiZ, pg8::StaticOrder, false>(lds + RING_OFF, g, S, E);
        if (BOTH(1)) GRID_BAR();
    }
    {
        const float* cw = args.in[7]; const float* cb = args.in[8]; const float* Wa = args.in[9]; const float* ba = args.in[10]; const float* Wi = args.in[11]; const float* bi = args.in[12]; const float* lam = args.in[13];
        float* comp = (float*)(ws + WS_COMP); float* carry = (float*)(ws + WS_CARRY);
        LAS float* xcs = (LAS float*)(lds + RING_OFF + wave * 16384);
        const int gw = vcu * NWAVES + wave, NGW = G * NWAVES;
        const bool pairmode = PAIR_SYNC && (G == 256) && IN(2) && IN(4) && !NAIVE_SCAN;
        if ((PHMASK >> 2 & 1) && IN(2)) {
#if NAIVE_ATTN
            for (int idx = bx * (NWAVES * 64) + tid; idx < BATCH * NH * SEQ; idx += G * NWAVES * 64) naive_attn_item(idx, Qb, Kb, Vb, kmp, args.in[6], OCAT, OC);
#else
            if (!(args.flags & 8)) { const attn_body::AttnTensors AT{(const attn_body::bf16*)Qb, (const attn_body::bf16*)Kb, (const attn_body::bf16*)Vb, (const unsigned short*)(ws + WS_KMH), (const unsigned short*)(ws + WS_KML), args.in[6], (attn_body::bf16*)OCAT};
              attn_body::attn_phase<8>((char*)lds_raw + RING_OFF, AT, vcu, G); }
#endif
#if NAIVE_SCAN
            for (int it = gw; it < BATCH * NCH * RB; it += NGW) naive_scan_item<false>(it, lane, xcs, XR, GY, cw, cb, Wa, ba, Wi, bi, lam, comp, carry, OCAT);
#else
            if (!(args.flags & 4)) rnn::scan_phase<false>(lds, vcu, G, wave, lane, tid, XR, GY, cw, cb, Wa, ba, Wi, bi, lam, comp, OCAT);
#endif
            if (pairmode) {
                asm volatile("s_waitcnt vmcnt(0)" ::: "memory"); __syncthreads();
                if (tid == 0) { __builtin_amdgcn_fence(__ATOMIC_RELEASE, "agent"); asm volatile("s_waitcnt vmcnt(0)" ::: "memory");
                    __hip_atomic_store(ctl + CW_PAIR + 64 * vcu, 1u, __ATOMIC_RELAXED, __HIP_MEMORY_SCOPE_AGENT); }
            } else if (BOTH(2)) GRID_BAR();
        }
        if ((PHMASK >> 3 & 1) && IN(3)) {
#if DBG_ATTN
            { float sd = 0.f, sr = 0.f;
              for (size_t i = (size_t)bx * (NWAVES * 64) + tid; i < (size_t)M * DA; i += (size_t)G * NWAVES * 64) { const size_t r = i / DA, c = i % DA;
                  const float a = bf2f(OCAT[r * OC + c]), b = bf2f((XN + (size_t)16 * 1024 * 1024)[r * DA + c]); sd += (a - b) * (a - b); sr += b * b; }
              sd = wave_sum(sd); sr = wave_sum(sr);
              if (lane == 0) { atomicAdd((float*)(ctl + 16), sd); atomicAdd((float*)(ctl + 17), sr); } }
#endif
#if NAIVE_SCAN
            for (int idx = bx * (NWAVES * 64) + tid; idx < BATCH * DR; idx += G * NWAVES * 64) naive_scan_prefix_item(idx, comp, carry);
            if (BOTH(3)) GRID_BAR();
#endif
        }
        if ((PHMASK >> 4 & 1) && IN(4)) {
#if NAIVE_SCAN
            for (int it = gw; it < BATCH * NCH * RB; it += NGW) naive_scan_item<true>(it, lane, xcs, XR, GY, cw, cb, Wa, ba, Wi, bi, lam, comp, carry, OCAT);
#else
            {
                constexpr int I_PA = (DA / 64) * (DM / 32), I_PR = (DR / 64) * (DM / 32), I_OUT = (DM / 64) * (DM / 32), I_F1 = (DM / 64) * (DFF / 32), I_F2 = (DFF / 64) * (DM / 32);
                LAS float* scr = (LAS float*)(lds + RING_OFF + wave * 16384);
                for (int it = gw; it < I_PA + I_PR + I_OUT + I_F1 + I_F2; it += NGW) {
                    int r = it;
                    if (r < I_PA) { p0_transpose_item<0>(args.in[14], DM, Wt_cat, OC, 0, nullptr, scr, r, lane); continue; } r -= I_PA;
                    if (r < I_PR) { p0_transpose_item<0>(args.in[15], DM, Wt_cat, OC, DA, nullptr, scr, r, lane); continue; } r -= I_PR;
                    if (r < I_OUT) { p0_transpose_item<0>(args.in[16], DM, Wt_out, DM, 0, nullptr, scr, r, lane); continue; } r -= I_OUT;
                    if (r < I_F1) { p0_transpose_item<0>(args.in[18], DFF, Wt_ff1, DM, 0, args.in[17], scr, r, lane); continue; } r -= I_F1;
                    p0_transpose_item<0>(args.in[19], DM, Wt_ff2, HP, 0, nullptr, scr, r, lane);
                }
            }
            if (pairmode) {
                if (tid == 0) {
                    if (vcu & 1) { unsigned sp = 0; while (__hip_atomic_load(ctl + CW_PAIR + 64 * (vcu - 1), __ATOMIC_RELAXED, __HIP_MEMORY_SCOPE_AGENT) == 0u) { __builtin_amdgcn_s_sleep(2);
                            if (++sp > (1u << 22)) { __hip_atomic_store(ctl + CW_TMO, 1u, __ATOMIC_RELAXED, __HIP_MEMORY_SCOPE_AGENT); break; } } }
                    __builtin_amdgcn_fence(__ATOMIC_ACQUIRE, "agent"); asm volatile("s_waitcnt vmcnt(0)" ::: "memory"); }
                __syncthreads();
            }
            rnn::scan_phase<true>(lds, vcu, G, wave, lane, tid, XR, GY, cw, cb, Wa, ba, Wi, bi, lam, comp, OCAT);
#endif
            if (BOTH(4)) GRID_BAR();
        }
    }
    if ((PHMASK >> 5 & 1) && IN(5)) {
        pg8::Gemm g = pg8::gemm_rowmajor(OCAT, Wt_cat, OC, OC, OC, DM, DA / 64, args.flags); pg8::StaticOrder S; S.init(M, DM, G, bx);
        pg8::EpiMerge E{GA, GR, MRG};
        pg8::gemm_phase<pg8::EpiMerge, pg8::StaticOrder, MIDFLAG>(lds + RING_OFF, g, S, E);
        if (BOTH(5)) GRID_BAR();
    }
    if ((PHMASK >> 6 & 1) && IN(6)) {
        pg8::Gemm g = pg8::gemm_rowmajor(MRG, Wt_out, DM, DM, DM, DM, -1, args.flags); g.imgA = 1; g.kstepA = 32768; g.tstepA = (size_t)(DM / 64) * 32768; pg8::StaticOrder S; S.init(M, DM, G, bx);
        pg8::EpiX1 E{XB, XN, ssq};
        pg8::gemm_phase<pg8::EpiX1, pg8::StaticOrder, false>(lds + RING_OFF, g, S, E);
        if (BOTH(6)) GRID_BAR();
    }
    if ((PHMASK >> 7 & 1) && IN(7)) {
        pg8::Gemm g = pg8::gemm_rowmajor(XN, Wt_ff1, DM, DM, DM, DFF, -1, args.flags); g.imgA = 1; g.kstepA = 32768; g.tstepA = (size_t)(DM / 64) * 32768; pg8::StaticOrder S; S.init(M, DFF, G, bx);
        LAS float* rs = (LAS float*)(lds + LDSCTL_OFF + 1024);
        { pg8::Unit u0; int nu = 0; while (nu < 8 && S.next(nu, u0)) ++nu;
          for (int e = tid; e < nu * 256; e += NWAVES * 64) { pg8::Unit u1; S.next(e >> 8, u1); const float* sp = ssq + (size_t)(u1.pm * 256 + (e & 255)) * 16;
              const f32x4 s0 = *(const f32x4*)sp, s1 = *(const f32x4*)(sp + 4), s2 = *(const f32x4*)(sp + 8), s3 = *(const f32x4*)(sp + 12);
              const float tot = (((s0[0] + s0[1]) + (s0[2] + s0[3])) + ((s1[0] + s1[1]) + (s1[2] + s1[3]))) + (((s2[0] + s2[1]) + (s2[2] + s2[3])) + ((s3[0] + s3[1]) + (s3[2] + s3[3])));
              rs[e] = 1.0f / sqrtf(tot * (1.0f / DM) + EPS); }
          __syncthreads(); }
        pg8::EpiH E{rs, HB};
        STAGGER(STAG7);
        pg8::gemm_phase<pg8::EpiH, pg8::StaticOrder, false>(lds + RING_OFF, g, S, E);
        if (BOTH(7)) GRID_BAR();
    }
    if ((PHMASK >> 8 & 1) && IN(8)) {
        pg8::Gemm g = pg8::gemm_rowmajor(HB, Wt_ff2, HP, HP, DFF, DM, -1, args.flags); g.imgA = 1; g.kstepA = 32768; g.tstepA = (size_t)(DFF / 64) * 32768;   pg8::StaticOrder S; S.init(M, DM, G, bx);
        pg8::EpiOut E{XN, args.out};
        pg8::gemm_phase<pg8::EpiOut, pg8::StaticOrder, false>(lds + RING_OFF, g, S, E);
#ifdef PROBE_BARRIERS
        if (multi) { for (int i = 0; i < PROBE_BARRIERS; ++i) GRID_BAR(); }
#endif
#if DBG_ATTN
        GRID_BAR();
        { const float sd = __hip_atomic_load((float*)(ctl + 16), __ATOMIC_RELAXED, __HIP_MEMORY_SCOPE_AGENT), sr = __hip_atomic_load((float*)(ctl + 17), __ATOMIC_RELAXED, __HIP_MEMORY_SCOPE_AGENT);
          const float e = sqrtf(sd / sr) * DBG_AMP;
          for (size_t i = (size_t)bx * (NWAVES * 64) + tid; i < (size_t)M * DM; i += (size_t)G * NWAVES * 64) args.out[i] *= (1.0f + e); }
#endif
    }
#undef IN
#undef BOTH
#undef GRID_BAR
}

#if DBG_ATTN
__global__ void __launch_bounds__(256) naive_attn_k(const bf16_t* Q, const bf16_t* K, const bf16_t* V, const float* kmp, const float* rel_bias, bf16_t* O, int opitch) {
    naive_attn_item(blockIdx.x * 256 + threadIdx.x, Q, K, V, kmp, rel_bias, O, opitch);
}
#endif
constexpr int N_PHASES = 9;
extern "C" void kernel_launch(void* const* d_in, const int* in_sizes, int n_in, void* d_out, int out_size, void* d_ws, size_t ws_size, hipStream_t stream) {
    static int grid = 0;
    if (grid == 0) {
        if (n_in != 20 || in_sizes[0] != M * DM || out_size != M * DM || ws_size < WS_END) { fprintf(stderr, "kernel_launch: unexpected shapes (n_in %d, in0 %d, out %d, ws %zu)\n", n_in, n_in > 0 ? in_sizes[0] : -1, out_size, ws_size); grid = -1; return; }
        int dev = 0, cus = 0;
        if (hipGetDevice(&dev) != hipSuccess || hipDeviceGetAttribute(&cus, hipDeviceAttributeMultiprocessorCount, dev) != hipSuccess) { grid = -1; return; }
        if (hipFuncSetAttribute((const void*)mk_fwd, hipFuncAttributeMaxDynamicSharedMemorySize, LDS_BYTES) != hipSuccess) { fprintf(stderr, "kernel_launch: hipFuncSetAttribute failed\n"); grid = -1; return; }
        (void)hipGetLastError();
        grid = cus;
    }
    if (grid < 0) return;
    (void)hipMemsetAsync((char*)d_ws + WS_CTL, 0, CTL_ZERO_BYTES, stream);
    Args a{};
    for (int i = 0; i < 20; ++i) a.in[i] = (const float*)d_in[i];
    a.out = (float*)d_out; a.ws = (unsigned char*)d_ws;
#if DBG_ATTN
    a.ph_lo = 0; a.ph_hi = 2;
    hipLaunchKernelGGL(mk_fwd, dim3(grid), dim3(NWAVES * 64), LDS_BYTES, stream, a);
    { unsigned char* ws = (unsigned char*)d_ws;
      hipLaunchKernelGGL(naive_attn_k, dim3(BATCH * NH * SEQ / 256), dim3(256), 0, stream, (const bf16_t*)(ws + WS_Q), (const bf16_t*)(ws + WS_K), (const bf16_t*)(ws + WS_V),
                         (const float*)(ws + WS_KMP), (const float*)d_in[6], (bf16_t*)(ws + WS_XN + 32 * MiB), DA); }
    a.ph_lo = 2; a.ph_hi = N_PHASES;
    hipLaunchKernelGGL(mk_fwd, dim3(grid), dim3(NWAVES * 64), LDS_BYTES, stream, a);
#elif defined(PROBE_REP)
#ifndef PROBE_FLAGS
#define PROBE_FLAGS 0
#endif
#ifndef PROBE_LO
#define PROBE_LO PROBE_REP
#endif
    a.ph_lo = 0; a.ph_hi = PROBE_REP + 1;
    hipLaunchKernelGGL(mk_fwd, dim3(grid), dim3(NWAVES * 64), LDS_BYTES, stream, a);
    a.ph_lo = PROBE_LO; a.ph_hi = PROBE_REP + 1; a.flags = PROBE_FLAGS;
    hipLaunchKernelGGL(mk_fwd, dim3(grid), dim3(NWAVES * 64), LDS_BYTES, stream, a);
    a.flags = 0;
    if (PROBE_REP + 1 < N_PHASES) { a.ph_lo = PROBE_REP + 1; a.ph_hi = N_PHASES;
    hipLaunchKernelGGL(mk_fwd, dim3(grid), dim3(NWAVES * 64), LDS_BYTES, stream, a); }
#elif MK_N_LAUNCHES == 1
    a.ph_lo = 0; a.ph_hi = N_PHASES;
    hipLaunchKernelGGL(mk_fwd, dim3(grid), dim3(NWAVES * 64), LDS_BYTES, stream, a);
#else
    for (int p = 0; p < N_PHASES; ++p) { a.ph_lo = p; a.ph_hi = p + 1; hipLaunchKernelGGL(mk_fwd, dim3(grid), dim3(NWAVES * 64), LDS_BYTES, stream, a); }
#endif
}
```

```cpp
#include <hip/hip_runtime.h>
#include <hip/hip_bf16.h>
#include <cstdio>
#include <cstdint>

#ifndef MIDFLAG
#define MIDFLAG true
#endif
#ifndef NAIVE_ATTN
#define NAIVE_ATTN 0
#endif
#ifndef NAIVE_SCAN
#define NAIVE_SCAN 0
#endif
#ifndef DBG_ATTN
#define DBG_ATTN 0
#endif
#ifndef DBG_AMP
#define DBG_AMP 10.0f
#endif
#ifndef STAG1
#define STAG1 0
#endif
#ifndef STAG7
#define STAG7 0
#endif
#ifndef PAIR_SYNC
#define PAIR_SYNC 1
#endif
#ifndef WGM_P1
#define WGM_P1 4
#endif
#ifndef WGM_P7
#define WGM_P7 8
#endif
#ifndef WGM_N4
#define WGM_N4 4
#endif
#ifndef PHMASK
#define PHMASK 0xffff
#endif
#ifndef MK_N_LAUNCHES
#define MK_N_LAUNCHES 1
#endif

constexpr int BATCH = 8, SEQ = 4096, DM = 1024, M = BATCH * SEQ;
constexpr int NH = 8, HD = 64, DA = 512, DR = 1024, DFF = 4096, DIN = 5632;
constexpr int KBLK = 256, NKB = SEQ / KBLK;
constexpr int RB = 16, RBD = 64;
constexpr int OC = DA + DR;
constexpr int HP = DFF + 128;
constexpr float EPS = 1e-6f;
constexpr float LOG2E = 1.4426950408889634f;
constexpr float C2 = 0.125f * LOG2E;

#define LAS __attribute__((address_space(3)))
#define GAS __attribute__((address_space(1)))
typedef unsigned short bf16_t;
typedef short bf16x8 __attribute__((ext_vector_type(8)));
typedef float f32x4 __attribute__((ext_vector_type(4)));
typedef float f32x2 __attribute__((ext_vector_type(2)));
typedef unsigned u32x4 __attribute__((ext_vector_type(4)));
typedef unsigned u32x2 __attribute__((ext_vector_type(2)));

constexpr size_t MiB = 1u << 20;
constexpr size_t WS_CTL = 0, CTL_ZERO_BYTES = 256 * 1024;
constexpr size_t WS_WIN = 2 * MiB;
constexpr size_t WS_WCAT = 13 * MiB;
constexpr size_t WS_WOUT = 16 * MiB;
constexpr size_t WS_WFF1 = 18 * MiB;
constexpr size_t WS_WFF2 = 26 * MiB;
constexpr size_t WS_KMP = 35 * MiB;
constexpr size_t WS_SSQ = 36 * MiB;
constexpr size_t WS_COMP = 38 * MiB;
constexpr size_t WS_CARRY = 42 * MiB;
constexpr size_t WS_KMH = 45 * MiB;
constexpr size_t WS_KML = 45 * MiB + 512 * 1024;
constexpr size_t WS_RSTD1 = 44 * MiB;
constexpr size_t WS_XB = 48 * MiB;
constexpr size_t WS_XR = 112 * MiB;
constexpr size_t WS_GY = 176 * MiB;
constexpr size_t WS_GA = 240 * MiB;
constexpr size_t WS_GR = 304 * MiB;
constexpr size_t WS_H = 112 * MiB;
constexpr size_t WS_K = 368 * MiB;
constexpr size_t WS_V = 400 * MiB;
constexpr size_t WS_MRG = 368 * MiB;
constexpr size_t WS_Q = 432 * MiB;
constexpr size_t WS_XN = 432 * MiB;
constexpr size_t WS_END = 496 * MiB;

constexpr int CW_TMO = 0, CW_BAR = 4096, CW_PAIR = 40000;

__device__ __forceinline__ float bf2f(unsigned short u) { return __uint_as_float(((unsigned)u) << 16); }
__device__ __forceinline__ unsigned f2bf(float f) { unsigned u = __builtin_bit_cast(unsigned, f); return (u + 0x7fffu + ((u >> 16) & 1u)) >> 16; }
__device__ __forceinline__ unsigned pk2(float lo, float hi) { return f2bf(lo) | (f2bf(hi) << 16); }
__device__ __forceinline__ unsigned cvt_pk_bf16(float lo, float hi) { unsigned r; asm volatile("s_nop 0\n\tv_cvt_pk_bf16_f32 %0, %1, %2" : "=v"(r) : "v"(lo), "v"(hi)); return r; }
__device__ __forceinline__ float fast_sigmoid(float x) { return __builtin_amdgcn_rcpf(1.0f + __builtin_amdgcn_exp2f(-LOG2E * x)); }
__device__ __forceinline__ float gelu_tanh(float x) { const float u = x + 0.044715f * x * x * x; return x * __builtin_amdgcn_rcpf(1.0f + __builtin_amdgcn_exp2f(-2.302208198f * u)); }
__device__ __forceinline__ float wave_sum(float v) {
#pragma unroll
    for (int o = 1; o < 64; o <<= 1) v += __shfl_xor(v, o);
    return v;
}
__device__ __forceinline__ int t5_bucket(int n) {
    if (n < 16) return n;
    int b = 16;
    b += (n >= 19); b += (n >= 21); b += (n >= 24); b += (n >= 27); b += (n >= 31); b += (n >= 35); b += (n >= 40); b += (n >= 46);
    b += (n >= 52); b += (n >= 59); b += (n >= 67); b += (n >= 77); b += (n >= 87); b += (n >= 99); b += (n >= 113);
    return b;
}

namespace pg8 {
constexpr int BM = 256, BK = 64, HALF = 128, HTB = HALF * BK * 2, STAGE_BYTES = 8 * HTB, NXCD = 8, WGM = 8;
__host__ __device__ __forceinline__ int lds_byte(int r, int c) { const int st = (r >> 4) * 2 + (c >> 5), rr = r & 15, cc = c & 31, ob = rr * 64 + cc * 2; return st * 1024 + (ob ^ (((ob >> 9) & 1) << 5)); }
__host__ __device__ __forceinline__ void stage_rc(int b, int& R, int& C) { const int st = b / 1024, sb = b % 1024, swz = sb ^ (((sb >> 9) & 1) << 5); R = (st >> 1) * 16 + swz / 64; C = (st & 1) * 32 + (swz % 64) / 2; }
__host__ __device__ __forceinline__ int perm32(int rho) { const int n = rho >> 4, i = rho & 15; return 8 * (i >> 2) + 4 * n + (i & 3); }

struct Unit { int pm, pn, idx; };
struct Gemm { const bf16_t* A; const bf16_t* Bt; int lda, ldb, K, N, mid_t, flags; size_t kstepA, kstepB, tstepA, tstepB; int imgA; };
__host__ __device__ __forceinline__ Gemm gemm_rowmajor(const bf16_t* A, const bf16_t* Bt, int lda, int ldb, int K, int N, int mid_t, int flags) { return Gemm{A, Bt, lda, ldb, K, N, mid_t, flags, (size_t)128, (size_t)128, (size_t)512 * lda, (size_t)512 * ldb, 0}; }

struct StaticOrder {
    int nM, nN, nwg, G, c, wgm;
    __host__ __device__ void init(int M_, int N_, int G_, int c_, int wgm_ = WGM) { nM = M_ / BM; nN = N_ / BM; nwg = nM * nN; G = G_; c = c_; wgm = wgm_; }
    __host__ __device__ bool next(int i, Unit& u) const {
        const long L = (long)i * G + c; if (L >= nwg) return false;
        int wgid = (int)L; { const int q = nwg / NXCD, r = nwg % NXCD, xcd = wgid % NXCD, off = wgid / NXCD; wgid = (xcd < r ? xcd * (q + 1) : r * (q + 1) + (xcd - r) * q) + off; }
        const int nig = wgm * nN, gid = wgid / nig, fm = gid * wgm, gsz = (nM - fm) < wgm ? (nM - fm) : wgm;
        u.pm = fm + ((wgid % nig) % gsz); u.pn = (wgid % nig) / gsz; u.idx = i; return true;
    }
};

typedef f32x4 Acc[2][2][4][2];

template <class Epi, class Sched, bool MID>
__device__ __forceinline__ void gemm_phase(LAS unsigned char* lds, const Gemm g, const Sched& S, const Epi& E) {
    const int tid = threadIdx.x, wid = __builtin_amdgcn_readfirstlane(tid >> 6), lane = tid & 63, wr = wid >> 2, wc = wid & 3, fr = lane & 15, fq = lane >> 4;
    const int nt = g.K / BK;
    unsigned voffA[2], voffB[2];
#pragma unroll
    for (int i = 0; i < 2; ++i) { int R, C; stage_rc(tid * 16 + i * 8192, R, C); const int Rb = Epi::PERM ? ((R & ~31) + perm32(R & 31)) : R;
        voffA[i] = g.imgA ? (unsigned)(tid * 16 + i * 8192) : (unsigned)(R * g.lda + C) * 2u; voffB[i] = (unsigned)(Rb * g.ldb + C) * 2u; }
    const size_t kstepA = g.kstepA, kstepB = g.kstepB;
    const size_t hstepA = g.imgA ? (size_t)HTB : (size_t)HALF * g.lda * 2, hstepB = (size_t)HALF * g.ldb * 2;
    const size_t tstepA = (g.flags & 2) ? 0 : g.tstepA, tstepB = (g.flags & 2) ? 0 : g.tstepB;
    const unsigned ldsw = (unsigned)wid * 1024u;
    const int aoff = lds_byte(wr * 64 + fr, fq * 8), boff = lds_byte(wc * 32 + fr, fq * 8);
#define PG8_SA(b, h) (((b) * 2 + (h)) * HTB)
#define PG8_SB(b, h) ((4 + (b) * 2 + (h)) * HTB)
#define PG8_STAGE(bufoff, gbase, voff) do { _Pragma("unroll") for (int _i = 0; _i < 2; ++_i) \
        __builtin_amdgcn_global_load_lds((const unsigned*)((const char*)(gbase) + (voff)[_i]), (LAS unsigned*)(lds + (bufoff) + ldsw + _i * 8192), 16, 0, 0); } while (0)
#define PG8_LDA(dst, b, h) do { _Pragma("unroll") for (int m = 0; m < 4; ++m) _Pragma("unroll") for (int k = 0; k < 2; ++k) dst[m][k] = *(const LAS bf16x8*)(lds + PG8_SA(b, h) + aoff + m * 2048 + k * 1024); } while (0)
#define PG8_LDB(dst, b, h) do { _Pragma("unroll") for (int n = 0; n < 2; ++n) _Pragma("unroll") for (int k = 0; k < 2; ++k) dst[n][k] = *(const LAS bf16x8*)(lds + PG8_SB(b, h) + boff + n * 2048 + k * 1024); } while (0)
#define PG8_MMA(ai, bj, At, Bt) do { __builtin_amdgcn_s_setprio(1); _Pragma("unroll") for (int m = 0; m < 4; ++m) _Pragma("unroll") for (int n = 0; n < 2; ++n) _Pragma("unroll") for (int k = 0; k < 2; ++k) \
        acc[ai][bj][m][n] = __builtin_amdgcn_mfma_f32_16x16x32_bf16(Bt[n][k], At[m][k], acc[ai][bj][m][n], 0, 0, 0); __builtin_amdgcn_s_setprio(0); } while (0)
#define PG8_WAIT_V(n) asm volatile("s_waitcnt vmcnt(" #n ")" ::: "memory")
#define PG8_WAIT_L(n) asm volatile("s_waitcnt lgkmcnt(" #n ")" ::: "memory")
#define PG8_BAR __builtin_amdgcn_s_barrier()
#define PG8_SCHED __builtin_amdgcn_sched_barrier(0)
    Unit cur, nxt; int ui = 0;
    if (!S.next(0, cur)) return;
    f32x4 acc[2][2][4][2];
#pragma unroll
    for (int a = 0; a < 2; ++a)
#pragma unroll
        for (int b = 0; b < 2; ++b)
#pragma unroll
            for (int m = 0; m < 4; ++m)
#pragma unroll
                for (int n = 0; n < 2; ++n) acc[a][b][m][n] = (f32x4){0.f, 0.f, 0.f, 0.f};
    bf16x8 At[4][2], B0[2][2], B1[2][2];
    const char* cA = (const char*)g.A + (size_t)cur.pm * tstepA; const char* cB = (const char*)g.Bt + (size_t)cur.pn * tstepB;
    PG8_STAGE(PG8_SB(0, 0), cB, voffB); PG8_STAGE(PG8_SB(0, 1), cB + hstepB, voffB); PG8_STAGE(PG8_SA(0, 0), cA, voffA); PG8_STAGE(PG8_SA(0, 1), cA + hstepA, voffA);
    if (wr == 1) PG8_BAR;
    PG8_WAIT_V(2); PG8_BAR;
    PG8_STAGE(PG8_SB(1, 0), cB + kstepB, voffB); PG8_STAGE(PG8_SA(1, 0), cA + kstepA, voffA); PG8_STAGE(PG8_SB(1, 1), cB + hstepB + kstepB, voffB);
    PG8_WAIT_V(6); PG8_BAR;
    for (;;) {
        const bool has_next = S.next(ui + 1, nxt);
        const char* nA = has_next ? (const char*)g.A + (size_t)nxt.pm * tstepA : cA; const char* nB = has_next ? (const char*)g.Bt + (size_t)nxt.pn * tstepB : cB;
        for (int t = 0; t < nt; t += 2) {
            if constexpr (MID) { if (t == g.mid_t) E.mid(acc, cur, wr, wc, fr, fq); }
            const bool last = (t == nt - 2);
            const char* a1 = cA + (size_t)(t + 1) * kstepA;
            const char* a2 = last ? nA : cA + (size_t)(t + 2) * kstepA; const char* b2 = last ? nB : cB + (size_t)(t + 2) * kstepB;
            const char* a3 = a2 + kstepA; const char* b3 = b2 + kstepB;
            PG8_LDB(B0, 0, 0); PG8_LDB(B1, 0, 1); PG8_SCHED; PG8_LDA(At, 0, 0); PG8_STAGE(PG8_SA(1, 1), a1 + hstepA, voffA);
            PG8_WAIT_V(8); PG8_WAIT_L(0); PG8_BAR; PG8_MMA(0, 0, At, B0); PG8_MMA(0, 1, At, B1); PG8_BAR; PG8_SCHED;
            PG8_LDA(At, 0, 1); PG8_STAGE(PG8_SB(0, 0), b2, voffB); PG8_STAGE(PG8_SB(0, 1), b2 + hstepB, voffB); PG8_STAGE(PG8_SA(0, 0), a2, voffA);
            PG8_WAIT_V(8); PG8_WAIT_L(0); PG8_BAR; PG8_MMA(1, 0, At, B0); PG8_MMA(1, 1, At, B1); PG8_BAR; PG8_SCHED;
            PG8_LDB(B0, 1, 0); PG8_LDB(B1, 1, 1); PG8_SCHED; PG8_LDA(At, 1, 0); PG8_STAGE(PG8_SA(0, 1), a2 + hstepA, voffA);
            PG8_WAIT_V(8); PG8_WAIT_L(0); PG8_BAR; PG8_MMA(0, 0, At, B0); PG8_MMA(0, 1, At, B1); PG8_BAR; PG8_SCHED;
            PG8_LDA(At, 1, 1); PG8_STAGE(PG8_SB(1, 0), b3, voffB); PG8_STAGE(PG8_SB(1, 1), b3 + hstepB, voffB); PG8_STAGE(PG8_SA(1, 0), a3, voffA);
            PG8_WAIT_V(8); PG8_WAIT_L(0); PG8_BAR; PG8_MMA(1, 0, At, B0); PG8_MMA(1, 1, At, B1); PG8_BAR; PG8_SCHED;
        }
        if (wr == 0) PG8_BAR;
        if (g.flags & 1) {
#pragma unroll
            for (int a = 0; a < 2; ++a)
#pragma unroll
                for (int b = 0; b < 2; ++b)
#pragma unroll
                    for (int m = 0; m < 4; ++m)
#pragma unroll
                        for (int n = 0; n < 2; ++n) asm volatile("" :: "v"(acc[a][b][m][n]));
        } else E(acc, cur, wr, wc, fr, fq);
        if (!has_next) break;
#pragma unroll
        for (int a = 0; a < 2; ++a)
#pragma unroll
            for (int b = 0; b < 2; ++b)
#pragma unroll
                for (int m = 0; m < 4; ++m)
#pragma unroll
                    for (int n = 0; n < 2; ++n) acc[a][b][m][n] = (f32x4){0.f, 0.f, 0.f, 0.f};
        cur = nxt; cA = nA; cB = nB; ++ui;
        if (wr == 1) PG8_BAR;
    }
    PG8_WAIT_V(0);
    PG8_BAR;
#undef PG8_SA
#undef PG8_SB
#undef PG8_STAGE
#undef PG8_LDA
#undef PG8_LDB
#undef PG8_MMA
#undef PG8_WAIT_V
#undef PG8_WAIT_L
#undef PG8_BAR
#undef PG8_SCHED
}

__device__ __forceinline__ size_t img_off(int pm, int lrow, int col, int KT) { return (((size_t)pm * KT + (col >> 6)) * 2 + (lrow >> 7)) * (size_t)(HTB / 2) + lds_byte(lrow & 127, col & 63) / 2; }
struct EpiZ {
    static constexpr bool PERM = true;
    bf16_t *Q, *K, *V, *XR, *GY, *GA, *GR; float* kmp; const float *qw, *kw, *bg; const LAS float* rs; unsigned char* wsb; LAS float* kx;
    __device__ __forceinline__ void mid(Acc&, const Unit&, int, int, int, int) const {}
    __device__ __forceinline__ void operator()(Acc& acc, const Unit& u, int wr, int wc, int fr, int fq) const {
        const int pn = u.pn; const int row0 = u.pm * BM + wr * 64 + fr;
        const LAS float* rsu = rs + u.idx * BM + wr * 64 + fr;
        if (pn < 4) {
            const bool isq = pn < 2; const int head = (pn & 1) * 4 + wc; const float* nw = isq ? qw : kw; const float osc = isq ? C2 : 1.0f;
            bf16_t* base = (isq ? Q : K) + head * HD + 8 * fq;
            f32x4 wv[2][2];
#pragma unroll
            for (int bj = 0; bj < 2; ++bj)
#pragma unroll
                for (int n = 0; n < 2; ++n) wv[bj][n] = *(const f32x4*)(nw + 32 * bj + 8 * fq + 4 * n) * osc;
            f32x4 cs[2][2];
#pragma unroll
            for (int bj = 0; bj < 2; ++bj)
#pragma unroll
                for (int n = 0; n < 2; ++n) cs[bj][n] = (f32x4){0.f, 0.f, 0.f, 0.f};
#pragma unroll
            for (int ai = 0; ai < 2; ++ai)
#pragma unroll
                for (int m = 0; m < 4; ++m) {
                    float ss = 0.f;
#pragma unroll
                    for (int bj = 0; bj < 2; ++bj)
#pragma unroll
                        for (int n = 0; n < 2; ++n) { const f32x4 v = acc[ai][bj][m][n]; ss += (v[0] * v[0] + v[1] * v[1]) + (v[2] * v[2] + v[3] * v[3]); }
                    ss += __shfl_xor(ss, 16); ss += __shfl_xor(ss, 32);
                    const float r1 = rsu[ai * HALF + m * 16];
                    const float rstd = r1 / sqrtf(ss * (r1 * r1) * (1.0f / 64.0f) + EPS);
                    bf16_t* rowp = base + (size_t)(row0 + ai * HALF + m * 16) * DA;
#pragma unroll
                    for (int bj = 0; bj < 2; ++bj) {
                        const f32x4 v0 = acc[ai][bj][m][0] * rstd * wv[bj][0], v1 = acc[ai][bj][m][1] * rstd * wv[bj][1];
                        cs[bj][0] += v0; cs[bj][1] += v1;
                        u32x4 w; w.x = cvt_pk_bf16(v0[0], v0[1]); w.y = cvt_pk_bf16(v0[2], v0[3]); w.z = cvt_pk_bf16(v1[0], v1[1]); w.w = cvt_pk_bf16(v1[2], v1[3]);
                        *(u32x4*)(rowp + 32 * bj) = w; }
                }
            if (!isq) {
#pragma unroll
                for (int bj = 0; bj < 2; ++bj)
#pragma unroll
                    for (int n = 0; n < 2; ++n)
#pragma unroll
                        for (int i = 0; i < 4; ++i) { float s = cs[bj][n][i]; s += __shfl_xor(s, 1); s += __shfl_xor(s, 2); s += __shfl_xor(s, 4); s += __shfl_xor(s, 8); cs[bj][n][i] = s; }
                if (fr == 0) { float* kp = kmp + (size_t)(u.pm * 2 + wr) * DA + head * HD + 8 * fq;
#pragma unroll
                    for (int bj = 0; bj < 2; ++bj) { *(f32x4*)(kp + 32 * bj) = cs[bj][0]; *(f32x4*)(kp + 32 * bj + 4) = cs[bj][1]; } }
                if (fr == 0) { LAS float* kl = kx + wr * 256 + wc * 64 + 8 * fq;
#pragma unroll
                    for (int bj = 0; bj < 2; ++bj) { *(LAS f32x4*)(kl + 32 * bj) = cs[bj][0]; *(LAS f32x4*)(kl + 32 * bj + 4) = cs[bj][1]; } }
                asm volatile("s_waitcnt lgkmcnt(0)" ::: "memory"); __builtin_amdgcn_s_barrier(); asm volatile("" ::: "memory");
                if (wr == 0) { const int d = fr + 16 * fq; const float mean = (kx[wc * 64 + d] + kx[256 + wc * 64 + d]) * (1.0f / 256.0f);
                    const unsigned hb = f2bf(mean), lb = f2bf(mean - __uint_as_float(hb << 16));
                    const size_t o = ((size_t)((u.pm >> 4) * NH + head) * NKB + (u.pm & 15)) * HD + d;
                    ((bf16_t*)(wsb + WS_KMH))[o] = (bf16_t)hb; ((bf16_t*)(wsb + WS_KML))[o] = (bf16_t)lb; }
            }
            return;
        }
        if (pn >= 14) {
            const int ch0 = (pn - 14) * 128 + wc * 32 + 8 * fq;
            const f32x4 ba0 = *(const f32x4*)(bg + ch0), ba1 = *(const f32x4*)(bg + ch0 + 4), br0 = *(const f32x4*)(bg + DM + ch0), br1 = *(const f32x4*)(bg + DM + ch0 + 4);
#pragma unroll
            for (int ai = 0; ai < 2; ++ai)
#pragma unroll
                for (int m = 0; m < 4; ++m) { const float r1 = rsu[ai * HALF + m * 16]; const size_t off = (size_t)(row0 + ai * HALF + m * 16) * DM + ch0;
                    unsigned r0_, r1_, r2_, r3_, g0_, g1_, g2_, g3_;
                    { const f32x4 a = acc[ai][0][m][0] * r1 + ba0, g = acc[ai][1][m][0] * r1 + br0;
                      const float ea0 = 1.0f + __builtin_amdgcn_exp2f(-LOG2E * a[0]), er0 = 1.0f + __builtin_amdgcn_exp2f(-LOG2E * g[0]), ea1 = 1.0f + __builtin_amdgcn_exp2f(-LOG2E * a[1]), er1 = 1.0f + __builtin_amdgcn_exp2f(-LOG2E * g[1]);
                      const float ea2 = 1.0f + __builtin_amdgcn_exp2f(-LOG2E * a[2]), er2 = 1.0f + __builtin_amdgcn_exp2f(-LOG2E * g[2]), ea3 = 1.0f + __builtin_amdgcn_exp2f(-LOG2E * a[3]), er3 = 1.0f + __builtin_amdgcn_exp2f(-LOG2E * g[3]);
                      r0_ = cvt_pk_bf16(er0 * __builtin_amdgcn_rcpf(ea0), er1 * __builtin_amdgcn_rcpf(ea1)); r1_ = cvt_pk_bf16(er2 * __builtin_amdgcn_rcpf(ea2), er3 * __builtin_amdgcn_rcpf(ea3));
                      g0_ = cvt_pk_bf16(__builtin_amdgcn_rcpf(er0), __builtin_amdgcn_rcpf(er1)); g1_ = cvt_pk_bf16(__builtin_amdgcn_rcpf(er2), __builtin_amdgcn_rcpf(er3)); }
                    { const f32x4 a = acc[ai][0][m][1] * r1 + ba1, g = acc[ai][1][m][1] * r1 + br1;
                      const float ea0 = 1.0f + __builtin_amdgcn_exp2f(-LOG2E * a[0]), er0 = 1.0f + __builtin_amdgcn_exp2f(-LOG2E * g[0]), ea1 = 1.0f + __builtin_amdgcn_exp2f(-LOG2E * a[1]), er1 = 1.0f + __builtin_amdgcn_exp2f(-LOG2E * g[1]);
                      const float ea2 = 1.0f + __builtin_amdgcn_exp2f(-LOG2E * a[2]), er2 = 1.0f + __builtin_amdgcn_exp2f(-LOG2E * g[2]), ea3 = 1.0f + __builtin_amdgcn_exp2f(-LOG2E * a[3]), er3 = 1.0f + __builtin_amdgcn_exp2f(-LOG2E * g[3]);
                      r2_ = cvt_pk_bf16(er0 * __builtin_amdgcn_rcpf(ea0), er1 * __builtin_amdgcn_rcpf(ea1)); r3_ = cvt_pk_bf16(er2 * __builtin_amdgcn_rcpf(ea2), er3 * __builtin_amdgcn_rcpf(ea3));
                      g2_ = cvt_pk_bf16(__builtin_amdgcn_rcpf(er0), __builtin_amdgcn_rcpf(er1)); g3_ = cvt_pk_bf16(__builtin_amdgcn_rcpf(er2), __builtin_amdgcn_rcpf(er3)); }
                    const u32x4 wr_ = {r0_, r1_, r2_, r3_}, wg_ = {g0_, g1_, g2_, g3_};
                    *(u32x4*)(GA + off) = wr_; *(u32x4*)(GR + off) = wg_;
                    asm volatile("" ::: "memory"); }
            return;
        }
        int mode, ldc, colt; bf16_t* base; const float* bias = nullptr;
        { const size_t boff = (pn < 6) ? WS_V : (pn < 10) ? WS_XR : WS_GY; base = (bf16_t*)(wsb + boff); ldc = (pn < 6) ? DA : DR; colt = (pn - ((pn < 6) ? 4 : (pn < 10) ? 6 : 10)) * BM; mode = (pn < 10) ? 0 : 1; }
        const int col0 = colt + wc * 32 + 8 * fq;
        f32x4 bv[2][2];
#pragma unroll
        for (int bj = 0; bj < 2; ++bj)
#pragma unroll
            for (int n = 0; n < 2; ++n) bv[bj][n] = bias ? *(const f32x4*)(bias + col0 + bj * HALF + 4 * n) : (f32x4){0.f, 0.f, 0.f, 0.f};
#pragma unroll
        for (int ai = 0; ai < 2; ++ai)
#pragma unroll
            for (int m = 0; m < 4; ++m) { bf16_t* rowp = base + (size_t)(row0 + ai * HALF + m * 16) * ldc + col0;
#pragma unroll
                for (int bj = 0; bj < 2; ++bj) { const float r1 = rsu[ai * HALF + m * 16]; f32x4 v0 = acc[ai][bj][m][0] * r1 + bv[bj][0], v1 = acc[ai][bj][m][1] * r1 + bv[bj][1];
                    if (mode == 1) {
#pragma unroll
                        for (int i = 0; i < 4; ++i) { v0[i] = gelu_tanh(v0[i]); v1[i] = gelu_tanh(v1[i]); } }
                    else if (mode == 2) {
#pragma unroll
                        for (int i = 0; i < 4; ++i) { v0[i] = fast_sigmoid(v0[i]); v1[i] = fast_sigmoid(v1[i]); } }
                    u32x4 w; w.x = cvt_pk_bf16(v0[0], v0[1]); w.y = cvt_pk_bf16(v0[2], v0[3]); w.z = cvt_pk_bf16(v1[0], v1[1]); w.w = cvt_pk_bf16(v1[2], v1[3]);
                    *(u32x4*)(rowp + bj * HALF) = w; } }
    }
};

struct EpiMerge {
    static constexpr bool PERM = true;
    const bf16_t *GA, *GR; bf16_t* O;
    __device__ __forceinline__ void mid(Acc& acc, const Unit& u, int wr, int wc, int fr, int fq) const {
        int row0 = u.pm * BM + wr * 64 + fr, col0 = u.pn * BM + wc * 32 + 8 * fq;
        asm volatile("" : "+v"(row0), "+v"(col0));
#pragma unroll
        for (int ai = 0; ai < 2; ++ai)
#pragma unroll
            for (int m = 0; m < 4; ++m) { const size_t off = (size_t)(row0 + ai * HALF + m * 16) * DM + col0;
#pragma unroll
                for (int bj = 0; bj < 2; ++bj) { const u32x4 a = *(const u32x4*)(GA + off + bj * HALF);
#pragma unroll
                    for (int j = 0; j < 4; ++j) { const unsigned aw = a[j];
                        acc[ai][bj][m][j >> 1][(j & 1) * 2] *= __uint_as_float(aw << 16); acc[ai][bj][m][j >> 1][(j & 1) * 2 + 1] *= __uint_as_float(aw & 0xffff0000u); } }
                if (m & 1) asm volatile("" ::: "memory"); }
    }
    __device__ __forceinline__ void operator()(Acc& acc, const Unit& u, int wr, int wc, int fr, int fq) const {
        const int row0 = u.pm * BM + wr * 64 + fr, col0 = u.pn * BM + wc * 32 + 8 * fq;
#pragma unroll
        for (int ai = 0; ai < 2; ++ai)
#pragma unroll
            for (int m = 0; m < 4; ++m) { const size_t off = (size_t)(row0 + ai * HALF + m * 16) * DM + col0;
#pragma unroll
                for (int bj = 0; bj < 2; ++bj) { const u32x4 r = *(const u32x4*)(GR + off + bj * HALF); u32x4 w;
#pragma unroll
                    for (int j = 0; j < 4; ++j) { const unsigned rw = r[j];
                        const float v0 = acc[ai][bj][m][j >> 1][(j & 1) * 2] * __uint_as_float(rw << 16), v1 = acc[ai][bj][m][j >> 1][(j & 1) * 2 + 1] * __uint_as_float(rw & 0xffff0000u);
                        w[j] = cvt_pk_bf16(v0, v1); }
                    *(u32x4*)(O + img_off(u.pm, wr * 64 + ai * HALF + m * 16 + fr, u.pn * BM + bj * HALF + wc * 32 + 8 * fq, DM / 64)) = w; }
                if (m & 1) asm volatile("" ::: "memory"); }
    }
};

struct EpiX1 {
    static constexpr bool PERM = true;
    const bf16_t* XB; bf16_t* XN2; float* ssq;
    __device__ __forceinline__ void mid(Acc&, const Unit&, int, int, int, int) const {}
    __device__ __forceinline__ void operator()(Acc& acc, const Unit& u, int wr, int wc, int fr, int fq) const {
        const int row0 = u.pm * BM + wr * 64 + fr, col0 = u.pn * BM + wc * 32 + 8 * fq;
#pragma unroll
        for (int ai = 0; ai < 2; ++ai)
#pragma unroll
            for (int m = 0; m < 4; ++m) { const int row = row0 + ai * HALF + m * 16; const size_t off = (size_t)row * DM + col0; float ss = 0.f;
#pragma unroll
                for (int bj = 0; bj < 2; ++bj) { const u32x4 xw = *(const u32x4*)(XB + off + bj * HALF);
                    const f32x4 x0 = {__uint_as_float(xw.x << 16), __uint_as_float(xw.x & 0xffff0000u), __uint_as_float(xw.y << 16), __uint_as_float(xw.y & 0xffff0000u)};
                    const f32x4 x1 = {__uint_as_float(xw.z << 16), __uint_as_float(xw.z & 0xffff0000u), __uint_as_float(xw.w << 16), __uint_as_float(xw.w & 0xffff0000u)};
                    const f32x4 v0 = acc[ai][bj][m][0] + x0, v1 = acc[ai][bj][m][1] + x1;
                    u32x4 w; w.x = cvt_pk_bf16(v0[0], v0[1]); w.y = cvt_pk_bf16(v0[2], v0[3]); w.z = cvt_pk_bf16(v1[0], v1[1]); w.w = cvt_pk_bf16(v1[2], v1[3]);
                    *(u32x4*)(XN2 + img_off(u.pm, wr * 64 + ai * HALF + m * 16 + fr, u.pn * BM + bj * HALF + wc * 32 + 8 * fq, DM / 64)) = w;
                    ss += ((v0[0] * v0[0] + v0[1] * v0[1]) + (v0[2] * v0[2] + v0[3] * v0[3])) + ((v1[0] * v1[0] + v1[1] * v1[1]) + (v1[2] * v1[2] + v1[3] * v1[3])); }
                ss += __shfl_xor(ss, 16); ss += __shfl_xor(ss, 32);
                if (fq == 0) ssq[(size_t)row * 16 + u.pn * 4 + wc] = ss;
                if (m & 1) asm volatile("" ::: "memory"); }
    }
};

struct EpiH {
    static constexpr bool PERM = true;
    const LAS float* rs; bf16_t* H;
    __device__ __forceinline__ void mid(Acc&, const Unit&, int, int, int, int) const {}
    __device__ __forceinline__ void operator()(Acc& acc, const Unit& u, int wr, int wc, int fr, int fq) const {
        const int lrow0 = wr * 64 + fr;
        const LAS float* rsu = rs + u.idx * BM;
#pragma unroll
        for (int ai = 0; ai < 2; ++ai)
#pragma unroll
            for (int m = 0; m < 4; ++m) { const int lrow = lrow0 + ai * HALF + m * 16;
                const float rstd = rsu[lrow];
                bf16_t* rowp = H + (((size_t)u.pm * (DFF / 64) + u.pn * 4 + (wc >> 1)) * 2 + ai) * (HTB / 2) + lds_byte(wr * 64 + m * 16 + fr, (wc & 1) * 32 + 8 * fq) / 2;
#pragma unroll
                for (int bj = 0; bj < 2; ++bj) { f32x4 v0 = acc[ai][bj][m][0] * rstd, v1 = acc[ai][bj][m][1] * rstd;
#pragma unroll
                    for (int i = 0; i < 4; ++i) { const float a = fmaxf(v0[i], 0.f), b = fmaxf(v1[i], 0.f); v0[i] = a * a; v1[i] = b * b; }
                    u32x4 w; w.x = cvt_pk_bf16(v0[0], v0[1]); w.y = cvt_pk_bf16(v0[2], v0[3]); w.z = cvt_pk_bf16(v1[0], v1[1]); w.w = cvt_pk_bf16(v1[2], v1[3]);
                    *(u32x4*)(rowp + bj * (2 * 256 * 64)) = w; } }
    }
};

struct EpiOut {
    static constexpr bool PERM = true;
    const bf16_t* XN2; float* OUT;
    __device__ __forceinline__ void mid(Acc&, const Unit&, int, int, int, int) const {}
    __device__ __forceinline__ void operator()(Acc& acc, const Unit& u, int wr, int wc, int fr, int fq) const {
        const int row0 = u.pm * BM + wr * 64 + fr, col0 = u.pn * BM + wc * 32 + 8 * fq;
#pragma unroll
        for (int ai = 0; ai < 2; ++ai)
#pragma unroll
            for (int m = 0; m < 4; ++m) { const size_t off = (size_t)(row0 + ai * HALF + m * 16) * DM + col0;
#pragma unroll
                for (int bj = 0; bj < 2; ++bj) { const u32x4 xw = *(const u32x4*)(XN2 + img_off(u.pm, wr * 64 + ai * HALF + m * 16 + fr, u.pn * BM + bj * HALF + wc * 32 + 8 * fq, DM / 64));
                    const f32x4 x0 = {__uint_as_float(xw.x << 16), __uint_as_float(xw.x & 0xffff0000u), __uint_as_float(xw.y << 16), __uint_as_float(xw.y & 0xffff0000u)};
                    const f32x4 x1 = {__uint_as_float(xw.z << 16), __uint_as_float(xw.z & 0xffff0000u), __uint_as_float(xw.w << 16), __uint_as_float(xw.w & 0xffff0000u)};
                    *(f32x4*)(OUT + off + bj * HALF) = acc[ai][bj][m][0] + x0; *(f32x4*)(OUT + off + bj * HALF + 4) = acc[ai][bj][m][1] + x1; }
                if (m & 1) asm volatile("" ::: "memory"); }
    }
};
}

#define XB_TMO      128
#define XB_XCNT(j)  (256  + 64 * (j))
#define XB_XSUB(j)  (1280 + 64 * (j))
#define XB_XGEN(j)  (2304 + 64 * (j))
#define XB_TOP      3328
#define XB_TOPGEN   3392
#define XCD_BAR_WORDS 3456
#define XB_SPIN_CAP (1u << 18)
__device__ __forceinline__ unsigned xb_ld(unsigned* p)              { return __hip_atomic_load(p, __ATOMIC_RELAXED, __HIP_MEMORY_SCOPE_AGENT); }
__device__ __forceinline__ unsigned xb_add(unsigned* p, unsigned v) { return __hip_atomic_fetch_add(p, v, __ATOMIC_RELAXED, __HIP_MEMORY_SCOPE_AGENT); }
__device__ __forceinline__ unsigned xb_xcc_id() { return (unsigned)__builtin_amdgcn_s_getreg((3 << 11) | 20) & 0xFu; }
#define XB_SPIN(cond, bar) do { unsigned _sp = 0; while (cond) { __builtin_amdgcn_s_sleep(1); \
    if ((++_sp & 255u) == 0u) { if (xb_ld(&(bar)[XB_TMO])) break; if (_sp > XB_SPIN_CAP) { atomicAdd(&(bar)[XB_TMO], 1u); break; } } } } while (0)
struct XcdBarrier { unsigned* bar; unsigned x; volatile LAS unsigned* st; };
__device__ __forceinline__ XcdBarrier xcd_barrier_post(unsigned* bar, volatile LAS unsigned* st) {
    XcdBarrier b; b.bar = bar; b.x = xb_xcc_id(); b.st = st;
    if (threadIdx.x == 0) (void)xb_add(&bar[XB_XCNT(b.x)], 1u);
    return b;
}
__device__ __forceinline__ void xcd_barrier_complete(unsigned* bar, unsigned x, unsigned& nloc, unsigned& nx) {
    const unsigned G = gridDim.x * gridDim.y * gridDim.z;
    unsigned sum, cnt, mine, sp = 0u;
    for (;;) {
        sum = 0u; cnt = 0u; mine = 0u;
#pragma unroll
        for (unsigned j = 0; j < 16; ++j) { const unsigned c = xb_ld(&bar[XB_XCNT(j)]); sum += c; cnt += (c > 0u) ? 1u : 0u; mine = (j == x) ? c : mine; }
        if (sum == G) break;
        __builtin_amdgcn_s_sleep(1);
        if ((++sp & 255u) == 0u) { if (xb_ld(&bar[XB_TMO])) break; if (sp > XB_SPIN_CAP) { atomicAdd(&bar[XB_TMO], 1u); break; } }
    }
    nloc = mine > 0u ? mine : 1u; nx = cnt > 0u ? cnt : 1u;
}
__device__ __forceinline__ void xcd_barrier(const XcdBarrier& b) {
    asm volatile("s_waitcnt vmcnt(0)" ::: "memory");
    __syncthreads();
    if (threadIdx.x == 0) {
        unsigned* bar = b.bar;
        __builtin_amdgcn_s_waitcnt(0);
        unsigned nloc = b.st[0], nx = b.st[1];
        if (nloc == 0u) { xcd_barrier_complete(bar, b.x, nloc, nx); b.st[0] = nloc; b.st[1] = nx; }
        const unsigned old = xb_add(&bar[XB_XSUB(b.x)], 1u);
        const unsigned gen = old / nloc;
        if (old + 1u == (gen + 1u) * nloc) {
            __builtin_amdgcn_fence(__ATOMIC_RELEASE, "agent");
            asm volatile("s_waitcnt vmcnt(0)" ::: "memory");
            const unsigned og = xb_add(&bar[XB_TOP], 1u);
            const unsigned tg = og / nx;
            if (og + 1u == (tg + 1u) * nx) xb_add(&bar[XB_TOPGEN], 1u);
            else XB_SPIN(xb_ld(&bar[XB_TOPGEN]) == tg, bar);
            __builtin_amdgcn_fence(__ATOMIC_ACQUIRE, "agent");
            xb_add(&bar[XB_XGEN(b.x)], 1u);
            asm volatile("s_waitcnt vmcnt(0)" ::: "memory");
        } else {
            XB_SPIN(xb_ld(&bar[XB_XGEN(b.x)]) == gen, bar);
            __builtin_amdgcn_fence(__ATOMIC_ACQUIRE, "agent");
            asm volatile("s_waitcnt vmcnt(0)" ::: "memory");
        }
    }
    __syncthreads();
}

constexpr int RING_OFF = 0, RING_BYTES = 131072;
constexpr int LDSCTL_OFF = RING_BYTES, MISC_OFF = LDSCTL_OFF + 320;
constexpr int LDS_BYTES = 147456;
constexpr int NWAVES = 8;

struct Args { const float* in[20]; float* out; unsigned char* ws; int ph_lo, ph_hi, flags, pad; };

template <int RMAP>
__device__ __forceinline__ int p0_rowmap(int n) {
    if (RMAP == 1) { if (n < 1024) { const int pn = n >> 8, lc = n & 255, hh = lc >> 6, d = lc & 63; return pn * 256 + 128 * (d >> 5) + 32 * hh + (d & 31); }
        if (n >= 3584) { const int isr = n >= 4608, c = n - (isr ? 4608 : 3584); return 256 * (14 + (c >> 7)) + 128 * isr + (c & 127); }
        return n; }
    return n;
}
template <int RMAP>
__device__ __forceinline__ void p0_transpose_item(const float* W, int N, bf16_t* WT, int ldt, int koff, const float* kscale, LAS float* scr, int item, int lane) {
    const int nblk = N / 32, kb = item / nblk, nb = item % nblk, k0 = 64 * kb, n0 = 32 * nb;
    float wv_[32];
#pragma unroll
    for (int i = 0; i < 32; ++i) { const int kk = 2 * i + (lane >> 5); wv_[i] = W[(size_t)(k0 + kk) * N + n0 + (lane & 31)]; }
    if (kscale) {
#pragma unroll
        for (int i = 0; i < 32; ++i) wv_[i] *= kscale[k0 + 2 * i + (lane >> 5)]; }
#pragma unroll
    for (int i = 0; i < 32; ++i) scr[(2 * i + (lane >> 5)) * 33 + (lane & 31)] = wv_[i];
    asm volatile("s_waitcnt lgkmcnt(0)" ::: "memory");
    const int c = lane & 7;
#pragma unroll
    for (int j = 0; j < 4; ++j) { const int n = (lane >> 3) + 8 * j; const LAS float* s = scr + (8 * c) * 33 + n;
        u32x4 o; o.x = pk2(s[0 * 33], s[1 * 33]); o.y = pk2(s[2 * 33], s[3 * 33]); o.z = pk2(s[4 * 33], s[5 * 33]); o.w = pk2(s[6 * 33], s[7 * 33]);
        *(u32x4*)(WT + (size_t)p0_rowmap<RMAP>(n0 + n) * ldt + koff + k0 + 8 * c) = o; }
    asm volatile("s_waitcnt lgkmcnt(0)" ::: "memory");
}
__device__ __forceinline__ void rms_row_to_bf16(const f32x4 (&v)[4], float* rstd_out, bf16_t* orow, int lane) {
    float s = 0.f;
#pragma unroll
    for (int j = 0; j < 4; ++j) s += (v[j].x * v[j].x + v[j].y * v[j].y) + (v[j].z * v[j].z + v[j].w * v[j].w);
    const float rstd = 1.f / sqrtf(wave_sum(s) * (1.f / DM) + EPS);
    if (lane == 0) *rstd_out = rstd;
    unsigned p[4][2];
#pragma unroll
    for (int j = 0; j < 4; ++j) { p[j][0] = pk2(v[j].x, v[j].y); p[j][1] = pk2(v[j].z, v[j].w); }
    const bool odd = lane & 1;
#pragma unroll
    for (int h = 0; h < 2; ++h) {
        const unsigned s0 = odd ? p[2 * h][0] : p[2 * h + 1][0], s1 = odd ? p[2 * h][1] : p[2 * h + 1][1];
        const unsigned r0 = __shfl_xor(s0, 1), r1 = __shfl_xor(s1, 1);
        u32x4 o; if (odd) { o.x = r0; o.y = r1; o.z = p[2 * h + 1][0]; o.w = p[2 * h + 1][1]; } else { o.x = p[2 * h][0]; o.y = p[2 * h][1]; o.z = r0; o.w = r1; }
        *(u32x4*)(orow + 256 * (2 * h + (odd ? 1 : 0)) + 8 * (lane >> 1)) = o; }
}

namespace attn_body {
using bf16=__hip_bfloat16;
using s16x4=__attribute__((ext_vector_type(4)))short;
using f32x16=__attribute__((ext_vector_type(16)))float;
constexpr int D=64,PQ=::DA,PO=::OC;
constexpr int NW=8,QBLK=32,QB=QBLK*NW,KVBLK=64,NQB=::SEQ/QB;
constexpr int TAB_N=384, LDS_TAB=86016;
__device__ __forceinline__ int crow(int r,int hi){return (r&3)+8*(r>>2)+4*hi;}
#define SBAR() __builtin_amdgcn_sched_barrier(0)
__device__ __forceinline__ void bmask(f32x16&p0,f32x16&p1,int jb,int qrel,int hi,const __attribute__((address_space(3))) float*tab){
  const int base=qrel-64*jb-4*hi+255;
  #pragma unroll
  for(int r=0;r<16;++r){const int i0=base-((r&3)+8*(r>>2)); const int j0=i0<368?i0:368; const int i1=i0-32; const int j1=i1<368?i1:368; p0[r]+=tab[j0]; p1[r]+=tab[j1];}
}

constexpr int NSLOT=3, SLOTB=8192;
constexpr int LDS_K=0, LDS_V=NSLOT*SLOTB, LDS_WS=2*NSLOT*SLOTB, LDS_OST=LDS_WS+NW*64*4, LDS_BYTES=LDS_OST+NW*4096;
__device__ __forceinline__ void glds16(const void*gsrc,unsigned lds_dst){unsigned keep;
  asm volatile("s_mov_b32 %0, m0\n\ts_mov_b32 m0, %2\n\ts_nop 0\n\tglobal_load_lds_dwordx4 %1, off\n\ts_mov_b32 m0, %0":"=&s"(keep):"v"(gsrc),"s"(lds_dst):"memory");}
__device__ __forceinline__ float max3f(float a,float b,float c){float r;asm("v_max3_f32 %0, %1, %2, %3":"=v"(r):"v"(a),"v"(b),"v"(c));return r;}
__device__ __forceinline__ float max2f(float a,float b){float r;asm("v_max_f32_e32 %0, %1, %2":"=v"(r):"v"(a),"v"(b));return r;}
__device__ __forceinline__ float fadd_s(float a,float b){float r;asm("v_add_f32_e32 %0, %1, %2":"=v"(r):"v"(a),"v"(b));return r;}
__device__ __forceinline__ float fsub_s(float a,float b){float r;asm("v_sub_f32_e32 %0, %1, %2":"=v"(r):"v"(a),"v"(b));return r;}
typedef float f32x2_t __attribute__((ext_vector_type(2))); typedef __bf16 bf16x2_t __attribute__((ext_vector_type(2)));
__device__ __forceinline__ unsigned cvtpk_s(float lo,float hi){f32x2_t v={lo,hi};bf16x2_t b=__builtin_convertvector(v,bf16x2_t);return __builtin_bit_cast(unsigned,b);}
#define WAIT_BAR(N) asm volatile("s_waitcnt vmcnt(" #N ") lgkmcnt(0)\n\ts_barrier":::"memory")

__device__ __forceinline__ void qkt(f32x16&p0,f32x16&p1,const char*Kslot,const bf16x8*qr,const f32x16&negm,int r32,int hi){
  const char*kb=Kslot+hi*1024+r32*16;
  #pragma unroll
  for(int d0=0;d0<4;++d0){
    const bf16x8 b0=*reinterpret_cast<const bf16x8*>(kb+d0*2048);
    const bf16x8 b1=*reinterpret_cast<const bf16x8*>(kb+d0*2048+512);
    if(d0==0){p0=__builtin_amdgcn_mfma_f32_32x32x16_bf16(b0,qr[0],negm,0,0,0);p1=__builtin_amdgcn_mfma_f32_32x32x16_bf16(b1,qr[0],negm,0,0,0);}
    else{p0=__builtin_amdgcn_mfma_f32_32x32x16_bf16(b0,qr[d0],p0,0,0,0);p1=__builtin_amdgcn_mfma_f32_32x32x16_bf16(b1,qr[d0],p1,0,0,0);}}
}
typedef __attribute__((address_space(3))) const char* lds_cptr;
typedef short v4i16_t __attribute__((ext_vector_type(4)));
__device__ __forceinline__ void kload8(bf16x8*kf,lds_cptr kp){
  kf[0]=*(const __attribute__((address_space(3))) bf16x8*)(kp);      kf[1]=*(const __attribute__((address_space(3))) bf16x8*)(kp+512);
  kf[2]=*(const __attribute__((address_space(3))) bf16x8*)(kp+2048); kf[3]=*(const __attribute__((address_space(3))) bf16x8*)(kp+2560);
  kf[4]=*(const __attribute__((address_space(3))) bf16x8*)(kp+4096); kf[5]=*(const __attribute__((address_space(3))) bf16x8*)(kp+4608);
  kf[6]=*(const __attribute__((address_space(3))) bf16x8*)(kp+6144); kf[7]=*(const __attribute__((address_space(3))) bf16x8*)(kp+6656);
}
__device__ __forceinline__ void kload2(bf16x8*kf,lds_cptr kp,int j){ kf[2*j]=*(const __attribute__((address_space(3))) bf16x8*)(kp+j*2048); kf[2*j+1]=*(const __attribute__((address_space(3))) bf16x8*)(kp+j*2048+512); }
__device__ __forceinline__ s16x4 vtr(lds_cptr p){ return __builtin_bit_cast(s16x4,__builtin_amdgcn_ds_read_tr16_b64_v4i16((__attribute__((address_space(3))) v4i16_t*)p)); }
__device__ __forceinline__ float rowmax(const f32x16&p0,const f32x16&p1){
  float a=max3f(p0[0],p0[1],p1[0]),b=max3f(p0[2],p0[3],p1[1]);a=max3f(a,p1[2],p1[3]);
  #pragma unroll
  for(int r=4;r<16;r+=4){a=max3f(a,p0[r],p0[r+1]);b=max3f(b,p0[r+2],p0[r+3]);a=max3f(a,p1[r],p1[r+1]);b=max3f(b,p1[r+2],p1[r+3]);}
  const float m=max2f(a,b);
  auto rr=__builtin_amdgcn_permlane32_swap(__float_as_uint(m),__float_as_uint(m),false,false);
  return max2f(__uint_as_float(rr[0]),__uint_as_float(rr[1]));
}
__device__ __forceinline__ void pv(f32x16*o,int vb,bf16x8 pa0,bf16x8 pa1,bf16x8 pa2,bf16x8 pa3){
  #pragma unroll
  for(int d0=0;d0<2;++d0){s16x4 lo[4],hi[4];
    #pragma unroll
    for(int ks=0;ks<4;++ks){
      asm volatile("ds_read_b64_tr_b16 %0,%1 offset:%c2":"=&v"(lo[ks]):"v"(vb),"i"(d0*4096+ks*1024):"memory");
      asm volatile("ds_read_b64_tr_b16 %0,%1 offset:%c2":"=&v"(hi[ks]):"v"(vb),"i"(d0*4096+ks*1024+512):"memory");}
    asm volatile("s_waitcnt lgkmcnt(0)":::"memory");SBAR();
    #define PK(k) (bf16x8){lo[k][0],lo[k][1],lo[k][2],lo[k][3],hi[k][0],hi[k][1],hi[k][2],hi[k][3]}
    o[d0]=__builtin_amdgcn_mfma_f32_32x32x16_bf16(pa0,PK(0),o[d0],0,0,0);
    o[d0]=__builtin_amdgcn_mfma_f32_32x32x16_bf16(pa1,PK(1),o[d0],0,0,0);
    o[d0]=__builtin_amdgcn_mfma_f32_32x32x16_bf16(pa2,PK(2),o[d0],0,0,0);
    o[d0]=__builtin_amdgcn_mfma_f32_32x32x16_bf16(pa3,PK(3),o[d0],0,0,0);
    #undef PK
  }
}

#ifndef ATTN_STORE16
#define ATTN_STORE16(p,v) (*(u32x4*)(p)=(v))
#endif
template<int THRL> __device__ __forceinline__ void attn_unit(int b,int h,int qb,const bf16*Q,const bf16*__restrict__ K,const bf16*__restrict__ V,const unsigned short*__restrict__ kmh,const unsigned short*__restrict__ kml,bf16*O,char*shm){
  const int tid=threadIdx.x,lane=tid&63,r32=lane&31,hi=lane>>5; const int wid=__builtin_amdgcn_readfirstlane(tid>>6);
  const long rowbase=(long)b*::SEQ; const int q0=qb*QB;
  const bf16*Qw=Q+(rowbase+q0+wid*QBLK)*PQ+h*D;
  const bf16*Kh=K+rowbase*PQ+h*D,*Vh=V+rowbase*PQ+h*D;
  const unsigned lds0=(unsigned)(uintptr_t)shm;
  float*wsf=(float*)(shm+LDS_WS)+wid*64;
  const bf16*ksrc=Kh+(long)lane*PQ+wid*8;
  const bf16*vsrc=Vh+(long)(16*(wid&3)+(lane>>2))*PQ+(wid>>2)*32+(lane&3)*8;
  const unsigned kdst=lds0+LDS_K+wid*1024, vdst=lds0+LDS_V+wid*1024;
  #define TOFF(t) ((long)(((t)<4)?(q0+KVBLK*(t)):(KVBLK*((t)-4)))*PQ)
  #define DMA_K(t,slot) glds16(ksrc+TOFF(t),(unsigned)__builtin_amdgcn_readfirstlane(kdst+(slot)))
  #define DMA_V(t,slot) glds16(vsrc+TOFF(t),(unsigned)__builtin_amdgcn_readfirstlane(vdst+(slot)))
  const int vb0=(int)(lds0+LDS_V)+((lane>>4)&1)*32+(lane&3)*8+(4*hi+((lane&15)>>2))*64;
  const char*Kbase=shm+LDS_K; bf16x8 kf[8];
  const lds_cptr shm3=(lds_cptr)shm; const lds_cptr kp0=shm3+LDS_K+hi*1024+r32*16; const lds_cptr vp0=shm3+LDS_V+((lane>>4)&1)*32+(lane&3)*8+(4*hi+((lane&15)>>2))*64;
  const int NT=(q0+QB)/KVBLK;
  DMA_K(0,0);DMA_V(0,0);DMA_K(1,SLOTB);
  bf16x8 qr[4];
  #pragma unroll
  for(int d0=0;d0<4;++d0)qr[d0]=*reinterpret_cast<const bf16x8*>(&Qw[(long)r32*PQ+d0*16+hi*8]);
  float mhat=0.f,l_reg=0.f;f32x16 o[2];o[0]=f32x16{};o[1]=f32x16{};f32x16 negm=f32x16{};asm volatile("":"+v"(negm));
  const int qrel=wid*QBLK+r32;
  const __attribute__((address_space(3))) float*tab=(const __attribute__((address_space(3))) float*)((lds_cptr)shm+LDS_TAB)+h*TAB_N;
  unsigned selmask=0u;
  if(qb>0){
    f32x16 gacc=f32x16{};
    const size_t ko=((size_t)(b*::NH+h)*::NKB+(r32&15))*D+hi*8;
    #pragma unroll
    for(int d0=0;d0<4;++d0){ const bf16x8 ah=*(const bf16x8*)(kmh+ko+d0*16), al=*(const bf16x8*)(kml+ko+d0*16);
      gacc=__builtin_amdgcn_mfma_f32_32x32x16_bf16(ah,qr[d0],gacc,0,0,0);
      gacc=__builtin_amdgcn_mfma_f32_32x32x16_bf16(al,qr[d0],gacc,0,0,0); }
    float g[16];
    #pragma unroll
    for(int r=0;r<4;++r){ const float m0=gacc[r],o0=__shfl_xor(m0,32),m1=gacc[4+r],o1=__shfl_xor(m1,32);
      g[r]=hi?o0:m0; g[4+r]=hi?m0:o0; g[8+r]=hi?o1:m1; g[12+r]=hi?m1:o1; }
    #pragma unroll
    for(int j=0;j<16;++j) if(j>=qb) g[j]=-INFINITY;
    #pragma unroll
    for(int rd=0;rd<3;++rd){ float best=-INFINITY; int bi=-1;
      #pragma unroll
      for(int j=0;j<16;++j) if(g[j]>best){best=g[j];bi=j;}
      if(bi>=0) selmask|=1u<<bi;
      #pragma unroll
      for(int j=0;j<16;++j) if(j==bi) g[j]=-INFINITY; }
  }
  #define SELT(t) (((t)<4)||((selmask>>(((t)-4)>>2))&1u))
  #define CMASK(P0,P1,t) do{ if((t)<4){ const int rmax_=wid*32+31-64*(t), rmin_=wid*32-64*(t)-63; if(rmax_<0){ _Pragma("unroll") for(int r=0;r<16;++r){P0[r]=-INFINITY;P1[r]=-INFINITY;} } else if(rmin_<=112) bmask(P0,P1,(t),qrel,hi,tab); } \
    else if((t)>=NT-2){ const int q0_=wid*32+128-64*((t)-(NT-2)); if(q0_-63<=112) bmask(P0,P1,0,qrel+128-64*((t)-(NT-2)),hi,tab); } }while(0)
  bool resc=false;
  #define START(P0,P1) do{ const float rm=rowmax(P0,P1); resc=false; \
    { const float dl=rm; mhat=fadd_s(mhat,dl); \
      _Pragma("unroll") for(int r=0;r<16;++r){P0[r]=fsub_s(P0[r],dl);P1[r]=fsub_s(P1[r],dl);} \
      _Pragma("unroll") for(int r=0;r<16;++r)negm[r]=-mhat; asm volatile("":"+v"(negm)); } \
    _Pragma("unroll") for(int r=0;r<16;++r)P0[r]=__builtin_amdgcn_exp2f(P0[r]); }while(0)
  #define RESC() do{ if(resc){ asm volatile("s_waitcnt lgkmcnt(0)":::"memory"); \
      _Pragma("unroll") for(int d_=0;d_<2;++d_) _Pragma("unroll") for(int r=0;r<16;++r)o[d_][r]*=wsf[crow(r,hi)]; } }while(0)
  f32x16 pA0,pA1,pB0,pB1;
  int sl_prev=0,sl_cur=0,sl_next=SLOTB;
  #define ROT() do{sl_prev=sl_cur;sl_cur=sl_next;sl_next=(sl_next==(NSLOT-1)*SLOTB)?0:sl_next+SLOTB;}while(0)
  DMA_K(2,2*SLOTB);
  WAIT_BAR(3);
  qkt(pA0,pA1,Kbase,qr,negm,r32,hi);asm volatile("s_nop 15\n\ts_nop 7":"+v"(pA0),"+v"(pA1));CMASK(pA0,pA1,0);
  START(pA0,pA1);
  _Pragma("unroll") for(int r=0;r<16;++r)pA1[r]=__builtin_amdgcn_exp2f(pA1[r]);
  WAIT_BAR(0);
  DMA_K(3,0);DMA_V(1,SLOTB);
  ROT();
  kload8(kf,kp0+sl_cur);
  WAIT_BAR(2);
  s16x4 vlo[8],vhi[8]; u32x4 pw0,pw1,pw2,pw3;
  #define PKW(P,B) cvtpk_s(P[B],P[B+1])
  #define PAF(k) __builtin_bit_cast(bf16x8,pw##k)
  #define VFR(i) (bf16x8){vlo[i][0],vlo[i][1],vlo[i][2],vlo[i][3],vhi[i][0],vhi[i][1],vhi[i][2],vhi[i][3]}
  #define PIN(x) asm volatile("":"+v"(x))
  #define MX3(a,b,c) __builtin_fmaxf(__builtin_fmaxf((a),(b)),(c))
  #define GAPA(MF,A0,A1,A2,A3,W0,W1,PW) do{ MF; sacc+=A0; sacc+=A1; sacc+=A2; sacc+=A3; PIN(sacc); W0; W1; PIN(PW); SBAR(); }while(0)
  #define EX(v) __builtin_amdgcn_exp2f(v)
  #define GAPB(MF,X,B) do{ MF; X[B]=EX(X[B]); X[B+1]=EX(X[B+1]); X[B+2]=EX(X[B+2]); X[B+3]=EX(X[B+3]); PIN(X); SBAR(); }while(0)
  #define VRD(i) do{ vlo[i]=vtr(vp_+(((i)>>2)*4096+((i)&3)*1024)); vhi[i]=vtr(vp_+(((i)>>2)*4096+((i)&3)*1024+512)); }while(0)
  #define KRD(G,j) do{ if(G){ kload2(kf,kp0+sl_next,j); SBAR(); } }while(0)
  #define STEP(C0,C1,P0,P1,t,GK,GV,GL) do{ SBAR(); \
    { const float nv_=SELT(t)?-mhat:-INFINITY; _Pragma("unroll") for(int r=0;r<16;++r)negm[r]=nv_; asm volatile("":"+v"(negm)); } SBAR(); \
    const lds_cptr vp_=vp0+sl_prev; \
    VRD(0); SBAR(); float sacc=(P0[0]+P0[1]); \
    GAPA(C0=__builtin_amdgcn_mfma_f32_32x32x16_bf16(kf[0],qr[0],negm,0,0,0), P0[2],P0[3],P0[4],P0[5],     pw0[0]=PKW(P0,0), pw0[1]=PKW(P0,2), pw0); \
    VRD(4); SBAR(); GAPA(C1=__builtin_amdgcn_mfma_f32_32x32x16_bf16(kf[1],qr[0],negm,0,0,0), P0[6],P0[7],P0[8],P0[9],     pw0[2]=PKW(P0,4), pw0[3]=PKW(P0,6), pw0); \
    VRD(1); SBAR(); GAPA(C0=__builtin_amdgcn_mfma_f32_32x32x16_bf16(kf[2],qr[1],C0,0,0,0),   P0[10],P0[11],P0[12],P0[13], pw1[0]=PKW(P0,8), pw1[1]=PKW(P0,10), pw1); \
    VRD(5); SBAR(); GAPA(C1=__builtin_amdgcn_mfma_f32_32x32x16_bf16(kf[3],qr[1],C1,0,0,0),   P0[14],P0[15],P1[0],P1[1],   pw1[2]=PKW(P0,12),pw1[3]=PKW(P0,14), pw1); \
    VRD(2); SBAR(); GAPA(C0=__builtin_amdgcn_mfma_f32_32x32x16_bf16(kf[4],qr[2],C0,0,0,0),   P1[2],P1[3],P1[4],P1[5],     pw2[0]=PKW(P1,0), pw2[1]=PKW(P1,2), pw2); \
    VRD(6); SBAR(); GAPA(C1=__builtin_amdgcn_mfma_f32_32x32x16_bf16(kf[5],qr[2],C1,0,0,0),   P1[6],P1[7],P1[8],P1[9],     pw2[2]=PKW(P1,4), pw2[3]=PKW(P1,6), pw2); \
    VRD(3); SBAR(); GAPA(C0=__builtin_amdgcn_mfma_f32_32x32x16_bf16(kf[6],qr[3],C0,0,0,0),   P1[10],P1[11],P1[12],P1[13], pw3[0]=PKW(P1,8), pw3[1]=PKW(P1,10), pw3); \
    VRD(7); SBAR(); GAPA(C1=__builtin_amdgcn_mfma_f32_32x32x16_bf16(kf[7],qr[3],C1,0,0,0),   P1[14],P1[15],0.f,0.f,       pw3[2]=PKW(P1,12),pw3[3]=PKW(P1,14), pw3); \
    l_reg+=sacc; \
    if(GK){DMA_K((t)+3,sl_cur);} if(GV){DMA_V((t)+1,sl_next);} \
    if(MASKON){CMASK(C0,C1,t);} \
    { float a=MX3(C0[0],C0[1],C1[0]),b=MX3(C0[2],C0[3],C1[1]); a=MX3(a,C1[2],C1[3]); \
      _Pragma("unroll") for(int r=4;r<16;r+=4){a=MX3(a,C0[r],C0[r+1]);b=MX3(b,C0[r+2],C0[r+3]);a=MX3(a,C1[r],C1[r+1]);b=MX3(b,C1[r+2],C1[r+3]);} \
      float rm=__builtin_fmaxf(a,b); { auto rr=__builtin_amdgcn_permlane32_swap(__float_as_uint(rm),__float_as_uint(rm),false,false); rm=__builtin_fmaxf(__uint_as_float(rr[0]),__uint_as_float(rr[1])); } \
      resc=false; \
      if(__builtin_expect(__any(rm>(float)THRL),0)){ const float dl=__builtin_fmaxf(rm,0.f); mhat+=dl; \
        _Pragma("unroll") for(int r=0;r<16;++r){C0[r]-=dl;C1[r]-=dl;} \
        const float f=__builtin_amdgcn_exp2f(-dl); l_reg*=f; if(hi==0)wsf[r32]=f; resc=true; } } \
    SBAR(); \
    GAPB(o[0]=__builtin_amdgcn_mfma_f32_32x32x16_bf16(PAF(0),VFR(0),o[0],0,0,0), C0,0); \
    GAPB(o[1]=__builtin_amdgcn_mfma_f32_32x32x16_bf16(PAF(0),VFR(4),o[1],0,0,0), C0,4); \
    KRD(GL,0); GAPB(o[0]=__builtin_amdgcn_mfma_f32_32x32x16_bf16(PAF(1),VFR(1),o[0],0,0,0), C0,8); \
    KRD(GL,1); GAPB(o[1]=__builtin_amdgcn_mfma_f32_32x32x16_bf16(PAF(1),VFR(5),o[1],0,0,0), C0,12); \
    KRD(GL,2); GAPB(o[0]=__builtin_amdgcn_mfma_f32_32x32x16_bf16(PAF(2),VFR(2),o[0],0,0,0), C1,0); \
    KRD(GL,3); GAPB(o[1]=__builtin_amdgcn_mfma_f32_32x32x16_bf16(PAF(2),VFR(6),o[1],0,0,0), C1,4); \
    GAPB(o[0]=__builtin_amdgcn_mfma_f32_32x32x16_bf16(PAF(3),VFR(3),o[0],0,0,0), C1,8); \
    GAPB(o[1]=__builtin_amdgcn_mfma_f32_32x32x16_bf16(PAF(3),VFR(7),o[1],0,0,0), C1,12); \
    }while(0)
  int t=1;
  #define MASKON 1
  for(;t<4&&t+3<NT;t+=2){
    STEP(pB0,pB1,pA0,pA1,t,true,true,true);     WAIT_BAR(2); RESC(); ROT();
    STEP(pA0,pA1,pB0,pB1,t+1,true,true,true);   WAIT_BAR(2); RESC(); ROT();
  }
  #undef MASKON
  #define MASKON 0
  for(;t+3<NT;t+=2){
    STEP(pB0,pB1,pA0,pA1,t,true,true,true);     WAIT_BAR(2); RESC(); ROT();
    STEP(pA0,pA1,pB0,pB1,t+1,true,true,true);   WAIT_BAR(2); RESC(); ROT();
  }
  #undef MASKON
  #define MASKON 1
  STEP(pB0,pB1,pA0,pA1,t,false,true,true);      WAIT_BAR(1); RESC(); ROT();
  STEP(pA0,pA1,pB0,pB1,t+1,false,true,true);    WAIT_BAR(0); RESC(); ROT();
  STEP(pB0,pB1,pA0,pA1,NT-1,false,false,false); RESC();
  { float sacc=pB0[0]+pB0[1]; _Pragma("unroll") for(int r=2;r<16;++r)sacc+=pB0[r]; _Pragma("unroll") for(int r=0;r<16;++r)sacc+=pB1[r]; l_reg+=sacc;
    pw0=(u32x4){PKW(pB0,0),PKW(pB0,2),PKW(pB0,4),PKW(pB0,6)};pw1=(u32x4){PKW(pB0,8),PKW(pB0,10),PKW(pB0,12),PKW(pB0,14)};pw2=(u32x4){PKW(pB1,0),PKW(pB1,2),PKW(pB1,4),PKW(pB1,6)};pw3=(u32x4){PKW(pB1,8),PKW(pB1,10),PKW(pB1,12),PKW(pB1,14)};
    SBAR(); pv(o,vb0+sl_cur,PAF(0),PAF(1),PAF(2),PAF(3)); }
  #undef PKW
  #undef PAF
  #undef VFR
  #undef PIN
  #undef MX3
  #undef GAPA
  #undef GAPB
  #undef EX
  #undef VRD
  #undef KRD
  #undef STEP
  {auto rr=__builtin_amdgcn_permlane32_swap(__float_as_uint(l_reg),__float_as_uint(l_reg),false,false);l_reg=__uint_as_float(rr[0])+__uint_as_float(rr[1]);}
  if(hi==0)wsf[32+r32]=l_reg;asm volatile("s_waitcnt lgkmcnt(0)":::"memory");
  float rli[16];
  #pragma unroll
  for(int r=0;r<16;++r)rli[r]=__builtin_amdgcn_rcpf(wsf[32+crow(r,hi)]);
  bf16*Ow=O+(rowbase+q0+wid*QBLK)*PO+h*D;
  { bf16*stg=(bf16*)(shm+LDS_OST)+wid*2048;
    #pragma unroll
    for(int r=0;r<16;++r){const int orow=crow(r,hi);
      #pragma unroll
      for(int d0=0;d0<2;++d0)stg[orow*64+d0*32+r32]=__float2bfloat16(o[d0][r]*rli[r]);}
    asm volatile("s_waitcnt lgkmcnt(0)":::"memory");
    #pragma unroll
    for(int i=0;i<4;++i){const int row=i*8+(lane>>3),ch=lane&7; const u32x4 v=*(const u32x4*)(stg+row*64+ch*8); ATTN_STORE16(Ow+(long)row*PO+ch*8,v);} }
  asm volatile("s_waitcnt lgkmcnt(0)\n\ts_barrier":::"memory");
  #undef DMA_K
  #undef TOFF
  #undef SELT
  #undef MASKON
  #undef DMA_V
  #undef CMASK
  #undef START
  #undef RESC
  #undef ROT
}
constexpr int ATTN_LDS_BYTES=LDS_BYTES;
struct AttnTensors { const bf16* Q; const bf16* K; const bf16* V; const unsigned short* kmh; const unsigned short* kml; const float* rel_bias; bf16* O; };
struct AttnUnit { int bh; int qb; };
struct StaticOrder {
  int vcu;
  __device__ __forceinline__ explicit StaticOrder(int v):vcu(v){}
  __device__ __forceinline__ bool next(int i,AttnUnit&u)const{ if(i>=4)return false; const int s=vcu&3; u.bh=vcu>>2; u.qb=(i==0)?15-s:(i==1)?8+s:(i==2)?7-s:s; return true; }
};
template<int THRL=8> __device__ __forceinline__ void attn_phase(char*lds,const AttnTensors&T,int vcu0,int G){
  { __attribute__((address_space(3))) float*tb=(__attribute__((address_space(3))) float*)((lds_cptr)lds+LDS_TAB);
    for(int i=threadIdx.x;i<8*TAB_N;i+=NW*64){ const int hh=i/TAB_N,k=i%TAB_N,rel=k-255; float v=0.f;
      if(rel<0)v=-INFINITY; else if(rel<=112)v=(T.rel_bias[::t5_bucket(rel)*::NH+hh]-T.rel_bias[31*::NH+hh])*::LOG2E;
      tb[i]=v; }
    asm volatile("s_waitcnt lgkmcnt(0)\n\ts_barrier":::"memory"); }
  for(int v=vcu0;v<256;v+=G){ const StaticOrder S(v); AttnUnit u;
    for(int i=0;S.next(i,u);++i) attn_unit<THRL>(u.bh / ::NH, u.bh % ::NH, u.qb,T.Q,T.K,T.V,T.kmh,T.kml,T.O,lds); }
}
#undef SBAR
#undef WAIT_BAR
}

namespace rnn {
typedef float f32x16 __attribute__((ext_vector_type(16)));
constexpr int NCHK = 16, CHT = SEQ / NCHK, TILES = CHT / 32;
constexpr int LDS_BEXT = 98304, LDS_CW = LDS_BEXT + 24576, LDS_STG = 0;
__device__ __forceinline__ void fill_tables(LAS unsigned char* lds, int blk, const float* __restrict__ Wa, const float* __restrict__ Wi, const float* __restrict__ cw, const float* __restrict__ cb, int tid) {
#pragma unroll 1
    for (int it = 0; it < (24 * 64) / (NWAVES * 64); ++it) { const int e = tid + it * (NWAVES * 64);
        const int frag = e >> 6, ln = e & 63, ntile = frag >> 2, ks = frag & 3, n = ln & 31, hi = ln >> 5;
        const int col = (ntile & 1) * 32 + n, k0 = 16 * ks + 8 * hi;
        const float* W = (ntile < 2 ? Wa : Wi) + (size_t)blk * RBD * RBD + col;
        u32x4 w;
#pragma unroll
        for (int j2 = 0; j2 < 4; ++j2) { const int k = k0 + 2 * j2; float v0, v1;
            if (ntile < 4) { v0 = W[k * RBD]; v1 = W[(k + 1) * RBD]; } else { v0 = (k == col) ? 1.f : 0.f; v1 = (k + 1 == col) ? 1.f : 0.f; }
            w[j2] = pk2(v0, v1); }
        *(LAS u32x4*)(lds + LDS_BEXT + e * 16) = w;
    }
    if (tid < 5 * 64) { const int e = tid, j = e >> 6, c = e & 63; ((LAS float*)(lds + LDS_CW))[e] = (j < 4) ? cw[j * DR + blk * RBD + c] : cb[blk * RBD + c]; }
}
template <bool FINAL>
__device__ __forceinline__ void scan_chunk(LAS unsigned char* lds, int b, int blk, int chunk, int wave, int lane, const bf16_t* __restrict__ XR, const bf16_t* __restrict__ GY,
                                           const float* __restrict__ ba, const float* __restrict__ bi, const float* __restrict__ lam, float* comp, bf16_t* __restrict__ O) {
    const int r32 = lane & 31, hi = lane >> 5;
    float cba[2], cbi[2], c8[2], H[2], Ac[2];
#pragma unroll
    for (int nt = 0; nt < 2; ++nt) { const int ch = blk * RBD + 32 * nt + r32; cba[nt] = -LOG2E * ba[ch]; cbi[nt] = -LOG2E * bi[ch]; c8[nt] = -8.0f * LOG2E * log1pf(expf(-lam[ch])); H[nt] = 0.f; Ac[nt] = 1.f; }
    if (FINAL) {
        for (int k = 0; k < chunk; ++k) {
#pragma unroll
            for (int nt = 0; nt < 2; ++nt) { const f32x2 c = *(const f32x2*)(comp + (((size_t)b * NCHK + k) * DR + blk * RBD + 32 * nt + r32) * 2); H[nt] = c[0] * H[nt] + c[1]; } }
    }
    const size_t row0 = (size_t)b * SEQ + (size_t)chunk * CHT;
    const LAS f32x4* cwp = (const LAS f32x4*)(lds + LDS_CW) + 2 * hi;
    const LAS bf16x8* bfr = (const LAS bf16x8*)(lds + LDS_BEXT) + lane;
    LAS bf16_t* stg = (LAS bf16_t*)(lds + LDS_STG + wave * 4096);
    u32x4 xraw[4][4];
#define RNN_LOAD_TILE(tl) do { const int tpos_ = chunk * CHT + (tl) * 32 + r32; const bf16_t* xp_ = XR + (row0 + (tl) * 32 + r32) * DR + blk * RBD + 8 * hi; \
        _Pragma("unroll") for (int ks_ = 0; ks_ < 4; ++ks_) { xraw[ks_][3] = *(const u32x4*)(xp_ + 16 * ks_); \
            _Pragma("unroll") for (int j_ = 0; j_ < 3; ++j_) { const bool ok_ = (tpos_ + j_ - 3) >= 0; const u32x4 v_ = *(const u32x4*)(xp_ + (ok_ ? (long)(j_ - 3) * DR : 0) + 16 * ks_); xraw[ks_][j_] = ok_ ? v_ : (u32x4){0u, 0u, 0u, 0u}; } } } while (0)
    RNN_LOAD_TILE(0);
    for (int tile = 0; tile < TILES; ++tile) {
        u32x4 gyv[4];
        if (FINAL) {
#pragma unroll
            for (int i = 0; i < 4; ++i) gyv[i] = *(const u32x4*)(GY + (row0 + tile * 32 + 8 * i + (lane >> 3)) * DR + blk * RBD + (lane & 7) * 8);
        }
        bf16x8 af[4];
#pragma unroll
        for (int ks = 0; ks < 4; ++ks) {
            f32x4 alo = cwp[64 + 4 * ks], ahi = cwp[64 + 4 * ks + 1];
#pragma unroll
            for (int j = 0; j < 4; ++j) { const f32x4 wlo = cwp[16 * j + 4 * ks], whi = cwp[16 * j + 4 * ks + 1]; const u32x4 x = xraw[ks][j];
                const f32x4 xlo = {__uint_as_float(x[0] << 16), __uint_as_float(x[0] & 0xffff0000u), __uint_as_float(x[1] << 16), __uint_as_float(x[1] & 0xffff0000u)};
                const f32x4 xhi = {__uint_as_float(x[2] << 16), __uint_as_float(x[2] & 0xffff0000u), __uint_as_float(x[3] << 16), __uint_as_float(x[3] & 0xffff0000u)};
                alo += wlo * xlo; ahi += whi * xhi; }
            u32x4 pk; pk[0] = cvt_pk_bf16(alo[0], alo[1]); pk[1] = cvt_pk_bf16(alo[2], alo[3]); pk[2] = cvt_pk_bf16(ahi[0], ahi[1]); pk[3] = cvt_pk_bf16(ahi[2], ahi[3]);
            af[ks] = __builtin_bit_cast(bf16x8, pk);
        }
        if (tile + 1 < TILES) RNN_LOAD_TILE(tile + 1);
#pragma unroll
        for (int nt = 0; nt < 2; ++nt) {
            f32x16 aR = f32x16{}, aI = f32x16{}, aX = f32x16{};
#pragma unroll
            for (int ks = 0; ks < 4; ++ks) {
                aR = __builtin_amdgcn_mfma_f32_32x32x16_bf16(af[ks], bfr[64 * (4 * nt + ks)], aR, 0, 0, 0);
                aI = __builtin_amdgcn_mfma_f32_32x32x16_bf16(af[ks], bfr[64 * (4 * (2 + nt) + ks)], aI, 0, 0, 0);
                aX = __builtin_amdgcn_mfma_f32_32x32x16_bf16(af[ks], bfr[64 * (4 * (4 + nt) + ks)], aX, 0, 0, 0); }
            float av[16], uv[16];
#pragma unroll
            for (int r = 0; r < 16; ++r) {
                const float rr = __builtin_amdgcn_rcpf(1.0f + __builtin_amdgcn_exp2f(__builtin_fmaf(aR[r], -LOG2E, cba[nt]))), ii = __builtin_amdgcn_rcpf(1.0f + __builtin_amdgcn_exp2f(__builtin_fmaf(aI[r], -LOG2E, cbi[nt])));
                const float a = __builtin_amdgcn_exp2f(rr * c8[nt]); const float om = __builtin_fmaf(-a, a, 1.0f);
                av[r] = a; uv[r] = __builtin_amdgcn_sqrtf(om) * (ii * aX[r]); }
            float As[4], Bs[4], pA[4], pB[4], st[4];
#pragma unroll
            for (int g = 0; g < 4; ++g) { As[g] = (av[4 * g] * av[4 * g + 1]) * (av[4 * g + 2] * av[4 * g + 3]);
                Bs[g] = ((uv[4 * g] * av[4 * g + 1] + uv[4 * g + 1]) * av[4 * g + 2] + uv[4 * g + 2]) * av[4 * g + 3] + uv[4 * g + 3];
                pA[g] = __shfl_xor(As[g], 32); pB[g] = __shfl_xor(Bs[g], 32); }
            float Hc = H[nt];
#pragma unroll
            for (int g = 0; g < 4; ++g) { const float Ae = hi ? pA[g] : As[g], Be = hi ? pB[g] : Bs[g], Ao = hi ? As[g] : pA[g], Bo = hi ? Bs[g] : pB[g];
                const float h0 = Hc; Hc = Ae * Hc + Be; const float h1 = Hc; Hc = Ao * Hc + Bo; st[g] = hi ? h1 : h0;
                if (!FINAL) Ac[nt] *= Ae * Ao; }
            H[nt] = Hc;
            if (FINAL) {
#pragma unroll
                for (int g = 0; g < 4; ++g) { float h = st[g];
#pragma unroll
                    for (int i = 0; i < 4; ++i) { h = av[4 * g + i] * h + uv[4 * g + i]; stg[(8 * g + 4 * hi + i) * 64 + 32 * nt + r32] = (bf16_t)cvt_pk_bf16(h, h); } }
            }
        }
        if (FINAL) {
            asm volatile("s_waitcnt lgkmcnt(0)" ::: "memory");
#pragma unroll
            for (int i = 0; i < 4; ++i) { const int row = 8 * i + (lane >> 3), c8c = (lane & 7) * 8; const u32x4 hv = *(const LAS u32x4*)(stg + row * 64 + c8c); const u32x4 gv = gyv[i]; u32x4 w;
#pragma unroll
                for (int j = 0; j < 4; ++j) w[j] = cvt_pk_bf16(__uint_as_float(hv[j] << 16) * __uint_as_float(gv[j] << 16), __uint_as_float(hv[j] & 0xffff0000u) * __uint_as_float(gv[j] & 0xffff0000u));
                *(u32x4*)(O + (row0 + tile * 32 + row) * OC + DA + blk * RBD + c8c) = w; }
            asm volatile("s_waitcnt lgkmcnt(0)" ::: "memory");
        }
    }
    if (!FINAL && hi == 0) {
#pragma unroll
        for (int nt = 0; nt < 2; ++nt) *(f32x2*)(comp + (((size_t)b * NCHK + chunk) * DR + blk * RBD + 32 * nt + r32) * 2) = (f32x2){Ac[nt], H[nt]};
    }
}
template <bool FINAL>
__device__ __forceinline__ void scan_phase(LAS unsigned char* lds, int vcu, int G, int wave, int lane, int tid, const bf16_t* XR, const bf16_t* GY, const float* cw, const float* cb, const float* Wa, const float* ba,
                                           const float* Wi, const float* bi, const float* lam, float* comp, bf16_t* O) {
    asm volatile("" : "+v"(lane), "+v"(tid));
    for (int v = vcu; v < 256; v += G) {
        const int b = v >> 5, blk = (v >> 1) & 15, chunk = (v & 1) * 8 + wave;
        __syncthreads();
        fill_tables(lds, blk, Wa, Wi, cw, cb, tid);
        __syncthreads();
        scan_chunk<FINAL>(lds, b, blk, chunk, wave, lane, XR, GY, ba, bi, lam, comp, O);
    }
}
#undef RNN_LOAD_TILE
}

__device__ __forceinline__ void naive_attn_item(int idx, const bf16_t* __restrict__ Q, const bf16_t* __restrict__ K, const bf16_t* __restrict__ V, const float* __restrict__ kmp,
                                                 const float* __restrict__ rel_bias, bf16_t* __restrict__ O, int opitch) {
    const int t = idx % SEQ, h = (idx / SEQ) % NH, b = idx / (SEQ * NH);
    const size_t row = (size_t)b * SEQ + t;
    float q[64];
    { const u32x4* qp = (const u32x4*)(Q + row * DA + h * HD);
#pragma unroll
      for (int c = 0; c < 8; ++c) { const u32x4 w = qp[c];
#pragma unroll
          for (int j = 0; j < 4; ++j) { q[c * 8 + 2 * j] = __uint_as_float(w[j] << 16); q[c * 8 + 2 * j + 1] = __uint_as_float(w[j] & 0xffff0000u); } } }
    const int own = t / KBLK;
    unsigned mask = 0;
    {
        float g[16];
#pragma unroll
        for (int j = 0; j < 16; ++j) { g[j] = -INFINITY;
            if (j < own) { const float* k0 = kmp + (size_t)((b * NKB + j) * 2) * DA + h * HD; const float* k1 = k0 + DA; float s = 0.f;
#pragma unroll
                for (int d = 0; d < 64; ++d) s += q[d] * ((k0[d] + k1[d]) * (1.0f / 256.0f));
                g[j] = s; } }
#pragma unroll
        for (int r = 0; r < 3; ++r) { float best = -INFINITY; int bi = -1;
#pragma unroll
            for (int j = 0; j < 16; ++j) if (g[j] > best) { best = g[j]; bi = j; }
            if (bi >= 0) { mask |= 1u << bi;
#pragma unroll
                for (int j = 0; j < 16; ++j) if (j == bi) g[j] = -INFINITY; } }
    }
    mask |= 1u << own;
    float o[64];
#pragma unroll
    for (int d = 0; d < 64; ++d) o[d] = 0.f;
    float mx = -INFINITY, l = 0.f;
    for (int j = 0; j <= own; ++j) {
        if (!((mask >> j) & 1u)) continue;
        const int kend = (j == own) ? (t - own * KBLK + 1) : KBLK;
        for (int kk = 0; kk < kend; ++kk) {
            const size_t krow = (size_t)b * SEQ + j * KBLK + kk;
            const u32x4* kp = (const u32x4*)(K + krow * DA + h * HD);
            float s = 0.f;
#pragma unroll
            for (int c = 0; c < 8; ++c) { const u32x4 w = kp[c];
#pragma unroll
                for (int jj = 0; jj < 4; ++jj) { s += q[c * 8 + 2 * jj] * __uint_as_float(w[jj] << 16); s += q[c * 8 + 2 * jj + 1] * __uint_as_float(w[jj] & 0xffff0000u); } }
            const int rel = t - (j * KBLK + kk);
            s += rel_bias[t5_bucket(rel) * NH + h] * LOG2E;
            if (s > mx) { const float f = exp2f(mx - s); l *= f;
#pragma unroll
                for (int d = 0; d < 64; ++d) o[d] *= f;
                mx = s; }
            const float p = exp2f(s - mx); l += p;
            const u32x4* vp = (const u32x4*)(V + krow * DA + h * HD);
#pragma unroll
            for (int c = 0; c < 8; ++c) { const u32x4 w = vp[c];
#pragma unroll
                for (int jj = 0; jj < 4; ++jj) { o[c * 8 + 2 * jj] += p * __uint_as_float(w[jj] << 16); o[c * 8 + 2 * jj + 1] += p * __uint_as_float(w[jj] & 0xffff0000u); } }
        }
    }
    const float il = 1.0f / l;
    u32x4* op = (u32x4*)(O + row * opitch + h * HD);
#pragma unroll
    for (int c = 0; c < 8; ++c) { u32x4 w;
#pragma unroll
        for (int jj = 0; jj < 4; ++jj) w[jj] = pk2(o[c * 8 + 2 * jj] * il, o[c * 8 + 2 * jj + 1] * il);
        op[c] = w; }
}

__device__ __forceinline__ void rg_au_ref(float rp, float ip, float xc, float c8sp, float& a, float& u) {
    const float r = 1.0f / (1.0f + expf(-rp)), i = 1.0f / (1.0f + expf(-ip));
    const float la = -c8sp * r; a = expf(la); u = sqrtf(-expm1f(2.0f * la)) * (i * xc);
}
constexpr int NCH = 64, CHL = SEQ / NCH;
template <bool FINAL>
__device__ __forceinline__ void naive_scan_item(int item, int c, LAS float* xcs, const bf16_t* __restrict__ XR, const bf16_t* __restrict__ GY, const float* __restrict__ cw, const float* __restrict__ cb,
                                                const float* __restrict__ Wa, const float* __restrict__ ba, const float* __restrict__ Wi, const float* __restrict__ bi,
                                                const float* __restrict__ lam, float* __restrict__ comp, const float* __restrict__ carry, bf16_t* __restrict__ O) {
    const int blk = item % RB, chunk = (item / RB) % NCH, b = item / (RB * NCH);
    const int ch = blk * RBD + c;
    const float w0 = cw[ch], w1 = cw[DR + ch], w2 = cw[2 * DR + ch], w3 = cw[3 * DR + ch], bb = cb[ch];
    for (int tt = 0; tt < CHL; ++tt) { const int t = chunk * CHL + tt; const bf16_t* xp = XR + ((size_t)b * SEQ + t) * DR + ch;
        float v = bb + w3 * bf2f(xp[0]);
        if (t >= 1) v += w2 * bf2f(xp[-DR]);
        if (t >= 2) v += w1 * bf2f(xp[-2 * DR]);
        if (t >= 3) v += w0 * bf2f(xp[-3 * DR]);
        xcs[tt * 64 + c] = v; }
    asm volatile("s_waitcnt lgkmcnt(0)" ::: "memory");
    const float c8sp = 8.0f * log1pf(expf(-lam[ch]));
    const float bav = ba[ch], biv = bi[ch];
    const float* wa = Wa + (size_t)blk * RBD * RBD + c; const float* wi = Wi + (size_t)blk * RBD * RBD + c;
    float A = 1.f, Bc = 0.f, hst = FINAL ? carry[((size_t)b * NCH + chunk) * DR + ch] : 0.f;
    for (int tt = 0; tt < CHL; ++tt) {
        float rp = bav, ip = biv;
#pragma unroll 8
        for (int d = 0; d < 64; ++d) { const float xv = xcs[tt * 64 + d]; rp += xv * wa[d * RBD]; ip += xv * wi[d * RBD]; }
        float a, u; rg_au_ref(rp, ip, xcs[tt * 64 + c], c8sp, a, u);
        if (FINAL) { hst = a * hst + u; const size_t off = ((size_t)b * SEQ + chunk * CHL + tt); O[off * OC + DA + ch] = (bf16_t)f2bf(hst * bf2f(GY[off * DR + ch])); }
        else { A *= a; Bc = a * Bc + u; }
    }
    if (!FINAL) { float* cp = comp + (((size_t)b * NCH + chunk) * DR + ch) * 2; cp[0] = A; cp[1] = Bc; }
    asm volatile("s_waitcnt lgkmcnt(0)" ::: "memory");
}
__device__ __forceinline__ void naive_scan_prefix_item(int idx, const float* __restrict__ comp, float* __restrict__ carry) {
    const int ch = idx % DR, b = idx / DR;
    float h = 0.f;
    for (int k = 0; k < NCH; ++k) { const size_t o = ((size_t)b * NCH + k) * DR + ch; carry[o] = h; h = comp[o * 2] * h + comp[o * 2 + 1]; }
}

__global__ void __launch_bounds__(NWAVES * 64, 2) mk_fwd(Args args) {
    extern __shared__ __attribute__((aligned(16))) unsigned char lds_raw[];
    LAS unsigned char* lds = (LAS unsigned char*)lds_raw;
    const int tid = threadIdx.x, lane = tid & 63, wave = __builtin_amdgcn_readfirstlane(tid >> 6);
    const int G = gridDim.x; const int bx = blockIdx.x; const int vcu = (G % 8 == 0) ? (bx % 8) * (G / 8) + bx / 8 : bx;
    unsigned char* ws = args.ws;
    unsigned* ctl = (unsigned*)(ws + WS_CTL);
    for (int u = tid; u < (LDS_BYTES - LDSCTL_OFF) / 4; u += NWAVES * 64) ((LAS unsigned*)(lds + LDSCTL_OFF))[u] = 0u;
    __syncthreads();
    volatile LAS unsigned* MISC = (volatile LAS unsigned*)(lds + MISC_OFF);
    const int lo = args.ph_lo, hi = args.ph_hi;
    XcdBarrier bar; bar.bar = ctl + CW_BAR + lo * XCD_BAR_WORDS; bar.x = 0; bar.st = nullptr;
    const bool multi = (hi - lo) > 1;
    if (multi) bar = xcd_barrier_post(ctl + CW_BAR + lo * XCD_BAR_WORDS, MISC + 8);
#define IN(k) (lo <= (k) && (k) < hi)
#define BOTH(k) (IN(k) && IN((k) + 1))
#define GRID_BAR() xcd_barrier(bar)
#define STAGGER(ticks) do { if ((ticks) > 0) { const unsigned long long t0_ = __builtin_amdgcn_s_memrealtime(), d_ = (unsigned long long)(vcu & 3) * (unsigned long long)(ticks); while (__builtin_amdgcn_s_memrealtime() - t0_ < d_) __builtin_amdgcn_s_sleep(8); } } while (0)

    const float* x = args.in[0];
    bf16_t* Wt_in = (bf16_t*)(ws + WS_WIN); bf16_t* Wt_cat = (bf16_t*)(ws + WS_WCAT); bf16_t* Wt_out = (bf16_t*)(ws + WS_WOUT);
    bf16_t* Wt_ff1 = (bf16_t*)(ws + WS_WFF1); bf16_t* Wt_ff2 = (bf16_t*)(ws + WS_WFF2);
    bf16_t* XN = (bf16_t*)(ws + WS_XN); bf16_t* XB = (bf16_t*)(ws + WS_XB); float* rstd1 = (float*)(ws + WS_RSTD1); bf16_t* Qb = (bf16_t*)(ws + WS_Q); bf16_t* Kb = (bf16_t*)(ws + WS_K); bf16_t* Vb = (bf16_t*)(ws + WS_V);
    bf16_t* XR = (bf16_t*)(ws + WS_XR); bf16_t* GY = (bf16_t*)(ws + WS_GY); bf16_t* GA = (bf16_t*)(ws + WS_GA); bf16_t* GR = (bf16_t*)(ws + WS_GR);
    bf16_t* MRG = (bf16_t*)(ws + WS_MRG); bf16_t* HB = (bf16_t*)(ws + WS_H);
    float* kmp = (float*)(ws + WS_KMP); float* ssq = (float*)(ws + WS_SSQ);
    bf16_t* OCAT = (bf16_t*)args.out;

    if ((PHMASK >> 0 & 1) && IN(0)) {
        LAS float* scr = (LAS float*)(lds + RING_OFF + wave * 16384);
        const int gw = vcu * NWAVES + wave, NGW = G * NWAVES;
        constexpr int I_IN = (DM / 64) * (DIN / 32), I_PA = (DA / 64) * (DM / 32), I_PR = (DR / 64) * (DM / 32), I_OUT = (DM / 64) * (DM / 32), I_F1 = (DM / 64) * (DFF / 32), I_F2 = (DFF / 64) * (DM / 32);
        (void)I_PA; (void)I_PR; (void)I_OUT; (void)I_F1; (void)I_F2;
        for (int it = gw; it < I_IN; it += NGW) p0_transpose_item<1>(args.in[2], DIN, Wt_in, DM, 0, args.in[1], scr, it, lane);
        { f32x4 cur[4], nxt[4];
#pragma unroll
          for (int j = 0; j < 4; ++j) cur[j] = ((const f32x4*)(x + (size_t)gw * DM) + lane)[64 * j];
          for (int m = gw; m < M; m += NGW) { const int mn = (m + NGW < M) ? m + NGW : m;
#pragma unroll
              for (int j = 0; j < 4; ++j) nxt[j] = ((const f32x4*)(x + (size_t)mn * DM) + lane)[64 * j];
              rms_row_to_bf16(cur, rstd1 + m, XB + (size_t)m * DM, lane);
#pragma unroll
              for (int j = 0; j < 4; ++j) cur[j] = nxt[j]; } }
        if (BOTH(0)) GRID_BAR();
    }
    if ((PHMASK >> 1 & 1) && IN(1)) {
        pg8::Gemm g = pg8::gemm_rowmajor(XB, Wt_in, DM, DM, DM, DIN, -1, args.flags); pg8::StaticOrder S; S.init(M, DIN, G, bx, WGM_P1);
        LAS float* rs = (LAS float*)(lds + LDSCTL_OFF + 1024);
        { pg8::Unit u0; int nu = 0; while (nu < 11 && S.next(nu, u0)) ++nu;
          for (int e = tid; e < nu * 256; e += NWAVES * 64) { pg8::Unit u1; S.next(e >> 8, u1); rs[e] = rstd1[u1.pm * 256 + (e & 255)]; }
          __syncthreads(); }
        pg8::EpiZ E{Qb, Kb, Vb, XR, GY, GA, GR, kmp, args.in[4], args.in[5], args.in[3], rs, ws, (LAS float*)(lds + LDSCTL_OFF + 13312)};
        STAGGER(STAG1);
        pg8::gemm_phase<pg8::EpiZ, pg8::StaticOrder, false>(lds + RING_OFF, g, S, E);
        if (BOTH(1)) GRID_BAR();
    }
    {
        const float* cw = args.in[7]; const float* cb = args.in[8]; const float* Wa = args.in[9]; const float* ba = args.in[10]; const float* Wi = args.in[11]; const float* bi = args.in[12]; const float* lam = args.in[13];
        float* comp = (float*)(ws + WS_COMP); float* carry = (float*)(ws + WS_CARRY);
        LAS float* xcs = (LAS float*)(lds + RING_OFF + wave * 16384);
        const int gw = vcu * NWAVES + wave, NGW = G * NWAVES;
        const bool pairmode = PAIR_SYNC && (G == 256) && IN(2) && IN(4) && !NAIVE_SCAN;
        if ((PHMASK >> 2 & 1) && IN(2)) {
#if NAIVE_ATTN
            for (int idx = bx * (NWAVES * 64) + tid; idx < BATCH * NH * SEQ; idx += G * NWAVES * 64) naive_attn_item(idx, Qb, Kb, Vb, kmp, args.in[6], OCAT, OC);
#else
            if (!(args.flags & 8)) { const attn_body::AttnTensors AT{(const attn_body::bf16*)Qb, (const attn_body::bf16*)Kb, (const attn_body::bf16*)Vb, (const unsigned short*)(ws + WS_KMH), (const unsigned short*)(ws + WS_KML), args.in[6], (attn_body::bf16*)OCAT};
              attn_body::attn_phase<8>((char*)lds_raw + RING_OFF, AT, vcu, G); }
#endif
#if NAIVE_SCAN
            for (int it = gw; it < BATCH * NCH * RB; it += NGW) naive_scan_item<false>(it, lane, xcs, XR, GY, cw, cb, Wa, ba, Wi, bi, lam, comp, carry, OCAT);
#else
            if (!(args.flags & 4)) rnn::scan_phase<false>(lds, vcu, G, wave, lane, tid, XR, GY, cw, cb, Wa, ba, Wi, bi, lam, comp, OCAT);
#endif
            if (pairmode) {
                asm volatile("s_waitcnt vmcnt(0)" ::: "memory"); __syncthreads();
                if (tid == 0) { __builtin_amdgcn_fence(__ATOMIC_RELEASE, "agent"); asm volatile("s_waitcnt vmcnt(0)" ::: "memory");
                    __hip_atomic_store(ctl + CW_PAIR + 64 * vcu, 1u, __ATOMIC_RELAXED, __HIP_MEMORY_SCOPE_AGENT); }
            } else if (BOTH(2)) GRID_BAR();
        }
        if ((PHMASK >> 3 & 1) && IN(3)) {
#if DBG_ATTN
            { float sd = 0.f, sr = 0.f;
              for (size_t i = (size_t)bx * (NWAVES * 64) + tid; i < (size_t)M * DA; i += (size_t)G * NWAVES * 64) { const size_t r = i / DA, c = i % DA;
                  const float a = bf2f(OCAT[r * OC + c]), b = bf2f((XN + (size_t)16 * 1024 * 1024)[r * DA + c]); sd += (a - b) * (a - b); sr += b * b; }
              sd = wave_sum(sd); sr = wave_sum(sr);
              if (lane == 0) { atomicAdd((float*)(ctl + 16), sd); atomicAdd((float*)(ctl + 17), sr); } }
#endif
#if NAIVE_SCAN
            for (int idx = bx * (NWAVES * 64) + tid; idx < BATCH * DR; idx += G * NWAVES * 64) naive_scan_prefix_item(idx, comp, carry);
            if (BOTH(3)) GRID_BAR();
#endif
        }
        if ((PHMASK >> 4 & 1) && IN(4)) {
#if NAIVE_SCAN
            for (int it = gw; it < BATCH * NCH * RB; it += NGW) naive_scan_item<true>(it, lane, xcs, XR, GY, cw, cb, Wa, ba, Wi, bi, lam, comp, carry, OCAT);
#else
            {
                constexpr int I_PA = (DA / 64) * (DM / 32), I_PR = (DR / 64) * (DM / 32), I_OUT = (DM / 64) * (DM / 32), I_F1 = (DM / 64) * (DFF / 32), I_F2 = (DFF / 64) * (DM / 32);
                LAS float* scr = (LAS float*)(lds + RING_OFF + wave * 16384);
                for (int it = gw; it < I_PA + I_PR + I_OUT + I_F1 + I_F2; it += NGW) {
                    int r = it;
                    if (r < I_PA) { p0_transpose_item<0>(args.in[14], DM, Wt_cat, OC, 0, nullptr, scr, r, lane); continue; } r -= I_PA;
                    if (r < I_PR) { p0_transpose_item<0>(args.in[15], DM, Wt_cat, OC, DA, nullptr, scr, r, lane); continue; } r -= I_PR;
                    if (r < I_OUT) { p0_transpose_item<0>(args.in[16], DM, Wt_out, DM, 0, nullptr, scr, r, lane); continue; } r -= I_OUT;
                    if (r < I_F1) { p0_transpose_item<0>(args.in[18], DFF, Wt_ff1, DM, 0, args.in[17], scr, r, lane); continue; } r -= I_F1;
                    p0_transpose_item<0>(args.in[19], DM, Wt_ff2, HP, 0, nullptr, scr, r, lane);
                }
            }
            if (pairmode) {
                if (tid == 0) {
                    if (vcu & 1) { unsigned sp = 0; while (__hip_atomic_load(ctl + CW_PAIR + 64 * (vcu - 1), __ATOMIC_RELAXED, __HIP_MEMORY_SCOPE_AGENT) == 0u) { __builtin_amdgcn_s_sleep(2);
                            if (++sp > (1u << 22)) { __hip_atomic_store(ctl + CW_TMO, 1u, __ATOMIC_RELAXED, __HIP_MEMORY_SCOPE_AGENT); break; } } }
                    __builtin_amdgcn_fence(__ATOMIC_ACQUIRE, "agent"); asm volatile("s_waitcnt vmcnt(0)" ::: "memory"); }
                __syncthreads();
            }
            rnn::scan_phase<true>(lds, vcu, G, wave, lane, tid, XR, GY, cw, cb, Wa, ba, Wi, bi, lam, comp, OCAT);
#endif
            if (BOTH(4)) GRID_BAR();
        }
    }
    if ((PHMASK >> 5 & 1) && IN(5)) {
        pg8::Gemm g = pg8::gemm_rowmajor(OCAT, Wt_cat, OC, OC, OC, DM, DA / 64, args.flags); pg8::StaticOrder S; S.init(M, DM, G, bx, WGM_N4);
        pg8::EpiMerge E{GA, GR, MRG};
        pg8::gemm_phase<pg8::EpiMerge, pg8::StaticOrder, MIDFLAG>(lds + RING_OFF, g, S, E);
        if (BOTH(5)) GRID_BAR();
    }
    if ((PHMASK >> 6 & 1) && IN(6)) {
        pg8::Gemm g = pg8::gemm_rowmajor(MRG, Wt_out, DM, DM, DM, DM, -1, args.flags); g.imgA = 1; g.kstepA = 32768; g.tstepA = (size_t)(DM / 64) * 32768; pg8::StaticOrder S; S.init(M, DM, G, bx, WGM_N4);
        pg8::EpiX1 E{XB, XN, ssq};
        pg8::gemm_phase<pg8::EpiX1, pg8::StaticOrder, false>(lds + RING_OFF, g, S, E);
        if (BOTH(6)) GRID_BAR();
    }
    if ((PHMASK >> 7 & 1) && IN(7)) {
        pg8::Gemm g = pg8::gemm_rowmajor(XN, Wt_ff1, DM, DM, DM, DFF, -1, args.flags); g.imgA = 1; g.kstepA = 32768; g.tstepA = (size_t)(DM / 64) * 32768; pg8::StaticOrder S; S.init(M, DFF, G, bx, WGM_P7);
        LAS float* rs = (LAS float*)(lds + LDSCTL_OFF + 1024);
        { pg8::Unit u0; int nu = 0; while (nu < 8 && S.next(nu, u0)) ++nu;
          for (int e = tid; e < nu * 256; e += NWAVES * 64) { pg8::Unit u1; S.next(e >> 8, u1); const float* sp = ssq + (size_t)(u1.pm * 256 + (e & 255)) * 16;
              const f32x4 s0 = *(const f32x4*)sp, s1 = *(const f32x4*)(sp + 4), s2 = *(const f32x4*)(sp + 8), s3 = *(const f32x4*)(sp + 12);
              const float tot = (((s0[0] + s0[1]) + (s0[2] + s0[3])) + ((s1[0] + s1[1]) + (s1[2] + s1[3]))) + (((s2[0] + s2[1]) + (s2[2] + s2[3])) + ((s3[0] + s3[1]) + (s3[2] + s3[3])));
              rs[e] = 1.0f / sqrtf(tot * (1.0f / DM) + EPS); }
          __syncthreads(); }
        pg8::EpiH E{rs, HB};
        STAGGER(STAG7);
        pg8::gemm_phase<pg8::EpiH, pg8::StaticOrder, false>(lds + RING_OFF, g, S, E);
        if (BOTH(7)) GRID_BAR();
    }
    if ((PHMASK >> 8 & 1) && IN(8)) {
        pg8::Gemm g = pg8::gemm_rowmajor(HB, Wt_ff2, HP, HP, DFF, DM, -1, args.flags); g.imgA = 1; g.kstepA = 32768; g.tstepA = (size_t)(DFF / 64) * 32768;   pg8::StaticOrder S; S.init(M, DM, G, bx, WGM_N4);
        pg8::EpiOut E{XN, args.out};
        pg8::gemm_phase<pg8::EpiOut, pg8::StaticOrder, false>(lds + RING_OFF, g, S, E);
#ifdef PROBE_BARRIERS
        if (multi) { for (int i = 0; i < PROBE_BARRIERS; ++i) GRID_BAR(); }
#endif
#if DBG_ATTN
        GRID_BAR();
        { const float sd = __hip_atomic_load((float*)(ctl + 16), __ATOMIC_RELAXED, __HIP_MEMORY_SCOPE_AGENT), sr = __hip_atomic_load((float*)(ctl + 17), __ATOMIC_RELAXED, __HIP_MEMORY_SCOPE_AGENT);
          const float e = sqrtf(sd / sr) * DBG_AMP;
          for (size_t i = (size_t)bx * (NWAVES * 64) + tid; i < (size_t)M * DM; i += (size_t)G * NWAVES * 64) args.out[i] *= (1.0f + e); }
#endif
    }
#undef IN
#undef BOTH
#undef GRID_BAR
}

#if DBG_ATTN
__global__ void __launch_bounds__(256) naive_attn_k(const bf16_t* Q, const bf16_t* K, const bf16_t* V, const float* kmp, const float* rel_bias, bf16_t* O, int opitch) {
    naive_attn_item(blockIdx.x * 256 + threadIdx.x, Q, K, V, kmp, rel_bias, O, opitch);
}
#endif
constexpr int N_PHASES = 9;
extern "C" void kernel_launch(void* const* d_in, const int* in_sizes, int n_in, void* d_out, int out_size, void* d_ws, size_t ws_size, hipStream_t stream) {
    static int grid = 0;
    if (grid == 0) {
        if (n_in != 20 || in_sizes[0] != M * DM || out_size != M * DM || ws_size < WS_END) { fprintf(stderr, "kernel_launch: unexpected shapes (n_in %d, in0 %d, out %d, ws %zu)\n", n_in, n_in > 0 ? in_sizes[0] : -1, out_size, ws_size); grid = -1; return; }
        int dev = 0, cus = 0;
        if (hipGetDevice(&dev) != hipSuccess || hipDeviceGetAttribute(&cus, hipDeviceAttributeMultiprocessorCount, dev) != hipSuccess) { grid = -1; return; }
        if (hipFuncSetAttribute((const void*)mk_fwd, hipFuncAttributeMaxDynamicSharedMemorySize, LDS_BYTES) != hipSuccess) { fprintf(stderr, "kernel_launch: hipFuncSetAttribute failed\n"); grid = -1; return; }
        (void)hipGetLastError();
        grid = cus;
    }
    if (grid < 0) return;
    (void)hipMemsetAsync((char*)d_ws + WS_CTL, 0, CTL_ZERO_BYTES, stream);
    Args a{};
    for (int i = 0; i < 20; ++i) a.in[i] = (const float*)d_in[i];
    a.out = (float*)d_out; a.ws = (unsigned char*)d_ws;
#if DBG_ATTN
    a.ph_lo = 0; a.ph_hi = 2;
    hipLaunchKernelGGL(mk_fwd, dim3(grid), dim3(NWAVES * 64), LDS_BYTES, stream, a);
    { unsigned char* ws = (unsigned char*)d_ws;
      hipLaunchKernelGGL(naive_attn_k, dim3(BATCH * NH * SEQ / 256), dim3(256), 0, stream, (const bf16_t*)(ws + WS_Q), (const bf16_t*)(ws + WS_K), (const bf16_t*)(ws + WS_V),
                         (const float*)(ws + WS_KMP), (const float*)d_in[6], (bf16_t*)(ws + WS_XN + 32 * MiB), DA); }
    a.ph_lo = 2; a.ph_hi = N_PHASES;
    hipLaunchKernelGGL(mk_fwd, dim3(grid), dim3(NWAVES * 64), LDS_BYTES, stream, a);
#elif defined(PROBE_REP)
#ifndef PROBE_FLAGS
#define PROBE_FLAGS 0
#endif
#ifndef PROBE_LO
#define PROBE_LO PROBE_REP
#endif
    a.ph_lo = 0; a.ph_hi = PROBE_REP + 1;
    hipLaunchKernelGGL(mk_fwd, dim3(grid), dim3(NWAVES * 64), LDS_BYTES, stream, a);
    a.ph_lo = PROBE_LO; a.ph_hi = PROBE_REP + 1; a.flags = PROBE_FLAGS;
    hipLaunchKernelGGL(mk_fwd, dim3(grid), dim3(NWAVES * 64), LDS_BYTES, stream, a);
    a.flags = 0;
    if (PROBE_REP + 1 < N_PHASES) { a.ph_lo = PROBE_REP + 1; a.ph_hi = N_PHASES;
    hipLaunchKernelGGL(mk_fwd, dim3(grid), dim3(NWAVES * 64), LDS_BYTES, stream, a); }
#elif MK_N_LAUNCHES == 1
    a.ph_lo = 0; a.ph_hi = N_PHASES;
    hipLaunchKernelGGL(mk_fwd, dim3(grid), dim3(NWAVES * 64), LDS_BYTES, stream, a);
#else
    for (int p = 0; p < N_PHASES; ++p) { a.ph_lo = p; a.ph_hi = p + 1; hipLaunchKernelGGL(mk_fwd, dim3(grid), dim3(NWAVES * 64), LDS_BYTES, stream, a); }
#endif
}
```

```cpp
#include <hip/hip_runtime.h>
#include <hip/hip_bf16.h>
#include <cstdio>
#include <cstdint>

#ifndef MIDFLAG
#define MIDFLAG true
#endif
#ifndef NAIVE_ATTN
#define NAIVE_ATTN 0
#endif
#ifndef NAIVE_SCAN
#define NAIVE_SCAN 0
#endif
#ifndef DBG_ATTN
#define DBG_ATTN 0
#endif
#ifndef DBG_AMP
#define DBG_AMP 10.0f
#endif
#ifndef STAG1
#define STAG1 0
#endif
#ifndef STAG7
#define STAG7 0
#endif
#ifndef PAIR_SYNC
#define PAIR_SYNC 1
#endif
#ifndef WGM_P1
#define WGM_P1 4
#endif
#ifndef WGM_P7
#define WGM_P7 8
#endif
#ifndef WGM_N4
#define WGM_N4 4
#endif
#ifndef PHMASK
#define PHMASK 0xffff
#endif
#ifndef MK_N_LAUNCHES
#define MK_N_LAUNCHES 1
#endif

constexpr int BATCH = 8, SEQ = 4096, DM = 1024, M = BATCH * SEQ;
constexpr int NH = 8, HD = 64, DA = 512, DR = 1024, DFF = 4096, DIN = 5632;
constexpr int KBLK = 256, NKB = SEQ / KBLK;
constexpr int RB = 16, RBD = 64;
constexpr int OC = DA + DR;
constexpr int HP = DFF + 128;
constexpr float EPS = 1e-6f;
constexpr float LOG2E = 1.4426950408889634f;
constexpr float C2 = 0.125f * LOG2E;

#define LAS __attribute__((address_space(3)))
#define GAS __attribute__((address_space(1)))
typedef unsigned short bf16_t;
typedef short bf16x8 __attribute__((ext_vector_type(8)));
typedef float f32x4 __attribute__((ext_vector_type(4)));
typedef float f32x2 __attribute__((ext_vector_type(2)));
typedef unsigned u32x4 __attribute__((ext_vector_type(4)));
typedef unsigned u32x2 __attribute__((ext_vector_type(2)));

constexpr size_t MiB = 1u << 20;
constexpr size_t WS_CTL = 0, CTL_ZERO_BYTES = 256 * 1024;
constexpr size_t WS_WIN = 2 * MiB;
constexpr size_t WS_WCAT = 13 * MiB;
constexpr size_t WS_WOUT = 16 * MiB;
constexpr size_t WS_WFF1 = 18 * MiB;
constexpr size_t WS_WFF2 = 26 * MiB;
constexpr size_t WS_KMP = 35 * MiB;
constexpr size_t WS_SSQ = 36 * MiB;
constexpr size_t WS_COMP = 38 * MiB;
constexpr size_t WS_CARRY = 42 * MiB;
constexpr size_t WS_KMH = 45 * MiB;
constexpr size_t WS_KML = 45 * MiB + 512 * 1024;
constexpr size_t WS_RSTD1 = 44 * MiB;
constexpr size_t WS_XB = 48 * MiB;
constexpr size_t WS_XR = 112 * MiB;
constexpr size_t WS_GY = 176 * MiB;
constexpr size_t WS_GA = 240 * MiB;
constexpr size_t WS_GR = 304 * MiB;
constexpr size_t WS_H = 112 * MiB;
constexpr size_t WS_K = 368 * MiB;
constexpr size_t WS_V = 400 * MiB;
constexpr size_t WS_MRG = 368 * MiB;
constexpr size_t WS_Q = 432 * MiB;
constexpr size_t WS_XN = 432 * MiB;
constexpr size_t WS_END = 496 * MiB;

constexpr int CW_TMO = 0, CW_BAR = 4096, CW_PAIR = 40000;

__device__ __forceinline__ float bf2f(unsigned short u) { return __uint_as_float(((unsigned)u) << 16); }
__device__ __forceinline__ unsigned f2bf(float f) { unsigned u = __builtin_bit_cast(unsigned, f); return (u + 0x7fffu + ((u >> 16) & 1u)) >> 16; }
__device__ __forceinline__ unsigned pk2(float lo, float hi) { return f2bf(lo) | (f2bf(hi) << 16); }
__device__ __forceinline__ unsigned cvt_pk_bf16(float lo, float hi) { unsigned r; asm volatile("s_nop 0\n\tv_cvt_pk_bf16_f32 %0, %1, %2" : "=v"(r) : "v"(lo), "v"(hi)); return r; }
__device__ __forceinline__ float fast_sigmoid(float x) { return __builtin_amdgcn_rcpf(1.0f + __builtin_amdgcn_exp2f(-LOG2E * x)); }
__device__ __forceinline__ float gelu_tanh(float x) { const float u = x + 0.044715f * x * x * x; return x * __builtin_amdgcn_rcpf(1.0f + __builtin_amdgcn_exp2f(-2.302208198f * u)); }
__device__ __forceinline__ float wave_sum(float v) {
#pragma unroll
    for (int o = 1; o < 64; o <<= 1) v += __shfl_xor(v, o);
    return v;
}
__device__ __forceinline__ int t5_bucket(int n) {
    if (n < 16) return n;
    int b = 16;
    b += (n >= 19); b += (n >= 21); b += (n >= 24); b += (n >= 27); b += (n >= 31); b += (n >= 35); b += (n >= 40); b += (n >= 46);
    b += (n >= 52); b += (n >= 59); b += (n >= 67); b += (n >= 77); b += (n >= 87); b += (n >= 99); b += (n >= 113);
    return b;
}

namespace pg8 {
constexpr int BM = 256, BK = 64, HALF = 128, HTB = HALF * BK * 2, STAGE_BYTES = 8 * HTB, NXCD = 8, WGM = 8;
__host__ __device__ __forceinline__ int lds_byte(int r, int c) { const int st = (r >> 4) * 2 + (c >> 5), rr = r & 15, cc = c & 31, ob = rr * 64 + cc * 2; return st * 1024 + (ob ^ (((ob >> 9) & 1) << 5)); }
__host__ __device__ __forceinline__ void stage_rc(int b, int& R, int& C) { const int st = b / 1024, sb = b % 1024, swz = sb ^ (((sb >> 9) & 1) << 5); R = (st >> 1) * 16 + swz / 64; C = (st & 1) * 32 + (swz % 64) / 2; }
__host__ __device__ __forceinline__ int perm32(int rho) { const int n = rho >> 4, i = rho & 15; return 8 * (i >> 2) + 4 * n + (i & 3); }

struct Unit { int pm, pn, idx; };
struct Gemm { const bf16_t* A; const bf16_t* Bt; int lda, ldb, K, N, mid_t, flags; size_t kstepA, kstepB, tstepA, tstepB; int imgA; };
__host__ __device__ __forceinline__ Gemm gemm_rowmajor(const bf16_t* A, const bf16_t* Bt, int lda, int ldb, int K, int N, int mid_t, int flags) { return Gemm{A, Bt, lda, ldb, K, N, mid_t, flags, (size_t)128, (size_t)128, (size_t)512 * lda, (size_t)512 * ldb, 0}; }

struct StaticOrder {
    int nM, nN, nwg, G, c, wgm;
    __host__ __device__ void init(int M_, int N_, int G_, int c_, int wgm_ = WGM) { nM = M_ / BM; nN = N_ / BM; nwg = nM * nN; G = G_; c = c_; wgm = wgm_; }
    __host__ __device__ bool next(int i, Unit& u) const {
        const long L = (long)i * G + c; if (L >= nwg) return false;
        int wgid = (int)L; { const int q = nwg / NXCD, r = nwg % NXCD, xcd = wgid % NXCD, off = wgid / NXCD; wgid = (xcd < r ? xcd * (q + 1) : r * (q + 1) + (xcd - r) * q) + off; }
        const int nig = wgm * nN, gid = wgid / nig, fm = gid * wgm, gsz = (nM - fm) < wgm ? (nM - fm) : wgm;
        u.pm = fm + ((wgid % nig) % gsz); u.pn = (wgid % nig) / gsz; u.idx = i; return true;
    }
};

typedef f32x4 Acc[2][2][4][2];

template <class Epi, class Sched, bool MID>
__device__ __forceinline__ void gemm_phase(LAS unsigned char* lds, const Gemm g, const Sched& S, const Epi& E) {
    const int tid = threadIdx.x, wid = __builtin_amdgcn_readfirstlane(tid >> 6), lane = tid & 63, wr = wid >> 2, wc = wid & 3, fr = lane & 15, fq = lane >> 4;
    const int nt = g.K / BK;
    unsigned voffA[2], voffB[2];
#pragma unroll
    for (int i = 0; i < 2; ++i) { int R, C; stage_rc(tid * 16 + i * 8192, R, C); const int Rb = Epi::PERM ? ((R & ~31) + perm32(R & 31)) : R;
        voffA[i] = g.imgA ? (unsigned)(tid * 16 + i * 8192) : (unsigned)(R * g.lda + C) * 2u; voffB[i] = (unsigned)(Rb * g.ldb + C) * 2u; }
    const size_t kstepA = g.kstepA, kstepB = g.kstepB;
    const size_t hstepA = g.imgA ? (size_t)HTB : (size_t)HALF * g.lda * 2, hstepB = (size_t)HALF * g.ldb * 2;
    const size_t tstepA = (g.flags & 2) ? 0 : g.tstepA, tstepB = (g.flags & 2) ? 0 : g.tstepB;
    const unsigned ldsw = (unsigned)wid * 1024u;
    const int aoff = lds_byte(wr * 64 + fr, fq * 8), boff = lds_byte(wc * 32 + fr, fq * 8);
#define PG8_SA(b, h) (((b) * 2 + (h)) * HTB)
#define PG8_SB(b, h) ((4 + (b) * 2 + (h)) * HTB)
#define PG8_STAGE(bufoff, gbase, voff) do { _Pragma("unroll") for (int _i = 0; _i < 2; ++_i) \
        __builtin_amdgcn_global_load_lds((const unsigned*)((const char*)(gbase) + (voff)[_i]), (LAS unsigned*)(lds + (bufoff) + ldsw + _i * 8192), 16, 0, 0); } while (0)
#define PG8_LDA(dst, b, h) do { _Pragma("unroll") for (int m = 0; m < 4; ++m) _Pragma("unroll") for (int k = 0; k < 2; ++k) dst[m][k] = *(const LAS bf16x8*)(lds + PG8_SA(b, h) + aoff + m * 2048 + k * 1024); } while (0)
#define PG8_LDB(dst, b, h) do { _Pragma("unroll") for (int n = 0; n < 2; ++n) _Pragma("unroll") for (int k = 0; k < 2; ++k) dst[n][k] = *(const LAS bf16x8*)(lds + PG8_SB(b, h) + boff + n * 2048 + k * 1024); } while (0)
#define PG8_MMA(ai, bj, At, Bt) do { __builtin_amdgcn_s_setprio(1); _Pragma("unroll") for (int m = 0; m < 4; ++m) _Pragma("unroll") for (int n = 0; n < 2; ++n) _Pragma("unroll") for (int k = 0; k < 2; ++k) \
        acc[ai][bj][m][n] = __builtin_amdgcn_mfma_f32_16x16x32_bf16(Bt[n][k], At[m][k], acc[ai][bj][m][n], 0, 0, 0); __builtin_amdgcn_s_setprio(0); } while (0)
#define PG8_WAIT_V(n) asm volatile("s_waitcnt vmcnt(" #n ")" ::: "memory")
#define PG8_WAIT_L(n) asm volatile("s_waitcnt lgkmcnt(" #n ")" ::: "memory")
#define PG8_BAR __builtin_amdgcn_s_barrier()
#define PG8_SCHED __builtin_amdgcn_sched_barrier(0)
    Unit cur, nxt; int ui = 0;
    if (!S.next(0, cur)) return;
    f32x4 acc[2][2][4][2];
#pragma unroll
    for (int a = 0; a < 2; ++a)
#pragma unroll
        for (int b = 0; b < 2; ++b)
#pragma unroll
            for (int m = 0; m < 4; ++m)
#pragma unroll
                for (int n = 0; n < 2; ++n) acc[a][b][m][n] = (f32x4){0.f, 0.f, 0.f, 0.f};
    bf16x8 At[4][2], B0[2][2], B1[2][2];
    const char* cA = (const char*)g.A + (size_t)cur.pm * tstepA; const char* cB = (const char*)g.Bt + (size_t)cur.pn * tstepB;
    PG8_STAGE(PG8_SB(0, 0), cB, voffB); PG8_STAGE(PG8_SB(0, 1), cB + hstepB, voffB); PG8_STAGE(PG8_SA(0, 0), cA, voffA); PG8_STAGE(PG8_SA(0, 1), cA + hstepA, voffA);
    if (wr == 1) PG8_BAR;
    PG8_WAIT_V(2); PG8_BAR;
    PG8_STAGE(PG8_SB(1, 0), cB + kstepB, voffB); PG8_STAGE(PG8_SA(1, 0), cA + kstepA, voffA); PG8_STAGE(PG8_SB(1, 1), cB + hstepB + kstepB, voffB);
    PG8_WAIT_V(6); PG8_BAR;
    for (;;) {
        const bool has_next = S.next(ui + 1, nxt);
        const char* nA = has_next ? (const char*)g.A + (size_t)nxt.pm * tstepA : cA; const char* nB = has_next ? (const char*)g.Bt + (size_t)nxt.pn * tstepB : cB;
        for (int t = 0; t < nt; t += 2) {
            if constexpr (MID) { if (t == g.mid_t) E.mid(acc, cur, wr, wc, fr, fq); }
            const bool last = (t == nt - 2);
            const char* a1 = cA + (size_t)(t + 1) * kstepA;
            const char* a2 = last ? nA : cA + (size_t)(t + 2) * kstepA; const char* b2 = last ? nB : cB + (size_t)(t + 2) * kstepB;
            const char* a3 = a2 + kstepA; const char* b3 = b2 + kstepB;
            PG8_LDB(B0, 0, 0); PG8_LDB(B1, 0, 1); PG8_SCHED; PG8_LDA(At, 0, 0); PG8_STAGE(PG8_SA(1, 1), a1 + hstepA, voffA);
            PG8_WAIT_V(8); PG8_WAIT_L(0); PG8_BAR; PG8_MMA(0, 0, At, B0); PG8_MMA(0, 1, At, B1); PG8_BAR; PG8_SCHED;
            PG8_LDA(At, 0, 1); PG8_STAGE(PG8_SB(0, 0), b2, voffB); PG8_STAGE(PG8_SB(0, 1), b2 + hstepB, voffB); PG8_STAGE(PG8_SA(0, 0), a2, voffA);
            PG8_WAIT_V(8); PG8_WAIT_L(0); PG8_BAR; PG8_MMA(1, 0, At, B0); PG8_MMA(1, 1, At, B1); PG8_BAR; PG8_SCHED;
            PG8_LDB(B0, 1, 0); PG8_LDB(B1, 1, 1); PG8_SCHED; PG8_LDA(At, 1, 0); PG8_STAGE(PG8_SA(0, 1), a2 + hstepA, voffA);
            PG8_WAIT_V(8); PG8_WAIT_L(0); PG8_BAR; PG8_MMA(0, 0, At, B0); PG8_MMA(0, 1, At, B1); PG8_BAR; PG8_SCHED;
            PG8_LDA(At, 1, 1); PG8_STAGE(PG8_SB(1, 0), b3, voffB); PG8_STAGE(PG8_SB(1, 1), b3 + hstepB, voffB); PG8_STAGE(PG8_SA(1, 0), a3, voffA);
            PG8_WAIT_V(8); PG8_WAIT_L(0); PG8_BAR; PG8_MMA(1, 0, At, B0); PG8_MMA(1, 1, At, B1); PG8_BAR; PG8_SCHED;
        }
        if (wr == 0) PG8_BAR;
        if (g.flags & 1) {
#pragma unroll
            for (int a = 0; a < 2; ++a)
#pragma unroll
                for (int b = 0; b < 2; ++b)
#pragma unroll
                    for (int m = 0; m < 4; ++m)
#pragma unroll
                        for (int n = 0; n < 2; ++n) asm volatile("" :: "v"(acc[a][b][m][n]));
        } else E(acc, cur, wr, wc, fr, fq);
        if (!has_next) break;
#pragma unroll
        for (int a = 0; a < 2; ++a)
#pragma unroll
            for (int b = 0; b < 2; ++b)
#pragma unroll
                for (int m = 0; m < 4; ++m)
#pragma unroll
                    for (int n = 0; n < 2; ++n) acc[a][b][m][n] = (f32x4){0.f, 0.f, 0.f, 0.f};
        cur = nxt; cA = nA; cB = nB; ++ui;
        if (wr == 1) PG8_BAR;
    }
    PG8_WAIT_V(0);
    PG8_BAR;
#undef PG8_SA
#undef PG8_SB
#undef PG8_STAGE
#undef PG8_LDA
#undef PG8_LDB
#undef PG8_MMA
#undef PG8_WAIT_V
#undef PG8_WAIT_L
#undef PG8_BAR
#undef PG8_SCHED
}

__device__ __forceinline__ size_t img_off(int pm, int lrow, int col, int KT) { return (((size_t)pm * KT + (col >> 6)) * 2 + (lrow >> 7)) * (size_t)(HTB / 2) + lds_byte(lrow & 127, col & 63) / 2; }
struct EpiZ {
    static constexpr bool PERM = true;
    bf16_t *Q, *K, *V, *XR, *GY, *GA, *GR; float* kmp; const float *qw, *kw, *bg; const LAS float* rs; unsigned char* wsb; LAS float* kx;
    __device__ __forceinline__ void mid(Acc&, const Unit&, int, int, int, int) const {}
    __device__ __forceinline__ void operator()(Acc& acc, const Unit& u, int wr, int wc, int fr, int fq) const {
        const int pn = u.pn; const int row0 = u.pm * BM + wr * 64 + fr;
        const LAS float* rsu = rs + u.idx * BM + wr * 64 + fr;
        if (pn < 4) {
            const bool isq = pn < 2; const int head = (pn & 1) * 4 + wc; const float* nw = isq ? qw : kw; const float osc = isq ? C2 : 1.0f;
            bf16_t* base = (isq ? Q : K) + head * HD + 8 * fq;
            f32x4 wv[2][2];
#pragma unroll
            for (int bj = 0; bj < 2; ++bj)
#pragma unroll
                for (int n = 0; n < 2; ++n) wv[bj][n] = *(const f32x4*)(nw + 32 * bj + 8 * fq + 4 * n) * osc;
            f32x4 cs[2][2];
#pragma unroll
            for (int bj = 0; bj < 2; ++bj)
#pragma unroll
                for (int n = 0; n < 2; ++n) cs[bj][n] = (f32x4){0.f, 0.f, 0.f, 0.f};
#pragma unroll
            for (int ai = 0; ai < 2; ++ai)
#pragma unroll
                for (int m = 0; m < 4; ++m) {
                    float ss = 0.f;
#pragma unroll
                    for (int bj = 0; bj < 2; ++bj)
#pragma unroll
                        for (int n = 0; n < 2; ++n) { const f32x4 v = acc[ai][bj][m][n]; ss += (v[0] * v[0] + v[1] * v[1]) + (v[2] * v[2] + v[3] * v[3]); }
                    ss += __shfl_xor(ss, 16); ss += __shfl_xor(ss, 32);
                    const float r1 = rsu[ai * HALF + m * 16];
                    const float rstd = r1 / sqrtf(ss * (r1 * r1) * (1.0f / 64.0f) + EPS);
                    bf16_t* rowp = base + (size_t)(row0 + ai * HALF + m * 16) * DA;
#pragma unroll
                    for (int bj = 0; bj < 2; ++bj) {
                        const f32x4 v0 = acc[ai][bj][m][0] * rstd * wv[bj][0], v1 = acc[ai][bj][m][1] * rstd * wv[bj][1];
                        cs[bj][0] += v0; cs[bj][1] += v1;
                        u32x4 w; w.x = cvt_pk_bf16(v0[0], v0[1]); w.y = cvt_pk_bf16(v0[2], v0[3]); w.z = cvt_pk_bf16(v1[0], v1[1]); w.w = cvt_pk_bf16(v1[2], v1[3]);
                        *(u32x4*)(rowp + 32 * bj) = w; }
                }
            if (!isq) {
#pragma unroll
                for (int bj = 0; bj < 2; ++bj)
#pragma unroll
                    for (int n = 0; n < 2; ++n)
#pragma unroll
                        for (int i = 0; i < 4; ++i) { float s = cs[bj][n][i]; s += __shfl_xor(s, 1); s += __shfl_xor(s, 2); s += __shfl_xor(s, 4); s += __shfl_xor(s, 8); cs[bj][n][i] = s; }
                if (fr == 0) { float* kp = kmp + (size_t)(u.pm * 2 + wr) * DA + head * HD + 8 * fq;
#pragma unroll
                    for (int bj = 0; bj < 2; ++bj) { *(f32x4*)(kp + 32 * bj) = cs[bj][0]; *(f32x4*)(kp + 32 * bj + 4) = cs[bj][1]; } }
                if (fr == 0) { LAS float* kl = kx + wr * 256 + wc * 64 + 8 * fq;
#pragma unroll
                    for (int bj = 0; bj < 2; ++bj) { *(LAS f32x4*)(kl + 32 * bj) = cs[bj][0]; *(LAS f32x4*)(kl + 32 * bj + 4) = cs[bj][1]; } }
                asm volatile("s_waitcnt lgkmcnt(0)" ::: "memory"); __builtin_amdgcn_s_barrier(); asm volatile("" ::: "memory");
                if (wr == 0) { const int d = fr + 16 * fq; const float mean = (kx[wc * 64 + d] + kx[256 + wc * 64 + d]) * (1.0f / 256.0f);
                    const unsigned hb = f2bf(mean), lb = f2bf(mean - __uint_as_float(hb << 16));
                    const size_t o = ((size_t)((u.pm >> 4) * NH + head) * NKB + (u.pm & 15)) * HD + d;
                    ((bf16_t*)(wsb + WS_KMH))[o] = (bf16_t)hb; ((bf16_t*)(wsb + WS_KML))[o] = (bf16_t)lb; }
            }
            return;
        }
        if (pn >= 14) {
            const int ch0 = (pn - 14) * 128 + wc * 32 + 8 * fq;
            const f32x4 ba0 = *(const f32x4*)(bg + ch0), ba1 = *(const f32x4*)(bg + ch0 + 4), br0 = *(const f32x4*)(bg + DM + ch0), br1 = *(const f32x4*)(bg + DM + ch0 + 4);
#pragma unroll
            for (int ai = 0; ai < 2; ++ai)
#pragma unroll
                for (int m = 0; m < 4; ++m) { const float r1 = rsu[ai * HALF + m * 16]; const size_t off = (size_t)(row0 + ai * HALF + m * 16) * DM + ch0;
                    unsigned r0_, r1_, r2_, r3_, g0_, g1_, g2_, g3_;
                    { const f32x4 a = acc[ai][0][m][0] * r1 + ba0, g = acc[ai][1][m][0] * r1 + br0;
                      const float ea0 = 1.0f + __builtin_amdgcn_exp2f(-LOG2E * a[0]), er0 = 1.0f + __builtin_amdgcn_exp2f(-LOG2E * g[0]), ea1 = 1.0f + __builtin_amdgcn_exp2f(-LOG2E * a[1]), er1 = 1.0f + __builtin_amdgcn_exp2f(-LOG2E * g[1]);
                      const float ea2 = 1.0f + __builtin_amdgcn_exp2f(-LOG2E * a[2]), er2 = 1.0f + __builtin_amdgcn_exp2f(-LOG2E * g[2]), ea3 = 1.0f + __builtin_amdgcn_exp2f(-LOG2E * a[3]), er3 = 1.0f + __builtin_amdgcn_exp2f(-LOG2E * g[3]);
                      r0_ = cvt_pk_bf16(er0 * __builtin_amdgcn_rcpf(ea0), er1 * __builtin_amdgcn_rcpf(ea1)); r1_ = cvt_pk_bf16(er2 * __builtin_amdgcn_rcpf(ea2), er3 * __builtin_amdgcn_rcpf(ea3));
                      g0_ = cvt_pk_bf16(__builtin_amdgcn_rcpf(er0), __builtin_amdgcn_rcpf(er1)); g1_ = cvt_pk_bf16(__builtin_amdgcn_rcpf(er2), __builtin_amdgcn_rcpf(er3)); }
                    { const f32x4 a = acc[ai][0][m][1] * r1 + ba1, g = acc[ai][1][m][1] * r1 + br1;
                      const float ea0 = 1.0f + __builtin_amdgcn_exp2f(-LOG2E * a[0]), er0 = 1.0f + __builtin_amdgcn_exp2f(-LOG2E * g[0]), ea1 = 1.0f + __builtin_amdgcn_exp2f(-LOG2E * a[1]), er1 = 1.0f + __builtin_amdgcn_exp2f(-LOG2E * g[1]);
                      const float ea2 = 1.0f + __builtin_amdgcn_exp2f(-LOG2E * a[2]), er2 = 1.0f + __builtin_amdgcn_exp2f(-LOG2E * g[2]), ea3 = 1.0f + __builtin_amdgcn_exp2f(-LOG2E * a[3]), er3 = 1.0f + __builtin_amdgcn_exp2f(-LOG2E * g[3]);
                      r2_ = cvt_pk_bf16(er0 * __builtin_amdgcn_rcpf(ea0), er1 * __builtin_amdgcn_rcpf(ea1)); r3_ = cvt_pk_bf16(er2 * __builtin_amdgcn_rcpf(ea2), er3 * __builtin_amdgcn_rcpf(ea3));
                      g2_ = cvt_pk_bf16(__builtin_amdgcn_rcpf(er0), __builtin_amdgcn_rcpf(er1)); g3_ = cvt_pk_bf16(__builtin_amdgcn_rcpf(er2), __builtin_amdgcn_rcpf(er3)); }
                    const u32x4 wr_ = {r0_, r1_, r2_, r3_}, wg_ = {g0_, g1_, g2_, g3_};
                    *(u32x4*)(GA + off) = wr_; *(u32x4*)(GR + off) = wg_;
                    asm volatile("" ::: "memory"); }
            return;
        }
        int mode, ldc, colt; bf16_t* base; const float* bias = nullptr;
        { const size_t boff = (pn < 6) ? WS_V : (pn < 10) ? WS_XR : WS_GY; base = (bf16_t*)(wsb + boff); ldc = (pn < 6) ? DA : DR; colt = (pn - ((pn < 6) ? 4 : (pn < 10) ? 6 : 10)) * BM; mode = (pn < 10) ? 0 : 1; }
        const int col0 = colt + wc * 32 + 8 * fq;
        f32x4 bv[2][2];
#pragma unroll
        for (int bj = 0; bj < 2; ++bj)
#pragma unroll
            for (int n = 0; n < 2; ++n) bv[bj][n] = bias ? *(const f32x4*)(bias + col0 + bj * HALF + 4 * n) : (f32x4){0.f, 0.f, 0.f, 0.f};
#pragma unroll
        for (int ai = 0; ai < 2; ++ai)
#pragma unroll
            for (int m = 0; m < 4; ++m) { bf16_t* rowp = base + (size_t)(row0 + ai * HALF + m * 16) * ldc + col0;
#pragma unroll
                for (int bj = 0; bj < 2; ++bj) { const float r1 = rsu[ai * HALF + m * 16]; f32x4 v0 = acc[ai][bj][m][0] * r1 + bv[bj][0], v1 = acc[ai][bj][m][1] * r1 + bv[bj][1];
                    if (mode == 1) {
#pragma unroll
                        for (int i = 0; i < 4; ++i) { v0[i] = gelu_tanh(v0[i]); v1[i] = gelu_tanh(v1[i]); } }
                    else if (mode == 2) {
#pragma unroll
                        for (int i = 0; i < 4; ++i) { v0[i] = fast_sigmoid(v0[i]); v1[i] = fast_sigmoid(v1[i]); } }
                    u32x4 w; w.x = cvt_pk_bf16(v0[0], v0[1]); w.y = cvt_pk_bf16(v0[2], v0[3]); w.z = cvt_pk_bf16(v1[0], v1[1]); w.w = cvt_pk_bf16(v1[2], v1[3]);
                    *(u32x4*)(rowp + bj * HALF) = w; } }
    }
};

struct EpiMerge {
    static constexpr bool PERM = true;
    const bf16_t *GA, *GR; bf16_t* O;
    __device__ __forceinline__ void mid(Acc& acc, const Unit& u, int wr, int wc, int fr, int fq) const {
        int row0 = u.pm * BM + wr * 64 + fr, col0 = u.pn * BM + wc * 32 + 8 * fq;
        asm volatile("" : "+v"(row0), "+v"(col0));
#pragma unroll
        for (int ai = 0; ai < 2; ++ai)
#pragma unroll
            for (int m = 0; m < 4; ++m) { const size_t off = (size_t)(row0 + ai * HALF + m * 16) * DM + col0;
#pragma unroll
                for (int bj = 0; bj < 2; ++bj) { const u32x4 a = *(const u32x4*)(GA + off + bj * HALF);
#pragma unroll
                    for (int j = 0; j < 4; ++j) { const unsigned aw = a[j];
                        acc[ai][bj][m][j >> 1][(j & 1) * 2] *= __uint_as_float(aw << 16); acc[ai][bj][m][j >> 1][(j & 1) * 2 + 1] *= __uint_as_float(aw & 0xffff0000u); } }
                if (m & 1) asm volatile("" ::: "memory"); }
    }
    __device__ __forceinline__ void operator()(Acc& acc, const Unit& u, int wr, int wc, int fr, int fq) const {
        const int row0 = u.pm * BM + wr * 64 + fr, col0 = u.pn * BM + wc * 32 + 8 * fq;
#pragma unroll
        for (int ai = 0; ai < 2; ++ai)
#pragma unroll
            for (int m = 0; m < 4; ++m) { const size_t off = (size_t)(row0 + ai * HALF + m * 16) * DM + col0;
#pragma unroll
                for (int bj = 0; bj < 2; ++bj) { const u32x4 r = *(const u32x4*)(GR + off + bj * HALF); u32x4 w;
#pragma unroll
                    for (int j = 0; j < 4; ++j) { const unsigned rw = r[j];
                        const float v0 = acc[ai][bj][m][j >> 1][(j & 1) * 2] * __uint_as_float(rw << 16), v1 = acc[ai][bj][m][j >> 1][(j & 1) * 2 + 1] * __uint_as_float(rw & 0xffff0000u);
                        w[j] = cvt_pk_bf16(v0, v1); }
                    *(u32x4*)(O + img_off(u.pm, wr * 64 + ai * HALF + m * 16 + fr, u.pn * BM + bj * HALF + wc * 32 + 8 * fq, DM / 64)) = w; }
                if (m & 1) asm volatile("" ::: "memory"); }
    }
};

struct EpiX1 {
    static constexpr bool PERM = true;
    const bf16_t* XB; bf16_t* XN2; float* ssq;
    __device__ __forceinline__ void mid(Acc&, const Unit&, int, int, int, int) const {}
    __device__ __forceinline__ void operator()(Acc& acc, const Unit& u, int wr, int wc, int fr, int fq) const {
        const int row0 = u.pm * BM + wr * 64 + fr, col0 = u.pn * BM + wc * 32 + 8 * fq;
#pragma unroll
        for (int ai = 0; ai < 2; ++ai)
#pragma unroll
            for (int m = 0; m < 4; ++m) { const int row = row0 + ai * HALF + m * 16; const size_t off = (size_t)row * DM + col0; float ss = 0.f;
#pragma unroll
                for (int bj = 0; bj < 2; ++bj) { const u32x4 xw = *(const u32x4*)(XB + off + bj * HALF);
                    const f32x4 x0 = {__uint_as_float(xw.x << 16), __uint_as_float(xw.x & 0xffff0000u), __uint_as_float(xw.y << 16), __uint_as_float(xw.y & 0xffff0000u)};
                    const f32x4 x1 = {__uint_as_float(xw.z << 16), __uint_as_float(xw.z & 0xffff0000u), __uint_as_float(xw.w << 16), __uint_as_float(xw.w & 0xffff0000u)};
                    const f32x4 v0 = acc[ai][bj][m][0] + x0, v1 = acc[ai][bj][m][1] + x1;
                    u32x4 w; w.x = cvt_pk_bf16(v0[0], v0[1]); w.y = cvt_pk_bf16(v0[2], v0[3]); w.z = cvt_pk_bf16(v1[0], v1[1]); w.w = cvt_pk_bf16(v1[2], v1[3]);
                    *(u32x4*)(XN2 + img_off(u.pm, wr * 64 + ai * HALF + m * 16 + fr, u.pn * BM + bj * HALF + wc * 32 + 8 * fq, DM / 64)) = w;
                    ss += ((v0[0] * v0[0] + v0[1] * v0[1]) + (v0[2] * v0[2] + v0[3] * v0[3])) + ((v1[0] * v1[0] + v1[1] * v1[1]) + (v1[2] * v1[2] + v1[3] * v1[3])); }
                ss += __shfl_xor(ss, 16); ss += __shfl_xor(ss, 32);
                if (fq == 0) ssq[(size_t)row * 16 + u.pn * 4 + wc] = ss;
                if (m & 1) asm volatile("" ::: "memory"); }
    }
};

struct EpiH {
    static constexpr bool PERM = true;
    const LAS float* rs; bf16_t* H;
    __device__ __forceinline__ void mid(Acc&, const Unit&, int, int, int, int) const {}
    __device__ __forceinline__ void operator()(Acc& acc, const Unit& u, int wr, int wc, int fr, int fq) const {
        const int lrow0 = wr * 64 + fr;
        const LAS float* rsu = rs + u.idx * BM;
#pragma unroll
        for (int ai = 0; ai < 2; ++ai)
#pragma unroll
            for (int m = 0; m < 4; ++m) { const int lrow = lrow0 + ai * HALF + m * 16;
                const float rstd = rsu[lrow];
                bf16_t* rowp = H + (((size_t)u.pm * (DFF / 64) + u.pn * 4 + (wc >> 1)) * 2 + ai) * (HTB / 2) + lds_byte(wr * 64 + m * 16 + fr, (wc & 1) * 32 + 8 * fq) / 2;
#pragma unroll
                for (int bj = 0; bj < 2; ++bj) { f32x4 v0 = acc[ai][bj][m][0] * rstd, v1 = acc[ai][bj][m][1] * rstd;
#pragma unroll
                    for (int i = 0; i < 4; ++i) { const float a = fmaxf(v0[i], 0.f), b = fmaxf(v1[i], 0.f); v0[i] = a * a; v1[i] = b * b; }
                    u32x4 w; w.x = cvt_pk_bf16(v0[0], v0[1]); w.y = cvt_pk_bf16(v0[2], v0[3]); w.z = cvt_pk_bf16(v1[0], v1[1]); w.w = cvt_pk_bf16(v1[2], v1[3]);
                    *(u32x4*)(rowp + bj * (2 * 256 * 64)) = w; } }
    }
};

struct EpiOut {
    static constexpr bool PERM = true;
    const bf16_t* XN2; float* OUT;
    __device__ __forceinline__ void mid(Acc&, const Unit&, int, int, int, int) const {}
    __device__ __forceinline__ void operator()(Acc& acc, const Unit& u, int wr, int wc, int fr, int fq) const {
        const int row0 = u.pm * BM + wr * 64 + fr, col0 = u.pn * BM + wc * 32 + 8 * fq;
#pragma unroll
        for (int ai = 0; ai < 2; ++ai)
#pragma unroll
            for (int m = 0; m < 4; ++m) { const size_t off = (size_t)(row0 + ai * HALF + m * 16) * DM + col0;
#pragma unroll
                for (int bj = 0; bj < 2; ++bj) { const u32x4 xw = *(const u32x4*)(XN2 + img_off(u.pm, wr * 64 + ai * HALF + m * 16 + fr, u.pn * BM + bj * HALF + wc * 32 + 8 * fq, DM / 64));
                    const f32x4 x0 = {__uint_as_float(xw.x << 16), __uint_as_float(xw.x & 0xffff0000u), __uint_as_float(xw.y << 16), __uint_as_float(xw.y & 0xffff0000u)};
                    const f32x4 x1 = {__uint_as_float(xw.z << 16), __uint_as_float(xw.z & 0xffff0000u), __uint_as_float(xw.w << 16), __uint_as_float(xw.w & 0xffff0000u)};
                    *(f32x4*)(OUT + off + bj * HALF) = acc[ai][bj][m][0] + x0; *(f32x4*)(OUT + off + bj * HALF + 4) = acc[ai][bj][m][1] + x1; }
                if (m & 1) asm volatile("" ::: "memory"); }
    }
};
}

#define XB_TMO      128
#define XB_XCNT(j)  (256  + 64 * (j))
#define XB_XSUB(j)  (1280 + 64 * (j))
#define XB_XGEN(j)  (2304 + 64 * (j))
#define XB_TOP      3328
#define XB_TOPGEN   3392
#define XCD_BAR_WORDS 3456
#define XB_SPIN_CAP (1u << 18)
__device__ __forceinline__ unsigned xb_ld(unsigned* p)              { return __hip_atomic_load(p, __ATOMIC_RELAXED, __HIP_MEMORY_SCOPE_AGENT); }
__device__ __forceinline__ unsigned xb_add(unsigned* p, unsigned v) { return __hip_atomic_fetch_add(p, v, __ATOMIC_RELAXED, __HIP_MEMORY_SCOPE_AGENT); }
__device__ __forceinline__ unsigned xb_xcc_id() { return (unsigned)__builtin_amdgcn_s_getreg((3 << 11) | 20) & 0xFu; }
#define XB_SPIN(cond, bar) do { unsigned _sp = 0; while (cond) { __builtin_amdgcn_s_sleep(1); \
    if ((++_sp & 255u) == 0u) { if (xb_ld(&(bar)[XB_TMO])) break; if (_sp > XB_SPIN_CAP) { atomicAdd(&(bar)[XB_TMO], 1u); break; } } } } while (0)
struct XcdBarrier { unsigned* bar; unsigned x; volatile LAS unsigned* st; };
__device__ __forceinline__ XcdBarrier xcd_barrier_post(unsigned* bar, volatile LAS unsigned* st) {
    XcdBarrier b; b.bar = bar; b.x = xb_xcc_id(); b.st = st;
    if (threadIdx.x == 0) (void)xb_add(&bar[XB_XCNT(b.x)], 1u);
    return b;
}
__device__ __forceinline__ void xcd_barrier_complete(unsigned* bar, unsigned x, unsigned& nloc, unsigned& nx) {
    const unsigned G = gridDim.x * gridDim.y * gridDim.z;
    unsigned sum, cnt, mine, sp = 0u;
    for (;;) {
        sum = 0u; cnt = 0u; mine = 0u;
#pragma unroll
        for (unsigned j = 0; j < 16; ++j) { const unsigned c = xb_ld(&bar[XB_XCNT(j)]); sum += c; cnt += (c > 0u) ? 1u : 0u; mine = (j == x) ? c : mine; }
        if (sum == G) break;
        __builtin_amdgcn_s_sleep(1);
        if ((++sp & 255u) == 0u) { if (xb_ld(&bar[XB_TMO])) break; if (sp > XB_SPIN_CAP) { atomicAdd(&bar[XB_TMO], 1u); break; } }
    }
    nloc = mine > 0u ? mine : 1u; nx = cnt > 0u ? cnt : 1u;
}
__device__ __forceinline__ void xcd_barrier(const XcdBarrier& b) {
    asm volatile("s_waitcnt vmcnt(0)" ::: "memory");
    __syncthreads();
    if (threadIdx.x == 0) {
        unsigned* bar = b.bar;
        __builtin_amdgcn_s_waitcnt(0);
        unsigned nloc = b.st[0], nx = b.st[1];
        if (nloc == 0u) { xcd_barrier_complete(bar, b.x, nloc, nx); b.st[0] = nloc; b.st[1] = nx; }
        const unsigned old = xb_add(&bar[XB_XSUB(b.x)], 1u);
        const unsigned gen = old / nloc;
        if (old + 1u == (gen + 1u) * nloc) {
            __builtin_amdgcn_fence(__ATOMIC_RELEASE, "agent");
            asm volatile("s_waitcnt vmcnt(0)" ::: "memory");
            const unsigned og = xb_add(&bar[XB_TOP], 1u);
            const unsigned tg = og / nx;
            if (og + 1u == (tg + 1u) * nx) xb_add(&bar[XB_TOPGEN], 1u);
            else XB_SPIN(xb_ld(&bar[XB_TOPGEN]) == tg, bar);
            __builtin_amdgcn_fence(__ATOMIC_ACQUIRE, "agent");
            xb_add(&bar[XB_XGEN(b.x)], 1u);
            asm volatile("s_waitcnt vmcnt(0)" ::: "memory");
        } else {
            XB_SPIN(xb_ld(&bar[XB_XGEN(b.x)]) == gen, bar);
            __builtin_amdgcn_fence(__ATOMIC_ACQUIRE, "agent");
            asm volatile("s_waitcnt vmcnt(0)" ::: "memory");
        }
    }
    __syncthreads();
}

constexpr int RING_OFF = 0, RING_BYTES = 131072;
constexpr int LDSCTL_OFF = RING_BYTES, MISC_OFF = LDSCTL_OFF + 320;
constexpr int LDS_BYTES = 147456;
constexpr int NWAVES = 8;

struct Args { const float* in[20]; float* out; unsigned char* ws; int ph_lo, ph_hi, flags, pad; };

template <int RMAP>
__device__ __forceinline__ int p0_rowmap(int n) {
    if (RMAP == 1) { if (n < 1024) { const int pn = n >> 8, lc = n & 255, hh = lc >> 6, d = lc & 63; return pn * 256 + 128 * (d >> 5) + 32 * hh + (d & 31); }
        if (n >= 3584) { const int isr = n >= 4608, c = n - (isr ? 4608 : 3584); return 256 * (14 + (c >> 7)) + 128 * isr + (c & 127); }
        return n; }
    return n;
}
template <int RMAP>
__device__ __forceinline__ void p0_transpose_item(const float* W, int N, bf16_t* WT, int ldt, int koff, const float* kscale, LAS float* scr, int item, int lane) {
    const int nblk = N / 32, kb = item / nblk, nb = item % nblk, k0 = 64 * kb, n0 = 32 * nb;
    float wv_[32];
#pragma unroll
    for (int i = 0; i < 32; ++i) { const int kk = 2 * i + (lane >> 5); wv_[i] = W[(size_t)(k0 + kk) * N + n0 + (lane & 31)]; }
    if (kscale) {
#pragma unroll
        for (int i = 0; i < 32; ++i) wv_[i] *= kscale[k0 + 2 * i + (lane >> 5)]; }
#pragma unroll
    for (int i = 0; i < 32; ++i) scr[(2 * i + (lane >> 5)) * 33 + (lane & 31)] = wv_[i];
    asm volatile("s_waitcnt lgkmcnt(0)" ::: "memory");
    const int c = lane & 7;
#pragma unroll
    for (int j = 0; j < 4; ++j) { const int n = (lane >> 3) + 8 * j; const LAS float* s = scr + (8 * c) * 33 + n;
        u32x4 o; o.x = pk2(s[0 * 33], s[1 * 33]); o.y = pk2(s[2 * 33], s[3 * 33]); o.z = pk2(s[4 * 33], s[5 * 33]); o.w = pk2(s[6 * 33], s[7 * 33]);
        *(u32x4*)(WT + (size_t)p0_rowmap<RMAP>(n0 + n) * ldt + koff + k0 + 8 * c) = o; }
    asm volatile("s_waitcnt lgkmcnt(0)" ::: "memory");
}
__device__ __forceinline__ void rms_row_to_bf16(const f32x4 (&v)[4], float* rstd_out, bf16_t* orow, int lane) {
    float s = 0.f;
#pragma unroll
    for (int j = 0; j < 4; ++j) s += (v[j].x * v[j].x + v[j].y * v[j].y) + (v[j].z * v[j].z + v[j].w * v[j].w);
    const float rstd = 1.f / sqrtf(wave_sum(s) * (1.f / DM) + EPS);
    if (lane == 0) *rstd_out = rstd;
    unsigned p[4][2];
#pragma unroll
    for (int j = 0; j < 4; ++j) { p[j][0] = pk2(v[j].x, v[j].y); p[j][1] = pk2(v[j].z, v[j].w); }
    const bool odd = lane & 1;
#pragma unroll
    for (int h = 0; h < 2; ++h) {
        const unsigned s0 = odd ? p[2 * h][0] : p[2 * h + 1][0], s1 = odd ? p[2 * h][1] : p[2 * h + 1][1];
        const unsigned r0 = __shfl_xor(s0, 1), r1 = __shfl_xor(s1, 1);
        u32x4 o; if (odd) { o.x = r0; o.y = r1; o.z = p[2 * h + 1][0]; o.w = p[2 * h + 1][1]; } else { o.x = p[2 * h][0]; o.y = p[2 * h][1]; o.z = r0; o.w = r1; }
        *(u32x4*)(orow + 256 * (2 * h + (odd ? 1 : 0)) + 8 * (lane >> 1)) = o; }
}

namespace attn_body {
using bf16=__hip_bfloat16;
using s16x4=__attribute__((ext_vector_type(4)))short;
using f32x16=__attribute__((ext_vector_type(16)))float;
constexpr int D=64,PQ=::DA,PO=::OC;
constexpr int NW=8,QBLK=32,QB=QBLK*NW,KVBLK=64,NQB=::SEQ/QB;
constexpr int TAB_N=384, LDS_TAB=86016;
__device__ __forceinline__ int crow(int r,int hi){return (r&3)+8*(r>>2)+4*hi;}
#define SBAR() __builtin_amdgcn_sched_barrier(0)
__device__ __forceinline__ void bmask(f32x16&p0,f32x16&p1,int jb,int qrel,int hi,const __attribute__((address_space(3))) float*tab){
  const int base=qrel-64*jb-4*hi+255;
  #pragma unroll
  for(int r=0;r<16;++r){const int i0=base-((r&3)+8*(r>>2)); const int j0=i0<368?i0:368; const int i1=i0-32; const int j1=i1<368?i1:368; p0[r]+=tab[j0]; p1[r]+=tab[j1];}
}

constexpr int NSLOT=3, SLOTB=8192;
constexpr int LDS_K=0, LDS_V=NSLOT*SLOTB, LDS_WS=2*NSLOT*SLOTB, LDS_OST=LDS_WS+NW*64*4, LDS_BYTES=LDS_OST+NW*4096;
__device__ __forceinline__ void glds16(const void*gsrc,unsigned lds_dst){unsigned keep;
  asm volatile("s_mov_b32 %0, m0\n\ts_mov_b32 m0, %2\n\ts_nop 0\n\tglobal_load_lds_dwordx4 %1, off\n\ts_mov_b32 m0, %0":"=&s"(keep):"v"(gsrc),"s"(lds_dst):"memory");}
__device__ __forceinline__ float max3f(float a,float b,float c){float r;asm("v_max3_f32 %0, %1, %2, %3":"=v"(r):"v"(a),"v"(b),"v"(c));return r;}
__device__ __forceinline__ float max2f(float a,float b){float r;asm("v_max_f32_e32 %0, %1, %2":"=v"(r):"v"(a),"v"(b));return r;}
__device__ __forceinline__ float fadd_s(float a,float b){float r;asm("v_add_f32_e32 %0, %1, %2":"=v"(r):"v"(a),"v"(b));return r;}
__device__ __forceinline__ float fsub_s(float a,float b){float r;asm("v_sub_f32_e32 %0, %1, %2":"=v"(r):"v"(a),"v"(b));return r;}
typedef float f32x2_t __attribute__((ext_vector_type(2))); typedef __bf16 bf16x2_t __attribute__((ext_vector_type(2)));
__device__ __forceinline__ unsigned cvtpk_s(float lo,float hi){f32x2_t v={lo,hi};bf16x2_t b=__builtin_convertvector(v,bf16x2_t);return __builtin_bit_cast(unsigned,b);}
#define WAIT_BAR(N) asm volatile("s_waitcnt vmcnt(" #N ") lgkmcnt(0)\n\ts_barrier":::"memory")

__device__ __forceinline__ void qkt(f32x16&p0,f32x16&p1,const char*Kslot,const bf16x8*qr,const f32x16&negm,int r32,int hi){
  const char*kb=Kslot+hi*1024+r32*16;
  #pragma unroll
  for(int d0=0;d0<4;++d0){
    const bf16x8 b0=*reinterpret_cast<const bf16x8*>(kb+d0*2048);
    const bf16x8 b1=*reinterpret_cast<const bf16x8*>(kb+d0*2048+512);
    if(d0==0){p0=__builtin_amdgcn_mfma_f32_32x32x16_bf16(b0,qr[0],negm,0,0,0);p1=__builtin_amdgcn_mfma_f32_32x32x16_bf16(b1,qr[0],negm,0,0,0);}
    else{p0=__builtin_amdgcn_mfma_f32_32x32x16_bf16(b0,qr[d0],p0,0,0,0);p1=__builtin_amdgcn_mfma_f32_32x32x16_bf16(b1,qr[d0],p1,0,0,0);}}
}
typedef __attribute__((address_space(3))) const char* lds_cptr;
typedef short v4i16_t __attribute__((ext_vector_type(4)));
__device__ __forceinline__ void kload8(bf16x8*kf,lds_cptr kp){
  kf[0]=*(const __attribute__((address_space(3))) bf16x8*)(kp);      kf[1]=*(const __attribute__((address_space(3))) bf16x8*)(kp+512);
  kf[2]=*(const __attribute__((address_space(3))) bf16x8*)(kp+2048); kf[3]=*(const __attribute__((address_space(3))) bf16x8*)(kp+2560);
  kf[4]=*(const __attribute__((address_space(3))) bf16x8*)(kp+4096); kf[5]=*(const __attribute__((address_space(3))) bf16x8*)(kp+4608);
  kf[6]=*(const __attribute__((address_space(3))) bf16x8*)(kp+6144); kf[7]=*(const __attribute__((address_space(3))) bf16x8*)(kp+6656);
}
__device__ __forceinline__ void kload2(bf16x8*kf,lds_cptr kp,int j){ kf[2*j]=*(const __attribute__((address_space(3))) bf16x8*)(kp+j*2048); kf[2*j+1]=*(const __attribute__((address_space(3))) bf16x8*)(kp+j*2048+512); }
__device__ __forceinline__ s16x4 vtr(lds_cptr p){ return __builtin_bit_cast(s16x4,__builtin_amdgcn_ds_read_tr16_b64_v4i16((__attribute__((address_space(3))) v4i16_t*)p)); }
__device__ __forceinline__ float rowmax(const f32x16&p0,const f32x16&p1){
  float a=max3f(p0[0],p0[1],p1[0]),b=max3f(p0[2],p0[3],p1[1]);a=max3f(a,p1[2],p1[3]);
  #pragma unroll
  for(int r=4;r<16;r+=4){a=max3f(a,p0[r],p0[r+1]);b=max3f(b,p0[r+2],p0[r+3]);a=max3f(a,p1[r],p1[r+1]);b=max3f(b,p1[r+2],p1[r+3]);}
  const float m=max2f(a,b);
  auto rr=__builtin_amdgcn_permlane32_swap(__float_as_uint(m),__float_as_uint(m),false,false);
  return max2f(__uint_as_float(rr[0]),__uint_as_float(rr[1]));
}
__device__ __forceinline__ void pv(f32x16*o,int vb,bf16x8 pa0,bf16x8 pa1,bf16x8 pa2,bf16x8 pa3){
  #pragma unroll
  for(int d0=0;d0<2;++d0){s16x4 lo[4],hi[4];
    #pragma unroll
    for(int ks=0;ks<4;++ks){
      asm volatile("ds_read_b64_tr_b16 %0,%1 offset:%c2":"=&v"(lo[ks]):"v"(vb),"i"(d0*4096+ks*1024):"memory");
      asm volatile("ds_read_b64_tr_b16 %0,%1 offset:%c2":"=&v"(hi[ks]):"v"(vb),"i"(d0*4096+ks*1024+512):"memory");}
    asm volatile("s_waitcnt lgkmcnt(0)":::"memory");SBAR();
    #define PK(k) (bf16x8){lo[k][0],lo[k][1],lo[k][2],lo[k][3],hi[k][0],hi[k][1],hi[k][2],hi[k][3]}
    o[d0]=__builtin_amdgcn_mfma_f32_32x32x16_bf16(pa0,PK(0),o[d0],0,0,0);
    o[d0]=__builtin_amdgcn_mfma_f32_32x32x16_bf16(pa1,PK(1),o[d0],0,0,0);
    o[d0]=__builtin_amdgcn_mfma_f32_32x32x16_bf16(pa2,PK(2),o[d0],0,0,0);
    o[d0]=__builtin_amdgcn_mfma_f32_32x32x16_bf16(pa3,PK(3),o[d0],0,0,0);
    #undef PK
  }
}

#ifndef ATTN_STORE16
#define ATTN_STORE16(p,v) (*(u32x4*)(p)=(v))
#endif
template<int THRL> __device__ __forceinline__ void attn_unit(int b,int h,int qb,const bf16*Q,const bf16*__restrict__ K,const bf16*__restrict__ V,const unsigned short*__restrict__ kmh,const unsigned short*__restrict__ kml,bf16*O,char*shm){
  const int tid=threadIdx.x,lane=tid&63,r32=lane&31,hi=lane>>5; const int wid=__builtin_amdgcn_readfirstlane(tid>>6);
  const long rowbase=(long)b*::SEQ; const int q0=qb*QB;
  const bf16*Qw=Q+(rowbase+q0+wid*QBLK)*PQ+h*D;
  const bf16*Kh=K+rowbase*PQ+h*D,*Vh=V+rowbase*PQ+h*D;
  const unsigned lds0=(unsigned)(uintptr_t)shm;
  float*wsf=(float*)(shm+LDS_WS)+wid*64;
  const bf16*ksrc=Kh+(long)lane*PQ+wid*8;
  const bf16*vsrc=Vh+(long)(16*(wid&3)+(lane>>2))*PQ+(wid>>2)*32+(lane&3)*8;
  const unsigned kdst=lds0+LDS_K+wid*1024, vdst=lds0+LDS_V+wid*1024;
  #define TOFF(t) ((long)(((t)<4)?(q0+KVBLK*(t)):(KVBLK*((t)-4)))*PQ)
  #define DMA_K(t,slot) glds16(ksrc+TOFF(t),(unsigned)__builtin_amdgcn_readfirstlane(kdst+(slot)))
  #define DMA_V(t,slot) glds16(vsrc+TOFF(t),(unsigned)__builtin_amdgcn_readfirstlane(vdst+(slot)))
  const int vb0=(int)(lds0+LDS_V)+((lane>>4)&1)*32+(lane&3)*8+(4*hi+((lane&15)>>2))*64;
  const char*Kbase=shm+LDS_K; bf16x8 kf[8];
  const lds_cptr shm3=(lds_cptr)shm; const lds_cptr kp0=shm3+LDS_K+hi*1024+r32*16; const lds_cptr vp0=shm3+LDS_V+((lane>>4)&1)*32+(lane&3)*8+(4*hi+((lane&15)>>2))*64;
  const int NT=(q0+QB)/KVBLK;
  DMA_K(0,0);DMA_V(0,0);DMA_K(1,SLOTB);
  bf16x8 qr[4];
  #pragma unroll
  for(int d0=0;d0<4;++d0)qr[d0]=*reinterpret_cast<const bf16x8*>(&Qw[(long)r32*PQ+d0*16+hi*8]);
  float mhat=0.f,l_reg=0.f;f32x16 o[2];o[0]=f32x16{};o[1]=f32x16{};f32x16 negm=f32x16{};asm volatile("":"+v"(negm));
  const int qrel=wid*QBLK+r32;
  const __attribute__((address_space(3))) float*tab=(const __attribute__((address_space(3))) float*)((lds_cptr)shm+LDS_TAB)+h*TAB_N;
  unsigned selmask=0u;
  if(qb>0){
    f32x16 gacc=f32x16{};
    const size_t ko=((size_t)(b*::NH+h)*::NKB+(r32&15))*D+hi*8;
    #pragma unroll
    for(int d0=0;d0<4;++d0){ const bf16x8 ah=*(const bf16x8*)(kmh+ko+d0*16), al=*(const bf16x8*)(kml+ko+d0*16);
      gacc=__builtin_amdgcn_mfma_f32_32x32x16_bf16(ah,qr[d0],gacc,0,0,0);
      gacc=__builtin_amdgcn_mfma_f32_32x32x16_bf16(al,qr[d0],gacc,0,0,0); }
    float g[16];
    #pragma unroll
    for(int r=0;r<4;++r){ const float m0=gacc[r],o0=__shfl_xor(m0,32),m1=gacc[4+r],o1=__shfl_xor(m1,32);
      g[r]=hi?o0:m0; g[4+r]=hi?m0:o0; g[8+r]=hi?o1:m1; g[12+r]=hi?m1:o1; }
    #pragma unroll
    for(int j=0;j<16;++j) if(j>=qb) g[j]=-INFINITY;
    #pragma unroll
    for(int rd=0;rd<3;++rd){ float best=-INFINITY; int bi=-1;
      #pragma unroll
      for(int j=0;j<16;++j) if(g[j]>best){best=g[j];bi=j;}
      if(bi>=0) selmask|=1u<<bi;
      #pragma unroll
      for(int j=0;j<16;++j) if(j==bi) g[j]=-INFINITY; }
  }
  #define SELT(t) (((t)<4)||((selmask>>(((t)-4)>>2))&1u))
  #define CMASK(P0,P1,t) do{ if((t)<4){ const int rmax_=wid*32+31-64*(t), rmin_=wid*32-64*(t)-63; if(rmax_<0){ _Pragma("unroll") for(int r=0;r<16;++r){P0[r]=-INFINITY;P1[r]=-INFINITY;} } else if(rmin_<=112) bmask(P0,P1,(t),qrel,hi,tab); } \
    else if((t)>=NT-2){ const int q0_=wid*32+128-64*((t)-(NT-2)); if(q0_-63<=112) bmask(P0,P1,0,qrel+128-64*((t)-(NT-2)),hi,tab); } }while(0)
  bool resc=false;
  #define START(P0,P1) do{ const float rm=rowmax(P0,P1); resc=false; \
    { const float dl=rm; mhat=fadd_s(mhat,dl); \
      _Pragma("unroll") for(int r=0;r<16;++r){P0[r]=fsub_s(P0[r],dl);P1[r]=fsub_s(P1[r],dl);} \
      _Pragma("unroll") for(int r=0;r<16;++r)negm[r]=-mhat; asm volatile("":"+v"(negm)); } \
    _Pragma("unroll") for(int r=0;r<16;++r)P0[r]=__builtin_amdgcn_exp2f(P0[r]); }while(0)
  #define RESC() do{ if(resc){ asm volatile("s_waitcnt lgkmcnt(0)":::"memory"); \
      _Pragma("unroll") for(int d_=0;d_<2;++d_) _Pragma("unroll") for(int r=0;r<16;++r)o[d_][r]*=wsf[crow(r,hi)]; } }while(0)
  f32x16 pA0,pA1,pB0,pB1;
  int sl_prev=0,sl_cur=0,sl_next=SLOTB;
  #define ROT() do{sl_prev=sl_cur;sl_cur=sl_next;sl_next=(sl_next==(NSLOT-1)*SLOTB)?0:sl_next+SLOTB;}while(0)
  DMA_K(2,2*SLOTB);
  WAIT_BAR(3);
  qkt(pA0,pA1,Kbase,qr,negm,r32,hi);asm volatile("s_nop 15\n\ts_nop 7":"+v"(pA0),"+v"(pA1));CMASK(pA0,pA1,0);
  START(pA0,pA1);
  _Pragma("unroll") for(int r=0;r<16;++r)pA1[r]=__builtin_amdgcn_exp2f(pA1[r]);
  WAIT_BAR(0);
  DMA_K(3,0);DMA_V(1,SLOTB);
  ROT();
  kload8(kf,kp0+sl_cur);
  WAIT_BAR(2);
  s16x4 vlo[8],vhi[8]; u32x4 pw0,pw1,pw2,pw3;
  #define PKW(P,B) cvtpk_s(P[B],P[B+1])
  #define PAF(k) __builtin_bit_cast(bf16x8,pw##k)
  #define VFR(i) (bf16x8){vlo[i][0],vlo[i][1],vlo[i][2],vlo[i][3],vhi[i][0],vhi[i][1],vhi[i][2],vhi[i][3]}
  #define PIN(x) asm volatile("":"+v"(x))
  #define MX3(a,b,c) __builtin_fmaxf(__builtin_fmaxf((a),(b)),(c))
  #define GAPA(MF,A0,A1,A2,A3,W0,W1,PW) do{ MF; sacc+=A0; sacc+=A1; sacc+=A2; sacc+=A3; PIN(sacc); W0; W1; PIN(PW); SBAR(); }while(0)
  #define EX(v) __builtin_amdgcn_exp2f(v)
  #define GAPB(MF,X,B) do{ MF; X[B]=EX(X[B]); X[B+1]=EX(X[B+1]); X[B+2]=EX(X[B+2]); X[B+3]=EX(X[B+3]); PIN(X); SBAR(); }while(0)
  #define VRD(i) do{ vlo[i]=vtr(vp_+(((i)>>2)*4096+((i)&3)*1024)); vhi[i]=vtr(vp_+(((i)>>2)*4096+((i)&3)*1024+512)); }while(0)
  #define KRD(G,j) do{ if(G){ kload2(kf,kp0+sl_next,j); SBAR(); } }while(0)
  #define STEP(C0,C1,P0,P1,t,GK,GV,GL) do{ SBAR(); \
    { const float nv_=SELT(t)?-mhat:-INFINITY; _Pragma("unroll") for(int r=0;r<16;++r)negm[r]=nv_; asm volatile("":"+v"(negm)); } SBAR(); \
    const lds_cptr vp_=vp0+sl_prev; \
    VRD(0); SBAR(); float sacc=(P0[0]+P0[1]); \
    GAPA(C0=__builtin_amdgcn_mfma_f32_32x32x16_bf16(kf[0],qr[0],negm,0,0,0), P0[2],P0[3],P0[4],P0[5],     pw0[0]=PKW(P0,0), pw0[1]=PKW(P0,2), pw0); \
    VRD(4); SBAR(); GAPA(C1=__builtin_amdgcn_mfma_f32_32x32x16_bf16(kf[1],qr[0],negm,0,0,0), P0[6],P0[7],P0[8],P0[9],     pw0[2]=PKW(P0,4), pw0[3]=PKW(P0,6), pw0); \
    VRD(1); SBAR(); GAPA(C0=__builtin_amdgcn_mfma_f32_32x32x16_bf16(kf[2],qr[1],C0,0,0,0),   P0[10],P0[11],P0[12],P0[13], pw1[0]=PKW(P0,8), pw1[1]=PKW(P0,10), pw1); \
    VRD(5); SBAR(); GAPA(C1=__builtin_amdgcn_mfma_f32_32x32x16_bf16(kf[3],qr[1],C1,0,0,0),   P0[14],P0[15],P1[0],P1[1],   pw1[2]=PKW(P0,12),pw1[3]=PKW(P0,14), pw1); \
    VRD(2); SBAR(); GAPA(C0=__builtin_amdgcn_mfma_f32_32x32x16_bf16(kf[4],qr[2],C0,0,0,0),   P1[2],P1[3],P1[4],P1[5],     pw2[0]=PKW(P1,0), pw2[1]=PKW(P1,2), pw2); \
    VRD(6); SBAR(); GAPA(C1=__builtin_amdgcn_mfma_f32_32x32x16_bf16(kf[5],qr[2],C1,0,0,0),   P1[6],P1[7],P1[8],P1[9],     pw2[2]=PKW(P1,4), pw2[3]=PKW(P1,6), pw2); \
    VRD(3); SBAR(); GAPA(C0=__builtin_amdgcn_mfma_f32_32x32x16_bf16(kf[6],qr[3],C0,0,0,0),   P1[10],P1[11],P1[12],P1[13], pw3[0]=PKW(P1,8), pw3[1]=PKW(P1,10), pw3); \
    VRD(7); SBAR(); GAPA(C1=__builtin_amdgcn_mfma_f32_32x32x16_bf16(kf[7],qr[3],C1,0,0,0),   P1[14],P1[15],0.f,0.f,       pw3[2]=PKW(P1,12),pw3[3]=PKW(P1,14), pw3); \
    l_reg+=sacc; \
    if(GK){DMA_K((t)+3,sl_cur);} if(GV){DMA_V((t)+1,sl_next);} \
    if(MASKON){CMASK(C0,C1,t);} \
    { float a=MX3(C0[0],C0[1],C1[0]),b=MX3(C0[2],C0[3],C1[1]); a=MX3(a,C1[2],C1[3]); \
      _Pragma("unroll") for(int r=4;r<16;r+=4){a=MX3(a,C0[r],C0[r+1]);b=MX3(b,C0[r+2],C0[r+3]);a=MX3(a,C1[r],C1[r+1]);b=MX3(b,C1[r+2],C1[r+3]);} \
      float rm=__builtin_fmaxf(a,b); { auto rr=__builtin_amdgcn_permlane32_swap(__float_as_uint(rm),__float_as_uint(rm),false,false); rm=__builtin_fmaxf(__uint_as_float(rr[0]),__uint_as_float(rr[1])); } \
      resc=false; \
      if(__builtin_expect(__any(rm>(float)THRL),0)){ const float dl=__builtin_fmaxf(rm,0.f); mhat+=dl; \
        _Pragma("unroll") for(int r=0;r<16;++r){C0[r]-=dl;C1[r]-=dl;} \
        const float f=__builtin_amdgcn_exp2f(-dl); l_reg*=f; if(hi==0)wsf[r32]=f; resc=true; } } \
    SBAR(); \
    GAPB(o[0]=__builtin_amdgcn_mfma_f32_32x32x16_bf16(PAF(0),VFR(0),o[0],0,0,0), C0,0); \
    GAPB(o[1]=__builtin_amdgcn_mfma_f32_32x32x16_bf16(PAF(0),VFR(4),o[1],0,0,0), C0,4); \
    KRD(GL,0); GAPB(o[0]=__builtin_amdgcn_mfma_f32_32x32x16_bf16(PAF(1),VFR(1),o[0],0,0,0), C0,8); \
    KRD(GL,1); GAPB(o[1]=__builtin_amdgcn_mfma_f32_32x32x16_bf16(PAF(1),VFR(5),o[1],0,0,0), C0,12); \
    KRD(GL,2); GAPB(o[0]=__builtin_amdgcn_mfma_f32_32x32x16_bf16(PAF(2),VFR(2),o[0],0,0,0), C1,0); \
    KRD(GL,3); GAPB(o[1]=__builtin_amdgcn_mfma_f32_32x32x16_bf16(PAF(2),VFR(6),o[1],0,0,0), C1,4); \
    GAPB(o[0]=__builtin_amdgcn_mfma_f32_32x32x16_bf16(PAF(3),VFR(3),o[0],0,0,0), C1,8); \
    GAPB(o[1]=__builtin_amdgcn_mfma_f32_32x32x16_bf16(PAF(3),VFR(7),o[1],0,0,0), C1,12); \
    }while(0)
  int t=1;
  #define MASKON 1
  for(;t<4&&t+3<NT;t+=2){
    STEP(pB0,pB1,pA0,pA1,t,true,true,true);     WAIT_BAR(2); RESC(); ROT();
    STEP(pA0,pA1,pB0,pB1,t+1,true,true,true);   WAIT_BAR(2); RESC(); ROT();
  }
  #undef MASKON
  #define MASKON 0
  for(;t+3<NT;t+=2){
    STEP(pB0,pB1,pA0,pA1,t,true,true,true);     WAIT_BAR(2); RESC(); ROT();
    STEP(pA0,pA1,pB0,pB1,t+1,true,true,true);   WAIT_BAR(2); RESC(); ROT();
  }
  #undef MASKON
  #define MASKON 1
  STEP(pB0,pB1,pA0,pA1,t,false,true,true);      WAIT_BAR(1); RESC(); ROT();
  STEP(pA0,pA1,pB0,pB1,t+1,false,true,true);    WAIT_BAR(0); RESC(); ROT();
  STEP(pB0,pB1,pA0,pA1,NT-1,false,false,false); RESC();
  { float sacc=pB0[0]+pB0[1]; _Pragma("unroll") for(int r=2;r<16;++r)sacc+=pB0[r]; _Pragma("unroll") for(int r=0;r<16;++r)sacc+=pB1[r]; l_reg+=sacc;
    pw0=(u32x4){PKW(pB0,0),PKW(pB0,2),PKW(pB0,4),PKW(pB0,6)};pw1=(u32x4){PKW(pB0,8),PKW(pB0,10),PKW(pB0,12),PKW(pB0,14)};pw2=(u32x4){PKW(pB1,0),PKW(pB1,2),PKW(pB1,4),PKW(pB1,6)};pw3=(u32x4){PKW(pB1,8),PKW(pB1,10),PKW(pB1,12),PKW(pB1,14)};
    SBAR(); pv(o,vb0+sl_cur,PAF(0),PAF(1),PAF(2),PAF(3)); }
  #undef PKW
  #undef PAF
  #undef VFR
  #undef PIN
  #undef MX3
  #undef GAPA
  #undef GAPB
  #undef EX
  #undef VRD
  #undef KRD
  #undef STEP
  {auto rr=__builtin_amdgcn_permlane32_swap(__float_as_uint(l_reg),__float_as_uint(l_reg),false,false);l_reg=__uint_as_float(rr[0])+__uint_as_float(rr[1]);}
  if(hi==0)wsf[32+r32]=l_reg;asm volatile("s_waitcnt lgkmcnt(0)":::"memory");
  float rli[16];
  #pragma unroll
  for(int r=0;r<16;++r)rli[r]=__builtin_amdgcn_rcpf(wsf[32+crow(r,hi)]);
  bf16*Ow=O+(rowbase+q0+wid*QBLK)*PO+h*D;
  { bf16*stg=(bf16*)(shm+LDS_OST)+wid*2048;
    #pragma unroll
    for(int r=0;r<16;++r){const int orow=crow(r,hi);
      #pragma unroll
      for(int d0=0;d0<2;++d0)stg[orow*64+d0*32+r32]=__float2bfloat16(o[d0][r]*rli[r]);}
    asm volatile("s_waitcnt lgkmcnt(0)":::"memory");
    #pragma unroll
    for(int i=0;i<4;++i){const int row=i*8+(lane>>3),ch=lane&7; const u32x4 v=*(const u32x4*)(stg+row*64+ch*8); ATTN_STORE16(Ow+(long)row*PO+ch*8,v);} }
  asm volatile("s_waitcnt lgkmcnt(0)\n\ts_barrier":::"memory");
  #undef DMA_K
  #undef TOFF
  #undef SELT
  #undef MASKON
  #undef DMA_V
  #undef CMASK
  #undef START
  #undef RESC
  #undef ROT
}
constexpr int ATTN_LDS_BYTES=LDS_BYTES;
struct AttnTensors { const bf16* Q; const bf16* K; const bf16* V; const unsigned short* kmh; const unsigned short* kml; const float* rel_bias; bf16* O; };
struct AttnUnit { int bh; int qb; };
struct StaticOrder {
  int vcu;
  __device__ __forceinline__ explicit StaticOrder(int v):vcu(v){}
  __device__ __forceinline__ bool next(int i,AttnUnit&u)const{ if(i>=4)return false; const int s=vcu&3; u.bh=vcu>>2; u.qb=(i==0)?15-s:(i==1)?8+s:(i==2)?7-s:s; return true; }
};
template<int THRL=8> __device__ __forceinline__ void attn_phase(char*lds,const AttnTensors&T,int vcu0,int G){
  { __attribute__((address_space(3))) float*tb=(__attribute__((address_space(3))) float*)((lds_cptr)lds+LDS_TAB);
    for(int i=threadIdx.x;i<8*TAB_N;i+=NW*64){ const int hh=i/TAB_N,k=i%TAB_N,rel=k-255; float v=0.f;
      if(rel<0)v=-INFINITY; else if(rel<=112)v=(T.rel_bias[::t5_bucket(rel)*::NH+hh]-T.rel_bias[31*::NH+hh])*::LOG2E;
      tb[i]=v; }
    asm volatile("s_waitcnt lgkmcnt(0)\n\ts_barrier":::"memory"); }
  for(int v=vcu0;v<256;v+=G){ const StaticOrder S(v); AttnUnit u;
    for(int i=0;S.next(i,u);++i) attn_unit<THRL>(u.bh / ::NH, u.bh % ::NH, u.qb,T.Q,T.K,T.V,T.kmh,T.kml,T.O,lds); }
}
#undef SBAR
#undef WAIT_BAR
}

namespace rnn {
typedef float f32x16 __attribute__((ext_vector_type(16)));
constexpr int NCHK = 16, CHT = SEQ / NCHK, TILES = CHT / 32;
constexpr int LDS_BEXT = 98304, LDS_CW = LDS_BEXT + 24576, LDS_STG = 0;
__device__ __forceinline__ void fill_tables(LAS unsigned char* lds, int blk, const float* __restrict__ Wa, const float* __restrict__ Wi, const float* __restrict__ cw, const float* __restrict__ cb, int tid) {
#pragma unroll 1
    for (int it = 0; it < (24 * 64) / (NWAVES * 64); ++it) { const int e = tid + it * (NWAVES * 64);
        const int frag = e >> 6, ln = e & 63, ntile = frag >> 2, ks = frag & 3, n = ln & 31, hi = ln >> 5;
        const int col = (ntile & 1) * 32 + n, k0 = 16 * ks + 8 * hi;
        const float* W = (ntile < 2 ? Wa : Wi) + (size_t)blk * RBD * RBD + col;
        u32x4 w;
#pragma unroll
        for (int j2 = 0; j2 < 4; ++j2) { const int k = k0 + 2 * j2; float v0, v1;
            if (ntile < 4) { v0 = W[k * RBD]; v1 = W[(k + 1) * RBD]; } else { v0 = (k == col) ? 1.f : 0.f; v1 = (k + 1 == col) ? 1.f : 0.f; }
            w[j2] = pk2(v0, v1); }
        *(LAS u32x4*)(lds + LDS_BEXT + e * 16) = w;
    }
    if (tid < 5 * 64) { const int e = tid, j = e >> 6, c = e & 63; ((LAS float*)(lds + LDS_CW))[e] = (j < 4) ? cw[j * DR + blk * RBD + c] : cb[blk * RBD + c]; }
}
template <bool FINAL>
__device__ __forceinline__ void scan_chunk(LAS unsigned char* lds, int b, int blk, int chunk, int wave, int lane, const bf16_t* __restrict__ XR, const bf16_t* __restrict__ GY,
                                           const float* __restrict__ ba, const float* __restrict__ bi, const float* __restrict__ lam, float* comp, bf16_t* __restrict__ O) {
    const int r32 = lane & 31, hi = lane >> 5;
    float cba[2], cbi[2], c8[2], H[2], Ac[2];
#pragma unroll
    for (int nt = 0; nt < 2; ++nt) { const int ch = blk * RBD + 32 * nt + r32; cba[nt] = -LOG2E * ba[ch]; cbi[nt] = -LOG2E * bi[ch]; c8[nt] = -8.0f * LOG2E * log1pf(expf(-lam[ch])); H[nt] = 0.f; Ac[nt] = 1.f; }
    if (FINAL) {
        for (int k = 0; k < chunk; ++k) {
#pragma unroll
            for (int nt = 0; nt < 2; ++nt) { const f32x2 c = *(const f32x2*)(comp + (((size_t)b * NCHK + k) * DR + blk * RBD + 32 * nt + r32) * 2); H[nt] = c[0] * H[nt] + c[1]; } }
    }
    const size_t row0 = (size_t)b * SEQ + (size_t)chunk * CHT;
    const LAS f32x4* cwp = (const LAS f32x4*)(lds + LDS_CW) + 2 * hi;
    const LAS bf16x8* bfr = (const LAS bf16x8*)(lds + LDS_BEXT) + lane;
    LAS bf16_t* stg = (LAS bf16_t*)(lds + LDS_STG + wave * 4096);
    u32x4 xraw[4][4];
#define RNN_LOAD_TILE(tl) do { const int tpos_ = chunk * CHT + (tl) * 32 + r32; const bf16_t* xp_ = XR + (row0 + (tl) * 32 + r32) * DR + blk * RBD + 8 * hi; \
        _Pragma("unroll") for (int ks_ = 0; ks_ < 4; ++ks_) { xraw[ks_][3] = *(const u32x4*)(xp_ + 16 * ks_); \
            _Pragma("unroll") for (int j_ = 0; j_ < 3; ++j_) { const bool ok_ = (tpos_ + j_ - 3) >= 0; const u32x4 v_ = *(const u32x4*)(xp_ + (ok_ ? (long)(j_ - 3) * DR : 0) + 16 * ks_); xraw[ks_][j_] = ok_ ? v_ : (u32x4){0u, 0u, 0u, 0u}; } } } while (0)
    RNN_LOAD_TILE(0);
    for (int tile = 0; tile < TILES; ++tile) {
        u32x4 gyv[4];
        if (FINAL) {
#pragma unroll
            for (int i = 0; i < 4; ++i) gyv[i] = *(const u32x4*)(GY + (row0 + tile * 32 + 8 * i + (lane >> 3)) * DR + blk * RBD + (lane & 7) * 8);
        }
        bf16x8 af[4];
#pragma unroll
        for (int ks = 0; ks < 4; ++ks) {
            f32x4 alo = cwp[64 + 4 * ks], ahi = cwp[64 + 4 * ks + 1];
#pragma unroll
            for (int j = 0; j < 4; ++j) { const f32x4 wlo = cwp[16 * j + 4 * ks], whi = cwp[16 * j + 4 * ks + 1]; const u32x4 x = xraw[ks][j];
                const f32x4 xlo = {__uint_as_float(x[0] << 16), __uint_as_float(x[0] & 0xffff0000u), __uint_as_float(x[1] << 16), __uint_as_float(x[1] & 0xffff0000u)};
                const f32x4 xhi = {__uint_as_float(x[2] << 16), __uint_as_float(x[2] & 0xffff0000u), __uint_as_float(x[3] << 16), __uint_as_float(x[3] & 0xffff0000u)};
                alo += wlo * xlo; ahi += whi * xhi; }
            u32x4 pk; pk[0] = cvt_pk_bf16(alo[0], alo[1]); pk[1] = cvt_pk_bf16(alo[2], alo[3]); pk[2] = cvt_pk_bf16(ahi[0], ahi[1]); pk[3] = cvt_pk_bf16(ahi[2], ahi[3]);
            af[ks] = __builtin_bit_cast(bf16x8, pk);
        }
        if (tile + 1 < TILES) RNN_LOAD_TILE(tile + 1);
#pragma unroll
        for (int nt = 0; nt < 2; ++nt) {
            f32x16 aR = f32x16{}, aI = f32x16{}, aX = f32x16{};
#pragma unroll
            for (int ks = 0; ks < 4; ++ks) {
                aR = __builtin_amdgcn_mfma_f32_32x32x16_bf16(af[ks], bfr[64 * (4 * nt + ks)], aR, 0, 0, 0);
                aI = __builtin_amdgcn_mfma_f32_32x32x16_bf16(af[ks], bfr[64 * (4 * (2 + nt) + ks)], aI, 0, 0, 0);
                aX = __builtin_amdgcn_mfma_f32_32x32x16_bf16(af[ks], bfr[64 * (4 * (4 + nt) + ks)], aX, 0, 0, 0); }
            float av[16], uv[16];
#pragma unroll
            for (int r = 0; r < 16; ++r) {
                const float rr = __builtin_amdgcn_rcpf(1.0f + __builtin_amdgcn_exp2f(__builtin_fmaf(aR[r], -LOG2E, cba[nt]))), ii = __builtin_amdgcn_rcpf(1.0f + __builtin_amdgcn_exp2f(__builtin_fmaf(aI[r], -LOG2E, cbi[nt])));
                const float a = __builtin_amdgcn_exp2f(rr * c8[nt]); const float om = __builtin_fmaf(-a, a, 1.0f);
                av[r] = a; uv[r] = __builtin_amdgcn_sqrtf(om) * (ii * aX[r]); }
            float As[4], Bs[4], pA[4], pB[4], st[4];
#pragma unroll
            for (int g = 0; g < 4; ++g) { As[g] = (av[4 * g] * av[4 * g + 1]) * (av[4 * g + 2] * av[4 * g + 3]);
                Bs[g] = ((uv[4 * g] * av[4 * g + 1] + uv[4 * g + 1]) * av[4 * g + 2] + uv[4 * g + 2]) * av[4 * g + 3] + uv[4 * g + 3];
                pA[g] = __shfl_xor(As[g], 32); pB[g] = __shfl_xor(Bs[g], 32); }
            float Hc = H[nt];
#pragma unroll
            for (int g = 0; g < 4; ++g) { const float Ae = hi ? pA[g] : As[g], Be = hi ? pB[g] : Bs[g], Ao = hi ? As[g] : pA[g], Bo = hi ? Bs[g] : pB[g];
                const float h0 = Hc; Hc = Ae * Hc + Be; const float h1 = Hc; Hc = Ao * Hc + Bo; st[g] = hi ? h1 : h0;
                if (!FINAL) Ac[nt] *= Ae * Ao; }
            H[nt] = Hc;
            if (FINAL) {
#pragma unroll
                for (int g = 0; g < 4; ++g) { float h = st[g];
#pragma unroll
                    for (int i = 0; i < 4; ++i) { h = av[4 * g + i] * h + uv[4 * g + i]; stg[(8 * g + 4 * hi + i) * 64 + 32 * nt + r32] = (bf16_t)cvt_pk_bf16(h, h); } }
            }
        }
        if (FINAL) {
            asm volatile("s_waitcnt lgkmcnt(0)" ::: "memory");
#pragma unroll
            for (int i = 0; i < 4; ++i) { const int row = 8 * i + (lane >> 3), c8c = (lane & 7) * 8; const u32x4 hv = *(const LAS u32x4*)(stg + row * 64 + c8c); const u32x4 gv = gyv[i]; u32x4 w;
#pragma unroll
                for (int j = 0; j < 4; ++j) w[j] = cvt_pk_bf16(__uint_as_float(hv[j] << 16) * __uint_as_float(gv[j] << 16), __uint_as_float(hv[j] & 0xffff0000u) * __uint_as_float(gv[j] & 0xffff0000u));
                *(u32x4*)(O + (row0 + tile * 32 + row) * OC + DA + blk * RBD + c8c) = w; }
            asm volatile("s_waitcnt lgkmcnt(0)" ::: "memory");
        }
    }
    if (!FINAL && hi == 0) {
#pragma unroll
        for (int nt = 0; nt < 2; ++nt) *(f32x2*)(comp + (((size_t)b * NCHK + chunk) * DR + blk * RBD + 32 * nt + r32) * 2) = (f32x2){Ac[nt], H[nt]};
    }
}
template <bool FINAL>
__device__ __forceinline__ void scan_phase(LAS unsigned char* lds, int vcu, int G, int wave, int lane, int tid, const bf16_t* XR, const bf16_t* GY, const float* cw, const float* cb, const float* Wa, const float* ba,
                                           const float* Wi, const float* bi, const float* lam, float* comp, bf16_t* O) {
    asm volatile("" : "+v"(lane), "+v"(tid));
    for (int v = vcu; v < 256; v += G) {
        const int b = v >> 5, blk = (v >> 1) & 15, chunk = (v & 1) * 8 + wave;
        __syncthreads();
        fill_tables(lds, blk, Wa, Wi, cw, cb, tid);
        __syncthreads();
        scan_chunk<FINAL>(lds, b, blk, chunk, wave, lane, XR, GY, ba, bi, lam, comp, O);
    }
}
#undef RNN_LOAD_TILE
}

__device__ __forceinline__ void naive_attn_item(int idx, const bf16_t* __restrict__ Q, const bf16_t* __restrict__ K, const bf16_t* __restrict__ V, const float* __restrict__ kmp,
                                                 const float* __restrict__ rel_bias, bf16_t* __restrict__ O, int opitch) {
    const int t = idx % SEQ, h = (idx / SEQ) % NH, b = idx / (SEQ * NH);
    const size_t row = (size_t)b * SEQ + t;
    float q[64];
    { const u32x4* qp = (const u32x4*)(Q + row * DA + h * HD);
#pragma unroll
      for (int c = 0; c < 8; ++c) { const u32x4 w = qp[c];
#pragma unroll
          for (int j = 0; j < 4; ++j) { q[c * 8 + 2 * j] = __uint_as_float(w[j] << 16); q[c * 8 + 2 * j + 1] = __uint_as_float(w[j] & 0xffff0000u); } } }
    const int own = t / KBLK;
    unsigned mask = 0;
    {
        float g[16];
#pragma unroll
        for (int j = 0; j < 16; ++j) { g[j] = -INFINITY;
            if (j < own) { const float* k0 = kmp + (size_t)((b * NKB + j) * 2) * DA + h * HD; const float* k1 = k0 + DA; float s = 0.f;
#pragma unroll
                for (int d = 0; d < 64; ++d) s += q[d] * ((k0[d] + k1[d]) * (1.0f / 256.0f));
                g[j] = s; } }
#pragma unroll
        for (int r = 0; r < 3; ++r) { float best = -INFINITY; int bi = -1;
#pragma unroll
            for (int j = 0; j < 16; ++j) if (g[j] > best) { best = g[j]; bi = j; }
            if (bi >= 0) { mask |= 1u << bi;
#pragma unroll
                for (int j = 0; j < 16; ++j) if (j == bi) g[j] = -INFINITY; } }
    }
    mask |= 1u << own;
    float o[64];
#pragma unroll
    for (int d = 0; d < 64; ++d) o[d] = 0.f;
    float mx = -INFINITY, l = 0.f;
    for (int j = 0; j <= own; ++j) {
        if (!((mask >> j) & 1u)) continue;
        const int kend = (j == own) ? (t - own * KBLK + 1) : KBLK;
        for (int kk = 0; kk < kend; ++kk) {
            const size_t krow = (size_t)b * SEQ + j * KBLK + kk;
            const u32x4* kp = (const u32x4*)(K + krow * DA + h * HD);
            float s = 0.f;
#pragma unroll
            for (int c = 0; c < 8; ++c) { const u32x4 w = kp[c];
#pragma unroll
                for (int jj = 0; jj < 4; ++jj) { s += q[c * 8 + 2 * jj] * __uint_as_float(w[jj] << 16); s += q[c * 8 + 2 * jj + 1] * __uint_as_float(w[jj] & 0xffff0000u); } }
            const int rel = t - (j * KBLK + kk);
            s += rel_bias[t5_bucket(rel) * NH + h] * LOG2E;
            if (s > mx) { const float f = exp2f(mx - s); l *= f;
#pragma unroll
                for (int d = 0; d < 64; ++d) o[d] *= f;
                mx = s; }
            const float p = exp2f(s - mx); l += p;
            const u32x4* vp = (const u32x4*)(V + krow * DA + h * HD);
#pragma unroll
            for (int c = 0; c < 8; ++c) { const u32x4 w = vp[c];
#pragma unroll
                for (int jj = 0; jj < 4; ++jj) { o[c * 8 + 2 * jj] += p * __uint_as_float(w[jj] << 16); o[c * 8 + 2 * jj + 1] += p * __uint_as_float(w[jj] & 0xffff0000u); } }
        }
    }
    const float il = 1.0f / l;
    u32x4* op = (u32x4*)(O + row * opitch + h * HD);
#pragma unroll
    for (int c = 0; c < 8; ++c) { u32x4 w;
#pragma unroll
        for (int jj = 0; jj < 4; ++jj) w[jj] = pk2(o[c * 8 + 2 * jj] * il, o[c * 8 + 2 * jj + 1] * il);
        op[c] = w; }
}

__device__ __forceinline__ void rg_au_ref(float rp, float ip, float xc, float c8sp, float& a, float& u) {
    const float r = 1.0f / (1.0f + expf(-rp)), i = 1.0f / (1.0f + expf(-ip));
    const float la = -c8sp * r; a = expf(la); u = sqrtf(-expm1f(2.0f * la)) * (i * xc);
}
constexpr int NCH = 64, CHL = SEQ / NCH;
template <bool FINAL>
__device__ __forceinline__ void naive_scan_item(int item, int c, LAS float* xcs, const bf16_t* __restrict__ XR, const bf16_t* __restrict__ GY, const float* __restrict__ cw, const float* __restrict__ cb,
                                                const float* __restrict__ Wa, const float* __restrict__ ba, const float* __restrict__ Wi, const float* __restrict__ bi,
                                                const float* __restrict__ lam, float* __restrict__ comp, const float* __restrict__ carry, bf16_t* __restrict__ O) {
    const int blk = item % RB, chunk = (item / RB) % NCH, b = item / (RB * NCH);
    const int ch = blk * RBD + c;
    const float w0 = cw[ch], w1 = cw[DR + ch], w2 = cw[2 * DR + ch], w3 = cw[3 * DR + ch], bb = cb[ch];
    for (int tt = 0; tt < CHL; ++tt) { const int t = chunk * CHL + tt; const bf16_t* xp = XR + ((size_t)b * SEQ + t) * DR + ch;
        float v = bb + w3 * bf2f(xp[0]);
        if (t >= 1) v += w2 * bf2f(xp[-DR]);
        if (t >= 2) v += w1 * bf2f(xp[-2 * DR]);
        if (t >= 3) v += w0 * bf2f(xp[-3 * DR]);
        xcs[tt * 64 + c] = v; }
    asm volatile("s_waitcnt lgkmcnt(0)" ::: "memory");
    const float c8sp = 8.0f * log1pf(expf(-lam[ch]));
    const float bav = ba[ch], biv = bi[ch];
    const float* wa = Wa + (size_t)blk * RBD * RBD + c; const float* wi = Wi + (size_t)blk * RBD * RBD + c;
    float A = 1.f, Bc = 0.f, hst = FINAL ? carry[((size_t)b * NCH + chunk) * DR + ch] : 0.f;
    for (int tt = 0; tt < CHL; ++tt) {
        float rp = bav, ip = biv;
#pragma unroll 8
        for (int d = 0; d < 64; ++d) { const float xv = xcs[tt * 64 + d]; rp += xv * wa[d * RBD]; ip += xv * wi[d * RBD]; }
        float a, u; rg_au_ref(rp, ip, xcs[tt * 64 + c], c8sp, a, u);
        if (FINAL) { hst = a * hst + u; const size_t off = ((size_t)b * SEQ + chunk * CHL + tt); O[off * OC + DA + ch] = (bf16_t)f2bf(hst * bf2f(GY[off * DR + ch])); }
        else { A *= a; Bc = a * Bc + u; }
    }
    if (!FINAL) { float* cp = comp + (((size_t)b * NCH + chunk) * DR + ch) * 2; cp[0] = A; cp[1] = Bc; }
    asm volatile("s_waitcnt lgkmcnt(0)" ::: "memory");
}
__device__ __forceinline__ void naive_scan_prefix_item(int idx, const float* __restrict__ comp, float* __restrict__ carry) {
    const int ch = idx % DR, b = idx / DR;
    float h = 0.f;
    for (int k = 0; k < NCH; ++k) { const size_t o = ((size_t)b * NCH + k) * DR + ch; carry[o] = h; h = comp[o * 2] * h + comp[o * 2 + 1]; }
}

__global__ void __launch_bounds__(NWAVES * 64, 2) mk_fwd(Args args) {
    extern __shared__ __attribute__((aligned(16))) unsigned char lds_raw[];
    LAS unsigned char* lds = (LAS unsigned char*)lds_raw;
    const int tid = threadIdx.x, lane = tid & 63, wave = __builtin_amdgcn_readfirstlane(tid >> 6);
    const int G = gridDim.x; const int bx = blockIdx.x; const int vcu = (G % 8 == 0) ? (bx % 8) * (G / 8) + bx / 8 : bx;
    unsigned char* ws = args.ws;
    unsigned* ctl = (unsigned*)(ws + WS_CTL);
    for (int u = tid; u < (LDS_BYTES - LDSCTL_OFF) / 4; u += NWAVES * 64) ((LAS unsigned*)(lds + LDSCTL_OFF))[u] = 0u;
    __syncthreads();
    volatile LAS unsigned* MISC = (volatile LAS unsigned*)(lds + MISC_OFF);
    const int lo = args.ph_lo, hi = args.ph_hi;
    XcdBarrier bar; bar.bar = ctl + CW_BAR + lo * XCD_BAR_WORDS; bar.x = 0; bar.st = nullptr;
    const bool multi = (hi - lo) > 1;
    if (multi) bar = xcd_barrier_post(ctl + CW_BAR + lo * XCD_BAR_WORDS, MISC + 8);
#define IN(k) (lo <= (k) && (k) < hi)
#define BOTH(k) (IN(k) && IN((k) + 1))
#define GRID_BAR() xcd_barrier(bar)
#define STAGGER(ticks) do { if ((ticks) > 0) { const unsigned long long t0_ = __builtin_amdgcn_s_memrealtime(), d_ = (unsigned long long)(vcu & 3) * (unsigned long long)(ticks); while (__builtin_amdgcn_s_memrealtime() - t0_ < d_) __builtin_amdgcn_s_sleep(8); } } while (0)

    const float* x = args.in[0];
    bf16_t* Wt_in = (bf16_t*)(ws + WS_WIN); bf16_t* Wt_cat = (bf16_t*)(ws + WS_WCAT); bf16_t* Wt_out = (bf16_t*)(ws + WS_WOUT);
    bf16_t* Wt_ff1 = (bf16_t*)(ws + WS_WFF1); bf16_t* Wt_ff2 = (bf16_t*)(ws + WS_WFF2);
    bf16_t* XN = (bf16_t*)(ws + WS_XN); bf16_t* XB = (bf16_t*)(ws + WS_XB); float* rstd1 = (float*)(ws + WS_RSTD1); bf16_t* Qb = (bf16_t*)(ws + WS_Q); bf16_t* Kb = (bf16_t*)(ws + WS_K); bf16_t* Vb = (bf16_t*)(ws + WS_V);
    bf16_t* XR = (bf16_t*)(ws + WS_XR); bf16_t* GY = (bf16_t*)(ws + WS_GY); bf16_t* GA = (bf16_t*)(ws + WS_GA); bf16_t* GR = (bf16_t*)(ws + WS_GR);
    bf16_t* MRG = (bf16_t*)(ws + WS_MRG); bf16_t* HB = (bf16_t*)(ws + WS_H);
    float* kmp = (float*)(ws + WS_KMP); float* ssq = (float*)(ws + WS_SSQ);
    bf16_t* OCAT = (bf16_t*)args.out;

    if ((PHMASK >> 0 & 1) && IN(0)) {
        LAS float* scr = (LAS float*)(lds + RING_OFF + wave * 16384);
        const int gw = vcu * NWAVES + wave, NGW = G * NWAVES;
        constexpr int I_IN = (DM / 64) * (DIN / 32), I_PA = (DA / 64) * (DM / 32), I_PR = (DR / 64) * (DM / 32), I_OUT = (DM / 64) * (DM / 32), I_F1 = (DM / 64) * (DFF / 32), I_F2 = (DFF / 64) * (DM / 32);
        (void)I_PA; (void)I_PR; (void)I_OUT; (void)I_F1; (void)I_F2;
        for (int it = gw; it < I_IN; it += NGW) p0_transpose_item<1>(args.in[2], DIN, Wt_in, DM, 0, args.in[1], scr, it, lane);
        { f32x4 cur[4], nxt[4];
#pragma unroll
          for (int j = 0; j < 4; ++j) cur[j] = ((const f32x4*)(x + (size_t)gw * DM) + lane)[64 * j];
          for (int m = gw; m < M; m += NGW) { const int mn = (m + NGW < M) ? m + NGW : m;
#pragma unroll
              for (int j = 0; j < 4; ++j) nxt[j] = ((const f32x4*)(x + (size_t)mn * DM) + lane)[64 * j];
              rms_row_to_bf16(cur, rstd1 + m, XB + (size_t)m * DM, lane);
#pragma unroll
              for (int j = 0; j < 4; ++j) cur[j] = nxt[j]; } }
        if (BOTH(0)) GRID_BAR();
    }
    if ((PHMASK >> 1 & 1) && IN(1)) {
        pg8::Gemm g = pg8::gemm_rowmajor(XB, Wt_in, DM, DM, DM, DIN, -1, args.flags); pg8::StaticOrder S; S.init(M, DIN, G, bx, WGM_P1);
        LAS float* rs = (LAS float*)(lds + LDSCTL_OFF + 1024);
        { pg8::Unit u0; int nu = 0; while (nu < 11 && S.next(nu, u0)) ++nu;
          for (int e = tid; e < nu * 256; e += NWAVES * 64) { pg8::Unit u1; S.next(e >> 8, u1); rs[e] = rstd1[u1.pm * 256 + (e & 255)]; }
          __syncthreads(); }
        pg8::EpiZ E{Qb, Kb, Vb, XR, GY, GA, GR, kmp, args.in[4], args.in[5], args.in[3], rs, ws, (LAS float*)(lds + LDSCTL_OFF + 13312)};
        STAGGER(STAG1);
        pg8::gemm_phase<pg8::EpiZ, pg8::StaticOrder, false>(lds + RING_OFF, g, S, E);
        if (BOTH(1)) GRID_BAR();
    }
    {
        const float* cw = args.in[7]; const float* cb = args.in[8]; const float* Wa = args.in[9]; const float* ba = args.in[10]; const float* Wi = args.in[11]; const float* bi = args.in[12]; const float* lam = args.in[13];
        float* comp = (float*)(ws + WS_COMP); float* carry = (float*)(ws + WS_CARRY);
        LAS float* xcs = (LAS float*)(lds + RING_OFF + wave * 16384);
        const int gw = vcu * NWAVES + wave, NGW = G * NWAVES;
        const bool pairmode = PAIR_SYNC && (G == 256) && IN(2) && IN(4) && !NAIVE_SCAN;
        if ((PHMASK >> 2 & 1) && IN(2)) {
            if (pairmode) {
#if NAIVE_SCAN
            for (int it = gw; it < BATCH * NCH * RB; it += NGW) naive_scan_item<false>(it, lane, xcs, XR, GY, cw, cb, Wa, ba, Wi, bi, lam, comp, carry, OCAT);
#else
            if (!(args.flags & 4)) rnn::scan_phase<false>(lds, vcu, G, wave, lane, tid, XR, GY, cw, cb, Wa, ba, Wi, bi, lam, comp, OCAT);
#endif
            if (pairmode) {
                asm volatile("s_waitcnt vmcnt(0)" ::: "memory"); __syncthreads();
                if (tid == 0) { __builtin_amdgcn_fence(__ATOMIC_RELEASE, "agent"); asm volatile("s_waitcnt vmcnt(0)" ::: "memory");
                    __hip_atomic_store(ctl + CW_PAIR + 64 * vcu, 1u, __ATOMIC_RELAXED, __HIP_MEMORY_SCOPE_AGENT); }
            }
            }
#if NAIVE_ATTN
            for (int idx = bx * (NWAVES * 64) + tid; idx < BATCH * NH * SEQ; idx += G * NWAVES * 64) naive_attn_item(idx, Qb, Kb, Vb, kmp, args.in[6], OCAT, OC);
#else
            if (!(args.flags & 8)) { const attn_body::AttnTensors AT{(const attn_body::bf16*)Qb, (const attn_body::bf16*)Kb, (const attn_body::bf16*)Vb, (const unsigned short*)(ws + WS_KMH), (const unsigned short*)(ws + WS_KML), args.in[6], (attn_body::bf16*)OCAT};
              attn_body::attn_phase<8>((char*)lds_raw + RING_OFF, AT, vcu, G); }
#endif
            if (!pairmode) {
#if NAIVE_SCAN
            for (int it = gw; it < BATCH * NCH * RB; it += NGW) naive_scan_item<false>(it, lane, xcs, XR, GY, cw, cb, Wa, ba, Wi, bi, lam, comp, carry, OCAT);
#else
            if (!(args.flags & 4)) rnn::scan_phase<false>(lds, vcu, G, wave, lane, tid, XR, GY, cw, cb, Wa, ba, Wi, bi, lam, comp, OCAT);
#endif
                if (BOTH(2)) GRID_BAR();
            }
        }
        if ((PHMASK >> 3 & 1) && IN(3)) {
#if DBG_ATTN
            { float sd = 0.f, sr = 0.f;
              for (size_t i = (size_t)bx * (NWAVES * 64) + tid; i < (size_t)M * DA; i += (size_t)G * NWAVES * 64) { const size_t r = i / DA, c = i % DA;
                  const float a = bf2f(OCAT[r * OC + c]), b = bf2f((XN + (size_t)16 * 1024 * 1024)[r * DA + c]); sd += (a - b) * (a - b); sr += b * b; }
              sd = wave_sum(sd); sr = wave_sum(sr);
              if (lane == 0) { atomicAdd((float*)(ctl + 16), sd); atomicAdd((float*)(ctl + 17), sr); } }
#endif
#if NAIVE_SCAN
            for (int idx = bx * (NWAVES * 64) + tid; idx < BATCH * DR; idx += G * NWAVES * 64) naive_scan_prefix_item(idx, comp, carry);
            if (BOTH(3)) GRID_BAR();
#endif
        }
        if ((PHMASK >> 4 & 1) && IN(4)) {
#if NAIVE_SCAN
            for (int it = gw; it < BATCH * NCH * RB; it += NGW) naive_scan_item<true>(it, lane, xcs, XR, GY, cw, cb, Wa, ba, Wi, bi, lam, comp, carry, OCAT);
#else
            {
                constexpr int I_PA = (DA / 64) * (DM / 32), I_PR = (DR / 64) * (DM / 32), I_OUT = (DM / 64) * (DM / 32), I_F1 = (DM / 64) * (DFF / 32), I_F2 = (DFF / 64) * (DM / 32);
                LAS float* scr = (LAS float*)(lds + RING_OFF + wave * 16384);
                for (int it = gw; it < I_PA + I_PR + I_OUT + I_F1 + I_F2; it += NGW) {
                    int r = it;
                    if (r < I_PA) { p0_transpose_item<0>(args.in[14], DM, Wt_cat, OC, 0, nullptr, scr, r, lane); continue; } r -= I_PA;
                    if (r < I_PR) { p0_transpose_item<0>(args.in[15], DM, Wt_cat, OC, DA, nullptr, scr, r, lane); continue; } r -= I_PR;
                    if (r < I_OUT) { p0_transpose_item<0>(args.in[16], DM, Wt_out, DM, 0, nullptr, scr, r, lane); continue; } r -= I_OUT;
                    if (r < I_F1) { p0_transpose_item<0>(args.in[18], DFF, Wt_ff1, DM, 0, args.in[17], scr, r, lane); continue; } r -= I_F1;
                    p0_transpose_item<0>(args.in[19], DM, Wt_ff2, HP, 0, nullptr, scr, r, lane);
                }
            }
            if (pairmode) {
                if (tid == 0) {
                    if (vcu & 1) { unsigned sp = 0; while (__hip_atomic_load(ctl + CW_PAIR + 64 * (vcu - 1), __ATOMIC_RELAXED, __HIP_MEMORY_SCOPE_AGENT) == 0u) { __builtin_amdgcn_s_sleep(2);
                            if (++sp > (1u << 22)) { __hip_atomic_store(ctl + CW_TMO, 1u, __ATOMIC_RELAXED, __HIP_MEMORY_SCOPE_AGENT); break; } } }
                    __builtin_amdgcn_fence(__ATOMIC_ACQUIRE, "agent"); asm volatile("s_waitcnt vmcnt(0)" ::: "memory"); }
                __syncthreads();
            }
            rnn::scan_phase<true>(lds, vcu, G, wave, lane, tid, XR, GY, cw, cb, Wa, ba, Wi, bi, lam, comp, OCAT);
#endif
            if (BOTH(4)) GRID_BAR();
        }
    }
    if ((PHMASK >> 5 & 1) && IN(5)) {
        pg8::Gemm g = pg8::gemm_rowmajor(OCAT, Wt_cat, OC, OC, OC, DM, DA / 64, args.flags); pg8::StaticOrder S; S.init(M, DM, G, bx, WGM_N4);
        pg8::EpiMerge E{GA, GR, MRG};
        pg8::gemm_phase<pg8::EpiMerge, pg8::StaticOrder, MIDFLAG>(lds + RING_OFF, g, S, E);
        if (BOTH(5)) GRID_BAR();
    }
    if ((PHMASK >> 6 & 1) && IN(6)) {
        pg8::Gemm g = pg8::gemm_rowmajor(MRG, Wt_out, DM, DM, DM, DM, -1, args.flags); g.imgA = 1; g.kstepA = 32768; g.tstepA = (size_t)(DM / 64) * 32768; pg8::StaticOrder S; S.init(M, DM, G, bx, WGM_N4);
        pg8::EpiX1 E{XB, XN, ssq};
        pg8::gemm_phase<pg8::EpiX1, pg8::StaticOrder, false>(lds + RING_OFF, g, S, E);
        if (BOTH(6)) GRID_BAR();
    }
    if ((PHMASK >> 7 & 1) && IN(7)) {
        pg8::Gemm g = pg8::gemm_rowmajor(XN, Wt_ff1, DM, DM, DM, DFF, -1, args.flags); g.imgA = 1; g.kstepA = 32768; g.tstepA = (size_t)(DM / 64) * 32768; pg8::StaticOrder S; S.init(M, DFF, G, bx, WGM_P7);
        LAS float* rs = (LAS float*)(lds + LDSCTL_OFF + 1024);
        { pg8::Unit u0; int nu = 0; while (nu < 8 && S.next(nu, u0)) ++nu;
          for (int e = tid; e < nu * 256; e += NWAVES * 64) { pg8::Unit u1; S.next(e >> 8, u1); const float* sp = ssq + (size_t)(u1.pm * 256 + (e & 255)) * 16;
              const f32x4 s0 = *(const f32x4*)sp, s1 = *(const f32x4*)(sp + 4), s2 = *(const f32x4*)(sp + 8), s3 = *(const f32x4*)(sp + 12);
              const float tot = (((s0[0] + s0[1]) + (s0[2] + s0[3])) + ((s1[0] + s1[1]) + (s1[2] + s1[3]))) + (((s2[0] + s2[1]) + (s2[2] + s2[3])) + ((s3[0] + s3[1]) + (s3[2] + s3[3])));
              rs[e] = 1.0f / sqrtf(tot * (1.0f / DM) + EPS); }
          __syncthreads(); }
        pg8::EpiH E{rs, HB};
        STAGGER(STAG7);
        pg8::gemm_phase<pg8::EpiH, pg8::StaticOrder, false>(lds + RING_OFF, g, S, E);
        if (BOTH(7)) GRID_BAR();
    }
    if ((PHMASK >> 8 & 1) && IN(8)) {
        pg8::Gemm g = pg8::gemm_rowmajor(HB, Wt_ff2, HP, HP, DFF, DM, -1, args.flags); g.imgA = 1; g.kstepA = 32768; g.tstepA = (size_t)(DFF / 64) * 32768;   pg8::StaticOrder S; S.init(M, DM, G, bx, WGM_N4);
        pg8::EpiOut E{XN, args.out};
        pg8::gemm_phase<pg8::EpiOut, pg8::StaticOrder, false>(lds + RING_OFF, g, S, E);
#ifdef PROBE_BARRIERS
        if (multi) { for (int i = 0; i < PROBE_BARRIERS; ++i) GRID_BAR(); }
#endif
#if DBG_ATTN
        GRID_BAR();
        { const float sd = __hip_atomic_load((float*)(ctl + 16), __ATOMIC_RELAXED, __HIP_MEMORY_SCOPE_AGENT), sr = __hip_atomic_load((float*)(ctl + 17), __ATOMIC_RELAXED, __HIP_MEMORY_SCOPE_AGENT);
          const float e = sqrtf(sd / sr) * DBG_AMP;
          for (size_t i = (size_t)bx * (NWAVES * 64) + tid; i < (size_t)M * DM; i += (size_t)G * NWAVES * 64) args.out[i] *= (1.0f + e); }
#endif
    }
#undef IN
#undef BOTH
#undef GRID_BAR
}

#if DBG_ATTN
__global__ void __launch_bounds__(256) naive_attn_k(const bf16_t* Q, const bf16_t* K, const bf16_t* V, const float* kmp, const float* rel_bias, bf16_t* O, int opitch) {
    naive_attn_item(blockIdx.x * 256 + threadIdx.x, Q, K, V, kmp, rel_bias, O, opitch);
}
#endif
constexpr int N_PHASES = 9;
extern "C" void kernel_launch(void* const* d_in, const int* in_sizes, int n_in, void* d_out, int out_size, void* d_ws, size_t ws_size, hipStream_t stream) {
    static int grid = 0;
    if (grid == 0) {
        if (n_in != 20 || in_sizes[0] != M * DM || out_size != M * DM || ws_size < WS_END) { fprintf(stderr, "kernel_launch: unexpected shapes (n_in %d, in0 %d, out %d, ws %zu)\n", n_in, n_in > 0 ? in_sizes[0] : -1, out_size, ws_size); grid = -1; return; }
        int dev = 0, cus = 0;
        if (hipGetDevice(&dev) != hipSuccess || hipDeviceGetAttribute(&cus, hipDeviceAttributeMultiprocessorCount, dev) != hipSuccess) { grid = -1; return; }
        if (hipFuncSetAttribute((const void*)mk_fwd, hipFuncAttributeMaxDynamicSharedMemorySize, LDS_BYTES) != hipSuccess) { fprintf(stderr, "kernel_launch: hipFuncSetAttribute failed\n"); grid = -1; return; }
        (void)hipGetLastError();
        grid = cus;
    }
    if (grid < 0) return;
    (void)hipMemsetAsync((char*)d_ws + WS_CTL, 0, CTL_ZERO_BYTES, stream);
    Args a{};
    for (int i = 0; i < 20; ++i) a.in[i] = (const float*)d_in[i];
    a.out = (float*)d_out; a.ws = (unsigned char*)d_ws;
#if DBG_ATTN
    a.ph_lo = 0; a.ph_hi = 2;
    hipLaunchKernelGGL(mk_fwd, dim3(grid), dim3(NWAVES * 64), LDS_BYTES, stream, a);
    { unsigned char* ws = (unsigned char*)d_ws;
      hipLaunchKernelGGL(naive_attn_k, dim3(BATCH * NH * SEQ / 256), dim3(256), 0, stream, (const bf16_t*)(ws + WS_Q), (const bf16_t*)(ws + WS_K), (const bf16_t*)(ws + WS_V),
                         (const float*)(ws + WS_KMP), (const float*)d_in[6], (bf16_t*)(ws + WS_XN + 32 * MiB), DA); }
    a.ph_lo = 2; a.ph_hi = N_PHASES;
    hipLaunchKernelGGL(mk_fwd, dim3(grid), dim3(NWAVES * 64), LDS_BYTES, stream, a);
#elif defined(PROBE_REP)
#ifndef PROBE_FLAGS
#define PROBE_FLAGS 0
#endif
#ifndef PROBE_LO
#define PROBE_LO PROBE_REP
#endif
    a.ph_lo = 0; a.ph_hi = PROBE_REP + 1;
    hipLaunchKernelGGL(mk_fwd, dim3(grid), dim3(NWAVES * 64), LDS_BYTES, stream, a);
    a.ph_lo = PROBE_LO; a.ph_hi = PROBE_REP + 1; a.flags = PROBE_FLAGS;
    hipLaunchKernelGGL(mk_fwd, dim3(grid), dim3(NWAVES * 64), LDS_BYTES, stream, a);
    a.flags = 0;
    if (PROBE_REP + 1 < N_PHASES) { a.ph_lo = PROBE_REP + 1; a.ph_hi = N_PHASES;
    hipLaunchKernelGGL(mk_fwd, dim3(grid), dim3(NWAVES * 64), LDS_BYTES, stream, a); }
#elif MK_N_LAUNCHES == 1
    a.ph_lo = 0; a.ph_hi = N_PHASES;
    hipLaunchKernelGGL(mk_fwd, dim3(grid), dim3(NWAVES * 64), LDS_BYTES, stream, a);
#else
    for (int p = 0; p < N_PHASES; ++p) { a.ph_lo = p; a.ph_hi = p + 1; hipLaunchKernelGGL(mk_fwd, dim3(grid), dim3(NWAVES * 64), LDS_BYTES, stream, a); }
#endif
}
```

```cpp
#include <hip/hip_runtime.h>
#include <hip/hip_bf16.h>
#include <cstdio>
#include <cstdint>

#ifndef MIDFLAG
#define MIDFLAG true
#endif
#ifndef NAIVE_ATTN
#define NAIVE_ATTN 0
#endif
#ifndef NAIVE_SCAN
#define NAIVE_SCAN 0
#endif
#ifndef DBG_ATTN
#define DBG_ATTN 0
#endif
#ifndef DBG_AMP
#define DBG_AMP 10.0f
#endif
#ifndef STAG1
#define STAG1 0
#endif
#ifndef STAG7
#define STAG7 0
#endif
#ifndef PAIR_SYNC
#define PAIR_SYNC 1
#endif
#ifndef WGM_P1
#define WGM_P1 4
#endif
#ifndef WGM_P7
#define WGM_P7 8
#endif
#ifndef WGM_N4
#define WGM_N4 4
#endif
#ifndef PHMASK
#define PHMASK 0xffff
#endif
#ifndef MK_N_LAUNCHES
#define MK_N_LAUNCHES 1
#endif

constexpr int BATCH = 8, SEQ = 4096, DM = 1024, M = BATCH * SEQ;
constexpr int NH = 8, HD = 64, DA = 512, DR = 1024, DFF = 4096, DIN = 5632;
constexpr int KBLK = 256, NKB = SEQ / KBLK;
constexpr int RB = 16, RBD = 64;
constexpr int OC = DA + DR;
constexpr int HP = DFF + 128;
constexpr float EPS = 1e-6f;
constexpr float LOG2E = 1.4426950408889634f;
constexpr float C2 = 0.125f * LOG2E;

#define LAS __attribute__((address_space(3)))
#define GAS __attribute__((address_space(1)))
typedef unsigned short bf16_t;
typedef short bf16x8 __attribute__((ext_vector_type(8)));
typedef float f32x4 __attribute__((ext_vector_type(4)));
typedef float f32x2 __attribute__((ext_vector_type(2)));
typedef unsigned u32x4 __attribute__((ext_vector_type(4)));
typedef unsigned u32x2 __attribute__((ext_vector_type(2)));

constexpr size_t MiB = 1u << 20;
constexpr size_t WS_CTL = 0, CTL_ZERO_BYTES = 256 * 1024;
constexpr size_t WS_WIN = 2 * MiB;
constexpr size_t WS_WCAT = 13 * MiB;
constexpr size_t WS_WOUT = 16 * MiB;
constexpr size_t WS_WFF1 = 18 * MiB;
constexpr size_t WS_WFF2 = 26 * MiB;
constexpr size_t WS_KMP = 35 * MiB;
constexpr size_t WS_SSQ = 36 * MiB;
constexpr size_t WS_COMP = 38 * MiB;
constexpr size_t WS_CARRY = 42 * MiB;
constexpr size_t WS_KMH = 45 * MiB;
constexpr size_t WS_KML = 45 * MiB + 512 * 1024;
constexpr size_t WS_RSTD1 = 44 * MiB;
constexpr size_t WS_XB = 48 * MiB;
constexpr size_t WS_XR = 112 * MiB;
constexpr size_t WS_GY = 176 * MiB;
constexpr size_t WS_GA = 240 * MiB;
constexpr size_t WS_GR = 304 * MiB;
constexpr size_t WS_H = 112 * MiB;
constexpr size_t WS_K = 368 * MiB;
constexpr size_t WS_V = 400 * MiB;
constexpr size_t WS_MRG = 368 * MiB;
constexpr size_t WS_Q = 432 * MiB;
constexpr size_t WS_XN = 432 * MiB;
constexpr size_t WS_END = 496 * MiB;

constexpr int CW_TMO = 0, CW_BAR = 4096, CW_PAIR = 40000;

__device__ __forceinline__ float bf2f(unsigned short u) { return __uint_as_float(((unsigned)u) << 16); }
__device__ __forceinline__ unsigned f2bf(float f) { unsigned u = __builtin_bit_cast(unsigned, f); return (u + 0x7fffu + ((u >> 16) & 1u)) >> 16; }
__device__ __forceinline__ unsigned pk2(float lo, float hi) { return f2bf(lo) | (f2bf(hi) << 16); }
__device__ __forceinline__ unsigned cvt_pk_bf16(float lo, float hi) { unsigned r; asm volatile("s_nop 0\n\tv_cvt_pk_bf16_f32 %0, %1, %2" : "=v"(r) : "v"(lo), "v"(hi)); return r; }
#ifndef NT_STORES
#define NT_STORES 1
#endif
#if NT_STORES
#define ST16(p, v) __builtin_nontemporal_store((v), (u32x4*)(p))
#define ST16F(p, v) __builtin_nontemporal_store((v), (f32x4*)(p))
#else
#define ST16(p, v) (*(u32x4*)(p) = (v))
#define ST16F(p, v) (*(f32x4*)(p) = (v))
#endif
__device__ __forceinline__ float fast_sigmoid(float x) { return __builtin_amdgcn_rcpf(1.0f + __builtin_amdgcn_exp2f(-LOG2E * x)); }
__device__ __forceinline__ float gelu_tanh(float x) { const float u = x + 0.044715f * x * x * x; return x * __builtin_amdgcn_rcpf(1.0f + __builtin_amdgcn_exp2f(-2.302208198f * u)); }
__device__ __forceinline__ float wave_sum(float v) {
#pragma unroll
    for (int o = 1; o < 64; o <<= 1) v += __shfl_xor(v, o);
    return v;
}
__device__ __forceinline__ int t5_bucket(int n) {
    if (n < 16) return n;
    int b = 16;
    b += (n >= 19); b += (n >= 21); b += (n >= 24); b += (n >= 27); b += (n >= 31); b += (n >= 35); b += (n >= 40); b += (n >= 46);
    b += (n >= 52); b += (n >= 59); b += (n >= 67); b += (n >= 77); b += (n >= 87); b += (n >= 99); b += (n >= 113);
    return b;
}

namespace pg8 {
constexpr int BM = 256, BK = 64, HALF = 128, HTB = HALF * BK * 2, STAGE_BYTES = 8 * HTB, NXCD = 8, WGM = 8;
__host__ __device__ __forceinline__ int lds_byte(int r, int c) { const int st = (r >> 4) * 2 + (c >> 5), rr = r & 15, cc = c & 31, ob = rr * 64 + cc * 2; return st * 1024 + (ob ^ (((ob >> 9) & 1) << 5)); }
__host__ __device__ __forceinline__ void stage_rc(int b, int& R, int& C) { const int st = b / 1024, sb = b % 1024, swz = sb ^ (((sb >> 9) & 1) << 5); R = (st >> 1) * 16 + swz / 64; C = (st & 1) * 32 + (swz % 64) / 2; }
__host__ __device__ __forceinline__ int perm32(int rho) { const int n = rho >> 4, i = rho & 15; return 8 * (i >> 2) + 4 * n + (i & 3); }

struct Unit { int pm, pn, idx; };
struct Gemm { const bf16_t* A; const bf16_t* Bt; int lda, ldb, K, N, mid_t, flags; size_t kstepA, kstepB, tstepA, tstepB; int imgA; };
__host__ __device__ __forceinline__ Gemm gemm_rowmajor(const bf16_t* A, const bf16_t* Bt, int lda, int ldb, int K, int N, int mid_t, int flags) { return Gemm{A, Bt, lda, ldb, K, N, mid_t, flags, (size_t)128, (size_t)128, (size_t)512 * lda, (size_t)512 * ldb, 0}; }

struct StaticOrder {
    int nM, nN, nwg, G, c, wgm;
    __host__ __device__ void init(int M_, int N_, int G_, int c_, int wgm_ = WGM) { nM = M_ / BM; nN = N_ / BM; nwg = nM * nN; G = G_; c = c_; wgm = wgm_; }
    __host__ __device__ bool next(int i, Unit& u) const {
        const long L = (long)i * G + c; if (L >= nwg) return false;
        int wgid = (int)L; { const int q = nwg / NXCD, r = nwg % NXCD, xcd = wgid % NXCD, off = wgid / NXCD; wgid = (xcd < r ? xcd * (q + 1) : r * (q + 1) + (xcd - r) * q) + off; }
        const int nig = wgm * nN, gid = wgid / nig, fm = gid * wgm, gsz = (nM - fm) < wgm ? (nM - fm) : wgm;
        u.pm = fm + ((wgid % nig) % gsz); u.pn = (wgid % nig) / gsz; u.idx = i; return true;
    }
};

typedef f32x4 Acc[2][2][4][2];

template <class Epi, class Sched, bool MID>
__device__ __forceinline__ void gemm_phase(LAS unsigned char* lds, const Gemm g, const Sched& S, const Epi& E) {
    const int tid = threadIdx.x, wid = __builtin_amdgcn_readfirstlane(tid >> 6), lane = tid & 63, wr = wid >> 2, wc = wid & 3, fr = lane & 15, fq = lane >> 4;
    const int nt = g.K / BK;
    unsigned voffA[2], voffB[2];
#pragma unroll
    for (int i = 0; i < 2; ++i) { int R, C; stage_rc(tid * 16 + i * 8192, R, C); const int Rb = Epi::PERM ? ((R & ~31) + perm32(R & 31)) : R;
        voffA[i] = g.imgA ? (unsigned)(tid * 16 + i * 8192) : (unsigned)(R * g.lda + C) * 2u; voffB[i] = (unsigned)(Rb * g.ldb + C) * 2u; }
    const size_t kstepA = g.kstepA, kstepB = g.kstepB;
    const size_t hstepA = g.imgA ? (size_t)HTB : (size_t)HALF * g.lda * 2, hstepB = (size_t)HALF * g.ldb * 2;
    const size_t tstepA = (g.flags & 2) ? 0 : g.tstepA, tstepB = (g.flags & 2) ? 0 : g.tstepB;
    const unsigned ldsw = (unsigned)wid * 1024u;
    const int aoff = lds_byte(wr * 64 + fr, fq * 8), boff = lds_byte(wc * 32 + fr, fq * 8);
#define PG8_SA(b, h) (((b) * 2 + (h)) * HTB)
#define PG8_SB(b, h) ((4 + (b) * 2 + (h)) * HTB)
#define PG8_STAGE(bufoff, gbase, voff) do { _Pragma("unroll") for (int _i = 0; _i < 2; ++_i) \
        __builtin_amdgcn_global_load_lds((const unsigned*)((const char*)(gbase) + (voff)[_i]), (LAS unsigned*)(lds + (bufoff) + ldsw + _i * 8192), 16, 0, 0); } while (0)
#define PG8_LDA(dst, b, h) do { _Pragma("unroll") for (int m = 0; m < 4; ++m) _Pragma("unroll") for (int k = 0; k < 2; ++k) dst[m][k] = *(const LAS bf16x8*)(lds + PG8_SA(b, h) + aoff + m * 2048 + k * 1024); } while (0)
#define PG8_LDB(dst, b, h) do { _Pragma("unroll") for (int n = 0; n < 2; ++n) _Pragma("unroll") for (int k = 0; k < 2; ++k) dst[n][k] = *(const LAS bf16x8*)(lds + PG8_SB(b, h) + boff + n * 2048 + k * 1024); } while (0)
#define PG8_MMA(ai, bj, At, Bt) do { __builtin_amdgcn_s_setprio(1); _Pragma("unroll") for (int m = 0; m < 4; ++m) _Pragma("unroll") for (int n = 0; n < 2; ++n) _Pragma("unroll") for (int k = 0; k < 2; ++k) \
        acc[ai][bj][m][n] = __builtin_amdgcn_mfma_f32_16x16x32_bf16(Bt[n][k], At[m][k], acc[ai][bj][m][n], 0, 0, 0); __builtin_amdgcn_s_setprio(0); } while (0)
#define PG8_WAIT_V(n) asm volatile("s_waitcnt vmcnt(" #n ")" ::: "memory")
#define PG8_WAIT_L(n) asm volatile("s_waitcnt lgkmcnt(" #n ")" ::: "memory")
#define PG8_BAR __builtin_amdgcn_s_barrier()
#define PG8_SCHED __builtin_amdgcn_sched_barrier(0)
    Unit cur, nxt; int ui = 0;
    if (!S.next(0, cur)) return;
    f32x4 acc[2][2][4][2];
#pragma unroll
    for (int a = 0; a < 2; ++a)
#pragma unroll
        for (int b = 0; b < 2; ++b)
#pragma unroll
            for (int m = 0; m < 4; ++m)
#pragma unroll
                for (int n = 0; n < 2; ++n) acc[a][b][m][n] = (f32x4){0.f, 0.f, 0.f, 0.f};
    bf16x8 At[4][2], B0[2][2], B1[2][2];
    const char* cA = (const char*)g.A + (size_t)cur.pm * tstepA; const char* cB = (const char*)g.Bt + (size_t)cur.pn * tstepB;
    PG8_STAGE(PG8_SB(0, 0), cB, voffB); PG8_STAGE(PG8_SB(0, 1), cB + hstepB, voffB); PG8_STAGE(PG8_SA(0, 0), cA, voffA); PG8_STAGE(PG8_SA(0, 1), cA + hstepA, voffA);
    if (wr == 1) PG8_BAR;
    PG8_WAIT_V(2); PG8_BAR;
    PG8_STAGE(PG8_SB(1, 0), cB + kstepB, voffB); PG8_STAGE(PG8_SA(1, 0), cA + kstepA, voffA); PG8_STAGE(PG8_SB(1, 1), cB + hstepB + kstepB, voffB);
    PG8_WAIT_V(6); PG8_BAR;
    for (;;) {
        const bool has_next = S.next(ui + 1, nxt);
        const char* nA = has_next ? (const char*)g.A + (size_t)nxt.pm * tstepA : cA; const char* nB = has_next ? (const char*)g.Bt + (size_t)nxt.pn * tstepB : cB;
        for (int t = 0; t < nt; t += 2) {
            if constexpr (MID) { if (t == g.mid_t) E.mid(acc, cur, wr, wc, fr, fq); }
            const bool last = (t == nt - 2);
            const char* a1 = cA + (size_t)(t + 1) * kstepA;
            const char* a2 = last ? nA : cA + (size_t)(t + 2) * kstepA; const char* b2 = last ? nB : cB + (size_t)(t + 2) * kstepB;
            const char* a3 = a2 + kstepA; const char* b3 = b2 + kstepB;
            PG8_LDB(B0, 0, 0); PG8_LDB(B1, 0, 1); PG8_SCHED; PG8_LDA(At, 0, 0); PG8_STAGE(PG8_SA(1, 1), a1 + hstepA, voffA);
            PG8_WAIT_V(8); PG8_WAIT_L(0); PG8_BAR; PG8_MMA(0, 0, At, B0); PG8_MMA(0, 1, At, B1); PG8_BAR; PG8_SCHED;
            PG8_LDA(At, 0, 1); PG8_STAGE(PG8_SB(0, 0), b2, voffB); PG8_STAGE(PG8_SB(0, 1), b2 + hstepB, voffB); PG8_STAGE(PG8_SA(0, 0), a2, voffA);
            PG8_WAIT_V(8); PG8_WAIT_L(0); PG8_BAR; PG8_MMA(1, 0, At, B0); PG8_MMA(1, 1, At, B1); PG8_BAR; PG8_SCHED;
            PG8_LDB(B0, 1, 0); PG8_LDB(B1, 1, 1); PG8_SCHED; PG8_LDA(At, 1, 0); PG8_STAGE(PG8_SA(0, 1), a2 + hstepA, voffA);
            PG8_WAIT_V(8); PG8_WAIT_L(0); PG8_BAR; PG8_MMA(0, 0, At, B0); PG8_MMA(0, 1, At, B1); PG8_BAR; PG8_SCHED;
            PG8_LDA(At, 1, 1); PG8_STAGE(PG8_SB(1, 0), b3, voffB); PG8_STAGE(PG8_SB(1, 1), b3 + hstepB, voffB); PG8_STAGE(PG8_SA(1, 0), a3, voffA);
            PG8_WAIT_V(8); PG8_WAIT_L(0); PG8_BAR; PG8_MMA(1, 0, At, B0); PG8_MMA(1, 1, At, B1); PG8_BAR; PG8_SCHED;
        }
        if (wr == 0) PG8_BAR;
        if (g.flags & 1) {
#pragma unroll
            for (int a = 0; a < 2; ++a)
#pragma unroll
                for (int b = 0; b < 2; ++b)
#pragma unroll
                    for (int m = 0; m < 4; ++m)
#pragma unroll
                        for (int n = 0; n < 2; ++n) asm volatile("" :: "v"(acc[a][b][m][n]));
        } else E(acc, cur, wr, wc, fr, fq);
        if (!has_next) break;
#pragma unroll
        for (int a = 0; a < 2; ++a)
#pragma unroll
            for (int b = 0; b < 2; ++b)
#pragma unroll
                for (int m = 0; m < 4; ++m)
#pragma unroll
                    for (int n = 0; n < 2; ++n) acc[a][b][m][n] = (f32x4){0.f, 0.f, 0.f, 0.f};
        cur = nxt; cA = nA; cB = nB; ++ui;
        if (wr == 1) PG8_BAR;
    }
    PG8_WAIT_V(0);
    PG8_BAR;
#undef PG8_SA
#undef PG8_SB
#undef PG8_STAGE
#undef PG8_LDA
#undef PG8_LDB
#undef PG8_MMA
#undef PG8_WAIT_V
#undef PG8_WAIT_L
#undef PG8_BAR
#undef PG8_SCHED
}

__device__ __forceinline__ size_t img_off(int pm, int lrow, int col, int KT) { return (((size_t)pm * KT + (col >> 6)) * 2 + (lrow >> 7)) * (size_t)(HTB / 2) + lds_byte(lrow & 127, col & 63) / 2; }
struct EpiZ {
    static constexpr bool PERM = true;
    bf16_t *Q, *K, *V, *XR, *GY, *GA, *GR; float* kmp; const float *qw, *kw, *bg; const LAS float* rs; unsigned char* wsb; LAS float* kx;
    __device__ __forceinline__ void mid(Acc&, const Unit&, int, int, int, int) const {}
    __device__ __forceinline__ void operator()(Acc& acc, const Unit& u, int wr, int wc, int fr, int fq) const {
        const int pn = u.pn; const int row0 = u.pm * BM + wr * 64 + fr;
        const LAS float* rsu = rs + u.idx * BM + wr * 64 + fr;
        if (pn < 4) {
            const bool isq = pn < 2; const int head = (pn & 1) * 4 + wc; const float* nw = isq ? qw : kw; const float osc = isq ? C2 : 1.0f;
            bf16_t* base = (isq ? Q : K) + head * HD + 8 * fq;
            f32x4 wv[2][2];
#pragma unroll
            for (int bj = 0; bj < 2; ++bj)
#pragma unroll
                for (int n = 0; n < 2; ++n) wv[bj][n] = *(const f32x4*)(nw + 32 * bj + 8 * fq + 4 * n) * osc;
            f32x4 cs[2][2];
#pragma unroll
            for (int bj = 0; bj < 2; ++bj)
#pragma unroll
                for (int n = 0; n < 2; ++n) cs[bj][n] = (f32x4){0.f, 0.f, 0.f, 0.f};
#pragma unroll
            for (int ai = 0; ai < 2; ++ai)
#pragma unroll
                for (int m = 0; m < 4; ++m) {
                    float ss = 0.f;
#pragma unroll
                    for (int bj = 0; bj < 2; ++bj)
#pragma unroll
                        for (int n = 0; n < 2; ++n) { const f32x4 v = acc[ai][bj][m][n]; ss += (v[0] * v[0] + v[1] * v[1]) + (v[2] * v[2] + v[3] * v[3]); }
                    ss += __shfl_xor(ss, 16); ss += __shfl_xor(ss, 32);
                    const float r1 = rsu[ai * HALF + m * 16];
                    const float rstd = r1 / sqrtf(ss * (r1 * r1) * (1.0f / 64.0f) + EPS);
                    bf16_t* rowp = base + (size_t)(row0 + ai * HALF + m * 16) * DA;
#pragma unroll
                    for (int bj = 0; bj < 2; ++bj) {
                        const f32x4 v0 = acc[ai][bj][m][0] * rstd * wv[bj][0], v1 = acc[ai][bj][m][1] * rstd * wv[bj][1];
                        cs[bj][0] += v0; cs[bj][1] += v1;
                        u32x4 w; w.x = cvt_pk_bf16(v0[0], v0[1]); w.y = cvt_pk_bf16(v0[2], v0[3]); w.z = cvt_pk_bf16(v1[0], v1[1]); w.w = cvt_pk_bf16(v1[2], v1[3]);
                        ST16(rowp + 32 * bj, w); }
                }
            if (!isq) {
#pragma unroll
                for (int bj = 0; bj < 2; ++bj)
#pragma unroll
                    for (int n = 0; n < 2; ++n)
#pragma unroll
                        for (int i = 0; i < 4; ++i) { float s = cs[bj][n][i]; s += __shfl_xor(s, 1); s += __shfl_xor(s, 2); s += __shfl_xor(s, 4); s += __shfl_xor(s, 8); cs[bj][n][i] = s; }
                if (fr == 0) { float* kp = kmp + (size_t)(u.pm * 2 + wr) * DA + head * HD + 8 * fq;
#pragma unroll
                    for (int bj = 0; bj < 2; ++bj) { *(f32x4*)(kp + 32 * bj) = cs[bj][0]; *(f32x4*)(kp + 32 * bj + 4) = cs[bj][1]; } }
                if (fr == 0) { LAS float* kl = kx + wr * 256 + wc * 64 + 8 * fq;
#pragma unroll
                    for (int bj = 0; bj < 2; ++bj) { *(LAS f32x4*)(kl + 32 * bj) = cs[bj][0]; *(LAS f32x4*)(kl + 32 * bj + 4) = cs[bj][1]; } }
                asm volatile("s_waitcnt lgkmcnt(0)" ::: "memory"); __builtin_amdgcn_s_barrier(); asm volatile("" ::: "memory");
                if (wr == 0) { const int d = fr + 16 * fq; const float mean = (kx[wc * 64 + d] + kx[256 + wc * 64 + d]) * (1.0f / 256.0f);
                    const unsigned hb = f2bf(mean), lb = f2bf(mean - __uint_as_float(hb << 16));
                    const size_t o = ((size_t)((u.pm >> 4) * NH + head) * NKB + (u.pm & 15)) * HD + d;
                    ((bf16_t*)(wsb + WS_KMH))[o] = (bf16_t)hb; ((bf16_t*)(wsb + WS_KML))[o] = (bf16_t)lb; }
            }
            return;
        }
        if (pn >= 14) {
            const int ch0 = (pn - 14) * 128 + wc * 32 + 8 * fq;
            const f32x4 ba0 = *(const f32x4*)(bg + ch0), ba1 = *(const f32x4*)(bg + ch0 + 4), br0 = *(const f32x4*)(bg + DM + ch0), br1 = *(const f32x4*)(bg + DM + ch0 + 4);
#pragma unroll
            for (int ai = 0; ai < 2; ++ai)
#pragma unroll
                for (int m = 0; m < 4; ++m) { const float r1 = rsu[ai * HALF + m * 16]; const size_t off = (size_t)(row0 + ai * HALF + m * 16) * DM + ch0;
                    unsigned r0_, r1_, r2_, r3_, g0_, g1_, g2_, g3_;
                    { const f32x4 a = acc[ai][0][m][0] * r1 + ba0, g = acc[ai][1][m][0] * r1 + br0;
                      const float ea0 = 1.0f + __builtin_amdgcn_exp2f(-LOG2E * a[0]), er0 = 1.0f + __builtin_amdgcn_exp2f(-LOG2E * g[0]), ea1 = 1.0f + __builtin_amdgcn_exp2f(-LOG2E * a[1]), er1 = 1.0f + __builtin_amdgcn_exp2f(-LOG2E * g[1]);
                      const float ea2 = 1.0f + __builtin_amdgcn_exp2f(-LOG2E * a[2]), er2 = 1.0f + __builtin_amdgcn_exp2f(-LOG2E * g[2]), ea3 = 1.0f + __builtin_amdgcn_exp2f(-LOG2E * a[3]), er3 = 1.0f + __builtin_amdgcn_exp2f(-LOG2E * g[3]);
                      r0_ = cvt_pk_bf16(er0 * __builtin_amdgcn_rcpf(ea0), er1 * __builtin_amdgcn_rcpf(ea1)); r1_ = cvt_pk_bf16(er2 * __builtin_amdgcn_rcpf(ea2), er3 * __builtin_amdgcn_rcpf(ea3));
                      g0_ = cvt_pk_bf16(__builtin_amdgcn_rcpf(er0), __builtin_amdgcn_rcpf(er1)); g1_ = cvt_pk_bf16(__builtin_amdgcn_rcpf(er2), __builtin_amdgcn_rcpf(er3)); }
                    { const f32x4 a = acc[ai][0][m][1] * r1 + ba1, g = acc[ai][1][m][1] * r1 + br1;
                      const float ea0 = 1.0f + __builtin_amdgcn_exp2f(-LOG2E * a[0]), er0 = 1.0f + __builtin_amdgcn_exp2f(-LOG2E * g[0]), ea1 = 1.0f + __builtin_amdgcn_exp2f(-LOG2E * a[1]), er1 = 1.0f + __builtin_amdgcn_exp2f(-LOG2E * g[1]);
                      const float ea2 = 1.0f + __builtin_amdgcn_exp2f(-LOG2E * a[2]), er2 = 1.0f + __builtin_amdgcn_exp2f(-LOG2E * g[2]), ea3 = 1.0f + __builtin_amdgcn_exp2f(-LOG2E * a[3]), er3 = 1.0f + __builtin_amdgcn_exp2f(-LOG2E * g[3]);
                      r2_ = cvt_pk_bf16(er0 * __builtin_amdgcn_rcpf(ea0), er1 * __builtin_amdgcn_rcpf(ea1)); r3_ = cvt_pk_bf16(er2 * __builtin_amdgcn_rcpf(ea2), er3 * __builtin_amdgcn_rcpf(ea3));
                      g2_ = cvt_pk_bf16(__builtin_amdgcn_rcpf(er0), __builtin_amdgcn_rcpf(er1)); g3_ = cvt_pk_bf16(__builtin_amdgcn_rcpf(er2), __builtin_amdgcn_rcpf(er3)); }
                    const u32x4 wr_ = {r0_, r1_, r2_, r3_}, wg_ = {g0_, g1_, g2_, g3_};
                    ST16(GA + off, wr_); ST16(GR + off, wg_);
                    asm volatile("" ::: "memory"); }
            return;
        }
        int mode, ldc, colt; bf16_t* base; const float* bias = nullptr;
        { const size_t boff = (pn < 6) ? WS_V : (pn < 10) ? WS_XR : WS_GY; base = (bf16_t*)(wsb + boff); ldc = (pn < 6) ? DA : DR; colt = (pn - ((pn < 6) ? 4 : (pn < 10) ? 6 : 10)) * BM; mode = (pn < 10) ? 0 : 1; }
        const int col0 = colt + wc * 32 + 8 * fq;
        f32x4 bv[2][2];
#pragma unroll
        for (int bj = 0; bj < 2; ++bj)
#pragma unroll
            for (int n = 0; n < 2; ++n) bv[bj][n] = bias ? *(const f32x4*)(bias + col0 + bj * HALF + 4 * n) : (f32x4){0.f, 0.f, 0.f, 0.f};
#pragma unroll
        for (int ai = 0; ai < 2; ++ai)
#pragma unroll
            for (int m = 0; m < 4; ++m) { bf16_t* rowp = base + (size_t)(row0 + ai * HALF + m * 16) * ldc + col0;
#pragma unroll
                for (int bj = 0; bj < 2; ++bj) { const float r1 = rsu[ai * HALF + m * 16]; f32x4 v0 = acc[ai][bj][m][0] * r1 + bv[bj][0], v1 = acc[ai][bj][m][1] * r1 + bv[bj][1];
                    if (mode == 1) {
#pragma unroll
                        for (int i = 0; i < 4; ++i) { v0[i] = gelu_tanh(v0[i]); v1[i] = gelu_tanh(v1[i]); } }
                    else if (mode == 2) {
#pragma unroll
                        for (int i = 0; i < 4; ++i) { v0[i] = fast_sigmoid(v0[i]); v1[i] = fast_sigmoid(v1[i]); } }
                    u32x4 w; w.x = cvt_pk_bf16(v0[0], v0[1]); w.y = cvt_pk_bf16(v0[2], v0[3]); w.z = cvt_pk_bf16(v1[0], v1[1]); w.w = cvt_pk_bf16(v1[2], v1[3]);
                    ST16(rowp + bj * HALF, w); } }
    }
};

struct EpiMerge {
    static constexpr bool PERM = true;
    const bf16_t *GA, *GR; bf16_t* O;
    __device__ __forceinline__ void mid(Acc& acc, const Unit& u, int wr, int wc, int fr, int fq) const {
        int row0 = u.pm * BM + wr * 64 + fr, col0 = u.pn * BM + wc * 32 + 8 * fq;
        asm volatile("" : "+v"(row0), "+v"(col0));
#pragma unroll
        for (int ai = 0; ai < 2; ++ai)
#pragma unroll
            for (int m = 0; m < 4; ++m) { const size_t off = (size_t)(row0 + ai * HALF + m * 16) * DM + col0;
#pragma unroll
                for (int bj = 0; bj < 2; ++bj) { const u32x4 a = *(const u32x4*)(GA + off + bj * HALF);
#pragma unroll
                    for (int j = 0; j < 4; ++j) { const unsigned aw = a[j];
                        acc[ai][bj][m][j >> 1][(j & 1) * 2] *= __uint_as_float(aw << 16); acc[ai][bj][m][j >> 1][(j & 1) * 2 + 1] *= __uint_as_float(aw & 0xffff0000u); } }
                if (m & 1) asm volatile("" ::: "memory"); }
    }
    __device__ __forceinline__ void operator()(Acc& acc, const Unit& u, int wr, int wc, int fr, int fq) const {
        const int row0 = u.pm * BM + wr * 64 + fr, col0 = u.pn * BM + wc * 32 + 8 * fq;
#pragma unroll
        for (int ai = 0; ai < 2; ++ai)
#pragma unroll
            for (int m = 0; m < 4; ++m) { const size_t off = (size_t)(row0 + ai * HALF + m * 16) * DM + col0;
#pragma unroll
                for (int bj = 0; bj < 2; ++bj) { const u32x4 r = *(const u32x4*)(GR + off + bj * HALF); u32x4 w;
#pragma unroll
                    for (int j = 0; j < 4; ++j) { const unsigned rw = r[j];
                        const float v0 = acc[ai][bj][m][j >> 1][(j & 1) * 2] * __uint_as_float(rw << 16), v1 = acc[ai][bj][m][j >> 1][(j & 1) * 2 + 1] * __uint_as_float(rw & 0xffff0000u);
                        w[j] = cvt_pk_bf16(v0, v1); }
                    ST16(O + img_off(u.pm, wr * 64 + ai * HALF + m * 16 + fr, u.pn * BM + bj * HALF + wc * 32 + 8 * fq, DM / 64), w); }
                if (m & 1) asm volatile("" ::: "memory"); }
    }
};

struct EpiX1 {
    static constexpr bool PERM = true;
    const bf16_t* XB; bf16_t* XN2; float* ssq;
    __device__ __forceinline__ void mid(Acc&, const Unit&, int, int, int, int) const {}
    __device__ __forceinline__ void operator()(Acc& acc, const Unit& u, int wr, int wc, int fr, int fq) const {
        const int row0 = u.pm * BM + wr * 64 + fr, col0 = u.pn * BM + wc * 32 + 8 * fq;
#pragma unroll
        for (int ai = 0; ai < 2; ++ai)
#pragma unroll
            for (int m = 0; m < 4; ++m) { const int row = row0 + ai * HALF + m * 16; const size_t off = (size_t)row * DM + col0; float ss = 0.f;
#pragma unroll
                for (int bj = 0; bj < 2; ++bj) { const u32x4 xw = *(const u32x4*)(XB + off + bj * HALF);
                    const f32x4 x0 = {__uint_as_float(xw.x << 16), __uint_as_float(xw.x & 0xffff0000u), __uint_as_float(xw.y << 16), __uint_as_float(xw.y & 0xffff0000u)};
                    const f32x4 x1 = {__uint_as_float(xw.z << 16), __uint_as_float(xw.z & 0xffff0000u), __uint_as_float(xw.w << 16), __uint_as_float(xw.w & 0xffff0000u)};
                    const f32x4 v0 = acc[ai][bj][m][0] + x0, v1 = acc[ai][bj][m][1] + x1;
                    u32x4 w; w.x = cvt_pk_bf16(v0[0], v0[1]); w.y = cvt_pk_bf16(v0[2], v0[3]); w.z = cvt_pk_bf16(v1[0], v1[1]); w.w = cvt_pk_bf16(v1[2], v1[3]);
                    ST16(XN2 + img_off(u.pm, wr * 64 + ai * HALF + m * 16 + fr, u.pn * BM + bj * HALF + wc * 32 + 8 * fq, DM / 64), w);
                    ss += ((v0[0] * v0[0] + v0[1] * v0[1]) + (v0[2] * v0[2] + v0[3] * v0[3])) + ((v1[0] * v1[0] + v1[1] * v1[1]) + (v1[2] * v1[2] + v1[3] * v1[3])); }
                ss += __shfl_xor(ss, 16); ss += __shfl_xor(ss, 32);
                if (fq == 0) ssq[(size_t)row * 16 + u.pn * 4 + wc] = ss;
                if (m & 1) asm volatile("" ::: "memory"); }
    }
};

struct EpiH {
    static constexpr bool PERM = true;
    const LAS float* rs; bf16_t* H;
    __device__ __forceinline__ void mid(Acc&, const Unit&, int, int, int, int) const {}
    __device__ __forceinline__ void operator()(Acc& acc, const Unit& u, int wr, int wc, int fr, int fq) const {
        const int lrow0 = wr * 64 + fr;
        const LAS float* rsu = rs + u.idx * BM;
#pragma unroll
        for (int ai = 0; ai < 2; ++ai)
#pragma unroll
            for (int m = 0; m < 4; ++m) { const int lrow = lrow0 + ai * HALF + m * 16;
                const float rstd = rsu[lrow];
                bf16_t* rowp = H + (((size_t)u.pm * (DFF / 64) + u.pn * 4 + (wc >> 1)) * 2 + ai) * (HTB / 2) + lds_byte(wr * 64 + m * 16 + fr, (wc & 1) * 32 + 8 * fq) / 2;
#pragma unroll
                for (int bj = 0; bj < 2; ++bj) { f32x4 v0 = acc[ai][bj][m][0] * rstd, v1 = acc[ai][bj][m][1] * rstd;
#pragma unroll
                    for (int i = 0; i < 4; ++i) { const float a = fmaxf(v0[i], 0.f), b = fmaxf(v1[i], 0.f); v0[i] = a * a; v1[i] = b * b; }
                    u32x4 w; w.x = cvt_pk_bf16(v0[0], v0[1]); w.y = cvt_pk_bf16(v0[2], v0[3]); w.z = cvt_pk_bf16(v1[0], v1[1]); w.w = cvt_pk_bf16(v1[2], v1[3]);
                    ST16(rowp + bj * (2 * 256 * 64), w); } }
    }
};

struct EpiOut {
    static constexpr bool PERM = true;
    const bf16_t* XN2; float* OUT;
    __device__ __forceinline__ void mid(Acc&, const Unit&, int, int, int, int) const {}
    __device__ __forceinline__ void operator()(Acc& acc, const Unit& u, int wr, int wc, int fr, int fq) const {
        const int row0 = u.pm * BM + wr * 64 + fr, col0 = u.pn * BM + wc * 32 + 8 * fq;
#pragma unroll
        for (int ai = 0; ai < 2; ++ai)
#pragma unroll
            for (int m = 0; m < 4; ++m) { const size_t off = (size_t)(row0 + ai * HALF + m * 16) * DM + col0;
#pragma unroll
                for (int bj = 0; bj < 2; ++bj) { const u32x4 xw = *(const u32x4*)(XN2 + img_off(u.pm, wr * 64 + ai * HALF + m * 16 + fr, u.pn * BM + bj * HALF + wc * 32 + 8 * fq, DM / 64));
                    const f32x4 x0 = {__uint_as_float(xw.x << 16), __uint_as_float(xw.x & 0xffff0000u), __uint_as_float(xw.y << 16), __uint_as_float(xw.y & 0xffff0000u)};
                    const f32x4 x1 = {__uint_as_float(xw.z << 16), __uint_as_float(xw.z & 0xffff0000u), __uint_as_float(xw.w << 16), __uint_as_float(xw.w & 0xffff0000u)};
                    ST16F(OUT + off + bj * HALF, acc[ai][bj][m][0] + x0); ST16F(OUT + off + bj * HALF + 4, acc[ai][bj][m][1] + x1); }
                if (m & 1) asm volatile("" ::: "memory"); }
    }
};
}

#define XB_TMO      128
#define XB_XCNT(j)  (256  + 64 * (j))
#define XB_XSUB(j)  (1280 + 64 * (j))
#define XB_XGEN(j)  (2304 + 64 * (j))
#define XB_TOP      3328
#define XB_TOPGEN   3392
#define XCD_BAR_WORDS 3456
#define XB_SPIN_CAP (1u << 18)
__device__ __forceinline__ unsigned xb_ld(unsigned* p)              { return __hip_atomic_load(p, __ATOMIC_RELAXED, __HIP_MEMORY_SCOPE_AGENT); }
__device__ __forceinline__ unsigned xb_add(unsigned* p, unsigned v) { return __hip_atomic_fetch_add(p, v, __ATOMIC_RELAXED, __HIP_MEMORY_SCOPE_AGENT); }
__device__ __forceinline__ unsigned xb_xcc_id() { return (unsigned)__builtin_amdgcn_s_getreg((3 << 11) | 20) & 0xFu; }
#define XB_SPIN(cond, bar) do { unsigned _sp = 0; while (cond) { __builtin_amdgcn_s_sleep(1); \
    if ((++_sp & 255u) == 0u) { if (xb_ld(&(bar)[XB_TMO])) break; if (_sp > XB_SPIN_CAP) { atomicAdd(&(bar)[XB_TMO], 1u); break; } } } } while (0)
struct XcdBarrier { unsigned* bar; unsigned x; volatile LAS unsigned* st; };
__device__ __forceinline__ XcdBarrier xcd_barrier_post(unsigned* bar, volatile LAS unsigned* st) {
    XcdBarrier b; b.bar = bar; b.x = xb_xcc_id(); b.st = st;
    if (threadIdx.x == 0) (void)xb_add(&bar[XB_XCNT(b.x)], 1u);
    return b;
}
__device__ __forceinline__ void xcd_barrier_complete(unsigned* bar, unsigned x, unsigned& nloc, unsigned& nx) {
    const unsigned G = gridDim.x * gridDim.y * gridDim.z;
    unsigned sum, cnt, mine, sp = 0u;
    for (;;) {
        sum = 0u; cnt = 0u; mine = 0u;
#pragma unroll
        for (unsigned j = 0; j < 16; ++j) { const unsigned c = xb_ld(&bar[XB_XCNT(j)]); sum += c; cnt += (c > 0u) ? 1u : 0u; mine = (j == x) ? c : mine; }
        if (sum == G) break;
        __builtin_amdgcn_s_sleep(1);
        if ((++sp & 255u) == 0u) { if (xb_ld(&bar[XB_TMO])) break; if (sp > XB_SPIN_CAP) { atomicAdd(&bar[XB_TMO], 1u); break; } }
    }
    nloc = mine > 0u ? mine : 1u; nx = cnt > 0u ? cnt : 1u;
}
__device__ __forceinline__ void xcd_barrier(const XcdBarrier& b) {
    asm volatile("s_waitcnt vmcnt(0)" ::: "memory");
    __syncthreads();
    if (threadIdx.x == 0) {
        unsigned* bar = b.bar;
        __builtin_amdgcn_s_waitcnt(0);
        unsigned nloc = b.st[0], nx = b.st[1];
        if (nloc == 0u) { xcd_barrier_complete(bar, b.x, nloc, nx); b.st[0] = nloc; b.st[1] = nx; }
        const unsigned old = xb_add(&bar[XB_XSUB(b.x)], 1u);
        const unsigned gen = old / nloc;
        if (old + 1u == (gen + 1u) * nloc) {
            __builtin_amdgcn_fence(__ATOMIC_RELEASE, "agent");
            asm volatile("s_waitcnt vmcnt(0)" ::: "memory");
            const unsigned og = xb_add(&bar[XB_TOP], 1u);
            const unsigned tg = og / nx;
            if (og + 1u == (tg + 1u) * nx) xb_add(&bar[XB_TOPGEN], 1u);
            else XB_SPIN(xb_ld(&bar[XB_TOPGEN]) == tg, bar);
            __builtin_amdgcn_fence(__ATOMIC_ACQUIRE, "agent");
            xb_add(&bar[XB_XGEN(b.x)], 1u);
            asm volatile("s_waitcnt vmcnt(0)" ::: "memory");
        } else {
            XB_SPIN(xb_ld(&bar[XB_XGEN(b.x)]) == gen, bar);
            __builtin_amdgcn_fence(__ATOMIC_ACQUIRE, "agent");
            asm volatile("s_waitcnt vmcnt(0)" ::: "memory");
        }
    }
    __syncthreads();
}

constexpr int RING_OFF = 0, RING_BYTES = 131072;
constexpr int LDSCTL_OFF = RING_BYTES, MISC_OFF = LDSCTL_OFF + 320;
constexpr int LDS_BYTES = 147456;
constexpr int NWAVES = 8;

struct Args { const float* in[20]; float* out; unsigned char* ws; int ph_lo, ph_hi, flags, pad; };

template <int RMAP>
__device__ __forceinline__ int p0_rowmap(int n) {
    if (RMAP == 1) { if (n < 1024) { const int pn = n >> 8, lc = n & 255, hh = lc >> 6, d = lc & 63; return pn * 256 + 128 * (d >> 5) + 32 * hh + (d & 31); }
        if (n >= 3584) { const int isr = n >= 4608, c = n - (isr ? 4608 : 3584); return 256 * (14 + (c >> 7)) + 128 * isr + (c & 127); }
        return n; }
    return n;
}
template <int RMAP>
__device__ __forceinline__ void p0_transpose_item(const float* W, int N, bf16_t* WT, int ldt, int koff, const float* kscale, LAS float* scr, int item, int lane) {
    const int nblk = N / 32, kb = item / nblk, nb = item % nblk, k0 = 64 * kb, n0 = 32 * nb;
    float wv_[32];
#pragma unroll
    for (int i = 0; i < 32; ++i) { const int kk = 2 * i + (lane >> 5); wv_[i] = __builtin_nontemporal_load(W + (size_t)(k0 + kk) * N + n0 + (lane & 31)); }
    if (kscale) {
#pragma unroll
        for (int i = 0; i < 32; ++i) wv_[i] *= kscale[k0 + 2 * i + (lane >> 5)]; }
#pragma unroll
    for (int i = 0; i < 32; ++i) scr[(2 * i + (lane >> 5)) * 33 + (lane & 31)] = wv_[i];
    asm volatile("s_waitcnt lgkmcnt(0)" ::: "memory");
    const int c = lane & 7;
#pragma unroll
    for (int j = 0; j < 4; ++j) { const int n = (lane >> 3) + 8 * j; const LAS float* s = scr + (8 * c) * 33 + n;
        u32x4 o; o.x = pk2(s[0 * 33], s[1 * 33]); o.y = pk2(s[2 * 33], s[3 * 33]); o.z = pk2(s[4 * 33], s[5 * 33]); o.w = pk2(s[6 * 33], s[7 * 33]);
        *(u32x4*)(WT + (size_t)p0_rowmap<RMAP>(n0 + n) * ldt + koff + k0 + 8 * c) = o; }
    asm volatile("s_waitcnt lgkmcnt(0)" ::: "memory");
}
__device__ __forceinline__ void rms_row_to_bf16(const f32x4 (&v)[4], float* rstd_out, bf16_t* orow, int lane) {
    float s = 0.f;
#pragma unroll
    for (int j = 0; j < 4; ++j) s += (v[j].x * v[j].x + v[j].y * v[j].y) + (v[j].z * v[j].z + v[j].w * v[j].w);
    const float rstd = 1.f / sqrtf(wave_sum(s) * (1.f / DM) + EPS);
    if (lane == 0) *rstd_out = rstd;
    unsigned p[4][2];
#pragma unroll
    for (int j = 0; j < 4; ++j) { p[j][0] = pk2(v[j].x, v[j].y); p[j][1] = pk2(v[j].z, v[j].w); }
    const bool odd = lane & 1;
#pragma unroll
    for (int h = 0; h < 2; ++h) {
        const unsigned s0 = odd ? p[2 * h][0] : p[2 * h + 1][0], s1 = odd ? p[2 * h][1] : p[2 * h + 1][1];
        const unsigned r0 = __shfl_xor(s0, 1), r1 = __shfl_xor(s1, 1);
        u32x4 o; if (odd) { o.x = r0; o.y = r1; o.z = p[2 * h + 1][0]; o.w = p[2 * h + 1][1]; } else { o.x = p[2 * h][0]; o.y = p[2 * h][1]; o.z = r0; o.w = r1; }
        *(u32x4*)(orow + 256 * (2 * h + (odd ? 1 : 0)) + 8 * (lane >> 1)) = o; }
}

namespace attn_body {
using bf16=__hip_bfloat16;
using s16x4=__attribute__((ext_vector_type(4)))short;
using f32x16=__attribute__((ext_vector_type(16)))float;
constexpr int D=64,PQ=::DA,PO=::OC;
constexpr int NW=8,QBLK=32,QB=QBLK*NW,KVBLK=64,NQB=::SEQ/QB;
constexpr int TAB_N=384, LDS_TAB=86016;
__device__ __forceinline__ int crow(int r,int hi){return (r&3)+8*(r>>2)+4*hi;}
#define SBAR() __builtin_amdgcn_sched_barrier(0)
__device__ __forceinline__ void bmask(f32x16&p0,f32x16&p1,int jb,int qrel,int hi,const __attribute__((address_space(3))) float*tab){
  const int base=qrel-64*jb-4*hi+255;
  #pragma unroll
  for(int r=0;r<16;++r){const int i0=base-((r&3)+8*(r>>2)); const int j0=i0<368?i0:368; const int i1=i0-32; const int j1=i1<368?i1:368; p0[r]+=tab[j0]; p1[r]+=tab[j1];}
}

constexpr int NSLOT=3, SLOTB=8192;
constexpr int LDS_K=0, LDS_V=NSLOT*SLOTB, LDS_WS=2*NSLOT*SLOTB, LDS_OST=LDS_WS+NW*64*4, LDS_BYTES=LDS_OST+NW*4096;
__device__ __forceinline__ void glds16(const void*gsrc,unsigned lds_dst){unsigned keep;
  asm volatile("s_mov_b32 %0, m0\n\ts_mov_b32 m0, %2\n\ts_nop 0\n\tglobal_load_lds_dwordx4 %1, off\n\ts_mov_b32 m0, %0":"=&s"(keep):"v"(gsrc),"s"(lds_dst):"memory");}
__device__ __forceinline__ float max3f(float a,float b,float c){float r;asm("v_max3_f32 %0, %1, %2, %3":"=v"(r):"v"(a),"v"(b),"v"(c));return r;}
__device__ __forceinline__ float max2f(float a,float b){float r;asm("v_max_f32_e32 %0, %1, %2":"=v"(r):"v"(a),"v"(b));return r;}
__device__ __forceinline__ float fadd_s(float a,float b){float r;asm("v_add_f32_e32 %0, %1, %2":"=v"(r):"v"(a),"v"(b));return r;}
__device__ __forceinline__ float fsub_s(float a,float b){float r;asm("v_sub_f32_e32 %0, %1, %2":"=v"(r):"v"(a),"v"(b));return r;}
typedef float f32x2_t __attribute__((ext_vector_type(2))); typedef __bf16 bf16x2_t __attribute__((ext_vector_type(2)));
__device__ __forceinline__ unsigned cvtpk_s(float lo,float hi){f32x2_t v={lo,hi};bf16x2_t b=__builtin_convertvector(v,bf16x2_t);return __builtin_bit_cast(unsigned,b);}
#define WAIT_BAR(N) asm volatile("s_waitcnt vmcnt(" #N ") lgkmcnt(0)\n\ts_barrier":::"memory")

__device__ __forceinline__ void qkt(f32x16&p0,f32x16&p1,const char*Kslot,const bf16x8*qr,const f32x16&negm,int r32,int hi){
  const char*kb=Kslot+hi*1024+r32*16;
  #pragma unroll
  for(int d0=0;d0<4;++d0){
    const bf16x8 b0=*reinterpret_cast<const bf16x8*>(kb+d0*2048);
    const bf16x8 b1=*reinterpret_cast<const bf16x8*>(kb+d0*2048+512);
    if(d0==0){p0=__builtin_amdgcn_mfma_f32_32x32x16_bf16(b0,qr[0],negm,0,0,0);p1=__builtin_amdgcn_mfma_f32_32x32x16_bf16(b1,qr[0],negm,0,0,0);}
    else{p0=__builtin_amdgcn_mfma_f32_32x32x16_bf16(b0,qr[d0],p0,0,0,0);p1=__builtin_amdgcn_mfma_f32_32x32x16_bf16(b1,qr[d0],p1,0,0,0);}}
}
typedef __attribute__((address_space(3))) const char* lds_cptr;
typedef short v4i16_t __attribute__((ext_vector_type(4)));
__device__ __forceinline__ void kload8(bf16x8*kf,lds_cptr kp){
  kf[0]=*(const __attribute__((address_space(3))) bf16x8*)(kp);      kf[1]=*(const __attribute__((address_space(3))) bf16x8*)(kp+512);
  kf[2]=*(const __attribute__((address_space(3))) bf16x8*)(kp+2048); kf[3]=*(const __attribute__((address_space(3))) bf16x8*)(kp+2560);
  kf[4]=*(const __attribute__((address_space(3))) bf16x8*)(kp+4096); kf[5]=*(const __attribute__((address_space(3))) bf16x8*)(kp+4608);
  kf[6]=*(const __attribute__((address_space(3))) bf16x8*)(kp+6144); kf[7]=*(const __attribute__((address_space(3))) bf16x8*)(kp+6656);
}
__device__ __forceinline__ void kload2(bf16x8*kf,lds_cptr kp,int j){ kf[2*j]=*(const __attribute__((address_space(3))) bf16x8*)(kp+j*2048); kf[2*j+1]=*(const __attribute__((address_space(3))) bf16x8*)(kp+j*2048+512); }
__device__ __forceinline__ s16x4 vtr(lds_cptr p){ return __builtin_bit_cast(s16x4,__builtin_amdgcn_ds_read_tr16_b64_v4i16((__attribute__((address_space(3))) v4i16_t*)p)); }
__device__ __forceinline__ float rowmax(const f32x16&p0,const f32x16&p1){
  float a=max3f(p0[0],p0[1],p1[0]),b=max3f(p0[2],p0[3],p1[1]);a=max3f(a,p1[2],p1[3]);
  #pragma unroll
  for(int r=4;r<16;r+=4){a=max3f(a,p0[r],p0[r+1]);b=max3f(b,p0[r+2],p0[r+3]);a=max3f(a,p1[r],p1[r+1]);b=max3f(b,p1[r+2],p1[r+3]);}
  const float m=max2f(a,b);
  auto rr=__builtin_amdgcn_permlane32_swap(__float_as_uint(m),__float_as_uint(m),false,false);
  return max2f(__uint_as_float(rr[0]),__uint_as_float(rr[1]));
}
__device__ __forceinline__ void pv(f32x16*o,int vb,bf16x8 pa0,bf16x8 pa1,bf16x8 pa2,bf16x8 pa3){
  #pragma unroll
  for(int d0=0;d0<2;++d0){s16x4 lo[4],hi[4];
    #pragma unroll
    for(int ks=0;ks<4;++ks){
      asm volatile("ds_read_b64_tr_b16 %0,%1 offset:%c2":"=&v"(lo[ks]):"v"(vb),"i"(d0*4096+ks*1024):"memory");
      asm volatile("ds_read_b64_tr_b16 %0,%1 offset:%c2":"=&v"(hi[ks]):"v"(vb),"i"(d0*4096+ks*1024+512):"memory");}
    asm volatile("s_waitcnt lgkmcnt(0)":::"memory");SBAR();
    #define PK(k) (bf16x8){lo[k][0],lo[k][1],lo[k][2],lo[k][3],hi[k][0],hi[k][1],hi[k][2],hi[k][3]}
    o[d0]=__builtin_amdgcn_mfma_f32_32x32x16_bf16(pa0,PK(0),o[d0],0,0,0);
    o[d0]=__builtin_amdgcn_mfma_f32_32x32x16_bf16(pa1,PK(1),o[d0],0,0,0);
    o[d0]=__builtin_amdgcn_mfma_f32_32x32x16_bf16(pa2,PK(2),o[d0],0,0,0);
    o[d0]=__builtin_amdgcn_mfma_f32_32x32x16_bf16(pa3,PK(3),o[d0],0,0,0);
    #undef PK
  }
}

#ifndef ATTN_STORE16
#define ATTN_STORE16(p,v) ST16(p,v)
#endif
template<int THRL> __device__ __forceinline__ void attn_unit(int b,int h,int qb,const bf16*Q,const bf16*__restrict__ K,const bf16*__restrict__ V,const unsigned short*__restrict__ kmh,const unsigned short*__restrict__ kml,bf16*O,char*shm){
  const int tid=threadIdx.x,lane=tid&63,r32=lane&31,hi=lane>>5; const int wid=__builtin_amdgcn_readfirstlane(tid>>6);
  const long rowbase=(long)b*::SEQ; const int q0=qb*QB;
  const bf16*Qw=Q+(rowbase+q0+wid*QBLK)*PQ+h*D;
  const bf16*Kh=K+rowbase*PQ+h*D,*Vh=V+rowbase*PQ+h*D;
  const unsigned lds0=(unsigned)(uintptr_t)shm;
  float*wsf=(float*)(shm+LDS_WS)+wid*64;
  const bf16*ksrc=Kh+(long)lane*PQ+wid*8;
  const bf16*vsrc=Vh+(long)(16*(wid&3)+(lane>>2))*PQ+(wid>>2)*32+(lane&3)*8;
  const unsigned kdst=lds0+LDS_K+wid*1024, vdst=lds0+LDS_V+wid*1024;
  #define TOFF(t) ((long)(((t)<4)?(q0+KVBLK*(t)):(KVBLK*((t)-4)))*PQ)
  #define DMA_K(t,slot) glds16(ksrc+TOFF(t),(unsigned)__builtin_amdgcn_readfirstlane(kdst+(slot)))
  #define DMA_V(t,slot) glds16(vsrc+TOFF(t),(unsigned)__builtin_amdgcn_readfirstlane(vdst+(slot)))
  const int vb0=(int)(lds0+LDS_V)+((lane>>4)&1)*32+(lane&3)*8+(4*hi+((lane&15)>>2))*64;
  const char*Kbase=shm+LDS_K; bf16x8 kf[8];
  const lds_cptr shm3=(lds_cptr)shm; const lds_cptr kp0=shm3+LDS_K+hi*1024+r32*16; const lds_cptr vp0=shm3+LDS_V+((lane>>4)&1)*32+(lane&3)*8+(4*hi+((lane&15)>>2))*64;
  const int NT=(q0+QB)/KVBLK;
  DMA_K(0,0);DMA_V(0,0);DMA_K(1,SLOTB);
  bf16x8 qr[4];
  #pragma unroll
  for(int d0=0;d0<4;++d0)qr[d0]=*reinterpret_cast<const bf16x8*>(&Qw[(long)r32*PQ+d0*16+hi*8]);
  float mhat=0.f,l_reg=0.f;f32x16 o[2];o[0]=f32x16{};o[1]=f32x16{};f32x16 negm=f32x16{};asm volatile("":"+v"(negm));
  const int qrel=wid*QBLK+r32;
  const __attribute__((address_space(3))) float*tab=(const __attribute__((address_space(3))) float*)((lds_cptr)shm+LDS_TAB)+h*TAB_N;
  unsigned selmask=0u;
  if(qb>0){
    f32x16 gacc=f32x16{};
    const size_t ko=((size_t)(b*::NH+h)*::NKB+(r32&15))*D+hi*8;
    #pragma unroll
    for(int d0=0;d0<4;++d0){ const bf16x8 ah=*(const bf16x8*)(kmh+ko+d0*16), al=*(const bf16x8*)(kml+ko+d0*16);
      gacc=__builtin_amdgcn_mfma_f32_32x32x16_bf16(ah,qr[d0],gacc,0,0,0);
      gacc=__builtin_amdgcn_mfma_f32_32x32x16_bf16(al,qr[d0],gacc,0,0,0); }
    float g[16];
    #pragma unroll
    for(int r=0;r<4;++r){ const float m0=gacc[r],o0=__shfl_xor(m0,32),m1=gacc[4+r],o1=__shfl_xor(m1,32);
      g[r]=hi?o0:m0; g[4+r]=hi?m0:o0; g[8+r]=hi?o1:m1; g[12+r]=hi?m1:o1; }
    #pragma unroll
    for(int j=0;j<16;++j) if(j>=qb) g[j]=-INFINITY;
    #pragma unroll
    for(int rd=0;rd<3;++rd){ float best=-INFINITY; int bi=-1;
      #pragma unroll
      for(int j=0;j<16;++j) if(g[j]>best){best=g[j];bi=j;}
      if(bi>=0) selmask|=1u<<bi;
      #pragma unroll
      for(int j=0;j<16;++j) if(j==bi) g[j]=-INFINITY; }
  }
  #define SELT(t) (((t)<4)||((selmask>>(((t)-4)>>2))&1u))
  #define CMASK(P0,P1,t) do{ if((t)<4){ const int rmax_=wid*32+31-64*(t), rmin_=wid*32-64*(t)-63; if(rmax_<0){ _Pragma("unroll") for(int r=0;r<16;++r){P0[r]=-INFINITY;P1[r]=-INFINITY;} } else if(rmin_<=112) bmask(P0,P1,(t),qrel,hi,tab); } \
    else if((t)>=NT-2){ const int q0_=wid*32+128-64*((t)-(NT-2)); if(q0_-63<=112) bmask(P0,P1,0,qrel+128-64*((t)-(NT-2)),hi,tab); } }while(0)
  bool resc=false;
  #define START(P0,P1) do{ const float rm=rowmax(P0,P1); resc=false; \
    { const float dl=rm; mhat=fadd_s(mhat,dl); \
      _Pragma("unroll") for(int r=0;r<16;++r){P0[r]=fsub_s(P0[r],dl);P1[r]=fsub_s(P1[r],dl);} \
      _Pragma("unroll") for(int r=0;r<16;++r)negm[r]=-mhat; asm volatile("":"+v"(negm)); } \
    _Pragma("unroll") for(int r=0;r<16;++r)P0[r]=__builtin_amdgcn_exp2f(P0[r]); }while(0)
  #define RESC() do{ if(resc){ asm volatile("s_waitcnt lgkmcnt(0)":::"memory"); \
      _Pragma("unroll") for(int d_=0;d_<2;++d_) _Pragma("unroll") for(int r=0;r<16;++r)o[d_][r]*=wsf[crow(r,hi)]; } }while(0)
  f32x16 pA0,pA1,pB0,pB1;
  int sl_prev=0,sl_cur=0,sl_next=SLOTB;
  #define ROT() do{sl_prev=sl_cur;sl_cur=sl_next;sl_next=(sl_next==(NSLOT-1)*SLOTB)?0:sl_next+SLOTB;}while(0)
  DMA_K(2,2*SLOTB);
  WAIT_BAR(3);
  qkt(pA0,pA1,Kbase,qr,negm,r32,hi);asm volatile("s_nop 15\n\ts_nop 7":"+v"(pA0),"+v"(pA1));CMASK(pA0,pA1,0);
  START(pA0,pA1);
  _Pragma("unroll") for(int r=0;r<16;++r)pA1[r]=__builtin_amdgcn_exp2f(pA1[r]);
  WAIT_BAR(0);
  DMA_K(3,0);DMA_V(1,SLOTB);
  ROT();
  kload8(kf,kp0+sl_cur);
  WAIT_BAR(2);
  s16x4 vlo[8],vhi[8]; u32x4 pw0,pw1,pw2,pw3;
  #define PKW(P,B) cvtpk_s(P[B],P[B+1])
  #define PAF(k) __builtin_bit_cast(bf16x8,pw##k)
  #define VFR(i) (bf16x8){vlo[i][0],vlo[i][1],vlo[i][2],vlo[i][3],vhi[i][0],vhi[i][1],vhi[i][2],vhi[i][3]}
  #define PIN(x) asm volatile("":"+v"(x))
  #define MX3(a,b,c) __builtin_fmaxf(__builtin_fmaxf((a),(b)),(c))
  #define GAPA(MF,A0,A1,A2,A3,W0,W1,PW) do{ MF; sacc+=A0; sacc+=A1; sacc+=A2; sacc+=A3; PIN(sacc); W0; W1; PIN(PW); SBAR(); }while(0)
  #define EX(v) __builtin_amdgcn_exp2f(v)
  #define GAPB(MF,X,B) do{ MF; X[B]=EX(X[B]); X[B+1]=EX(X[B+1]); X[B+2]=EX(X[B+2]); X[B+3]=EX(X[B+3]); PIN(X); SBAR(); }while(0)
  #define VRD(i) do{ vlo[i]=vtr(vp_+(((i)>>2)*4096+((i)&3)*1024)); vhi[i]=vtr(vp_+(((i)>>2)*4096+((i)&3)*1024+512)); }while(0)
  #define KRD(G,j) do{ if(G){ kload2(kf,kp0+sl_next,j); SBAR(); } }while(0)
  #define STEP(C0,C1,P0,P1,t,GK,GV,GL) do{ SBAR(); \
    { const float nv_=SELT(t)?-mhat:-INFINITY; _Pragma("unroll") for(int r=0;r<16;++r)negm[r]=nv_; asm volatile("":"+v"(negm)); } SBAR(); \
    const lds_cptr vp_=vp0+sl_prev; \
    VRD(0); SBAR(); float sacc=(P0[0]+P0[1]); \
    GAPA(C0=__builtin_amdgcn_mfma_f32_32x32x16_bf16(kf[0],qr[0],negm,0,0,0), P0[2],P0[3],P0[4],P0[5],     pw0[0]=PKW(P0,0), pw0[1]=PKW(P0,2), pw0); \
    VRD(4); SBAR(); GAPA(C1=__builtin_amdgcn_mfma_f32_32x32x16_bf16(kf[1],qr[0],negm,0,0,0), P0[6],P0[7],P0[8],P0[9],     pw0[2]=PKW(P0,4), pw0[3]=PKW(P0,6), pw0); \
    VRD(1); SBAR(); GAPA(C0=__builtin_amdgcn_mfma_f32_32x32x16_bf16(kf[2],qr[1],C0,0,0,0),   P0[10],P0[11],P0[12],P0[13], pw1[0]=PKW(P0,8), pw1[1]=PKW(P0,10), pw1); \
    VRD(5); SBAR(); GAPA(C1=__builtin_amdgcn_mfma_f32_32x32x16_bf16(kf[3],qr[1],C1,0,0,0),   P0[14],P0[15],P1[0],P1[1],   pw1[2]=PKW(P0,12),pw1[3]=PKW(P0,14), pw1); \
    VRD(2); SBAR(); GAPA(C0=__builtin_amdgcn_mfma_f32_32x32x16_bf16(kf[4],qr[2],C0,0,0,0),   P1[2],P1[3],P1[4],P1[5],     pw2[0]=PKW(P1,0), pw2[1]=PKW(P1,2), pw2); \
    VRD(6); SBAR(); GAPA(C1=__builtin_amdgcn_mfma_f32_32x32x16_bf16(kf[5],qr[2],C1,0,0,0),   P1[6],P1[7],P1[8],P1[9],     pw2[2]=PKW(P1,4), pw2[3]=PKW(P1,6), pw2); \
    VRD(3); SBAR(); GAPA(C0=__builtin_amdgcn_mfma_f32_32x32x16_bf16(kf[6],qr[3],C0,0,0,0),   P1[10],P1[11],P1[12],P1[13], pw3[0]=PKW(P1,8), pw3[1]=PKW(P1,10), pw3); \
    VRD(7); SBAR(); GAPA(C1=__builtin_amdgcn_mfma_f32_32x32x16_bf16(kf[7],qr[3],C1,0,0,0),   P1[14],P1[15],0.f,0.f,       pw3[2]=PKW(P1,12),pw3[3]=PKW(P1,14), pw3); \
    l_reg+=sacc; \
    if(GK){DMA_K((t)+3,sl_cur);} if(GV){DMA_V((t)+1,sl_next);} \
    if(MASKON){CMASK(C0,C1,t);} \
    { float a=MX3(C0[0],C0[1],C1[0]),b=MX3(C0[2],C0[3],C1[1]); a=MX3(a,C1[2],C1[3]); \
      _Pragma("unroll") for(int r=4;r<16;r+=4){a=MX3(a,C0[r],C0[r+1]);b=MX3(b,C0[r+2],C0[r+3]);a=MX3(a,C1[r],C1[r+1]);b=MX3(b,C1[r+2],C1[r+3]);} \
      float rm=__builtin_fmaxf(a,b); { auto rr=__builtin_amdgcn_permlane32_swap(__float_as_uint(rm),__float_as_uint(rm),false,false); rm=__builtin_fmaxf(__uint_as_float(rr[0]),__uint_as_float(rr[1])); } \
      resc=false; \
      if(__builtin_expect(__any(rm>(float)THRL),0)){ const float dl=__builtin_fmaxf(rm,0.f); mhat+=dl; \
        _Pragma("unroll") for(int r=0;r<16;++r){C0[r]-=dl;C1[r]-=dl;} \
        const float f=__builtin_amdgcn_exp2f(-dl); l_reg*=f; if(hi==0)wsf[r32]=f; resc=true; } } \
    SBAR(); \
    GAPB(o[0]=__builtin_amdgcn_mfma_f32_32x32x16_bf16(PAF(0),VFR(0),o[0],0,0,0), C0,0); \
    GAPB(o[1]=__builtin_amdgcn_mfma_f32_32x32x16_bf16(PAF(0),VFR(4),o[1],0,0,0), C0,4); \
    KRD(GL,0); GAPB(o[0]=__builtin_amdgcn_mfma_f32_32x32x16_bf16(PAF(1),VFR(1),o[0],0,0,0), C0,8); \
    KRD(GL,1); GAPB(o[1]=__builtin_amdgcn_mfma_f32_32x32x16_bf16(PAF(1),VFR(5),o[1],0,0,0), C0,12); \
    KRD(GL,2); GAPB(o[0]=__builtin_amdgcn_mfma_f32_32x32x16_bf16(PAF(2),VFR(2),o[0],0,0,0), C1,0); \
    KRD(GL,3); GAPB(o[1]=__builtin_amdgcn_mfma_f32_32x32x16_bf16(PAF(2),VFR(6),o[1],0,0,0), C1,4); \
    GAPB(o[0]=__builtin_amdgcn_mfma_f32_32x32x16_bf16(PAF(3),VFR(3),o[0],0,0,0), C1,8); \
    GAPB(o[1]=__builtin_amdgcn_mfma_f32_32x32x16_bf16(PAF(3),VFR(7),o[1],0,0,0), C1,12); \
    }while(0)
  int t=1;
  #define MASKON 1
  for(;t<4&&t+3<NT;t+=2){
    STEP(pB0,pB1,pA0,pA1,t,true,true,true);     WAIT_BAR(2); RESC(); ROT();
    STEP(pA0,pA1,pB0,pB1,t+1,true,true,true);   WAIT_BAR(2); RESC(); ROT();
  }
  #undef MASKON
  #define MASKON 0
  for(;t+3<NT;t+=2){
    STEP(pB0,pB1,pA0,pA1,t,true,true,true);     WAIT_BAR(2); RESC(); ROT();
    STEP(pA0,pA1,pB0,pB1,t+1,true,true,true);   WAIT_BAR(2); RESC(); ROT();
  }
  #undef MASKON
  #define MASKON 1
  STEP(pB0,pB1,pA0,pA1,t,false,true,true);      WAIT_BAR(1); RESC(); ROT();
  STEP(pA0,pA1,pB0,pB1,t+1,false,true,true);    WAIT_BAR(0); RESC(); ROT();
  STEP(pB0,pB1,pA0,pA1,NT-1,false,false,false); RESC();
  { float sacc=pB0[0]+pB0[1]; _Pragma("unroll") for(int r=2;r<16;++r)sacc+=pB0[r]; _Pragma("unroll") for(int r=0;r<16;++r)sacc+=pB1[r]; l_reg+=sacc;
    pw0=(u32x4){PKW(pB0,0),PKW(pB0,2),PKW(pB0,4),PKW(pB0,6)};pw1=(u32x4){PKW(pB0,8),PKW(pB0,10),PKW(pB0,12),PKW(pB0,14)};pw2=(u32x4){PKW(pB1,0),PKW(pB1,2),PKW(pB1,4),PKW(pB1,6)};pw3=(u32x4){PKW(pB1,8),PKW(pB1,10),PKW(pB1,12),PKW(pB1,14)};
    SBAR(); pv(o,vb0+sl_cur,PAF(0),PAF(1),PAF(2),PAF(3)); }
  #undef PKW
  #undef PAF
  #undef VFR
  #undef PIN
  #undef MX3
  #undef GAPA
  #undef GAPB
  #undef EX
  #undef VRD
  #undef KRD
  #undef STEP
  {auto rr=__builtin_amdgcn_permlane32_swap(__float_as_uint(l_reg),__float_as_uint(l_reg),false,false);l_reg=__uint_as_float(rr[0])+__uint_as_float(rr[1]);}
  if(hi==0)wsf[32+r32]=l_reg;asm volatile("s_waitcnt lgkmcnt(0)":::"memory");
  float rli[16];
  #pragma unroll
  for(int r=0;r<16;++r)rli[r]=__builtin_amdgcn_rcpf(wsf[32+crow(r,hi)]);
  bf16*Ow=O+(rowbase+q0+wid*QBLK)*PO+h*D;
  { bf16*stg=(bf16*)(shm+LDS_OST)+wid*2048;
    #pragma unroll
    for(int r=0;r<16;++r){const int orow=crow(r,hi);
      #pragma unroll
      for(int d0=0;d0<2;++d0)stg[orow*64+d0*32+r32]=__float2bfloat16(o[d0][r]*rli[r]);}
    asm volatile("s_waitcnt lgkmcnt(0)":::"memory");
    #pragma unroll
    for(int i=0;i<4;++i){const int row=i*8+(lane>>3),ch=lane&7; const u32x4 v=*(const u32x4*)(stg+row*64+ch*8); ATTN_STORE16(Ow+(long)row*PO+ch*8,v);} }
  asm volatile("s_waitcnt lgkmcnt(0)\n\ts_barrier":::"memory");
  #undef DMA_K
  #undef TOFF
  #undef SELT
  #undef MASKON
  #undef DMA_V
  #undef CMASK
  #undef START
  #undef RESC
  #undef ROT
}
constexpr int ATTN_LDS_BYTES=LDS_BYTES;
struct AttnTensors { const bf16* Q; const bf16* K; const bf16* V; const unsigned short* kmh; const unsigned short* kml; const float* rel_bias; bf16* O; };
struct AttnUnit { int bh; int qb; };
struct StaticOrder {
  int vcu;
  __device__ __forceinline__ explicit StaticOrder(int v):vcu(v){}
  __device__ __forceinline__ bool next(int i,AttnUnit&u)const{ if(i>=4)return false; const int s=vcu&3; u.bh=vcu>>2; u.qb=(i==0)?15-s:(i==1)?8+s:(i==2)?7-s:s; return true; }
};
template<int THRL=8> __device__ __forceinline__ void attn_phase(char*lds,const AttnTensors&T,int vcu0,int G){
  { __attribute__((address_space(3))) float*tb=(__attribute__((address_space(3))) float*)((lds_cptr)lds+LDS_TAB);
    for(int i=threadIdx.x;i<8*TAB_N;i+=NW*64){ const int hh=i/TAB_N,k=i%TAB_N,rel=k-255; float v=0.f;
      if(rel<0)v=-INFINITY; else if(rel<=112)v=(T.rel_bias[::t5_bucket(rel)*::NH+hh]-T.rel_bias[31*::NH+hh])*::LOG2E;
      tb[i]=v; }
    asm volatile("s_waitcnt lgkmcnt(0)\n\ts_barrier":::"memory"); }
  for(int v=vcu0;v<256;v+=G){ const StaticOrder S(v); AttnUnit u;
    for(int i=0;S.next(i,u);++i) attn_unit<THRL>(u.bh / ::NH, u.bh % ::NH, u.qb,T.Q,T.K,T.V,T.kmh,T.kml,T.O,lds); }
}
#undef SBAR
#undef WAIT_BAR
}

namespace rnn {
typedef float f32x16 __attribute__((ext_vector_type(16)));
constexpr int NCHK = 16, CHT = SEQ / NCHK, TILES = CHT / 32;
constexpr int LDS_BEXT = 98304, LDS_CW = LDS_BEXT + 24576, LDS_STG = 0;
__device__ __forceinline__ void fill_tables(LAS unsigned char* lds, int blk, const float* __restrict__ Wa, const float* __restrict__ Wi, const float* __restrict__ cw, const float* __restrict__ cb, int tid) {
#pragma unroll 1
    for (int it = 0; it < (24 * 64) / (NWAVES * 64); ++it) { const int e = tid + it * (NWAVES * 64);
        const int frag = e >> 6, ln = e & 63, ntile = frag >> 2, ks = frag & 3, n = ln & 31, hi = ln >> 5;
        const int col = (ntile & 1) * 32 + n, k0 = 16 * ks + 8 * hi;
        const float* W = (ntile < 2 ? Wa : Wi) + (size_t)blk * RBD * RBD + col;
        u32x4 w;
#pragma unroll
        for (int j2 = 0; j2 < 4; ++j2) { const int k = k0 + 2 * j2; float v0, v1;
            if (ntile < 4) { v0 = W[k * RBD]; v1 = W[(k + 1) * RBD]; } else { v0 = (k == col) ? 1.f : 0.f; v1 = (k + 1 == col) ? 1.f : 0.f; }
            w[j2] = pk2(v0, v1); }
        *(LAS u32x4*)(lds + LDS_BEXT + e * 16) = w;
    }
    if (tid < 5 * 64) { const int e = tid, j = e >> 6, c = e & 63; ((LAS float*)(lds + LDS_CW))[e] = (j < 4) ? cw[j * DR + blk * RBD + c] : cb[blk * RBD + c]; }
}
template <bool FINAL>
__device__ __forceinline__ void scan_chunk(LAS unsigned char* lds, int b, int blk, int chunk, int wave, int lane, const bf16_t* __restrict__ XR, const bf16_t* __restrict__ GY,
                                           const float* __restrict__ ba, const float* __restrict__ bi, const float* __restrict__ lam, float* comp, bf16_t* __restrict__ O) {
    const int r32 = lane & 31, hi = lane >> 5;
    float cba[2], cbi[2], c8[2], H[2], Ac[2];
#pragma unroll
    for (int nt = 0; nt < 2; ++nt) { const int ch = blk * RBD + 32 * nt + r32; cba[nt] = -LOG2E * ba[ch]; cbi[nt] = -LOG2E * bi[ch]; c8[nt] = -8.0f * LOG2E * log1pf(expf(-lam[ch])); H[nt] = 0.f; Ac[nt] = 1.f; }
    if (FINAL) {
        for (int k = 0; k < chunk; ++k) {
#pragma unroll
            for (int nt = 0; nt < 2; ++nt) { const f32x2 c = *(const f32x2*)(comp + (((size_t)b * NCHK + k) * DR + blk * RBD + 32 * nt + r32) * 2); H[nt] = c[0] * H[nt] + c[1]; } }
    }
    const size_t row0 = (size_t)b * SEQ + (size_t)chunk * CHT;
    const LAS f32x4* cwp = (const LAS f32x4*)(lds + LDS_CW) + 2 * hi;
    const LAS bf16x8* bfr = (const LAS bf16x8*)(lds + LDS_BEXT) + lane;
    LAS bf16_t* stg = (LAS bf16_t*)(lds + LDS_STG + wave * 4096);
    u32x4 xraw[4][4];
#define RNN_LOAD_TILE(tl) do { const int tpos_ = chunk * CHT + (tl) * 32 + r32; const bf16_t* xp_ = XR + (row0 + (tl) * 32 + r32) * DR + blk * RBD + 8 * hi; \
        _Pragma("unroll") for (int ks_ = 0; ks_ < 4; ++ks_) { xraw[ks_][3] = *(const u32x4*)(xp_ + 16 * ks_); \
            _Pragma("unroll") for (int j_ = 0; j_ < 3; ++j_) { const bool ok_ = (tpos_ + j_ - 3) >= 0; const u32x4 v_ = *(const u32x4*)(xp_ + (ok_ ? (long)(j_ - 3) * DR : 0) + 16 * ks_); xraw[ks_][j_] = ok_ ? v_ : (u32x4){0u, 0u, 0u, 0u}; } } } while (0)
    RNN_LOAD_TILE(0);
    for (int tile = 0; tile < TILES; ++tile) {
        u32x4 gyv[4];
        if (FINAL) {
#pragma unroll
            for (int i = 0; i < 4; ++i) gyv[i] = *(const u32x4*)(GY + (row0 + tile * 32 + 8 * i + (lane >> 3)) * DR + blk * RBD + (lane & 7) * 8);
        }
        bf16x8 af[4];
#pragma unroll
        for (int ks = 0; ks < 4; ++ks) {
            f32x4 alo = cwp[64 + 4 * ks], ahi = cwp[64 + 4 * ks + 1];
#pragma unroll
            for (int j = 0; j < 4; ++j) { const f32x4 wlo = cwp[16 * j + 4 * ks], whi = cwp[16 * j + 4 * ks + 1]; const u32x4 x = xraw[ks][j];
                const f32x4 xlo = {__uint_as_float(x[0] << 16), __uint_as_float(x[0] & 0xffff0000u), __uint_as_float(x[1] << 16), __uint_as_float(x[1] & 0xffff0000u)};
                const f32x4 xhi = {__uint_as_float(x[2] << 16), __uint_as_float(x[2] & 0xffff0000u), __uint_as_float(x[3] << 16), __uint_as_float(x[3] & 0xffff0000u)};
                alo += wlo * xlo; ahi += whi * xhi; }
            u32x4 pk; pk[0] = cvt_pk_bf16(alo[0], alo[1]); pk[1] = cvt_pk_bf16(alo[2], alo[3]); pk[2] = cvt_pk_bf16(ahi[0], ahi[1]); pk[3] = cvt_pk_bf16(ahi[2], ahi[3]);
            af[ks] = __builtin_bit_cast(bf16x8, pk);
        }
        if (tile + 1 < TILES) RNN_LOAD_TILE(tile + 1);
#pragma unroll
        for (int nt = 0; nt < 2; ++nt) {
            f32x16 aR = f32x16{}, aI = f32x16{}, aX = f32x16{};
#pragma unroll
            for (int ks = 0; ks < 4; ++ks) {
                aR = __builtin_amdgcn_mfma_f32_32x32x16_bf16(af[ks], bfr[64 * (4 * nt + ks)], aR, 0, 0, 0);
                aI = __builtin_amdgcn_mfma_f32_32x32x16_bf16(af[ks], bfr[64 * (4 * (2 + nt) + ks)], aI, 0, 0, 0);
                aX = __builtin_amdgcn_mfma_f32_32x32x16_bf16(af[ks], bfr[64 * (4 * (4 + nt) + ks)], aX, 0, 0, 0); }
            float av[16], uv[16];
#pragma unroll
            for (int r = 0; r < 16; ++r) {
                const float rr = __builtin_amdgcn_rcpf(1.0f + __builtin_amdgcn_exp2f(__builtin_fmaf(aR[r], -LOG2E, cba[nt]))), ii = __builtin_amdgcn_rcpf(1.0f + __builtin_amdgcn_exp2f(__builtin_fmaf(aI[r], -LOG2E, cbi[nt])));
                const float a = __builtin_amdgcn_exp2f(rr * c8[nt]); const float om = __builtin_fmaf(-a, a, 1.0f);
                av[r] = a; uv[r] = __builtin_amdgcn_sqrtf(om) * (ii * aX[r]); }
            float As[4], Bs[4], pA[4], pB[4], st[4];
#pragma unroll
            for (int g = 0; g < 4; ++g) { As[g] = (av[4 * g] * av[4 * g + 1]) * (av[4 * g + 2] * av[4 * g + 3]);
                Bs[g] = ((uv[4 * g] * av[4 * g + 1] + uv[4 * g + 1]) * av[4 * g + 2] + uv[4 * g + 2]) * av[4 * g + 3] + uv[4 * g + 3];
                pA[g] = __shfl_xor(As[g], 32); pB[g] = __shfl_xor(Bs[g], 32); }
            float Hc = H[nt];
#pragma unroll
            for (int g = 0; g < 4; ++g) { const float Ae = hi ? pA[g] : As[g], Be = hi ? pB[g] : Bs[g], Ao = hi ? As[g] : pA[g], Bo = hi ? Bs[g] : pB[g];
                const float h0 = Hc; Hc = Ae * Hc + Be; const float h1 = Hc; Hc = Ao * Hc + Bo; st[g] = hi ? h1 : h0;
                if (!FINAL) Ac[nt] *= Ae * Ao; }
            H[nt] = Hc;
            if (FINAL) {
#pragma unroll
                for (int g = 0; g < 4; ++g) { float h = st[g];
#pragma unroll
                    for (int i = 0; i < 4; ++i) { h = av[4 * g + i] * h + uv[4 * g + i]; stg[(8 * g + 4 * hi + i) * 64 + 32 * nt + r32] = (bf16_t)cvt_pk_bf16(h, h); } }
            }
        }
        if (FINAL) {
            asm volatile("s_waitcnt lgkmcnt(0)" ::: "memory");
#pragma unroll
            for (int i = 0; i < 4; ++i) { const int row = 8 * i + (lane >> 3), c8c = (lane & 7) * 8; const u32x4 hv = *(const LAS u32x4*)(stg + row * 64 + c8c); const u32x4 gv = gyv[i]; u32x4 w;
#pragma unroll
                for (int j = 0; j < 4; ++j) w[j] = cvt_pk_bf16(__uint_as_float(hv[j] << 16) * __uint_as_float(gv[j] << 16), __uint_as_float(hv[j] & 0xffff0000u) * __uint_as_float(gv[j] & 0xffff0000u));
                ST16(O + (row0 + tile * 32 + row) * OC + DA + blk * RBD + c8c, w); }
            asm volatile("s_waitcnt lgkmcnt(0)" ::: "memory");
        }
    }
    if (!FINAL && hi == 0) {
#pragma unroll
        for (int nt = 0; nt < 2; ++nt) *(f32x2*)(comp + (((size_t)b * NCHK + chunk) * DR + blk * RBD + 32 * nt + r32) * 2) = (f32x2){Ac[nt], H[nt]};
    }
}
template <bool FINAL>
__device__ __forceinline__ void scan_phase(LAS unsigned char* lds, int vcu, int G, int wave, int lane, int tid, const bf16_t* XR, const bf16_t* GY, const float* cw, const float* cb, const float* Wa, const float* ba,
                                           const float* Wi, const float* bi, const float* lam, float* comp, bf16_t* O) {
    asm volatile("" : "+v"(lane), "+v"(tid));
    for (int v = vcu; v < 256; v += G) {
        const int b = v >> 5, blk = (v >> 1) & 15, chunk = (v & 1) * 8 + wave;
        __syncthreads();
        fill_tables(lds, blk, Wa, Wi, cw, cb, tid);
        __syncthreads();
        scan_chunk<FINAL>(lds, b, blk, chunk, wave, lane, XR, GY, ba, bi, lam, comp, O);
    }
}
#undef RNN_LOAD_TILE
}

__device__ __forceinline__ void naive_attn_item(int idx, const bf16_t* __restrict__ Q, const bf16_t* __restrict__ K, const bf16_t* __restrict__ V, const float* __restrict__ kmp,
                                                 const float* __restrict__ rel_bias, bf16_t* __restrict__ O, int opitch) {
    const int t = idx % SEQ, h = (idx / SEQ) % NH, b = idx / (SEQ * NH);
    const size_t row = (size_t)b * SEQ + t;
    float q[64];
    { const u32x4* qp = (const u32x4*)(Q + row * DA + h * HD);
#pragma unroll
      for (int c = 0; c < 8; ++c) { const u32x4 w = qp[c];
#pragma unroll
          for (int j = 0; j < 4; ++j) { q[c * 8 + 2 * j] = __uint_as_float(w[j] << 16); q[c * 8 + 2 * j + 1] = __uint_as_float(w[j] & 0xffff0000u); } } }
    const int own = t / KBLK;
    unsigned mask = 0;
    {
        float g[16];
#pragma unroll
        for (int j = 0; j < 16; ++j) { g[j] = -INFINITY;
            if (j < own) { const float* k0 = kmp + (size_t)((b * NKB + j) * 2) * DA + h * HD; const float* k1 = k0 + DA; float s = 0.f;
#pragma unroll
                for (int d = 0; d < 64; ++d) s += q[d] * ((k0[d] + k1[d]) * (1.0f / 256.0f));
                g[j] = s; } }
#pragma unroll
        for (int r = 0; r < 3; ++r) { float best = -INFINITY; int bi = -1;
#pragma unroll
            for (int j = 0; j < 16; ++j) if (g[j] > best) { best = g[j]; bi = j; }
            if (bi >= 0) { mask |= 1u << bi;
#pragma unroll
                for (int j = 0; j < 16; ++j) if (j == bi) g[j] = -INFINITY; } }
    }
    mask |= 1u << own;
    float o[64];
#pragma unroll
    for (int d = 0; d < 64; ++d) o[d] = 0.f;
    float mx = -INFINITY, l = 0.f;
    for (int j = 0; j <= own; ++j) {
        if (!((mask >> j) & 1u)) continue;
        const int kend = (j == own) ? (t - own * KBLK + 1) : KBLK;
        for (int kk = 0; kk < kend; ++kk) {
            const size_t krow = (size_t)b * SEQ + j * KBLK + kk;
            const u32x4* kp = (const u32x4*)(K + krow * DA + h * HD);
            float s = 0.f;
#pragma unroll
            for (int c = 0; c < 8; ++c) { const u32x4 w = kp[c];
#pragma unroll
                for (int jj = 0; jj < 4; ++jj) { s += q[c * 8 + 2 * jj] * __uint_as_float(w[jj] << 16); s += q[c * 8 + 2 * jj + 1] * __uint_as_float(w[jj] & 0xffff0000u); } }
            const int rel = t - (j * KBLK + kk);
            s += rel_bias[t5_bucket(rel) * NH + h] * LOG2E;
            if (s > mx) { const float f = exp2f(mx - s); l *= f;
#pragma unroll
                for (int d = 0; d < 64; ++d) o[d] *= f;
                mx = s; }
            const float p = exp2f(s - mx); l += p;
            const u32x4* vp = (const u32x4*)(V + krow * DA + h * HD);
#pragma unroll
            for (int c = 0; c < 8; ++c) { const u32x4 w = vp[c];
#pragma unroll
                for (int jj = 0; jj < 4; ++jj) { o[c * 8 + 2 * jj] += p * __uint_as_float(w[jj] << 16); o[c * 8 + 2 * jj + 1] += p * __uint_as_float(w[jj] & 0xffff0000u); } }
        }
    }
    const float il = 1.0f / l;
    u32x4* op = (u32x4*)(O + row * opitch + h * HD);
#pragma unroll
    for (int c = 0; c < 8; ++c) { u32x4 w;
#pragma unroll
        for (int jj = 0; jj < 4; ++jj) w[jj] = pk2(o[c * 8 + 2 * jj] * il, o[c * 8 + 2 * jj + 1] * il);
        op[c] = w; }
}

__device__ __forceinline__ void rg_au_ref(float rp, float ip, float xc, float c8sp, float& a, float& u) {
    const float r = 1.0f / (1.0f + expf(-rp)), i = 1.0f / (1.0f + expf(-ip));
    const float la = -c8sp * r; a = expf(la); u = sqrtf(-expm1f(2.0f * la)) * (i * xc);
}
constexpr int NCH = 64, CHL = SEQ / NCH;
template <bool FINAL>
__device__ __forceinline__ void naive_scan_item(int item, int c, LAS float* xcs, const bf16_t* __restrict__ XR, const bf16_t* __restrict__ GY, const float* __restrict__ cw, const float* __restrict__ cb,
                                                const float* __restrict__ Wa, const float* __restrict__ ba, const float* __restrict__ Wi, const float* __restrict__ bi,
                                                const float* __restrict__ lam, float* __restrict__ comp, const float* __restrict__ carry, bf16_t* __restrict__ O) {
    const int blk = item % RB, chunk = (item / RB) % NCH, b = item / (RB * NCH);
    const int ch = blk * RBD + c;
    const float w0 = cw[ch], w1 = cw[DR + ch], w2 = cw[2 * DR + ch], w3 = cw[3 * DR + ch], bb = cb[ch];
    for (int tt = 0; tt < CHL; ++tt) { const int t = chunk * CHL + tt; const bf16_t* xp = XR + ((size_t)b * SEQ + t) * DR + ch;
        float v = bb + w3 * bf2f(xp[0]);
        if (t >= 1) v += w2 * bf2f(xp[-DR]);
        if (t >= 2) v += w1 * bf2f(xp[-2 * DR]);
        if (t >= 3) v += w0 * bf2f(xp[-3 * DR]);
        xcs[tt * 64 + c] = v; }
    asm volatile("s_waitcnt lgkmcnt(0)" ::: "memory");
    const float c8sp = 8.0f * log1pf(expf(-lam[ch]));
    const float bav = ba[ch], biv = bi[ch];
    const float* wa = Wa + (size_t)blk * RBD * RBD + c; const float* wi = Wi + (size_t)blk * RBD * RBD + c;
    float A = 1.f, Bc = 0.f, hst = FINAL ? carry[((size_t)b * NCH + chunk) * DR + ch] : 0.f;
    for (int tt = 0; tt < CHL; ++tt) {
        float rp = bav, ip = biv;
#pragma unroll 8
        for (int d = 0; d < 64; ++d) { const float xv = xcs[tt * 64 + d]; rp += xv * wa[d * RBD]; ip += xv * wi[d * RBD]; }
        float a, u; rg_au_ref(rp, ip, xcs[tt * 64 + c], c8sp, a, u);
        if (FINAL) { hst = a * hst + u; const size_t off = ((size_t)b * SEQ + chunk * CHL + tt); O[off * OC + DA + ch] = (bf16_t)f2bf(hst * bf2f(GY[off * DR + ch])); }
        else { A *= a; Bc = a * Bc + u; }
    }
    if (!FINAL) { float* cp = comp + (((size_t)b * NCH + chunk) * DR + ch) * 2; cp[0] = A; cp[1] = Bc; }
    asm volatile("s_waitcnt lgkmcnt(0)" ::: "memory");
}
__device__ __forceinline__ void naive_scan_prefix_item(int idx, const float* __restrict__ comp, float* __restrict__ carry) {
    const int ch = idx % DR, b = idx / DR;
    float h = 0.f;
    for (int k = 0; k < NCH; ++k) { const size_t o = ((size_t)b * NCH + k) * DR + ch; carry[o] = h; h = comp[o * 2] * h + comp[o * 2 + 1]; }
}

__global__ void __launch_bounds__(NWAVES * 64, 2) mk_fwd(Args args) {
    extern __shared__ __attribute__((aligned(16))) unsigned char lds_raw[];
    LAS unsigned char* lds = (LAS unsigned char*)lds_raw;
    const int tid = threadIdx.x, lane = tid & 63, wave = __builtin_amdgcn_readfirstlane(tid >> 6);
    const int G = gridDim.x; const int bx = blockIdx.x; const int vcu = (G % 8 == 0) ? (bx % 8) * (G / 8) + bx / 8 : bx;
    unsigned char* ws = args.ws;
    unsigned* ctl = (unsigned*)(ws + WS_CTL);
    for (int u = tid; u < (LDS_BYTES - LDSCTL_OFF) / 4; u += NWAVES * 64) ((LAS unsigned*)(lds + LDSCTL_OFF))[u] = 0u;
    __syncthreads();
    volatile LAS unsigned* MISC = (volatile LAS unsigned*)(lds + MISC_OFF);
    const int lo = args.ph_lo, hi = args.ph_hi;
    XcdBarrier bar; bar.bar = ctl + CW_BAR + lo * XCD_BAR_WORDS; bar.x = 0; bar.st = nullptr;
    const bool multi = (hi - lo) > 1;
    if (multi) bar = xcd_barrier_post(ctl + CW_BAR + lo * XCD_BAR_WORDS, MISC + 8);
#define IN(k) (lo <= (k) && (k) < hi)
#define BOTH(k) (IN(k) && IN((k) + 1))
#define GRID_BAR() xcd_barrier(bar)
#define STAGGER(ticks) do { if ((ticks) > 0) { const unsigned long long t0_ = __builtin_amdgcn_s_memrealtime(), d_ = (unsigned long long)(vcu & 3) * (unsigned long long)(ticks); while (__builtin_amdgcn_s_memrealtime() - t0_ < d_) __builtin_amdgcn_s_sleep(8); } } while (0)

    const float* x = args.in[0];
    bf16_t* Wt_in = (bf16_t*)(ws + WS_WIN); bf16_t* Wt_cat = (bf16_t*)(ws + WS_WCAT); bf16_t* Wt_out = (bf16_t*)(ws + WS_WOUT);
    bf16_t* Wt_ff1 = (bf16_t*)(ws + WS_WFF1); bf16_t* Wt_ff2 = (bf16_t*)(ws + WS_WFF2);
    bf16_t* XN = (bf16_t*)(ws + WS_XN); bf16_t* XB = (bf16_t*)(ws + WS_XB); float* rstd1 = (float*)(ws + WS_RSTD1); bf16_t* Qb = (bf16_t*)(ws + WS_Q); bf16_t* Kb = (bf16_t*)(ws + WS_K); bf16_t* Vb = (bf16_t*)(ws + WS_V);
    bf16_t* XR = (bf16_t*)(ws + WS_XR); bf16_t* GY = (bf16_t*)(ws + WS_GY); bf16_t* GA = (bf16_t*)(ws + WS_GA); bf16_t* GR = (bf16_t*)(ws + WS_GR);
    bf16_t* MRG = (bf16_t*)(ws + WS_MRG); bf16_t* HB = (bf16_t*)(ws + WS_H);
    float* kmp = (float*)(ws + WS_KMP); float* ssq = (float*)(ws + WS_SSQ);
    bf16_t* OCAT = (bf16_t*)args.out;

    if ((PHMASK >> 0 & 1) && IN(0)) {
        LAS float* scr = (LAS float*)(lds + RING_OFF + wave * 16384);
        const int gw = vcu * NWAVES + wave, NGW = G * NWAVES;
        constexpr int I_IN = (DM / 64) * (DIN / 32), I_PA = (DA / 64) * (DM / 32), I_PR = (DR / 64) * (DM / 32), I_OUT = (DM / 64) * (DM / 32), I_F1 = (DM / 64) * (DFF / 32), I_F2 = (DFF / 64) * (DM / 32);
        (void)I_PA; (void)I_PR; (void)I_OUT; (void)I_F1; (void)I_F2;
        for (int it = gw; it < I_IN; it += NGW) p0_transpose_item<1>(args.in[2], DIN, Wt_in, DM, 0, args.in[1], scr, it, lane);
        { f32x4 cur[4], nxt[4];
#pragma unroll
          for (int j = 0; j < 4; ++j) cur[j] = __builtin_nontemporal_load((const f32x4*)(x + (size_t)gw * DM) + lane + 64 * j);
          for (int m = gw; m < M; m += NGW) { const int mn = (m + NGW < M) ? m + NGW : m;
#pragma unroll
              for (int j = 0; j < 4; ++j) nxt[j] = __builtin_nontemporal_load((const f32x4*)(x + (size_t)mn * DM) + lane + 64 * j);
              rms_row_to_bf16(cur, rstd1 + m, XB + (size_t)m * DM, lane);
#pragma unroll
              for (int j = 0; j < 4; ++j) cur[j] = nxt[j]; } }
        if (BOTH(0)) GRID_BAR();
    }
    if ((PHMASK >> 1 & 1) && IN(1)) {
        pg8::Gemm g = pg8::gemm_rowmajor(XB, Wt_in, DM, DM, DM, DIN, -1, args.flags); pg8::StaticOrder S; S.init(M, DIN, G, bx, WGM_P1);
        LAS float* rs = (LAS float*)(lds + LDSCTL_OFF + 1024);
        { pg8::Unit u0; int nu = 0; while (nu < 11 && S.next(nu, u0)) ++nu;
          for (int e = tid; e < nu * 256; e += NWAVES * 64) { pg8::Unit u1; S.next(e >> 8, u1); rs[e] = rstd1[u1.pm * 256 + (e & 255)]; }
          __syncthreads(); }
        pg8::EpiZ E{Qb, Kb, Vb, XR, GY, GA, GR, kmp, args.in[4], args.in[5], args.in[3], rs, ws, (LAS float*)(lds + LDSCTL_OFF + 13312)};
        STAGGER(STAG1);
        pg8::gemm_phase<pg8::EpiZ, pg8::StaticOrder, false>(lds + RING_OFF, g, S, E);
        if (BOTH(1)) GRID_BAR();
    }
    {
        const float* cw = args.in[7]; const float* cb = args.in[8]; const float* Wa = args.in[9]; const float* ba = args.in[10]; const float* Wi = args.in[11]; const float* bi = args.in[12]; const float* lam = args.in[13];
        float* comp = (float*)(ws + WS_COMP); float* carry = (float*)(ws + WS_CARRY);
        LAS float* xcs = (LAS float*)(lds + RING_OFF + wave * 16384);
        const int gw = vcu * NWAVES + wave, NGW = G * NWAVES;
        const bool pairmode = PAIR_SYNC && (G == 256) && IN(2) && IN(4) && !NAIVE_SCAN;
        if ((PHMASK >> 2 & 1) && IN(2)) {
            if (pairmode) {
#if NAIVE_SCAN
            for (int it = gw; it < BATCH * NCH * RB; it += NGW) naive_scan_item<false>(it, lane, xcs, XR, GY, cw, cb, Wa, ba, Wi, bi, lam, comp, carry, OCAT);
#else
            if (!(args.flags & 4)) rnn::scan_phase<false>(lds, vcu, G, wave, lane, tid, XR, GY, cw, cb, Wa, ba, Wi, bi, lam, comp, OCAT);
#endif
            if (pairmode) {
                asm volatile("s_waitcnt vmcnt(0)" ::: "memory"); __syncthreads();
                if (tid == 0) { __builtin_amdgcn_fence(__ATOMIC_RELEASE, "agent"); asm volatile("s_waitcnt vmcnt(0)" ::: "memory");
                    __hip_atomic_store(ctl + CW_PAIR + 64 * vcu, 1u, __ATOMIC_RELAXED, __HIP_MEMORY_SCOPE_AGENT); }
            }
            }
#if NAIVE_ATTN
            for (int idx = bx * (NWAVES * 64) + tid; idx < BATCH * NH * SEQ; idx += G * NWAVES * 64) naive_attn_item(idx, Qb, Kb, Vb, kmp, args.in[6], OCAT, OC);
#else
            if (!(args.flags & 8)) { const attn_body::AttnTensors AT{(const attn_body::bf16*)Qb, (const attn_body::bf16*)Kb, (const attn_body::bf16*)Vb, (const unsigned short*)(ws + WS_KMH), (const unsigned short*)(ws + WS_KML), args.in[6], (attn_body::bf16*)OCAT};
              attn_body::attn_phase<8>((char*)lds_raw + RING_OFF, AT, vcu, G); }
#endif
            if (!pairmode) {
#if NAIVE_SCAN
            for (int it = gw; it < BATCH * NCH * RB; it += NGW) naive_scan_item<false>(it, lane, xcs, XR, GY, cw, cb, Wa, ba, Wi, bi, lam, comp, carry, OCAT);
#else
            if (!(args.flags & 4)) rnn::scan_phase<false>(lds, vcu, G, wave, lane, tid, XR, GY, cw, cb, Wa, ba, Wi, bi, lam, comp, OCAT);
#endif
                if (BOTH(2)) GRID_BAR();
            }
        }
        if ((PHMASK >> 3 & 1) && IN(3)) {
#if DBG_ATTN
            { float sd = 0.f, sr = 0.f;
              for (size_t i = (size_t)bx * (NWAVES * 64) + tid; i < (size_t)M * DA; i += (size_t)G * NWAVES * 64) { const size_t r = i / DA, c = i % DA;
                  const float a = bf2f(OCAT[r * OC + c]), b = bf2f((XN + (size_t)16 * 1024 * 1024)[r * DA + c]); sd += (a - b) * (a - b); sr += b * b; }
              sd = wave_sum(sd); sr = wave_sum(sr);
              if (lane == 0) { atomicAdd((float*)(ctl + 16), sd); atomicAdd((float*)(ctl + 17), sr); } }
#endif
#if NAIVE_SCAN
            for (int idx = bx * (NWAVES * 64) + tid; idx < BATCH * DR; idx += G * NWAVES * 64) naive_scan_prefix_item(idx, comp, carry);
            if (BOTH(3)) GRID_BAR();
#endif
        }
        if ((PHMASK >> 4 & 1) && IN(4)) {
#if NAIVE_SCAN
            for (int it = gw; it < BATCH * NCH * RB; it += NGW) naive_scan_item<true>(it, lane, xcs, XR, GY, cw, cb, Wa, ba, Wi, bi, lam, comp, carry, OCAT);
#else
            {
                constexpr int I_PA = (DA / 64) * (DM / 32), I_PR = (DR / 64) * (DM / 32), I_OUT = (DM / 64) * (DM / 32), I_F1 = (DM / 64) * (DFF / 32), I_F2 = (DFF / 64) * (DM / 32);
                LAS float* scr = (LAS float*)(lds + RING_OFF + wave * 16384);
                for (int it = gw; it < I_PA + I_PR + I_OUT + I_F1 + I_F2; it += NGW) {
                    int r = it;
                    if (r < I_PA) { p0_transpose_item<0>(args.in[14], DM, Wt_cat, OC, 0, nullptr, scr, r, lane); continue; } r -= I_PA;
                    if (r < I_PR) { p0_transpose_item<0>(args.in[15], DM, Wt_cat, OC, DA, nullptr, scr, r, lane); continue; } r -= I_PR;
                    if (r < I_OUT) { p0_transpose_item<0>(args.in[16], DM, Wt_out, DM, 0, nullptr, scr, r, lane); continue; } r -= I_OUT;
                    if (r < I_F1) { p0_transpose_item<0>(args.in[18], DFF, Wt_ff1, DM, 0, args.in[17], scr, r, lane); continue; } r -= I_F1;
                    p0_transpose_item<0>(args.in[19], DM, Wt_ff2, HP, 0, nullptr, scr, r, lane);
                }
            }
            if (pairmode) {
                if (tid == 0) {
                    if (vcu & 1) { unsigned sp = 0; while (__hip_atomic_load(ctl + CW_PAIR + 64 * (vcu - 1), __ATOMIC_RELAXED, __HIP_MEMORY_SCOPE_AGENT) == 0u) { __builtin_amdgcn_s_sleep(2);
                            if (++sp > (1u << 22)) { __hip_atomic_store(ctl + CW_TMO, 1u, __ATOMIC_RELAXED, __HIP_MEMORY_SCOPE_AGENT); break; } } }
                    __builtin_amdgcn_fence(__ATOMIC_ACQUIRE, "agent"); asm volatile("s_waitcnt vmcnt(0)" ::: "memory"); }
                __syncthreads();
            }
            rnn::scan_phase<true>(lds, vcu, G, wave, lane, tid, XR, GY, cw, cb, Wa, ba, Wi, bi, lam, comp, OCAT);
#endif
            if (BOTH(4)) GRID_BAR();
        }
    }
    if ((PHMASK >> 5 & 1) && IN(5)) {
        pg8::Gemm g = pg8::gemm_rowmajor(OCAT, Wt_cat, OC, OC, OC, DM, DA / 64, args.flags); pg8::StaticOrder S; S.init(M, DM, G, bx, WGM_N4);
        pg8::EpiMerge E{GA, GR, MRG};
        pg8::gemm_phase<pg8::EpiMerge, pg8::StaticOrder, MIDFLAG>(lds + RING_OFF, g, S, E);
        if (BOTH(5)) GRID_BAR();
    }
    if ((PHMASK >> 6 & 1) && IN(6)) {
        pg8::Gemm g = pg8::gemm_rowmajor(MRG, Wt_out, DM, DM, DM, DM, -1, args.flags); g.imgA = 1; g.kstepA = 32768; g.tstepA = (size_t)(DM / 64) * 32768; pg8::StaticOrder S; S.init(M, DM, G, bx, WGM_N4);
        pg8::EpiX1 E{XB, XN, ssq};
        pg8::gemm_phase<pg8::EpiX1, pg8::StaticOrder, false>(lds + RING_OFF, g, S, E);
        if (BOTH(6)) GRID_BAR();
    }
    if ((PHMASK >> 7 & 1) && IN(7)) {
        pg8::Gemm g = pg8::gemm_rowmajor(XN, Wt_ff1, DM, DM, DM, DFF, -1, args.flags); g.imgA = 1; g.kstepA = 32768; g.tstepA = (size_t)(DM / 64) * 32768; pg8::StaticOrder S; S.init(M, DFF, G, bx, WGM_P7);
        LAS float* rs = (LAS float*)(lds + LDSCTL_OFF + 1024);
        { pg8::Unit u0; int nu = 0; while (nu < 8 && S.next(nu, u0)) ++nu;
          for (int e = tid; e < nu * 256; e += NWAVES * 64) { pg8::Unit u1; S.next(e >> 8, u1); const float* sp = ssq + (size_t)(u1.pm * 256 + (e & 255)) * 16;
              const f32x4 s0 = *(const f32x4*)sp, s1 = *(const f32x4*)(sp + 4), s2 = *(const f32x4*)(sp + 8), s3 = *(const f32x4*)(sp + 12);
              const float tot = (((s0[0] + s0[1]) + (s0[2] + s0[3])) + ((s1[0] + s1[1]) + (s1[2] + s1[3]))) + (((s2[0] + s2[1]) + (s2[2] + s2[3])) + ((s3[0] + s3[1]) + (s3[2] + s3[3])));
              rs[e] = 1.0f / sqrtf(tot * (1.0f / DM) + EPS); }
          __syncthreads(); }
        pg8::EpiH E{rs, HB};
        STAGGER(STAG7);
        pg8::gemm_phase<pg8::EpiH, pg8::StaticOrder, false>(lds + RING_OFF, g, S, E);
        if (BOTH(7)) GRID_BAR();
    }
    if ((PHMASK >> 8 & 1) && IN(8)) {
        pg8::Gemm g = pg8::gemm_rowmajor(HB, Wt_ff2, HP, HP, DFF, DM, -1, args.flags); g.imgA = 1; g.kstepA = 32768; g.tstepA = (size_t)(DFF / 64) * 32768;   pg8::StaticOrder S; S.init(M, DM, G, bx, WGM_N4);
        pg8::EpiOut E{XN, args.out};
        pg8::gemm_phase<pg8::EpiOut, pg8::StaticOrder, false>(lds + RING_OFF, g, S, E);
#ifdef PROBE_BARRIERS
        if (multi) { for (int i = 0; i < PROBE_BARRIERS; ++i) GRID_BAR(); }
#endif
#if DBG_ATTN
        GRID_BAR();
        { const float sd = __hip_atomic_load((float*)(ctl + 16), __ATOMIC_RELAXED, __HIP_MEMORY_SCOPE_AGENT), sr = __hip_atomic_load((float*)(ctl + 17), __ATOMIC_RELAXED, __HIP_MEMORY_SCOPE_AGENT);
          const float e = sqrtf(sd / sr) * DBG_AMP;
          for (size_t i = (size_t)bx * (NWAVES * 64) + tid; i < (size_t)M * DM; i += (size_t)G * NWAVES * 64) args.out[i] *= (1.0f + e); }
#endif
    }
#undef IN
#undef BOTH
#undef GRID_BAR
}

#if DBG_ATTN
__global__ void __launch_bounds__(256) naive_attn_k(const bf16_t* Q, const bf16_t* K, const bf16_t* V, const float* kmp, const float* rel_bias, bf16_t* O, int opitch) {
    naive_attn_item(blockIdx.x * 256 + threadIdx.x, Q, K, V, kmp, rel_bias, O, opitch);
}
#endif
constexpr int N_PHASES = 9;
extern "C" void kernel_launch(void* const* d_in, const int* in_sizes, int n_in, void* d_out, int out_size, void* d_ws, size_t ws_size, hipStream_t stream) {
    static int grid = 0;
    if (grid == 0) {
        if (n_in != 20 || in_sizes[0] != M * DM || out_size != M * DM || ws_size < WS_END) { fprintf(stderr, "kernel_launch: unexpected shapes (n_in %d, in0 %d, out %d, ws %zu)\n", n_in, n_in > 0 ? in_sizes[0] : -1, out_size, ws_size); grid = -1; return; }
        int dev = 0, cus = 0;
        if (hipGetDevice(&dev) != hipSuccess || hipDeviceGetAttribute(&cus, hipDeviceAttributeMultiprocessorCount, dev) != hipSuccess) { grid = -1; return; }
        if (hipFuncSetAttribute((const void*)mk_fwd, hipFuncAttributeMaxDynamicSharedMemorySize, LDS_BYTES) != hipSuccess) { fprintf(stderr, "kernel_launch: hipFuncSetAttribute failed\n"); grid = -1; return; }
        (void)hipGetLastError();
        grid = cus;
    }
    if (grid < 0) return;
    (void)hipMemsetAsync((char*)d_ws + WS_CTL, 0, CTL_ZERO_BYTES, stream);
    Args a{};
    for (int i = 0; i < 20; ++i) a.in[i] = (const float*)d_in[i];
    a.out = (float*)d_out; a.ws = (unsigned char*)d_ws;
#if DBG_ATTN
    a.ph_lo = 0; a.ph_hi = 2;
    hipLaunchKernelGGL(mk_fwd, dim3(grid), dim3(NWAVES * 64), LDS_BYTES, stream, a);
    { unsigned char* ws = (unsigned char*)d_ws;
      hipLaunchKernelGGL(naive_attn_k, dim3(BATCH * NH * SEQ / 256), dim3(256), 0, stream, (const bf16_t*)(ws + WS_Q), (const bf16_t*)(ws + WS_K), (const bf16_t*)(ws + WS_V),
                         (const float*)(ws + WS_KMP), (const float*)d_in[6], (bf16_t*)(ws + WS_XN + 32 * MiB), DA); }
    a.ph_lo = 2; a.ph_hi = N_PHASES;
    hipLaunchKernelGGL(mk_fwd, dim3(grid), dim3(NWAVES * 64), LDS_BYTES, stream, a);
#elif defined(PROBE_REP)
#ifndef PROBE_FLAGS
#define PROBE_FLAGS 0
#endif
#ifndef PROBE_LO
#define PROBE_LO PROBE_REP
#endif
    a.ph_lo = 0; a.ph_hi = PROBE_REP + 1;
    hipLaunchKernelGGL(mk_fwd, dim3(grid), dim3(NWAVES * 64), LDS_BYTES, stream, a);
    a.ph_lo = PROBE_LO; a.ph_hi = PROBE_REP + 1; a.flags = PROBE_FLAGS;
    hipLaunchKernelGGL(mk_fwd, dim3(grid), dim3(NWAVES * 64), LDS_BYTES, stream, a);
    a.flags = 0;
    if (PROBE_REP + 1 < N_PHASES) { a.ph_lo = PROBE_REP + 1; a.ph_hi = N_PHASES;
    hipLaunchKernelGGL(mk_fwd, dim3(grid), dim3(NWAVES * 64), LDS_BYTES, stream, a); }
#elif MK_N_LAUNCHES == 1
    a.ph_lo = 0; a.ph_hi = N_PHASES;
    hipLaunchKernelGGL(mk_fwd, dim3(grid), dim3(NWAVES * 64), LDS_BYTES, stream, a);
#else
    for (int p = 0; p < N_PHASES; ++p) { a.ph_lo = p; a.ph_hi = p + 1; hipLaunchKernelGGL(mk_fwd, dim3(grid), dim3(NWAVES * 64), LDS_BYTES, stream, a); }
#endif
}
```

```cpp
#include <hip/hip_runtime.h>
#include <hip/hip_bf16.h>
#include <cstdio>
#include <cstdint>

#ifndef MIDFLAG
#define MIDFLAG true
#endif
#ifndef NAIVE_ATTN
#define NAIVE_ATTN 0
#endif
#ifndef NAIVE_SCAN
#define NAIVE_SCAN 0
#endif
#ifndef DBG_ATTN
#define DBG_ATTN 0
#endif
#ifndef DBG_AMP
#define DBG_AMP 10.0f
#endif
#ifndef STAG1
#define STAG1 0
#endif
#ifndef STAG7
#define STAG7 0
#endif
#ifndef PAIR_SYNC
#define PAIR_SYNC 1
#endif
#ifndef WGM_P1
#define WGM_P1 4
#endif
#ifndef WGM_P7
#define WGM_P7 8
#endif
#ifndef WGM_N4
#define WGM_N4 4
#endif
#ifndef PHMASK
#define PHMASK 0xffff
#endif
#ifndef MK_N_LAUNCHES
#define MK_N_LAUNCHES 1
#endif

constexpr int BATCH = 8, SEQ = 4096, DM = 1024, M = BATCH * SEQ;
constexpr int NH = 8, HD = 64, DA = 512, DR = 1024, DFF = 4096, DIN = 5632;
constexpr int KBLK = 256, NKB = SEQ / KBLK;
constexpr int RB = 16, RBD = 64;
constexpr int OC = DA + DR;
constexpr int HP = DFF + 128;
constexpr float EPS = 1e-6f;
constexpr float LOG2E = 1.4426950408889634f;
constexpr float C2 = 0.125f * LOG2E;

#define LAS __attribute__((address_space(3)))
#define GAS __attribute__((address_space(1)))
typedef unsigned short bf16_t;
typedef short bf16x8 __attribute__((ext_vector_type(8)));
typedef float f32x4 __attribute__((ext_vector_type(4)));
typedef float f32x2 __attribute__((ext_vector_type(2)));
typedef unsigned u32x4 __attribute__((ext_vector_type(4)));
typedef unsigned u32x2 __attribute__((ext_vector_type(2)));

constexpr size_t MiB = 1u << 20;
constexpr size_t WS_CTL = 0, CTL_ZERO_BYTES = 256 * 1024;
constexpr size_t WS_WIN = 2 * MiB;
constexpr size_t WS_WCAT = 13 * MiB;
constexpr size_t WS_WOUT = 16 * MiB;
constexpr size_t WS_WFF1 = 18 * MiB;
constexpr size_t WS_WFF2 = 26 * MiB;
constexpr size_t WS_KMP = 35 * MiB;
constexpr size_t WS_SSQ = 36 * MiB;
constexpr size_t WS_COMP = 38 * MiB;
constexpr size_t WS_CARRY = 42 * MiB;
constexpr size_t WS_KMH = 45 * MiB;
constexpr size_t WS_KML = 45 * MiB + 512 * 1024;
constexpr size_t WS_RSTD1 = 44 * MiB;
constexpr size_t WS_XB = 48 * MiB;
constexpr size_t WS_XR = 112 * MiB;
constexpr size_t WS_GY = 176 * MiB;
constexpr size_t WS_GA = 240 * MiB;
constexpr size_t WS_GR = 304 * MiB;
constexpr size_t WS_H = 112 * MiB;
constexpr size_t WS_K = 368 * MiB;
constexpr size_t WS_V = 400 * MiB;
constexpr size_t WS_MRG = 368 * MiB;
constexpr size_t WS_Q = 432 * MiB;
constexpr size_t WS_XN = 432 * MiB;
constexpr size_t WS_END = 496 * MiB;

constexpr int CW_TMO = 0, CW_BAR = 4096, CW_PAIR = 40000;

__device__ __forceinline__ float bf2f(unsigned short u) { return __uint_as_float(((unsigned)u) << 16); }
__device__ __forceinline__ unsigned f2bf(float f) { unsigned u = __builtin_bit_cast(unsigned, f); return (u + 0x7fffu + ((u >> 16) & 1u)) >> 16; }
__device__ __forceinline__ unsigned pk2(float lo, float hi) { return f2bf(lo) | (f2bf(hi) << 16); }
__device__ __forceinline__ unsigned cvt_pk_bf16(float lo, float hi) { unsigned r; asm volatile("s_nop 0\n\tv_cvt_pk_bf16_f32 %0, %1, %2" : "=v"(r) : "v"(lo), "v"(hi)); return r; }
#ifndef NT_STORES
#define NT_STORES 1
#endif
#if NT_STORES
#define ST16(p, v) __builtin_nontemporal_store((v), (u32x4*)(p))
#define ST16F(p, v) __builtin_nontemporal_store((v), (f32x4*)(p))
#else
#define ST16(p, v) (*(u32x4*)(p) = (v))
#define ST16F(p, v) (*(f32x4*)(p) = (v))
#endif
__device__ __forceinline__ float fast_sigmoid(float x) { return __builtin_amdgcn_rcpf(1.0f + __builtin_amdgcn_exp2f(-LOG2E * x)); }
__device__ __forceinline__ float gelu_tanh(float x) { const float u = x + 0.044715f * x * x * x; return x * __builtin_amdgcn_rcpf(1.0f + __builtin_amdgcn_exp2f(-2.302208198f * u)); }
__device__ __forceinline__ float wave_sum(float v) {
#pragma unroll
    for (int o = 1; o < 64; o <<= 1) v += __shfl_xor(v, o);
    return v;
}
__device__ __forceinline__ int t5_bucket(int n) {
    if (n < 16) return n;
    int b = 16;
    b += (n >= 19); b += (n >= 21); b += (n >= 24); b += (n >= 27); b += (n >= 31); b += (n >= 35); b += (n >= 40); b += (n >= 46);
    b += (n >= 52); b += (n >= 59); b += (n >= 67); b += (n >= 77); b += (n >= 87); b += (n >= 99); b += (n >= 113);
    return b;
}

namespace pg8 {
constexpr int BM = 256, BK = 64, HALF = 128, HTB = HALF * BK * 2, STAGE_BYTES = 8 * HTB, NXCD = 8, WGM = 8;
__host__ __device__ __forceinline__ int lds_byte(int r, int c) { const int st = (r >> 4) * 2 + (c >> 5), rr = r & 15, cc = c & 31, ob = rr * 64 + cc * 2; return st * 1024 + (ob ^ (((ob >> 9) & 1) << 5)); }
__host__ __device__ __forceinline__ void stage_rc(int b, int& R, int& C) { const int st = b / 1024, sb = b % 1024, swz = sb ^ (((sb >> 9) & 1) << 5); R = (st >> 1) * 16 + swz / 64; C = (st & 1) * 32 + (swz % 64) / 2; }
__host__ __device__ __forceinline__ int perm32(int rho) { const int n = rho >> 4, i = rho & 15; return 8 * (i >> 2) + 4 * n + (i & 3); }

struct Unit { int pm, pn, idx; };
struct Gemm { const bf16_t* A; const bf16_t* Bt; int lda, ldb, K, N, mid_t, flags; size_t kstepA, kstepB, tstepA, tstepB; int imgA; };
__host__ __device__ __forceinline__ Gemm gemm_rowmajor(const bf16_t* A, const bf16_t* Bt, int lda, int ldb, int K, int N, int mid_t, int flags) { return Gemm{A, Bt, lda, ldb, K, N, mid_t, flags, (size_t)128, (size_t)128, (size_t)512 * lda, (size_t)512 * ldb, 0}; }

struct StaticOrder {
    int nM, nN, nwg, G, c, wgm;
    __host__ __device__ void init(int M_, int N_, int G_, int c_, int wgm_ = WGM) { nM = M_ / BM; nN = N_ / BM; nwg = nM * nN; G = G_; c = c_; wgm = wgm_; }
    __host__ __device__ bool next(int i, Unit& u) const {
        const long L = (long)i * G + c; if (L >= nwg) return false;
        int wgid = (int)L; { const int q = nwg / NXCD, r = nwg % NXCD, xcd = wgid % NXCD, off = wgid / NXCD; wgid = (xcd < r ? xcd * (q + 1) : r * (q + 1) + (xcd - r) * q) + off; }
        const int nig = wgm * nN, gid = wgid / nig, fm = gid * wgm, gsz = (nM - fm) < wgm ? (nM - fm) : wgm;
        u.pm = fm + ((wgid % nig) % gsz); u.pn = (wgid % nig) / gsz; u.idx = i; return true;
    }
};

typedef f32x4 Acc[2][2][4][2];

template <class Epi, class Sched, bool MID>
__device__ __forceinline__ void gemm_phase(LAS unsigned char* lds, const Gemm g, const Sched& S, const Epi& E) {
    const int tid = threadIdx.x, wid = __builtin_amdgcn_readfirstlane(tid >> 6), lane = tid & 63, wr = wid >> 2, wc = wid & 3, fr = lane & 15, fq = lane >> 4;
    const int nt = g.K / BK;
    unsigned voffA[2], voffB[2];
#pragma unroll
    for (int i = 0; i < 2; ++i) { int R, C; stage_rc(tid * 16 + i * 8192, R, C); const int Rb = Epi::PERM ? ((R & ~31) + perm32(R & 31)) : R;
        voffA[i] = g.imgA ? (unsigned)(tid * 16 + i * 8192) : (unsigned)(R * g.lda + C) * 2u; voffB[i] = (unsigned)(Rb * g.ldb + C) * 2u; }
    const size_t kstepA = g.kstepA, kstepB = g.kstepB;
    const size_t hstepA = g.imgA ? (size_t)HTB : (size_t)HALF * g.lda * 2, hstepB = (size_t)HALF * g.ldb * 2;
    const size_t tstepA = (g.flags & 2) ? 0 : g.tstepA, tstepB = (g.flags & 2) ? 0 : g.tstepB;
    const unsigned ldsw = (unsigned)wid * 1024u;
    const int aoff = lds_byte(wr * 64 + fr, fq * 8), boff = lds_byte(wc * 32 + fr, fq * 8);
#define PG8_SA(b, h) (((b) * 2 + (h)) * HTB)
#define PG8_SB(b, h) ((4 + (b) * 2 + (h)) * HTB)
#define PG8_STAGE(bufoff, gbase, voff) do { _Pragma("unroll") for (int _i = 0; _i < 2; ++_i) \
        __builtin_amdgcn_global_load_lds((const unsigned*)((const char*)(gbase) + (voff)[_i]), (LAS unsigned*)(lds + (bufoff) + ldsw + _i * 8192), 16, 0, 0); } while (0)
#define PG8_LDA(dst, b, h) do { _Pragma("unroll") for (int m = 0; m < 4; ++m) _Pragma("unroll") for (int k = 0; k < 2; ++k) dst[m][k] = *(const LAS bf16x8*)(lds + PG8_SA(b, h) + aoff + m * 2048 + k * 1024); } while (0)
#define PG8_LDB(dst, b, h) do { _Pragma("unroll") for (int n = 0; n < 2; ++n) _Pragma("unroll") for (int k = 0; k < 2; ++k) dst[n][k] = *(const LAS bf16x8*)(lds + PG8_SB(b, h) + boff + n * 2048 + k * 1024); } while (0)
#define PG8_MMA(ai, bj, At, Bt) do { __builtin_amdgcn_s_setprio(1); _Pragma("unroll") for (int m = 0; m < 4; ++m) _Pragma("unroll") for (int n = 0; n < 2; ++n) _Pragma("unroll") for (int k = 0; k < 2; ++k) \
        acc[ai][bj][m][n] = __builtin_amdgcn_mfma_f32_16x16x32_bf16(Bt[n][k], At[m][k], acc[ai][bj][m][n], 0, 0, 0); __builtin_amdgcn_s_setprio(0); } while (0)
#define PG8_WAIT_V(n) asm volatile("s_waitcnt vmcnt(" #n ")" ::: "memory")
#define PG8_WAIT_L(n) asm volatile("s_waitcnt lgkmcnt(" #n ")" ::: "memory")
#define PG8_BAR __builtin_amdgcn_s_barrier()
#define PG8_SCHED __builtin_amdgcn_sched_barrier(0)
    Unit cur, nxt; int ui = 0;
    if (!S.next(0, cur)) return;
    f32x4 acc[2][2][4][2];
#pragma unroll
    for (int a = 0; a < 2; ++a)
#pragma unroll
        for (int b = 0; b < 2; ++b)
#pragma unroll
            for (int m = 0; m < 4; ++m)
#pragma unroll
                for (int n = 0; n < 2; ++n) acc[a][b][m][n] = (f32x4){0.f, 0.f, 0.f, 0.f};
    bf16x8 At[4][2], B0[2][2], B1[2][2];
    const char* cA = (const char*)g.A + (size_t)cur.pm * tstepA; const char* cB = (const char*)g.Bt + (size_t)cur.pn * tstepB;
    PG8_STAGE(PG8_SB(0, 0), cB, voffB); PG8_STAGE(PG8_SB(0, 1), cB + hstepB, voffB); PG8_STAGE(PG8_SA(0, 0), cA, voffA); PG8_STAGE(PG8_SA(0, 1), cA + hstepA, voffA);
    if (wr == 1) PG8_BAR;
    PG8_WAIT_V(2); PG8_BAR;
    PG8_STAGE(PG8_SB(1, 0), cB + kstepB, voffB); PG8_STAGE(PG8_SA(1, 0), cA + kstepA, voffA); PG8_STAGE(PG8_SB(1, 1), cB + hstepB + kstepB, voffB);
    PG8_WAIT_V(6); PG8_BAR;
    for (;;) {
        const bool has_next = S.next(ui + 1, nxt);
        const char* nA = has_next ? (const char*)g.A + (size_t)nxt.pm * tstepA : cA; const char* nB = has_next ? (const char*)g.Bt + (size_t)nxt.pn * tstepB : cB;
        for (int t = 0; t < nt; t += 2) {
            if constexpr (MID) { if (t == g.mid_t) E.mid(acc, cur, wr, wc, fr, fq); }
            const bool last = (t == nt - 2);
            const char* a1 = cA + (size_t)(t + 1) * kstepA;
            const char* a2 = last ? nA : cA + (size_t)(t + 2) * kstepA; const char* b2 = last ? nB : cB + (size_t)(t + 2) * kstepB;
            const char* a3 = a2 + kstepA; const char* b3 = b2 + kstepB;
            PG8_LDB(B0, 0, 0); PG8_LDB(B1, 0, 1); PG8_SCHED; PG8_LDA(At, 0, 0); PG8_STAGE(PG8_SA(1, 1), a1 + hstepA, voffA);
            PG8_WAIT_V(8); PG8_WAIT_L(0); PG8_BAR; PG8_MMA(0, 0, At, B0); PG8_MMA(0, 1, At, B1); PG8_BAR; PG8_SCHED;
            PG8_LDA(At, 0, 1); PG8_STAGE(PG8_SB(0, 0), b2, voffB); PG8_STAGE(PG8_SB(0, 1), b2 + hstepB, voffB); PG8_STAGE(PG8_SA(0, 0), a2, voffA);
            PG8_WAIT_V(8); PG8_WAIT_L(0); PG8_BAR; PG8_MMA(1, 0, At, B0); PG8_MMA(1, 1, At, B1); PG8_BAR; PG8_SCHED;
            PG8_LDB(B0, 1, 0); PG8_LDB(B1, 1, 1); PG8_SCHED; PG8_LDA(At, 1, 0); PG8_STAGE(PG8_SA(0, 1), a2 + hstepA, voffA);
            PG8_WAIT_V(8); PG8_WAIT_L(0); PG8_BAR; PG8_MMA(0, 0, At, B0); PG8_MMA(0, 1, At, B1); PG8_BAR; PG8_SCHED;
            PG8_LDA(At, 1, 1); PG8_STAGE(PG8_SB(1, 0), b3, voffB); PG8_STAGE(PG8_SB(1, 1), b3 + hstepB, voffB); PG8_STAGE(PG8_SA(1, 0), a3, voffA);
            PG8_WAIT_V(8); PG8_WAIT_L(0); PG8_BAR; PG8_MMA(1, 0, At, B0); PG8_MMA(1, 1, At, B1); PG8_BAR; PG8_SCHED;
        }
        if (wr == 0) PG8_BAR;
        if (g.flags & 1) {
#pragma unroll
            for (int a = 0; a < 2; ++a)
#pragma unroll
                for (int b = 0; b < 2; ++b)
#pragma unroll
                    for (int m = 0; m < 4; ++m)
#pragma unroll
                        for (int n = 0; n < 2; ++n) asm volatile("" :: "v"(acc[a][b][m][n]));
        } else E(acc, cur, wr, wc, fr, fq);
        if (!has_next) break;
#pragma unroll
        for (int a = 0; a < 2; ++a)
#pragma unroll
            for (int b = 0; b < 2; ++b)
#pragma unroll
                for (int m = 0; m < 4; ++m)
#pragma unroll
                    for (int n = 0; n < 2; ++n) acc[a][b][m][n] = (f32x4){0.f, 0.f, 0.f, 0.f};
        cur = nxt; cA = nA; cB = nB; ++ui;
        if (wr == 1) PG8_BAR;
    }
    PG8_WAIT_V(0);
    PG8_BAR;
#undef PG8_SA
#undef PG8_SB
#undef PG8_STAGE
#undef PG8_LDA
#undef PG8_LDB
#undef PG8_MMA
#undef PG8_WAIT_V
#undef PG8_WAIT_L
#undef PG8_BAR
#undef PG8_SCHED
}

__device__ __forceinline__ size_t img_off(int pm, int lrow, int col, int KT) { return (((size_t)pm * KT + (col >> 6)) * 2 + (lrow >> 7)) * (size_t)(HTB / 2) + lds_byte(lrow & 127, col & 63) / 2; }
struct EpiZ {
    static constexpr bool PERM = true;
    bf16_t *Q, *K, *V, *XR, *GY, *GA, *GR; float* kmp; const float *qw, *kw, *bg; const LAS float* rs; unsigned char* wsb; LAS float* kx;
    __device__ __forceinline__ void mid(Acc&, const Unit&, int, int, int, int) const {}
    __device__ __forceinline__ void operator()(Acc& acc, const Unit& u, int wr, int wc, int fr, int fq) const {
        const int pn = u.pn; const int row0 = u.pm * BM + wr * 64 + fr;
        const LAS float* rsu = rs + u.idx * BM + wr * 64 + fr;
        if (pn < 4) {
            const bool isq = pn < 2; const int head = (pn & 1) * 4 + wc; const float* nw = isq ? qw : kw; const float osc = isq ? C2 : 1.0f;
            bf16_t* base = (isq ? Q : K) + head * HD + 8 * fq;
            f32x4 wv[2][2];
#pragma unroll
            for (int bj = 0; bj < 2; ++bj)
#pragma unroll
                for (int n = 0; n < 2; ++n) wv[bj][n] = *(const f32x4*)(nw + 32 * bj + 8 * fq + 4 * n) * osc;
            f32x4 cs[2][2];
#pragma unroll
            for (int bj = 0; bj < 2; ++bj)
#pragma unroll
                for (int n = 0; n < 2; ++n) cs[bj][n] = (f32x4){0.f, 0.f, 0.f, 0.f};
#pragma unroll
            for (int ai = 0; ai < 2; ++ai)
#pragma unroll
                for (int m = 0; m < 4; ++m) {
                    float ss = 0.f;
#pragma unroll
                    for (int bj = 0; bj < 2; ++bj)
#pragma unroll
                        for (int n = 0; n < 2; ++n) { const f32x4 v = acc[ai][bj][m][n]; ss += (v[0] * v[0] + v[1] * v[1]) + (v[2] * v[2] + v[3] * v[3]); }
                    ss += __shfl_xor(ss, 16); ss += __shfl_xor(ss, 32);
                    const float r1 = rsu[ai * HALF + m * 16];
                    const float rstd = r1 / sqrtf(ss * (r1 * r1) * (1.0f / 64.0f) + EPS);
                    bf16_t* rowp = isq ? base + (size_t)(row0 + ai * HALF + m * 16) * DA
                                       : K + ((size_t)(((u.pm >> 4) * NH + head) * 64 + (u.pm & 15) * 4 + wr + 2 * ai)) * 4096 + (size_t)fq * 512 + (fr + m * 16) * 8;
#pragma unroll
                    for (int bj = 0; bj < 2; ++bj) {
                        const f32x4 v0 = acc[ai][bj][m][0] * rstd * wv[bj][0], v1 = acc[ai][bj][m][1] * rstd * wv[bj][1];
                        cs[bj][0] += v0; cs[bj][1] += v1;
                        u32x4 w; w.x = cvt_pk_bf16(v0[0], v0[1]); w.y = cvt_pk_bf16(v0[2], v0[3]); w.z = cvt_pk_bf16(v1[0], v1[1]); w.w = cvt_pk_bf16(v1[2], v1[3]);
                        ST16(rowp + (isq ? 32 * bj : 2048 * bj), w); }
                }
            if (!isq) {
#pragma unroll
                for (int bj = 0; bj < 2; ++bj)
#pragma unroll
                    for (int n = 0; n < 2; ++n)
#pragma unroll
                        for (int i = 0; i < 4; ++i) { float s = cs[bj][n][i]; s += __shfl_xor(s, 1); s += __shfl_xor(s, 2); s += __shfl_xor(s, 4); s += __shfl_xor(s, 8); cs[bj][n][i] = s; }
                if (fr == 0) { float* kp = kmp + (size_t)(u.pm * 2 + wr) * DA + head * HD + 8 * fq;
#pragma unroll
                    for (int bj = 0; bj < 2; ++bj) { *(f32x4*)(kp + 32 * bj) = cs[bj][0]; *(f32x4*)(kp + 32 * bj + 4) = cs[bj][1]; } }
                if (fr == 0) { LAS float* kl = kx + wr * 256 + wc * 64 + 8 * fq;
#pragma unroll
                    for (int bj = 0; bj < 2; ++bj) { *(LAS f32x4*)(kl + 32 * bj) = cs[bj][0]; *(LAS f32x4*)(kl + 32 * bj + 4) = cs[bj][1]; } }
                asm volatile("s_waitcnt lgkmcnt(0)" ::: "memory"); __builtin_amdgcn_s_barrier(); asm volatile("" ::: "memory");
                if (wr == 0) { const int d = fr + 16 * fq; const float mean = (kx[wc * 64 + d] + kx[256 + wc * 64 + d]) * (1.0f / 256.0f);
                    const unsigned hb = f2bf(mean), lb = f2bf(mean - __uint_as_float(hb << 16));
                    const size_t o = ((size_t)((u.pm >> 4) * NH + head) * NKB + (u.pm & 15)) * HD + d;
                    ((bf16_t*)(wsb + WS_KMH))[o] = (bf16_t)hb; ((bf16_t*)(wsb + WS_KML))[o] = (bf16_t)lb; }
            }
            return;
        }
        if (pn >= 14) {
            const int ch0 = (pn - 14) * 128 + wc * 32 + 8 * fq;
            const f32x4 ba0 = *(const f32x4*)(bg + ch0), ba1 = *(const f32x4*)(bg + ch0 + 4), br0 = *(const f32x4*)(bg + DM + ch0), br1 = *(const f32x4*)(bg + DM + ch0 + 4);
#pragma unroll
            for (int ai = 0; ai < 2; ++ai)
#pragma unroll
                for (int m = 0; m < 4; ++m) { const float r1 = rsu[ai * HALF + m * 16]; const size_t off = (size_t)(row0 + ai * HALF + m * 16) * DM + ch0;
                    unsigned r0_, r1_, r2_, r3_, g0_, g1_, g2_, g3_;
                    { const f32x4 a = acc[ai][0][m][0] * r1 + ba0, g = acc[ai][1][m][0] * r1 + br0;
                      const float ea0 = 1.0f + __builtin_amdgcn_exp2f(-LOG2E * a[0]), er0 = 1.0f + __builtin_amdgcn_exp2f(-LOG2E * g[0]), ea1 = 1.0f + __builtin_amdgcn_exp2f(-LOG2E * a[1]), er1 = 1.0f + __builtin_amdgcn_exp2f(-LOG2E * g[1]);
                      const float ea2 = 1.0f + __builtin_amdgcn_exp2f(-LOG2E * a[2]), er2 = 1.0f + __builtin_amdgcn_exp2f(-LOG2E * g[2]), ea3 = 1.0f + __builtin_amdgcn_exp2f(-LOG2E * a[3]), er3 = 1.0f + __builtin_amdgcn_exp2f(-LOG2E * g[3]);
                      r0_ = cvt_pk_bf16(er0 * __builtin_amdgcn_rcpf(ea0), er1 * __builtin_amdgcn_rcpf(ea1)); r1_ = cvt_pk_bf16(er2 * __builtin_amdgcn_rcpf(ea2), er3 * __builtin_amdgcn_rcpf(ea3));
                      g0_ = cvt_pk_bf16(__builtin_amdgcn_rcpf(er0), __builtin_amdgcn_rcpf(er1)); g1_ = cvt_pk_bf16(__builtin_amdgcn_rcpf(er2), __builtin_amdgcn_rcpf(er3)); }
                    { const f32x4 a = acc[ai][0][m][1] * r1 + ba1, g = acc[ai][1][m][1] * r1 + br1;
                      const float ea0 = 1.0f + __builtin_amdgcn_exp2f(-LOG2E * a[0]), er0 = 1.0f + __builtin_amdgcn_exp2f(-LOG2E * g[0]), ea1 = 1.0f + __builtin_amdgcn_exp2f(-LOG2E * a[1]), er1 = 1.0f + __builtin_amdgcn_exp2f(-LOG2E * g[1]);
                      const float ea2 = 1.0f + __builtin_amdgcn_exp2f(-LOG2E * a[2]), er2 = 1.0f + __builtin_amdgcn_exp2f(-LOG2E * g[2]), ea3 = 1.0f + __builtin_amdgcn_exp2f(-LOG2E * a[3]), er3 = 1.0f + __builtin_amdgcn_exp2f(-LOG2E * g[3]);
                      r2_ = cvt_pk_bf16(er0 * __builtin_amdgcn_rcpf(ea0), er1 * __builtin_amdgcn_rcpf(ea1)); r3_ = cvt_pk_bf16(er2 * __builtin_amdgcn_rcpf(ea2), er3 * __builtin_amdgcn_rcpf(ea3));
                      g2_ = cvt_pk_bf16(__builtin_amdgcn_rcpf(er0), __builtin_amdgcn_rcpf(er1)); g3_ = cvt_pk_bf16(__builtin_amdgcn_rcpf(er2), __builtin_amdgcn_rcpf(er3)); }
                    const u32x4 wr_ = {r0_, r1_, r2_, r3_}, wg_ = {g0_, g1_, g2_, g3_};
                    ST16(GA + off, wr_); ST16(GR + off, wg_);
                    asm volatile("" ::: "memory"); }
            return;
        }
        if (pn < 6) {
#pragma unroll
            for (int ai = 0; ai < 2; ++ai)
#pragma unroll
                for (int m = 0; m < 4; ++m) { const float r1 = rsu[ai * HALF + m * 16];
#pragma unroll
                    for (int bj = 0; bj < 2; ++bj) { const f32x4 v0 = acc[ai][bj][m][0] * r1, v1 = acc[ai][bj][m][1] * r1; const int head = (pn - 4) * 4 + 2 * bj + (wc >> 1);
                        u32x4 w; w.x = cvt_pk_bf16(v0[0], v0[1]); w.y = cvt_pk_bf16(v0[2], v0[3]); w.z = cvt_pk_bf16(v1[0], v1[1]); w.w = cvt_pk_bf16(v1[2], v1[3]);
                        ST16(V + ((size_t)(((u.pm >> 4) * NH + head) * 64 + (u.pm & 15) * 4 + wr + 2 * ai)) * 4096 + (wc & 1) * 2048 + (fr + m * 16) * 32 + fq * 8, w); } }
            return;
        }
        int mode, ldc, colt; bf16_t* base; const float* bias = nullptr;
        { const size_t boff = (pn < 6) ? WS_V : (pn < 10) ? WS_XR : WS_GY; base = (bf16_t*)(wsb + boff); ldc = (pn < 6) ? DA : DR; colt = (pn - ((pn < 6) ? 4 : (pn < 10) ? 6 : 10)) * BM; mode = (pn < 10) ? 0 : 1; }
        const int col0 = colt + wc * 32 + 8 * fq;
        f32x4 bv[2][2];
#pragma unroll
        for (int bj = 0; bj < 2; ++bj)
#pragma unroll
            for (int n = 0; n < 2; ++n) bv[bj][n] = bias ? *(const f32x4*)(bias + col0 + bj * HALF + 4 * n) : (f32x4){0.f, 0.f, 0.f, 0.f};
#pragma unroll
        for (int ai = 0; ai < 2; ++ai)
#pragma unroll
            for (int m = 0; m < 4; ++m) { bf16_t* rowp = base + (size_t)(row0 + ai * HALF + m * 16) * ldc + col0;
#pragma unroll
                for (int bj = 0; bj < 2; ++bj) { const float r1 = rsu[ai * HALF + m * 16]; f32x4 v0 = acc[ai][bj][m][0] * r1 + bv[bj][0], v1 = acc[ai][bj][m][1] * r1 + bv[bj][1];
                    if (mode == 1) {
#pragma unroll
                        for (int i = 0; i < 4; ++i) { v0[i] = gelu_tanh(v0[i]); v1[i] = gelu_tanh(v1[i]); } }
                    else if (mode == 2) {
#pragma unroll
                        for (int i = 0; i < 4; ++i) { v0[i] = fast_sigmoid(v0[i]); v1[i] = fast_sigmoid(v1[i]); } }
                    u32x4 w; w.x = cvt_pk_bf16(v0[0], v0[1]); w.y = cvt_pk_bf16(v0[2], v0[3]); w.z = cvt_pk_bf16(v1[0], v1[1]); w.w = cvt_pk_bf16(v1[2], v1[3]);
                    ST16(rowp + bj * HALF, w); } }
    }
};

struct EpiMerge {
    static constexpr bool PERM = true;
    const bf16_t *GA, *GR; bf16_t* O;
    __device__ __forceinline__ void mid(Acc& acc, const Unit& u, int wr, int wc, int fr, int fq) const {
        int row0 = u.pm * BM + wr * 64 + fr, col0 = u.pn * BM + wc * 32 + 8 * fq;
        asm volatile("" : "+v"(row0), "+v"(col0));
#pragma unroll
        for (int ai = 0; ai < 2; ++ai)
#pragma unroll
            for (int m = 0; m < 4; ++m) { const size_t off = (size_t)(row0 + ai * HALF + m * 16) * DM + col0;
#pragma unroll
                for (int bj = 0; bj < 2; ++bj) { const u32x4 a = *(const u32x4*)(GA + off + bj * HALF);
#pragma unroll
                    for (int j = 0; j < 4; ++j) { const unsigned aw = a[j];
                        acc[ai][bj][m][j >> 1][(j & 1) * 2] *= __uint_as_float(aw << 16); acc[ai][bj][m][j >> 1][(j & 1) * 2 + 1] *= __uint_as_float(aw & 0xffff0000u); } }
                if (m & 1) asm volatile("" ::: "memory"); }
    }
    __device__ __forceinline__ void operator()(Acc& acc, const Unit& u, int wr, int wc, int fr, int fq) const {
        const int row0 = u.pm * BM + wr * 64 + fr, col0 = u.pn * BM + wc * 32 + 8 * fq;
#pragma unroll
        for (int ai = 0; ai < 2; ++ai)
#pragma unroll
            for (int m = 0; m < 4; ++m) { const size_t off = (size_t)(row0 + ai * HALF + m * 16) * DM + col0;
#pragma unroll
                for (int bj = 0; bj < 2; ++bj) { const u32x4 r = *(const u32x4*)(GR + off + bj * HALF); u32x4 w;
#pragma unroll
                    for (int j = 0; j < 4; ++j) { const unsigned rw = r[j];
                        const float v0 = acc[ai][bj][m][j >> 1][(j & 1) * 2] * __uint_as_float(rw << 16), v1 = acc[ai][bj][m][j >> 1][(j & 1) * 2 + 1] * __uint_as_float(rw & 0xffff0000u);
                        w[j] = cvt_pk_bf16(v0, v1); }
                    ST16(O + img_off(u.pm, wr * 64 + ai * HALF + m * 16 + fr, u.pn * BM + bj * HALF + wc * 32 + 8 * fq, DM / 64), w); }
                if (m & 1) asm volatile("" ::: "memory"); }
    }
};

struct EpiX1 {
    static constexpr bool PERM = true;
    const bf16_t* XB; bf16_t* XN2; float* ssq;
    __device__ __forceinline__ void mid(Acc&, const Unit&, int, int, int, int) const {}
    __device__ __forceinline__ void operator()(Acc& acc, const Unit& u, int wr, int wc, int fr, int fq) const {
        const int row0 = u.pm * BM + wr * 64 + fr, col0 = u.pn * BM + wc * 32 + 8 * fq;
#pragma unroll
        for (int ai = 0; ai < 2; ++ai)
#pragma unroll
            for (int m = 0; m < 4; ++m) { const int row = row0 + ai * HALF + m * 16; const size_t off = (size_t)row * DM + col0; float ss = 0.f;
#pragma unroll
                for (int bj = 0; bj < 2; ++bj) { const u32x4 xw = *(const u32x4*)(XB + off + bj * HALF);
                    const f32x4 x0 = {__uint_as_float(xw.x << 16), __uint_as_float(xw.x & 0xffff0000u), __uint_as_float(xw.y << 16), __uint_as_float(xw.y & 0xffff0000u)};
                    const f32x4 x1 = {__uint_as_float(xw.z << 16), __uint_as_float(xw.z & 0xffff0000u), __uint_as_float(xw.w << 16), __uint_as_float(xw.w & 0xffff0000u)};
                    const f32x4 v0 = acc[ai][bj][m][0] + x0, v1 = acc[ai][bj][m][1] + x1;
                    u32x4 w; w.x = cvt_pk_bf16(v0[0], v0[1]); w.y = cvt_pk_bf16(v0[2], v0[3]); w.z = cvt_pk_bf16(v1[0], v1[1]); w.w = cvt_pk_bf16(v1[2], v1[3]);
                    ST16(XN2 + img_off(u.pm, wr * 64 + ai * HALF + m * 16 + fr, u.pn * BM + bj * HALF + wc * 32 + 8 * fq, DM / 64), w);
                    ss += ((v0[0] * v0[0] + v0[1] * v0[1]) + (v0[2] * v0[2] + v0[3] * v0[3])) + ((v1[0] * v1[0] + v1[1] * v1[1]) + (v1[2] * v1[2] + v1[3] * v1[3])); }
                ss += __shfl_xor(ss, 16); ss += __shfl_xor(ss, 32);
                if (fq == 0) ssq[(size_t)row * 16 + u.pn * 4 + wc] = ss;
                if (m & 1) asm volatile("" ::: "memory"); }
    }
};

struct EpiH {
    static constexpr bool PERM = true;
    const LAS float* rs; bf16_t* H;
    __device__ __forceinline__ void mid(Acc&, const Unit&, int, int, int, int) const {}
    __device__ __forceinline__ void operator()(Acc& acc, const Unit& u, int wr, int wc, int fr, int fq) const {
        const int lrow0 = wr * 64 + fr;
        const LAS float* rsu = rs + u.idx * BM;
#pragma unroll
        for (int ai = 0; ai < 2; ++ai)
#pragma unroll
            for (int m = 0; m < 4; ++m) { const int lrow = lrow0 + ai * HALF + m * 16;
                const float rstd = rsu[lrow];
                bf16_t* rowp = H + (((size_t)u.pm * (DFF / 64) + u.pn * 4 + (wc >> 1)) * 2 + ai) * (HTB / 2) + lds_byte(wr * 64 + m * 16 + fr, (wc & 1) * 32 + 8 * fq) / 2;
#pragma unroll
                for (int bj = 0; bj < 2; ++bj) { f32x4 v0 = acc[ai][bj][m][0] * rstd, v1 = acc[ai][bj][m][1] * rstd;
#pragma unroll
                    for (int i = 0; i < 4; ++i) { const float a = fmaxf(v0[i], 0.f), b = fmaxf(v1[i], 0.f); v0[i] = a * a; v1[i] = b * b; }
                    u32x4 w; w.x = cvt_pk_bf16(v0[0], v0[1]); w.y = cvt_pk_bf16(v0[2], v0[3]); w.z = cvt_pk_bf16(v1[0], v1[1]); w.w = cvt_pk_bf16(v1[2], v1[3]);
                    ST16(rowp + bj * (2 * 256 * 64), w); } }
    }
};

struct EpiOut {
    static constexpr bool PERM = true;
    const bf16_t* XN2; float* OUT;
    __device__ __forceinline__ void mid(Acc&, const Unit&, int, int, int, int) const {}
    __device__ __forceinline__ void operator()(Acc& acc, const Unit& u, int wr, int wc, int fr, int fq) const {
        const int row0 = u.pm * BM + wr * 64 + fr, col0 = u.pn * BM + wc * 32 + 8 * fq;
#pragma unroll
        for (int ai = 0; ai < 2; ++ai)
#pragma unroll
            for (int m = 0; m < 4; ++m) { const size_t off = (size_t)(row0 + ai * HALF + m * 16) * DM + col0;
#pragma unroll
                for (int bj = 0; bj < 2; ++bj) { const u32x4 xw = *(const u32x4*)(XN2 + img_off(u.pm, wr * 64 + ai * HALF + m * 16 + fr, u.pn * BM + bj * HALF + wc * 32 + 8 * fq, DM / 64));
                    const f32x4 x0 = {__uint_as_float(xw.x << 16), __uint_as_float(xw.x & 0xffff0000u), __uint_as_float(xw.y << 16), __uint_as_float(xw.y & 0xffff0000u)};
                    const f32x4 x1 = {__uint_as_float(xw.z << 16), __uint_as_float(xw.z & 0xffff0000u), __uint_as_float(xw.w << 16), __uint_as_float(xw.w & 0xffff0000u)};
                    ST16F(OUT + off + bj * HALF, acc[ai][bj][m][0] + x0); ST16F(OUT + off + bj * HALF + 4, acc[ai][bj][m][1] + x1); }
                if (m & 1) asm volatile("" ::: "memory"); }
    }
};
}

#define XB_TMO      128
#define XB_XCNT(j)  (256  + 64 * (j))
#define XB_XSUB(j)  (1280 + 64 * (j))
#define XB_XGEN(j)  (2304 + 64 * (j))
#define XB_TOP      3328
#define XB_TOPGEN   3392
#define XCD_BAR_WORDS 3456
#define XB_SPIN_CAP (1u << 18)
__device__ __forceinline__ unsigned xb_ld(unsigned* p)              { return __hip_atomic_load(p, __ATOMIC_RELAXED, __HIP_MEMORY_SCOPE_AGENT); }
__device__ __forceinline__ unsigned xb_add(unsigned* p, unsigned v) { return __hip_atomic_fetch_add(p, v, __ATOMIC_RELAXED, __HIP_MEMORY_SCOPE_AGENT); }
__device__ __forceinline__ unsigned xb_xcc_id() { return (unsigned)__builtin_amdgcn_s_getreg((3 << 11) | 20) & 0xFu; }
#define XB_SPIN(cond, bar) do { unsigned _sp = 0; while (cond) { __builtin_amdgcn_s_sleep(1); \
    if ((++_sp & 255u) == 0u) { if (xb_ld(&(bar)[XB_TMO])) break; if (_sp > XB_SPIN_CAP) { atomicAdd(&(bar)[XB_TMO], 1u); break; } } } } while (0)
struct XcdBarrier { unsigned* bar; unsigned x; volatile LAS unsigned* st; };
__device__ __forceinline__ XcdBarrier xcd_barrier_post(unsigned* bar, volatile LAS unsigned* st) {
    XcdBarrier b; b.bar = bar; b.x = xb_xcc_id(); b.st = st;
    if (threadIdx.x == 0) (void)xb_add(&bar[XB_XCNT(b.x)], 1u);
    return b;
}
__device__ __forceinline__ void xcd_barrier_complete(unsigned* bar, unsigned x, unsigned& nloc, unsigned& nx) {
    const unsigned G = gridDim.x * gridDim.y * gridDim.z;
    unsigned sum, cnt, mine, sp = 0u;
    for (;;) {
        sum = 0u; cnt = 0u; mine = 0u;
#pragma unroll
        for (unsigned j = 0; j < 16; ++j) { const unsigned c = xb_ld(&bar[XB_XCNT(j)]); sum += c; cnt += (c > 0u) ? 1u : 0u; mine = (j == x) ? c : mine; }
        if (sum == G) break;
        __builtin_amdgcn_s_sleep(1);
        if ((++sp & 255u) == 0u) { if (xb_ld(&bar[XB_TMO])) break; if (sp > XB_SPIN_CAP) { atomicAdd(&bar[XB_TMO], 1u); break; } }
    }
    nloc = mine > 0u ? mine : 1u; nx = cnt > 0u ? cnt : 1u;
}
__device__ __forceinline__ void xcd_barrier(const XcdBarrier& b) {
    asm volatile("s_waitcnt vmcnt(0)" ::: "memory");
    __syncthreads();
    if (threadIdx.x == 0) {
        unsigned* bar = b.bar;
        __builtin_amdgcn_s_waitcnt(0);
        unsigned nloc = b.st[0], nx = b.st[1];
        if (nloc == 0u) { xcd_barrier_complete(bar, b.x, nloc, nx); b.st[0] = nloc; b.st[1] = nx; }
        const unsigned old = xb_add(&bar[XB_XSUB(b.x)], 1u);
        const unsigned gen = old / nloc;
        if (old + 1u == (gen + 1u) * nloc) {
            __builtin_amdgcn_fence(__ATOMIC_RELEASE, "agent");
            asm volatile("s_waitcnt vmcnt(0)" ::: "memory");
            const unsigned og = xb_add(&bar[XB_TOP], 1u);
            const unsigned tg = og / nx;
            if (og + 1u == (tg + 1u) * nx) xb_add(&bar[XB_TOPGEN], 1u);
            else XB_SPIN(xb_ld(&bar[XB_TOPGEN]) == tg, bar);
            __builtin_amdgcn_fence(__ATOMIC_ACQUIRE, "agent");
            xb_add(&bar[XB_XGEN(b.x)], 1u);
            asm volatile("s_waitcnt vmcnt(0)" ::: "memory");
        } else {
            XB_SPIN(xb_ld(&bar[XB_XGEN(b.x)]) == gen, bar);
            __builtin_amdgcn_fence(__ATOMIC_ACQUIRE, "agent");
            asm volatile("s_waitcnt vmcnt(0)" ::: "memory");
        }
    }
    __syncthreads();
}

constexpr int RING_OFF = 0, RING_BYTES = 131072;
constexpr int LDSCTL_OFF = RING_BYTES, MISC_OFF = LDSCTL_OFF + 320;
constexpr int LDS_BYTES = 147456;
constexpr int NWAVES = 8;

struct Args { const float* in[20]; float* out; unsigned char* ws; int ph_lo, ph_hi, flags, pad; };

template <int RMAP>
__device__ __forceinline__ int p0_rowmap(int n) {
    if (RMAP == 1) { if (n < 1024) { const int pn = n >> 8, lc = n & 255, hh = lc >> 6, d = lc & 63; return pn * 256 + 128 * (d >> 5) + 32 * hh + (d & 31); }
        if (n >= 3584) { const int isr = n >= 4608, c = n - (isr ? 4608 : 3584); return 256 * (14 + (c >> 7)) + 128 * isr + (c & 127); }
        return n; }
    return n;
}
template <int RMAP>
__device__ __forceinline__ void p0_transpose_item(const float* W, int N, bf16_t* WT, int ldt, int koff, const float* kscale, LAS float* scr, int item, int lane) {
    const int nblk = N / 32, kb = item / nblk, nb = item % nblk, k0 = 64 * kb, n0 = 32 * nb;
    float wv_[32];
#pragma unroll
    for (int i = 0; i < 32; ++i) { const int kk = 2 * i + (lane >> 5); wv_[i] = __builtin_nontemporal_load(W + (size_t)(k0 + kk) * N + n0 + (lane & 31)); }
    if (kscale) {
#pragma unroll
        for (int i = 0; i < 32; ++i) wv_[i] *= kscale[k0 + 2 * i + (lane >> 5)]; }
#pragma unroll
    for (int i = 0; i < 32; ++i) scr[(2 * i + (lane >> 5)) * 33 + (lane & 31)] = wv_[i];
    asm volatile("s_waitcnt lgkmcnt(0)" ::: "memory");
    const int c = lane & 7;
#pragma unroll
    for (int j = 0; j < 4; ++j) { const int n = (lane >> 3) + 8 * j; const LAS float* s = scr + (8 * c) * 33 + n;
        u32x4 o; o.x = pk2(s[0 * 33], s[1 * 33]); o.y = pk2(s[2 * 33], s[3 * 33]); o.z = pk2(s[4 * 33], s[5 * 33]); o.w = pk2(s[6 * 33], s[7 * 33]);
        *(u32x4*)(WT + (size_t)p0_rowmap<RMAP>(n0 + n) * ldt + koff + k0 + 8 * c) = o; }
    asm volatile("s_waitcnt lgkmcnt(0)" ::: "memory");
}
__device__ __forceinline__ void rms_row_to_bf16(const f32x4 (&v)[4], float* rstd_out, bf16_t* orow, int lane) {
    float s = 0.f;
#pragma unroll
    for (int j = 0; j < 4; ++j) s += (v[j].x * v[j].x + v[j].y * v[j].y) + (v[j].z * v[j].z + v[j].w * v[j].w);
    const float rstd = 1.f / sqrtf(wave_sum(s) * (1.f / DM) + EPS);
    if (lane == 0) *rstd_out = rstd;
    unsigned p[4][2];
#pragma unroll
    for (int j = 0; j < 4; ++j) { p[j][0] = pk2(v[j].x, v[j].y); p[j][1] = pk2(v[j].z, v[j].w); }
    const bool odd = lane & 1;
#pragma unroll
    for (int h = 0; h < 2; ++h) {
        const unsigned s0 = odd ? p[2 * h][0] : p[2 * h + 1][0], s1 = odd ? p[2 * h][1] : p[2 * h + 1][1];
        const unsigned r0 = __shfl_xor(s0, 1), r1 = __shfl_xor(s1, 1);
        u32x4 o; if (odd) { o.x = r0; o.y = r1; o.z = p[2 * h + 1][0]; o.w = p[2 * h + 1][1]; } else { o.x = p[2 * h][0]; o.y = p[2 * h][1]; o.z = r0; o.w = r1; }
        *(u32x4*)(orow + 256 * (2 * h + (odd ? 1 : 0)) + 8 * (lane >> 1)) = o; }
}

namespace attn_body {
using bf16=__hip_bfloat16;
using s16x4=__attribute__((ext_vector_type(4)))short;
using f32x16=__attribute__((ext_vector_type(16)))float;
constexpr int D=64,PQ=::DA,PO=::OC;
constexpr int NW=8,QBLK=32,QB=QBLK*NW,KVBLK=64,NQB=::SEQ/QB;
constexpr int TAB_N=384, LDS_TAB=86016;
__device__ __forceinline__ int crow(int r,int hi){return (r&3)+8*(r>>2)+4*hi;}
#define SBAR() __builtin_amdgcn_sched_barrier(0)
__device__ __forceinline__ void bmask(f32x16&p0,f32x16&p1,int jb,int qrel,int hi,const __attribute__((address_space(3))) float*tab){
  const int base=qrel-64*jb-4*hi+255;
  #pragma unroll
  for(int r=0;r<16;++r){const int i0=base-((r&3)+8*(r>>2)); const int j0=i0<368?i0:368; const int i1=i0-32; const int j1=i1<368?i1:368; p0[r]+=tab[j0]; p1[r]+=tab[j1];}
}

constexpr int NSLOT=3, SLOTB=8192;
constexpr int LDS_K=0, LDS_V=NSLOT*SLOTB, LDS_WS=2*NSLOT*SLOTB, LDS_OST=LDS_WS+NW*64*4, LDS_BYTES=LDS_OST+NW*4096;
__device__ __forceinline__ void glds16(const void*gsrc,unsigned lds_dst){unsigned keep;
  asm volatile("s_mov_b32 %0, m0\n\ts_mov_b32 m0, %2\n\ts_nop 0\n\tglobal_load_lds_dwordx4 %1, off\n\ts_mov_b32 m0, %0":"=&s"(keep):"v"(gsrc),"s"(lds_dst):"memory");}
__device__ __forceinline__ float max3f(float a,float b,float c){float r;asm("v_max3_f32 %0, %1, %2, %3":"=v"(r):"v"(a),"v"(b),"v"(c));return r;}
__device__ __forceinline__ float max2f(float a,float b){float r;asm("v_max_f32_e32 %0, %1, %2":"=v"(r):"v"(a),"v"(b));return r;}
__device__ __forceinline__ float fadd_s(float a,float b){float r;asm("v_add_f32_e32 %0, %1, %2":"=v"(r):"v"(a),"v"(b));return r;}
__device__ __forceinline__ float fsub_s(float a,float b){float r;asm("v_sub_f32_e32 %0, %1, %2":"=v"(r):"v"(a),"v"(b));return r;}
typedef float f32x2_t __attribute__((ext_vector_type(2))); typedef __bf16 bf16x2_t __attribute__((ext_vector_type(2)));
__device__ __forceinline__ unsigned cvtpk_s(float lo,float hi){f32x2_t v={lo,hi};bf16x2_t b=__builtin_convertvector(v,bf16x2_t);return __builtin_bit_cast(unsigned,b);}
#define WAIT_BAR(N) asm volatile("s_waitcnt vmcnt(" #N ") lgkmcnt(0)\n\ts_barrier":::"memory")

__device__ __forceinline__ void qkt(f32x16&p0,f32x16&p1,const char*Kslot,const bf16x8*qr,const f32x16&negm,int r32,int hi){
  const char*kb=Kslot+hi*1024+r32*16;
  #pragma unroll
  for(int d0=0;d0<4;++d0){
    const bf16x8 b0=*reinterpret_cast<const bf16x8*>(kb+d0*2048);
    const bf16x8 b1=*reinterpret_cast<const bf16x8*>(kb+d0*2048+512);
    if(d0==0){p0=__builtin_amdgcn_mfma_f32_32x32x16_bf16(b0,qr[0],negm,0,0,0);p1=__builtin_amdgcn_mfma_f32_32x32x16_bf16(b1,qr[0],negm,0,0,0);}
    else{p0=__builtin_amdgcn_mfma_f32_32x32x16_bf16(b0,qr[d0],p0,0,0,0);p1=__builtin_amdgcn_mfma_f32_32x32x16_bf16(b1,qr[d0],p1,0,0,0);}}
}
typedef __attribute__((address_space(3))) const char* lds_cptr;
typedef short v4i16_t __attribute__((ext_vector_type(4)));
__device__ __forceinline__ void kload8(bf16x8*kf,lds_cptr kp){
  kf[0]=*(const __attribute__((address_space(3))) bf16x8*)(kp);      kf[1]=*(const __attribute__((address_space(3))) bf16x8*)(kp+512);
  kf[2]=*(const __attribute__((address_space(3))) bf16x8*)(kp+2048); kf[3]=*(const __attribute__((address_space(3))) bf16x8*)(kp+2560);
  kf[4]=*(const __attribute__((address_space(3))) bf16x8*)(kp+4096); kf[5]=*(const __attribute__((address_space(3))) bf16x8*)(kp+4608);
  kf[6]=*(const __attribute__((address_space(3))) bf16x8*)(kp+6144); kf[7]=*(const __attribute__((address_space(3))) bf16x8*)(kp+6656);
}
__device__ __forceinline__ void kload2(bf16x8*kf,lds_cptr kp,int j){ kf[2*j]=*(const __attribute__((address_space(3))) bf16x8*)(kp+j*2048); kf[2*j+1]=*(const __attribute__((address_space(3))) bf16x8*)(kp+j*2048+512); }
__device__ __forceinline__ s16x4 vtr(lds_cptr p){ return __builtin_bit_cast(s16x4,__builtin_amdgcn_ds_read_tr16_b64_v4i16((__attribute__((address_space(3))) v4i16_t*)p)); }
__device__ __forceinline__ float rowmax(const f32x16&p0,const f32x16&p1){
  float a=max3f(p0[0],p0[1],p1[0]),b=max3f(p0[2],p0[3],p1[1]);a=max3f(a,p1[2],p1[3]);
  #pragma unroll
  for(int r=4;r<16;r+=4){a=max3f(a,p0[r],p0[r+1]);b=max3f(b,p0[r+2],p0[r+3]);a=max3f(a,p1[r],p1[r+1]);b=max3f(b,p1[r+2],p1[r+3]);}
  const float m=max2f(a,b);
  auto rr=__builtin_amdgcn_permlane32_swap(__float_as_uint(m),__float_as_uint(m),false,false);
  return max2f(__uint_as_float(rr[0]),__uint_as_float(rr[1]));
}
__device__ __forceinline__ void pv(f32x16*o,int vb,bf16x8 pa0,bf16x8 pa1,bf16x8 pa2,bf16x8 pa3){
  #pragma unroll
  for(int d0=0;d0<2;++d0){s16x4 lo[4],hi[4];
    #pragma unroll
    for(int ks=0;ks<4;++ks){
      asm volatile("ds_read_b64_tr_b16 %0,%1 offset:%c2":"=&v"(lo[ks]):"v"(vb),"i"(d0*4096+ks*1024):"memory");
      asm volatile("ds_read_b64_tr_b16 %0,%1 offset:%c2":"=&v"(hi[ks]):"v"(vb),"i"(d0*4096+ks*1024+512):"memory");}
    asm volatile("s_waitcnt lgkmcnt(0)":::"memory");SBAR();
    #define PK(k) (bf16x8){lo[k][0],lo[k][1],lo[k][2],lo[k][3],hi[k][0],hi[k][1],hi[k][2],hi[k][3]}
    o[d0]=__builtin_amdgcn_mfma_f32_32x32x16_bf16(pa0,PK(0),o[d0],0,0,0);
    o[d0]=__builtin_amdgcn_mfma_f32_32x32x16_bf16(pa1,PK(1),o[d0],0,0,0);
    o[d0]=__builtin_amdgcn_mfma_f32_32x32x16_bf16(pa2,PK(2),o[d0],0,0,0);
    o[d0]=__builtin_amdgcn_mfma_f32_32x32x16_bf16(pa3,PK(3),o[d0],0,0,0);
    #undef PK
  }
}

#ifndef ATTN_STORE16
#define ATTN_STORE16(p,v) ST16(p,v)
#endif
template<int THRL> __device__ __forceinline__ void attn_unit(int b,int h,int qb,const bf16*Q,const bf16*__restrict__ K,const bf16*__restrict__ V,const unsigned short*__restrict__ kmh,const unsigned short*__restrict__ kml,bf16*O,char*shm){
  const int tid=threadIdx.x,lane=tid&63,r32=lane&31,hi=lane>>5; const int wid=__builtin_amdgcn_readfirstlane(tid>>6);
  const long rowbase=(long)b*::SEQ; const int q0=qb*QB;
  const bf16*Qw=Q+(rowbase+q0+wid*QBLK)*PQ+h*D;
  const bf16*Kh=K+(size_t)(b*::NH+h)*64*4096,*Vh=V+(size_t)(b*::NH+h)*64*4096;
  const unsigned lds0=(unsigned)(uintptr_t)shm;
  float*wsf=(float*)(shm+LDS_WS)+wid*64;
  const bf16*ksrc=Kh+wid*512+lane*8;
  const bf16*vsrc=Vh+wid*512+lane*8;
  const unsigned kdst=lds0+LDS_K+wid*1024, vdst=lds0+LDS_V+wid*1024;
  #define TOFF(t) ((long)(((t)<4)?(4*qb+(t)):((t)-4))*4096)
  #define DMA_K(t,slot) glds16(ksrc+TOFF(t),(unsigned)__builtin_amdgcn_readfirstlane(kdst+(slot)))
  #define DMA_V(t,slot) glds16(vsrc+TOFF(t),(unsigned)__builtin_amdgcn_readfirstlane(vdst+(slot)))
  const int vb0=(int)(lds0+LDS_V)+((lane>>4)&1)*32+(lane&3)*8+(4*hi+((lane&15)>>2))*64;
  const char*Kbase=shm+LDS_K; bf16x8 kf[8];
  const lds_cptr shm3=(lds_cptr)shm; const lds_cptr kp0=shm3+LDS_K+hi*1024+r32*16; const lds_cptr vp0=shm3+LDS_V+((lane>>4)&1)*32+(lane&3)*8+(4*hi+((lane&15)>>2))*64;
  const int NT=(q0+QB)/KVBLK;
  DMA_K(0,0);DMA_V(0,0);DMA_K(1,SLOTB);
  bf16x8 qr[4];
  #pragma unroll
  for(int d0=0;d0<4;++d0)qr[d0]=*reinterpret_cast<const bf16x8*>(&Qw[(long)r32*PQ+d0*16+hi*8]);
  float mhat=0.f,l_reg=0.f;f32x16 o[2];o[0]=f32x16{};o[1]=f32x16{};f32x16 negm=f32x16{};asm volatile("":"+v"(negm));
  const int qrel=wid*QBLK+r32;
  const __attribute__((address_space(3))) float*tab=(const __attribute__((address_space(3))) float*)((lds_cptr)shm+LDS_TAB)+h*TAB_N;
  unsigned selmask=0u;
  if(qb>0){
    f32x16 gacc=f32x16{};
    const size_t ko=((size_t)(b*::NH+h)*::NKB+(r32&15))*D+hi*8;
    #pragma unroll
    for(int d0=0;d0<4;++d0){ const bf16x8 ah=*(const bf16x8*)(kmh+ko+d0*16), al=*(const bf16x8*)(kml+ko+d0*16);
      gacc=__builtin_amdgcn_mfma_f32_32x32x16_bf16(ah,qr[d0],gacc,0,0,0);
      gacc=__builtin_amdgcn_mfma_f32_32x32x16_bf16(al,qr[d0],gacc,0,0,0); }
    float g[16];
    #pragma unroll
    for(int r=0;r<4;++r){ const float m0=gacc[r],o0=__shfl_xor(m0,32),m1=gacc[4+r],o1=__shfl_xor(m1,32);
      g[r]=hi?o0:m0; g[4+r]=hi?m0:o0; g[8+r]=hi?o1:m1; g[12+r]=hi?m1:o1; }
    #pragma unroll
    for(int j=0;j<16;++j) if(j>=qb) g[j]=-INFINITY;
    #pragma unroll
    for(int rd=0;rd<3;++rd){ float best=-INFINITY; int bi=-1;
      #pragma unroll
      for(int j=0;j<16;++j) if(g[j]>best){best=g[j];bi=j;}
      if(bi>=0) selmask|=1u<<bi;
      #pragma unroll
      for(int j=0;j<16;++j) if(j==bi) g[j]=-INFINITY; }
  }
  #define SELT(t) (((t)<4)||((selmask>>(((t)-4)>>2))&1u))
  #define CMASK(P0,P1,t) do{ if((t)<4){ const int rmax_=wid*32+31-64*(t), rmin_=wid*32-64*(t)-63; if(rmax_<0){ _Pragma("unroll") for(int r=0;r<16;++r){P0[r]=-INFINITY;P1[r]=-INFINITY;} } else if(rmin_<=112) bmask(P0,P1,(t),qrel,hi,tab); } \
    else if((t)>=NT-2){ const int q0_=wid*32+128-64*((t)-(NT-2)); if(q0_-63<=112) bmask(P0,P1,0,qrel+128-64*((t)-(NT-2)),hi,tab); } }while(0)
  bool resc=false;
  #define START(P0,P1) do{ const float rm=rowmax(P0,P1); resc=false; \
    { const float dl=rm; mhat=fadd_s(mhat,dl); \
      _Pragma("unroll") for(int r=0;r<16;++r){P0[r]=fsub_s(P0[r],dl);P1[r]=fsub_s(P1[r],dl);} \
      _Pragma("unroll") for(int r=0;r<16;++r)negm[r]=-mhat; asm volatile("":"+v"(negm)); } \
    _Pragma("unroll") for(int r=0;r<16;++r)P0[r]=__builtin_amdgcn_exp2f(P0[r]); }while(0)
  #define RESC() do{ if(resc){ asm volatile("s_waitcnt lgkmcnt(0)":::"memory"); \
      _Pragma("unroll") for(int d_=0;d_<2;++d_) _Pragma("unroll") for(int r=0;r<16;++r)o[d_][r]*=wsf[crow(r,hi)]; } }while(0)
  f32x16 pA0,pA1,pB0,pB1;
  int sl_prev=0,sl_cur=0,sl_next=SLOTB;
  #define ROT() do{sl_prev=sl_cur;sl_cur=sl_next;sl_next=(sl_next==(NSLOT-1)*SLOTB)?0:sl_next+SLOTB;}while(0)
  DMA_K(2,2*SLOTB);
  WAIT_BAR(3);
  qkt(pA0,pA1,Kbase,qr,negm,r32,hi);asm volatile("s_nop 15\n\ts_nop 7":"+v"(pA0),"+v"(pA1));CMASK(pA0,pA1,0);
  START(pA0,pA1);
  _Pragma("unroll") for(int r=0;r<16;++r)pA1[r]=__builtin_amdgcn_exp2f(pA1[r]);
  WAIT_BAR(0);
  DMA_K(3,0);DMA_V(1,SLOTB);
  ROT();
  kload8(kf,kp0+sl_cur);
  WAIT_BAR(2);
  s16x4 vlo[8],vhi[8]; u32x4 pw0,pw1,pw2,pw3;
  #define PKW(P,B) cvtpk_s(P[B],P[B+1])
  #define PAF(k) __builtin_bit_cast(bf16x8,pw##k)
  #define VFR(i) (bf16x8){vlo[i][0],vlo[i][1],vlo[i][2],vlo[i][3],vhi[i][0],vhi[i][1],vhi[i][2],vhi[i][3]}
  #define PIN(x) asm volatile("":"+v"(x))
  #define MX3(a,b,c) __builtin_fmaxf(__builtin_fmaxf((a),(b)),(c))
  #define GAPA(MF,A0,A1,A2,A3,W0,W1,PW) do{ MF; sacc+=A0; sacc+=A1; sacc+=A2; sacc+=A3; PIN(sacc); W0; W1; PIN(PW); SBAR(); }while(0)
  #define EX(v) __builtin_amdgcn_exp2f(v)
  #define GAPB(MF,X,B) do{ MF; X[B]=EX(X[B]); X[B+1]=EX(X[B+1]); X[B+2]=EX(X[B+2]); X[B+3]=EX(X[B+3]); PIN(X); SBAR(); }while(0)
  #define VRD(i) do{ vlo[i]=vtr(vp_+(((i)>>2)*4096+((i)&3)*1024)); vhi[i]=vtr(vp_+(((i)>>2)*4096+((i)&3)*1024+512)); }while(0)
  #define KRD(G,j) do{ if(G){ kload2(kf,kp0+sl_next,j); SBAR(); } }while(0)
  #define STEP(C0,C1,P0,P1,t,GK,GV,GL) do{ SBAR(); \
    { const float nv_=SELT(t)?-mhat:-INFINITY; _Pragma("unroll") for(int r=0;r<16;++r)negm[r]=nv_; asm volatile("":"+v"(negm)); } SBAR(); \
    const lds_cptr vp_=vp0+sl_prev; \
    VRD(0); SBAR(); float sacc=(P0[0]+P0[1]); \
    GAPA(C0=__builtin_amdgcn_mfma_f32_32x32x16_bf16(kf[0],qr[0],negm,0,0,0), P0[2],P0[3],P0[4],P0[5],     pw0[0]=PKW(P0,0), pw0[1]=PKW(P0,2), pw0); \
    VRD(4); SBAR(); GAPA(C1=__builtin_amdgcn_mfma_f32_32x32x16_bf16(kf[1],qr[0],negm,0,0,0), P0[6],P0[7],P0[8],P0[9],     pw0[2]=PKW(P0,4), pw0[3]=PKW(P0,6), pw0); \
    VRD(1); SBAR(); GAPA(C0=__builtin_amdgcn_mfma_f32_32x32x16_bf16(kf[2],qr[1],C0,0,0,0),   P0[10],P0[11],P0[12],P0[13], pw1[0]=PKW(P0,8), pw1[1]=PKW(P0,10), pw1); \
    VRD(5); SBAR(); GAPA(C1=__builtin_amdgcn_mfma_f32_32x32x16_bf16(kf[3],qr[1],C1,0,0,0),   P0[14],P0[15],P1[0],P1[1],   pw1[2]=PKW(P0,12),pw1[3]=PKW(P0,14), pw1); \
    VRD(2); SBAR(); GAPA(C0=__builtin_amdgcn_mfma_f32_32x32x16_bf16(kf[4],qr[2],C0,0,0,0),   P1[2],P1[3],P1[4],P1[5],     pw2[0]=PKW(P1,0), pw2[1]=PKW(P1,2), pw2); \
    VRD(6); SBAR(); GAPA(C1=__builtin_amdgcn_mfma_f32_32x32x16_bf16(kf[5],qr[2],C1,0,0,0),   P1[6],P1[7],P1[8],P1[9],     pw2[2]=PKW(P1,4), pw2[3]=PKW(P1,6), pw2); \
    VRD(3); SBAR(); GAPA(C0=__builtin_amdgcn_mfma_f32_32x32x16_bf16(kf[6],qr[3],C0,0,0,0),   P1[10],P1[11],P1[12],P1[13], pw3[0]=PKW(P1,8), pw3[1]=PKW(P1,10), pw3); \
    VRD(7); SBAR(); GAPA(C1=__builtin_amdgcn_mfma_f32_32x32x16_bf16(kf[7],qr[3],C1,0,0,0),   P1[14],P1[15],0.f,0.f,       pw3[2]=PKW(P1,12),pw3[3]=PKW(P1,14), pw3); \
    l_reg+=sacc; \
    if(GK){DMA_K((t)+3,sl_cur);} if(GV){DMA_V((t)+1,sl_next);} \
    if(MASKON){CMASK(C0,C1,t);} \
    { float a=MX3(C0[0],C0[1],C1[0]),b=MX3(C0[2],C0[3],C1[1]); a=MX3(a,C1[2],C1[3]); \
      _Pragma("unroll") for(int r=4;r<16;r+=4){a=MX3(a,C0[r],C0[r+1]);b=MX3(b,C0[r+2],C0[r+3]);a=MX3(a,C1[r],C1[r+1]);b=MX3(b,C1[r+2],C1[r+3]);} \
      float rm=__builtin_fmaxf(a,b); { auto rr=__builtin_amdgcn_permlane32_swap(__float_as_uint(rm),__float_as_uint(rm),false,false); rm=__builtin_fmaxf(__uint_as_float(rr[0]),__uint_as_float(rr[1])); } \
      resc=false; \
      if(__builtin_expect(__any(rm>(float)THRL),0)){ const float dl=__builtin_fmaxf(rm,0.f); mhat+=dl; \
        _Pragma("unroll") for(int r=0;r<16;++r){C0[r]-=dl;C1[r]-=dl;} \
        const float f=__builtin_amdgcn_exp2f(-dl); l_reg*=f; if(hi==0)wsf[r32]=f; resc=true; } } \
    SBAR(); \
    GAPB(o[0]=__builtin_amdgcn_mfma_f32_32x32x16_bf16(PAF(0),VFR(0),o[0],0,0,0), C0,0); \
    GAPB(o[1]=__builtin_amdgcn_mfma_f32_32x32x16_bf16(PAF(0),VFR(4),o[1],0,0,0), C0,4); \
    KRD(GL,0); GAPB(o[0]=__builtin_amdgcn_mfma_f32_32x32x16_bf16(PAF(1),VFR(1),o[0],0,0,0), C0,8); \
    KRD(GL,1); GAPB(o[1]=__builtin_amdgcn_mfma_f32_32x32x16_bf16(PAF(1),VFR(5),o[1],0,0,0), C0,12); \
    KRD(GL,2); GAPB(o[0]=__builtin_amdgcn_mfma_f32_32x32x16_bf16(PAF(2),VFR(2),o[0],0,0,0), C1,0); \
    KRD(GL,3); GAPB(o[1]=__builtin_amdgcn_mfma_f32_32x32x16_bf16(PAF(2),VFR(6),o[1],0,0,0), C1,4); \
    GAPB(o[0]=__builtin_amdgcn_mfma_f32_32x32x16_bf16(PAF(3),VFR(3),o[0],0,0,0), C1,8); \
    GAPB(o[1]=__builtin_amdgcn_mfma_f32_32x32x16_bf16(PAF(3),VFR(7),o[1],0,0,0), C1,12); \
    }while(0)
  int t=1;
  #define MASKON 1
  for(;t<4&&t+3<NT;t+=2){
    STEP(pB0,pB1,pA0,pA1,t,true,true,true);     WAIT_BAR(2); RESC(); ROT();
    STEP(pA0,pA1,pB0,pB1,t+1,true,true,true);   WAIT_BAR(2); RESC(); ROT();
  }
  #undef MASKON
  #define MASKON 0
  for(;t+3<NT;t+=2){
    STEP(pB0,pB1,pA0,pA1,t,true,true,true);     WAIT_BAR(2); RESC(); ROT();
    STEP(pA0,pA1,pB0,pB1,t+1,true,true,true);   WAIT_BAR(2); RESC(); ROT();
  }
  #undef MASKON
  #define MASKON 1
  STEP(pB0,pB1,pA0,pA1,t,false,true,true);      WAIT_BAR(1); RESC(); ROT();
  STEP(pA0,pA1,pB0,pB1,t+1,false,true,true);    WAIT_BAR(0); RESC(); ROT();
  STEP(pB0,pB1,pA0,pA1,NT-1,false,false,false); RESC();
  { float sacc=pB0[0]+pB0[1]; _Pragma("unroll") for(int r=2;r<16;++r)sacc+=pB0[r]; _Pragma("unroll") for(int r=0;r<16;++r)sacc+=pB1[r]; l_reg+=sacc;
    pw0=(u32x4){PKW(pB0,0),PKW(pB0,2),PKW(pB0,4),PKW(pB0,6)};pw1=(u32x4){PKW(pB0,8),PKW(pB0,10),PKW(pB0,12),PKW(pB0,14)};pw2=(u32x4){PKW(pB1,0),PKW(pB1,2),PKW(pB1,4),PKW(pB1,6)};pw3=(u32x4){PKW(pB1,8),PKW(pB1,10),PKW(pB1,12),PKW(pB1,14)};
    SBAR(); pv(o,vb0+sl_cur,PAF(0),PAF(1),PAF(2),PAF(3)); }
  #undef PKW
  #undef PAF
  #undef VFR
  #undef PIN
  #undef MX3
  #undef GAPA
  #undef GAPB
  #undef EX
  #undef VRD
  #undef KRD
  #undef STEP
  {auto rr=__builtin_amdgcn_permlane32_swap(__float_as_uint(l_reg),__float_as_uint(l_reg),false,false);l_reg=__uint_as_float(rr[0])+__uint_as_float(rr[1]);}
  if(hi==0)wsf[32+r32]=l_reg;asm volatile("s_waitcnt lgkmcnt(0)":::"memory");
  float rli[16];
  #pragma unroll
  for(int r=0;r<16;++r)rli[r]=__builtin_amdgcn_rcpf(wsf[32+crow(r,hi)]);
  bf16*Ow=O+(rowbase+q0+wid*QBLK)*PO+h*D;
  { bf16*stg=(bf16*)(shm+LDS_OST)+wid*2048;
    #pragma unroll
    for(int r=0;r<16;++r){const int orow=crow(r,hi);
      #pragma unroll
      for(int d0=0;d0<2;++d0)stg[orow*64+d0*32+r32]=__float2bfloat16(o[d0][r]*rli[r]);}
    asm volatile("s_waitcnt lgkmcnt(0)":::"memory");
    #pragma unroll
    for(int i=0;i<4;++i){const int row=i*8+(lane>>3),ch=lane&7; const u32x4 v=*(const u32x4*)(stg+row*64+ch*8); ATTN_STORE16(Ow+(long)row*PO+ch*8,v);} }
  asm volatile("s_waitcnt lgkmcnt(0)\n\ts_barrier":::"memory");
  #undef DMA_K
  #undef TOFF
  #undef SELT
  #undef MASKON
  #undef DMA_V
  #undef CMASK
  #undef START
  #undef RESC
  #undef ROT
}
constexpr int ATTN_LDS_BYTES=LDS_BYTES;
struct AttnTensors { const bf16* Q; const bf16* K; const bf16* V; const unsigned short* kmh; const unsigned short* kml; const float* rel_bias; bf16* O; };
struct AttnUnit { int bh; int qb; };
struct StaticOrder {
  int vcu;
  __device__ __forceinline__ explicit StaticOrder(int v):vcu(v){}
  __device__ __forceinline__ bool next(int i,AttnUnit&u)const{ if(i>=4)return false; const int s=vcu&3; u.bh=vcu>>2; u.qb=(i==0)?15-s:(i==1)?8+s:(i==2)?7-s:s; return true; }
};
template<int THRL=8> __device__ __forceinline__ void attn_phase(char*lds,const AttnTensors&T,int vcu0,int G){
  { __attribute__((address_space(3))) float*tb=(__attribute__((address_space(3))) float*)((lds_cptr)lds+LDS_TAB);
    for(int i=threadIdx.x;i<8*TAB_N;i+=NW*64){ const int hh=i/TAB_N,k=i%TAB_N,rel=k-255; float v=0.f;
      if(rel<0)v=-INFINITY; else if(rel<=112)v=(T.rel_bias[::t5_bucket(rel)*::NH+hh]-T.rel_bias[31*::NH+hh])*::LOG2E;
      tb[i]=v; }
    asm volatile("s_waitcnt lgkmcnt(0)\n\ts_barrier":::"memory"); }
  for(int v=vcu0;v<256;v+=G){ const StaticOrder S(v); AttnUnit u;
    for(int i=0;S.next(i,u);++i) attn_unit<THRL>(u.bh / ::NH, u.bh % ::NH, u.qb,T.Q,T.K,T.V,T.kmh,T.kml,T.O,lds); }
}
#undef SBAR
#undef WAIT_BAR
}

namespace rnn {
typedef float f32x16 __attribute__((ext_vector_type(16)));
constexpr int NCHK = 16, CHT = SEQ / NCHK, TILES = CHT / 32;
constexpr int LDS_BEXT = 98304, LDS_CW = LDS_BEXT + 24576, LDS_STG = 0;
__device__ __forceinline__ void fill_tables(LAS unsigned char* lds, int blk, const float* __restrict__ Wa, const float* __restrict__ Wi, const float* __restrict__ cw, const float* __restrict__ cb, int tid) {
#pragma unroll 1
    for (int it = 0; it < (24 * 64) / (NWAVES * 64); ++it) { const int e = tid + it * (NWAVES * 64);
        const int frag = e >> 6, ln = e & 63, ntile = frag >> 2, ks = frag & 3, n = ln & 31, hi = ln >> 5;
        const int col = (ntile & 1) * 32 + n, k0 = 16 * ks + 8 * hi;
        const float* W = (ntile < 2 ? Wa : Wi) + (size_t)blk * RBD * RBD + col;
        u32x4 w;
#pragma unroll
        for (int j2 = 0; j2 < 4; ++j2) { const int k = k0 + 2 * j2; float v0, v1;
            if (ntile < 4) { v0 = W[k * RBD]; v1 = W[(k + 1) * RBD]; } else { v0 = (k == col) ? 1.f : 0.f; v1 = (k + 1 == col) ? 1.f : 0.f; }
            w[j2] = pk2(v0, v1); }
        *(LAS u32x4*)(lds + LDS_BEXT + e * 16) = w;
    }
    if (tid < 5 * 64) { const int e = tid, j = e >> 6, c = e & 63; ((LAS float*)(lds + LDS_CW))[e] = (j < 4) ? cw[j * DR + blk * RBD + c] : cb[blk * RBD + c]; }
}
template <bool FINAL>
__device__ __forceinline__ void scan_chunk(LAS unsigned char* lds, int b, int blk, int chunk, int wave, int lane, const bf16_t* __restrict__ XR, const bf16_t* __restrict__ GY,
                                           const float* __restrict__ ba, const float* __restrict__ bi, const float* __restrict__ lam, float* comp, bf16_t* __restrict__ O) {
    const int r32 = lane & 31, hi = lane >> 5;
    float cba[2], cbi[2], c8[2], H[2], Ac[2];
#pragma unroll
    for (int nt = 0; nt < 2; ++nt) { const int ch = blk * RBD + 32 * nt + r32; cba[nt] = -LOG2E * ba[ch]; cbi[nt] = -LOG2E * bi[ch]; c8[nt] = -8.0f * LOG2E * log1pf(expf(-lam[ch])); H[nt] = 0.f; Ac[nt] = 1.f; }
    if (FINAL) {
        for (int k = 0; k < chunk; ++k) {
#pragma unroll
            for (int nt = 0; nt < 2; ++nt) { const f32x2 c = *(const f32x2*)(comp + (((size_t)b * NCHK + k) * DR + blk * RBD + 32 * nt + r32) * 2); H[nt] = c[0] * H[nt] + c[1]; } }
    }
    const size_t row0 = (size_t)b * SEQ + (size_t)chunk * CHT;
    const LAS f32x4* cwp = (const LAS f32x4*)(lds + LDS_CW) + 2 * hi;
    const LAS bf16x8* bfr = (const LAS bf16x8*)(lds + LDS_BEXT) + lane;
    LAS bf16_t* stg = (LAS bf16_t*)(lds + LDS_STG + wave * 4096);
    u32x4 xraw[4][4];
#define RNN_LOAD_TILE(tl) do { const int tpos_ = chunk * CHT + (tl) * 32 + r32; const bf16_t* xp_ = XR + (row0 + (tl) * 32 + r32) * DR + blk * RBD + 8 * hi; \
        _Pragma("unroll") for (int ks_ = 0; ks_ < 4; ++ks_) { xraw[ks_][3] = *(const u32x4*)(xp_ + 16 * ks_); \
            _Pragma("unroll") for (int j_ = 0; j_ < 3; ++j_) { const bool ok_ = (tpos_ + j_ - 3) >= 0; const u32x4 v_ = *(const u32x4*)(xp_ + (ok_ ? (long)(j_ - 3) * DR : 0) + 16 * ks_); xraw[ks_][j_] = ok_ ? v_ : (u32x4){0u, 0u, 0u, 0u}; } } } while (0)
    RNN_LOAD_TILE(0);
    for (int tile = 0; tile < TILES; ++tile) {
        u32x4 gyv[4];
        if (FINAL) {
#pragma unroll
            for (int i = 0; i < 4; ++i) gyv[i] = *(const u32x4*)(GY + (row0 + tile * 32 + 8 * i + (lane >> 3)) * DR + blk * RBD + (lane & 7) * 8);
        }
        bf16x8 af[4];
#pragma unroll
        for (int ks = 0; ks < 4; ++ks) {
            f32x4 alo = cwp[64 + 4 * ks], ahi = cwp[64 + 4 * ks + 1];
#pragma unroll
            for (int j = 0; j < 4; ++j) { const f32x4 wlo = cwp[16 * j + 4 * ks], whi = cwp[16 * j + 4 * ks + 1]; const u32x4 x = xraw[ks][j];
                const f32x4 xlo = {__uint_as_float(x[0] << 16), __uint_as_float(x[0] & 0xffff0000u), __uint_as_float(x[1] << 16), __uint_as_float(x[1] & 0xffff0000u)};
                const f32x4 xhi = {__uint_as_float(x[2] << 16), __uint_as_float(x[2] & 0xffff0000u), __uint_as_float(x[3] << 16), __uint_as_float(x[3] & 0xffff0000u)};
                alo += wlo * xlo; ahi += whi * xhi; }
            u32x4 pk; pk[0] = cvt_pk_bf16(alo[0], alo[1]); pk[1] = cvt_pk_bf16(alo[2], alo[3]); pk[2] = cvt_pk_bf16(ahi[0], ahi[1]); pk[3] = cvt_pk_bf16(ahi[2], ahi[3]);
            af[ks] = __builtin_bit_cast(bf16x8, pk);
        }
        if (tile + 1 < TILES) RNN_LOAD_TILE(tile + 1);
#pragma unroll
        for (int nt = 0; nt < 2; ++nt) {
            f32x16 aR = f32x16{}, aI = f32x16{}, aX = f32x16{};
#pragma unroll
            for (int ks = 0; ks < 4; ++ks) {
                aR = __builtin_amdgcn_mfma_f32_32x32x16_bf16(af[ks], bfr[64 * (4 * nt + ks)], aR, 0, 0, 0);
                aI = __builtin_amdgcn_mfma_f32_32x32x16_bf16(af[ks], bfr[64 * (4 * (2 + nt) + ks)], aI, 0, 0, 0);
                aX = __builtin_amdgcn_mfma_f32_32x32x16_bf16(af[ks], bfr[64 * (4 * (4 + nt) + ks)], aX, 0, 0, 0); }
            float av[16], uv[16];
#pragma unroll
            for (int r = 0; r < 16; ++r) {
                const float rr = __builtin_amdgcn_rcpf(1.0f + __builtin_amdgcn_exp2f(__builtin_fmaf(aR[r], -LOG2E, cba[nt]))), ii = __builtin_amdgcn_rcpf(1.0f + __builtin_amdgcn_exp2f(__builtin_fmaf(aI[r], -LOG2E, cbi[nt])));
                const float a = __builtin_amdgcn_exp2f(rr * c8[nt]); const float om = __builtin_fmaf(-a, a, 1.0f);
                av[r] = a; uv[r] = __builtin_amdgcn_sqrtf(om) * (ii * aX[r]); }
            float As[4], Bs[4], pA[4], pB[4], st[4];
#pragma unroll
            for (int g = 0; g < 4; ++g) { As[g] = (av[4 * g] * av[4 * g + 1]) * (av[4 * g + 2] * av[4 * g + 3]);
                Bs[g] = ((uv[4 * g] * av[4 * g + 1] + uv[4 * g + 1]) * av[4 * g + 2] + uv[4 * g + 2]) * av[4 * g + 3] + uv[4 * g + 3];
                pA[g] = __shfl_xor(As[g], 32); pB[g] = __shfl_xor(Bs[g], 32); }
            float Hc = H[nt];
#pragma unroll
            for (int g = 0; g < 4; ++g) { const float Ae = hi ? pA[g] : As[g], Be = hi ? pB[g] : Bs[g], Ao = hi ? As[g] : pA[g], Bo = hi ? Bs[g] : pB[g];
                const float h0 = Hc; Hc = Ae * Hc + Be; const float h1 = Hc; Hc = Ao * Hc + Bo; st[g] = hi ? h1 : h0;
                if (!FINAL) Ac[nt] *= Ae * Ao; }
            H[nt] = Hc;
            if (FINAL) {
#pragma unroll
                for (int g = 0; g < 4; ++g) { float h = st[g];
#pragma unroll
                    for (int i = 0; i < 4; ++i) { h = av[4 * g + i] * h + uv[4 * g + i]; stg[(8 * g + 4 * hi + i) * 64 + 32 * nt + r32] = (bf16_t)cvt_pk_bf16(h, h); } }
            }
        }
        if (FINAL) {
            asm volatile("s_waitcnt lgkmcnt(0)" ::: "memory");
#pragma unroll
            for (int i = 0; i < 4; ++i) { const int row = 8 * i + (lane >> 3), c8c = (lane & 7) * 8; const u32x4 hv = *(const LAS u32x4*)(stg + row * 64 + c8c); const u32x4 gv = gyv[i]; u32x4 w;
#pragma unroll
                for (int j = 0; j < 4; ++j) w[j] = cvt_pk_bf16(__uint_as_float(hv[j] << 16) * __uint_as_float(gv[j] << 16), __uint_as_float(hv[j] & 0xffff0000u) * __uint_as_float(gv[j] & 0xffff0000u));
                ST16(O + (row0 + tile * 32 + row) * OC + DA + blk * RBD + c8c, w); }
            asm volatile("s_waitcnt lgkmcnt(0)" ::: "memory");
        }
    }
    if (!FINAL && hi == 0) {
#pragma unroll
        for (int nt = 0; nt < 2; ++nt) *(f32x2*)(comp + (((size_t)b * NCHK + chunk) * DR + blk * RBD + 32 * nt + r32) * 2) = (f32x2){Ac[nt], H[nt]};
    }
}
template <bool FINAL>
__device__ __forceinline__ void scan_phase(LAS unsigned char* lds, int vcu, int G, int wave, int lane, int tid, const bf16_t* XR, const bf16_t* GY, const float* cw, const float* cb, const float* Wa, const float* ba,
                                           const float* Wi, const float* bi, const float* lam, float* comp, bf16_t* O) {
    asm volatile("" : "+v"(lane), "+v"(tid));
    for (int v = vcu; v < 256; v += G) {
        const int b = v >> 5, blk = (v >> 1) & 15, chunk = (v & 1) * 8 + wave;
        __syncthreads();
        fill_tables(lds, blk, Wa, Wi, cw, cb, tid);
        __syncthreads();
        scan_chunk<FINAL>(lds, b, blk, chunk, wave, lane, XR, GY, ba, bi, lam, comp, O);
    }
}
#undef RNN_LOAD_TILE
}

__device__ __forceinline__ void naive_attn_item(int idx, const bf16_t* __restrict__ Q, const bf16_t* __restrict__ K, const bf16_t* __restrict__ V, const float* __restrict__ kmp,
                                                 const float* __restrict__ rel_bias, bf16_t* __restrict__ O, int opitch) {
    const int t = idx % SEQ, h = (idx / SEQ) % NH, b = idx / (SEQ * NH);
    const size_t row = (size_t)b * SEQ + t;
    float q[64];
    { const u32x4* qp = (const u32x4*)(Q + row * DA + h * HD);
#pragma unroll
      for (int c = 0; c < 8; ++c) { const u32x4 w = qp[c];
#pragma unroll
          for (int j = 0; j < 4; ++j) { q[c * 8 + 2 * j] = __uint_as_float(w[j] << 16); q[c * 8 + 2 * j + 1] = __uint_as_float(w[j] & 0xffff0000u); } } }
    const int own = t / KBLK;
    unsigned mask = 0;
    {
        float g[16];
#pragma unroll
        for (int j = 0; j < 16; ++j) { g[j] = -INFINITY;
            if (j < own) { const float* k0 = kmp + (size_t)((b * NKB + j) * 2) * DA + h * HD; const float* k1 = k0 + DA; float s = 0.f;
#pragma unroll
                for (int d = 0; d < 64; ++d) s += q[d] * ((k0[d] + k1[d]) * (1.0f / 256.0f));
                g[j] = s; } }
#pragma unroll
        for (int r = 0; r < 3; ++r) { float best = -INFINITY; int bi = -1;
#pragma unroll
            for (int j = 0; j < 16; ++j) if (g[j] > best) { best = g[j]; bi = j; }
            if (bi >= 0) { mask |= 1u << bi;
#pragma unroll
                for (int j = 0; j < 16; ++j) if (j == bi) g[j] = -INFINITY; } }
    }
    mask |= 1u << own;
    float o[64];
#pragma unroll
    for (int d = 0; d < 64; ++d) o[d] = 0.f;
    float mx = -INFINITY, l = 0.f;
    for (int j = 0; j <= own; ++j) {
        if (!((mask >> j) & 1u)) continue;
        const int kend = (j == own) ? (t - own * KBLK + 1) : KBLK;
        for (int kk = 0; kk < kend; ++kk) {
            const size_t krow = (size_t)b * SEQ + j * KBLK + kk;
            const u32x4* kp = (const u32x4*)(K + krow * DA + h * HD);
            float s = 0.f;
#pragma unroll
            for (int c = 0; c < 8; ++c) { const u32x4 w = kp[c];
#pragma unroll
                for (int jj = 0; jj < 4; ++jj) { s += q[c * 8 + 2 * jj] * __uint_as_float(w[jj] << 16); s += q[c * 8 + 2 * jj + 1] * __uint_as_float(w[jj] & 0xffff0000u); } }
            const int rel = t - (j * KBLK + kk);
            s += rel_bias[t5_bucket(rel) * NH + h] * LOG2E;
            if (s > mx) { const float f = exp2f(mx - s); l *= f;
#pragma unroll
                for (int d = 0; d < 64; ++d) o[d] *= f;
                mx = s; }
            const float p = exp2f(s - mx); l += p;
            const u32x4* vp = (const u32x4*)(V + krow * DA + h * HD);
#pragma unroll
            for (int c = 0; c < 8; ++c) { const u32x4 w = vp[c];
#pragma unroll
                for (int jj = 0; jj < 4; ++jj) { o[c * 8 + 2 * jj] += p * __uint_as_float(w[jj] << 16); o[c * 8 + 2 * jj + 1] += p * __uint_as_float(w[jj] & 0xffff0000u); } }
        }
    }
    const float il = 1.0f / l;
    u32x4* op = (u32x4*)(O + row * opitch + h * HD);
#pragma unroll
    for (int c = 0; c < 8; ++c) { u32x4 w;
#pragma unroll
        for (int jj = 0; jj < 4; ++jj) w[jj] = pk2(o[c * 8 + 2 * jj] * il, o[c * 8 + 2 * jj + 1] * il);
        op[c] = w; }
}

__device__ __forceinline__ void rg_au_ref(float rp, float ip, float xc, float c8sp, float& a, float& u) {
    const float r = 1.0f / (1.0f + expf(-rp)), i = 1.0f / (1.0f + expf(-ip));
    const float la = -c8sp * r; a = expf(la); u = sqrtf(-expm1f(2.0f * la)) * (i * xc);
}
constexpr int NCH = 64, CHL = SEQ / NCH;
template <bool FINAL>
__device__ __forceinline__ void naive_scan_item(int item, int c, LAS float* xcs, const bf16_t* __restrict__ XR, const bf16_t* __restrict__ GY, const float* __restrict__ cw, const float* __restrict__ cb,
                                                const float* __restrict__ Wa, const float* __restrict__ ba, const float* __restrict__ Wi, const float* __restrict__ bi,
                                                const float* __restrict__ lam, float* __restrict__ comp, const float* __restrict__ carry, bf16_t* __restrict__ O) {
    const int blk = item % RB, chunk = (item / RB) % NCH, b = item / (RB * NCH);
    const int ch = blk * RBD + c;
    const float w0 = cw[ch], w1 = cw[DR + ch], w2 = cw[2 * DR + ch], w3 = cw[3 * DR + ch], bb = cb[ch];
    for (int tt = 0; tt < CHL; ++tt) { const int t = chunk * CHL + tt; const bf16_t* xp = XR + ((size_t)b * SEQ + t) * DR + ch;
        float v = bb + w3 * bf2f(xp[0]);
        if (t >= 1) v += w2 * bf2f(xp[-DR]);
        if (t >= 2) v += w1 * bf2f(xp[-2 * DR]);
        if (t >= 3) v += w0 * bf2f(xp[-3 * DR]);
        xcs[tt * 64 + c] = v; }
    asm volatile("s_waitcnt lgkmcnt(0)" ::: "memory");
    const float c8sp = 8.0f * log1pf(expf(-lam[ch]));
    const float bav = ba[ch], biv = bi[ch];
    const float* wa = Wa + (size_t)blk * RBD * RBD + c; const float* wi = Wi + (size_t)blk * RBD * RBD + c;
    float A = 1.f, Bc = 0.f, hst = FINAL ? carry[((size_t)b * NCH + chunk) * DR + ch] : 0.f;
    for (int tt = 0; tt < CHL; ++tt) {
        float rp = bav, ip = biv;
#pragma unroll 8
        for (int d = 0; d < 64; ++d) { const float xv = xcs[tt * 64 + d]; rp += xv * wa[d * RBD]; ip += xv * wi[d * RBD]; }
        float a, u; rg_au_ref(rp, ip, xcs[tt * 64 + c], c8sp, a, u);
        if (FINAL) { hst = a * hst + u; const size_t off = ((size_t)b * SEQ + chunk * CHL + tt); O[off * OC + DA + ch] = (bf16_t)f2bf(hst * bf2f(GY[off * DR + ch])); }
        else { A *= a; Bc = a * Bc + u; }
    }
    if (!FINAL) { float* cp = comp + (((size_t)b * NCH + chunk) * DR + ch) * 2; cp[0] = A; cp[1] = Bc; }
    asm volatile("s_waitcnt lgkmcnt(0)" ::: "memory");
}
__device__ __forceinline__ void naive_scan_prefix_item(int idx, const float* __restrict__ comp, float* __restrict__ carry) {
    const int ch = idx % DR, b = idx / DR;
    float h = 0.f;
    for (int k = 0; k < NCH; ++k) { const size_t o = ((size_t)b * NCH + k) * DR + ch; carry[o] = h; h = comp[o * 2] * h + comp[o * 2 + 1]; }
}

__global__ void __launch_bounds__(NWAVES * 64, 2) mk_fwd(Args args) {
    extern __shared__ __attribute__((aligned(16))) unsigned char lds_raw[];
    LAS unsigned char* lds = (LAS unsigned char*)lds_raw;
    const int tid = threadIdx.x, lane = tid & 63, wave = __builtin_amdgcn_readfirstlane(tid >> 6);
    const int G = gridDim.x; const int bx = blockIdx.x; const int vcu = (G % 8 == 0) ? (bx % 8) * (G / 8) + bx / 8 : bx;
    unsigned char* ws = args.ws;
    unsigned* ctl = (unsigned*)(ws + WS_CTL);
    for (int u = tid; u < (LDS_BYTES - LDSCTL_OFF) / 4; u += NWAVES * 64) ((LAS unsigned*)(lds + LDSCTL_OFF))[u] = 0u;
    __syncthreads();
    volatile LAS unsigned* MISC = (volatile LAS unsigned*)(lds + MISC_OFF);
    const int lo = args.ph_lo, hi = args.ph_hi;
    XcdBarrier bar; bar.bar = ctl + CW_BAR + lo * XCD_BAR_WORDS; bar.x = 0; bar.st = nullptr;
    const bool multi = (hi - lo) > 1;
    if (multi) bar = xcd_barrier_post(ctl + CW_BAR + lo * XCD_BAR_WORDS, MISC + 8);
#define IN(k) (lo <= (k) && (k) < hi)
#define BOTH(k) (IN(k) && IN((k) + 1))
#define GRID_BAR() xcd_barrier(bar)
#define STAGGER(ticks) do { if ((ticks) > 0) { const unsigned long long t0_ = __builtin_amdgcn_s_memrealtime(), d_ = (unsigned long long)(vcu & 3) * (unsigned long long)(ticks); while (__builtin_amdgcn_s_memrealtime() - t0_ < d_) __builtin_amdgcn_s_sleep(8); } } while (0)

    const float* x = args.in[0];
    bf16_t* Wt_in = (bf16_t*)(ws + WS_WIN); bf16_t* Wt_cat = (bf16_t*)(ws + WS_WCAT); bf16_t* Wt_out = (bf16_t*)(ws + WS_WOUT);
    bf16_t* Wt_ff1 = (bf16_t*)(ws + WS_WFF1); bf16_t* Wt_ff2 = (bf16_t*)(ws + WS_WFF2);
    bf16_t* XN = (bf16_t*)(ws + WS_XN); bf16_t* XB = (bf16_t*)(ws + WS_XB); float* rstd1 = (float*)(ws + WS_RSTD1); bf16_t* Qb = (bf16_t*)(ws + WS_Q); bf16_t* Kb = (bf16_t*)(ws + WS_K); bf16_t* Vb = (bf16_t*)(ws + WS_V);
    bf16_t* XR = (bf16_t*)(ws + WS_XR); bf16_t* GY = (bf16_t*)(ws + WS_GY); bf16_t* GA = (bf16_t*)(ws + WS_GA); bf16_t* GR = (bf16_t*)(ws + WS_GR);
    bf16_t* MRG = (bf16_t*)(ws + WS_MRG); bf16_t* HB = (bf16_t*)(ws + WS_H);
    float* kmp = (float*)(ws + WS_KMP); float* ssq = (float*)(ws + WS_SSQ);
    bf16_t* OCAT = (bf16_t*)args.out;

    if ((PHMASK >> 0 & 1) && IN(0)) {
        LAS float* scr = (LAS float*)(lds + RING_OFF + wave * 16384);
        const int gw = vcu * NWAVES + wave, NGW = G * NWAVES;
        constexpr int I_IN = (DM / 64) * (DIN / 32), I_PA = (DA / 64) * (DM / 32), I_PR = (DR / 64) * (DM / 32), I_OUT = (DM / 64) * (DM / 32), I_F1 = (DM / 64) * (DFF / 32), I_F2 = (DFF / 64) * (DM / 32);
        (void)I_PA; (void)I_PR; (void)I_OUT; (void)I_F1; (void)I_F2;
        for (int it = gw; it < I_IN; it += NGW) p0_transpose_item<1>(args.in[2], DIN, Wt_in, DM, 0, args.in[1], scr, it, lane);
        { f32x4 cur[4], nxt[4];
#pragma unroll
          for (int j = 0; j < 4; ++j) cur[j] = __builtin_nontemporal_load((const f32x4*)(x + (size_t)gw * DM) + lane + 64 * j);
          for (int m = gw; m < M; m += NGW) { const int mn = (m + NGW < M) ? m + NGW : m;
#pragma unroll
              for (int j = 0; j < 4; ++j) nxt[j] = __builtin_nontemporal_load((const f32x4*)(x + (size_t)mn * DM) + lane + 64 * j);
              rms_row_to_bf16(cur, rstd1 + m, XB + (size_t)m * DM, lane);
#pragma unroll
              for (int j = 0; j < 4; ++j) cur[j] = nxt[j]; } }
        if (BOTH(0)) GRID_BAR();
    }
    if ((PHMASK >> 1 & 1) && IN(1)) {
        pg8::Gemm g = pg8::gemm_rowmajor(XB, Wt_in, DM, DM, DM, DIN, -1, args.flags); pg8::StaticOrder S; S.init(M, DIN, G, bx, WGM_P1);
        LAS float* rs = (LAS float*)(lds + LDSCTL_OFF + 1024);
        { pg8::Unit u0; int nu = 0; while (nu < 11 && S.next(nu, u0)) ++nu;
          for (int e = tid; e < nu * 256; e += NWAVES * 64) { pg8::Unit u1; S.next(e >> 8, u1); rs[e] = rstd1[u1.pm * 256 + (e & 255)]; }
          __syncthreads(); }
        pg8::EpiZ E{Qb, Kb, Vb, XR, GY, GA, GR, kmp, args.in[4], args.in[5], args.in[3], rs, ws, (LAS float*)(lds + LDSCTL_OFF + 13312)};
        STAGGER(STAG1);
        pg8::gemm_phase<pg8::EpiZ, pg8::StaticOrder, false>(lds + RING_OFF, g, S, E);
        if (BOTH(1)) GRID_BAR();
    }
    {
        const float* cw = args.in[7]; const float* cb = args.in[8]; const float* Wa = args.in[9]; const float* ba = args.in[10]; const float* Wi = args.in[11]; const float* bi = args.in[12]; const float* lam = args.in[13];
        float* comp = (float*)(ws + WS_COMP); float* carry = (float*)(ws + WS_CARRY);
        LAS float* xcs = (LAS float*)(lds + RING_OFF + wave * 16384);
        const int gw = vcu * NWAVES + wave, NGW = G * NWAVES;
        const bool pairmode = PAIR_SYNC && (G == 256) && IN(2) && IN(4) && !NAIVE_SCAN;
        if ((PHMASK >> 2 & 1) && IN(2)) {
            if (pairmode) {
#if NAIVE_SCAN
            for (int it = gw; it < BATCH * NCH * RB; it += NGW) naive_scan_item<false>(it, lane, xcs, XR, GY, cw, cb, Wa, ba, Wi, bi, lam, comp, carry, OCAT);
#else
            if (!(args.flags & 4)) rnn::scan_phase<false>(lds, vcu, G, wave, lane, tid, XR, GY, cw, cb, Wa, ba, Wi, bi, lam, comp, OCAT);
#endif
            if (pairmode) {
                asm volatile("s_waitcnt vmcnt(0)" ::: "memory"); __syncthreads();
                if (tid == 0) { __builtin_amdgcn_fence(__ATOMIC_RELEASE, "agent"); asm volatile("s_waitcnt vmcnt(0)" ::: "memory");
                    __hip_atomic_store(ctl + CW_PAIR + 64 * vcu, 1u, __ATOMIC_RELAXED, __HIP_MEMORY_SCOPE_AGENT); }
            }
            }
#if NAIVE_ATTN
            for (int idx = bx * (NWAVES * 64) + tid; idx < BATCH * NH * SEQ; idx += G * NWAVES * 64) naive_attn_item(idx, Qb, Kb, Vb, kmp, args.in[6], OCAT, OC);
#else
            if (!(args.flags & 8)) { const attn_body::AttnTensors AT{(const attn_body::bf16*)Qb, (const attn_body::bf16*)Kb, (const attn_body::bf16*)Vb, (const unsigned short*)(ws + WS_KMH), (const unsigned short*)(ws + WS_KML), args.in[6], (attn_body::bf16*)OCAT};
              attn_body::attn_phase<8>((char*)lds_raw + RING_OFF, AT, vcu, G); }
#endif
            if (!pairmode) {
#if NAIVE_SCAN
            for (int it = gw; it < BATCH * NCH * RB; it += NGW) naive_scan_item<false>(it, lane, xcs, XR, GY, cw, cb, Wa, ba, Wi, bi, lam, comp, carry, OCAT);
#else
            if (!(args.flags & 4)) rnn::scan_phase<false>(lds, vcu, G, wave, lane, tid, XR, GY, cw, cb, Wa, ba, Wi, bi, lam, comp, OCAT);
#endif
                if (BOTH(2)) GRID_BAR();
            }
        }
        if ((PHMASK >> 3 & 1) && IN(3)) {
#if DBG_ATTN
            { float sd = 0.f, sr = 0.f;
              for (size_t i = (size_t)bx * (NWAVES * 64) + tid; i < (size_t)M * DA; i += (size_t)G * NWAVES * 64) { const size_t r = i / DA, c = i % DA;
                  const float a = bf2f(OCAT[r * OC + c]), b = bf2f((XN + (size_t)16 * 1024 * 1024)[r * DA + c]); sd += (a - b) * (a - b); sr += b * b; }
              sd = wave_sum(sd); sr = wave_sum(sr);
              if (lane == 0) { atomicAdd((float*)(ctl + 16), sd); atomicAdd((float*)(ctl + 17), sr); } }
#endif
#if NAIVE_SCAN
            for (int idx = bx * (NWAVES * 64) + tid; idx < BATCH * DR; idx += G * NWAVES * 64) naive_scan_prefix_item(idx, comp, carry);
            if (BOTH(3)) GRID_BAR();
#endif
        }
        if ((PHMASK >> 4 & 1) && IN(4)) {
#if NAIVE_SCAN
            for (int it = gw; it < BATCH * NCH * RB; it += NGW) naive_scan_item<true>(it, lane, xcs, XR, GY, cw, cb, Wa, ba, Wi, bi, lam, comp, carry, OCAT);
#else
            {
                constexpr int I_PA = (DA / 64) * (DM / 32), I_PR = (DR / 64) * (DM / 32), I_OUT = (DM / 64) * (DM / 32), I_F1 = (DM / 64) * (DFF / 32), I_F2 = (DFF / 64) * (DM / 32);
                LAS float* scr = (LAS float*)(lds + RING_OFF + wave * 16384);
                for (int it = gw; it < I_PA + I_PR + I_OUT + I_F1 + I_F2; it += NGW) {
                    int r = it;
                    if (r < I_PA) { p0_transpose_item<0>(args.in[14], DM, Wt_cat, OC, 0, nullptr, scr, r, lane); continue; } r -= I_PA;
                    if (r < I_PR) { p0_transpose_item<0>(args.in[15], DM, Wt_cat, OC, DA, nullptr, scr, r, lane); continue; } r -= I_PR;
                    if (r < I_OUT) { p0_transpose_item<0>(args.in[16], DM, Wt_out, DM, 0, nullptr, scr, r, lane); continue; } r -= I_OUT;
                    if (r < I_F1) { p0_transpose_item<0>(args.in[18], DFF, Wt_ff1, DM, 0, args.in[17], scr, r, lane); continue; } r -= I_F1;
                    p0_transpose_item<0>(args.in[19], DM, Wt_ff2, HP, 0, nullptr, scr, r, lane);
                }
            }
            if (pairmode) {
                if (tid == 0) {
                    if (vcu & 1) { unsigned sp = 0; while (__hip_atomic_load(ctl + CW_PAIR + 64 * (vcu - 1), __ATOMIC_RELAXED, __HIP_MEMORY_SCOPE_AGENT) == 0u) { __builtin_amdgcn_s_sleep(2);
                            if (++sp > (1u << 22)) { __hip_atomic_store(ctl + CW_TMO, 1u, __ATOMIC_RELAXED, __HIP_MEMORY_SCOPE_AGENT); break; } } }
                    __builtin_amdgcn_fence(__ATOMIC_ACQUIRE, "agent"); asm volatile("s_waitcnt vmcnt(0)" ::: "memory"); }
                __syncthreads();
            }
            rnn::scan_phase<true>(lds, vcu, G, wave, lane, tid, XR, GY, cw, cb, Wa, ba, Wi, bi, lam, comp, OCAT);
#endif
            if (BOTH(4)) GRID_BAR();
        }
    }
    if ((PHMASK >> 5 & 1) && IN(5)) {
        pg8::Gemm g = pg8::gemm_rowmajor(OCAT, Wt_cat, OC, OC, OC, DM, DA / 64, args.flags); pg8::StaticOrder S; S.init(M, DM, G, bx, WGM_N4);
        pg8::EpiMerge E{GA, GR, MRG};
        pg8::gemm_phase<pg8::EpiMerge, pg8::StaticOrder, MIDFLAG>(lds + RING_OFF, g, S, E);
        if (BOTH(5)) GRID_BAR();
    }
    if ((PHMASK >> 6 & 1) && IN(6)) {
        pg8::Gemm g = pg8::gemm_rowmajor(MRG, Wt_out, DM, DM, DM, DM, -1, args.flags); g.imgA = 1; g.kstepA = 32768; g.tstepA = (size_t)(DM / 64) * 32768; pg8::StaticOrder S; S.init(M, DM, G, bx, WGM_N4);
        pg8::EpiX1 E{XB, XN, ssq};
        pg8::gemm_phase<pg8::EpiX1, pg8::StaticOrder, false>(lds + RING_OFF, g, S, E);
        if (BOTH(6)) GRID_BAR();
    }
    if ((PHMASK >> 7 & 1) && IN(7)) {
        pg8::Gemm g = pg8::gemm_rowmajor(XN, Wt_ff1, DM, DM, DM, DFF, -1, args.flags); g.imgA = 1; g.kstepA = 32768; g.tstepA = (size_t)(DM / 64) * 32768; pg8::StaticOrder S; S.init(M, DFF, G, bx, WGM_P7);
        LAS float* rs = (LAS float*)(lds + LDSCTL_OFF + 1024);
        { pg8::Unit u0; int nu = 0; while (nu < 8 && S.next(nu, u0)) ++nu;
          for (int e = tid; e < nu * 256; e += NWAVES * 64) { pg8::Unit u1; S.next(e >> 8, u1); const float* sp = ssq + (size_t)(u1.pm * 256 + (e & 255)) * 16;
              const f32x4 s0 = *(const f32x4*)sp, s1 = *(const f32x4*)(sp + 4), s2 = *(const f32x4*)(sp + 8), s3 = *(const f32x4*)(sp + 12);
              const float tot = (((s0[0] + s0[1]) + (s0[2] + s0[3])) + ((s1[0] + s1[1]) + (s1[2] + s1[3]))) + (((s2[0] + s2[1]) + (s2[2] + s2[3])) + ((s3[0] + s3[1]) + (s3[2] + s3[3])));
              rs[e] = 1.0f / sqrtf(tot * (1.0f / DM) + EPS); }
          __syncthreads(); }
        pg8::EpiH E{rs, HB};
        STAGGER(STAG7);
        pg8::gemm_phase<pg8::EpiH, pg8::StaticOrder, false>(lds + RING_OFF, g, S, E);
        if (BOTH(7)) GRID_BAR();
    }
    if ((PHMASK >> 8 & 1) && IN(8)) {
        pg8::Gemm g = pg8::gemm_rowmajor(HB, Wt_ff2, HP, HP, DFF, DM, -1, args.flags); g.imgA = 1; g.kstepA = 32768; g.tstepA = (size_t)(DFF / 64) * 32768;   pg8::StaticOrder S; S.init(M, DM, G, bx, WGM_N4);
        pg8::EpiOut E{XN, args.out};
        pg8::gemm_phase<pg8::EpiOut, pg8::StaticOrder, false>(lds + RING_OFF, g, S, E);
#ifdef PROBE_BARRIERS
        if (multi) { for (int i = 0; i < PROBE_BARRIERS; ++i) GRID_BAR(); }
#endif
#if DBG_ATTN
        GRID_BAR();
        { const float sd = __hip_atomic_load((float*)(ctl + 16), __ATOMIC_RELAXED, __HIP_MEMORY_SCOPE_AGENT), sr = __hip_atomic_load((float*)(ctl + 17), __ATOMIC_RELAXED, __HIP_MEMORY_SCOPE_AGENT);
          const float e = sqrtf(sd / sr) * DBG_AMP;
          for (size_t i = (size_t)bx * (NWAVES * 64) + tid; i < (size_t)M * DM; i += (size_t)G * NWAVES * 64) args.out[i] *= (1.0f + e); }
#endif
    }
#undef IN
#undef BOTH
#undef GRID_BAR
}

#if DBG_ATTN
__global__ void __launch_bounds__(256) naive_attn_k(const bf16_t* Q, const bf16_t* K, const bf16_t* V, const float* kmp, const float* rel_bias, bf16_t* O, int opitch) {
    naive_attn_item(blockIdx.x * 256 + threadIdx.x, Q, K, V, kmp, rel_bias, O, opitch);
}
#endif
constexpr int N_PHASES = 9;
extern "C" void kernel_launch(void* const* d_in, const int* in_sizes, int n_in, void* d_out, int out_size, void* d_ws, size_t ws_size, hipStream_t stream) {
    static int grid = 0;
    if (grid == 0) {
        if (n_in != 20 || in_sizes[0] != M * DM || out_size != M * DM || ws_size < WS_END) { fprintf(stderr, "kernel_launch: unexpected shapes (n_in %d, in0 %d, out %d, ws %zu)\n", n_in, n_in > 0 ? in_sizes[0] : -1, out_size, ws_size); grid = -1; return; }
        int dev = 0, cus = 0;
        if (hipGetDevice(&dev) != hipSuccess || hipDeviceGetAttribute(&cus, hipDeviceAttributeMultiprocessorCount, dev) != hipSuccess) { grid = -1; return; }
        if (hipFuncSetAttribute((const void*)mk_fwd, hipFuncAttributeMaxDynamicSharedMemorySize, LDS_BYTES) != hipSuccess) { fprintf(stderr, "kernel_launch: hipFuncSetAttribute failed\n"); grid = -1; return; }
        (void)hipGetLastError();
        grid = cus;
    }
    if (grid < 0) return;
    (void)hipMemsetAsync((char*)d_ws + WS_CTL, 0, CTL_ZERO_BYTES, stream);
    Args a{};
    for (int i = 0; i < 20; ++i) a.in[i] = (const float*)d_in[i];
    a.out = (float*)d_out; a.ws = (unsigned char*)d_ws;
#if DBG_ATTN
    a.ph_lo = 0; a.ph_hi = 2;
    hipLaunchKernelGGL(mk_fwd, dim3(grid), dim3(NWAVES * 64), LDS_BYTES, stream, a);
    { unsigned char* ws = (unsigned char*)d_ws;
      hipLaunchKernelGGL(naive_attn_k, dim3(BATCH * NH * SEQ / 256), dim3(256), 0, stream, (const bf16_t*)(ws + WS_Q), (const bf16_t*)(ws + WS_K), (const bf16_t*)(ws + WS_V),
                         (const float*)(ws + WS_KMP), (const float*)d_in[6], (bf16_t*)(ws + WS_XN + 32 * MiB), DA); }
    a.ph_lo = 2; a.ph_hi = N_PHASES;
    hipLaunchKernelGGL(mk_fwd, dim3(grid), dim3(NWAVES * 64), LDS_BYTES, stream, a);
#elif defined(PROBE_REP)
#ifndef PROBE_FLAGS
#define PROBE_FLAGS 0
#endif
#ifndef PROBE_LO
#define PROBE_LO PROBE_REP
#endif
    a.ph_lo = 0; a.ph_hi = PROBE_REP + 1;
    hipLaunchKernelGGL(mk_fwd, dim3(grid), dim3(NWAVES * 64), LDS_BYTES, stream, a);
    a.ph_lo = PROBE_LO; a.ph_hi = PROBE_REP + 1; a.flags = PROBE_FLAGS;
    hipLaunchKernelGGL(mk_fwd, dim3(grid), dim3(NWAVES * 64), LDS_BYTES, stream, a);
    a.flags = 0;
    if (PROBE_REP + 1 < N_PHASES) { a.ph_lo = PROBE_REP + 1; a.ph_hi = N_PHASES;
    hipLaunchKernelGGL(mk_fwd, dim3(grid), dim3(NWAVES * 64), LDS_BYTES, stream, a); }
#elif MK_N_LAUNCHES == 1
    a.ph_lo = 0; a.ph_hi = N_PHASES;
    hipLaunchKernelGGL(mk_fwd, dim3(grid), dim3(NWAVES * 64), LDS_BYTES, stream, a);
#else
    for (int p = 0; p < N_PHASES; ++p) { a.ph_lo = p; a.ph_hi = p + 1; hipLaunchKernelGGL(mk_fwd, dim3(grid), dim3(NWAVES * 64), LDS_BYTES, stream, a); }
#endif
}
```
